# Optimizing an MI355X kernel written in HIP

```python
import jax, jax.numpy as jnp
from jax import lax
import numpy as np

D_MODEL = 1024
BATCH = 1
SEQ = 16384
DEPTH = 4
DEC_BATCH = 16
DEC_SEQ = 64
PAST_LEN = 4096

CHUNK = 64
QBLOCK = 128
EPS = 1e-6
GN_EPS = 64e-5

MLA_HEADS = 8
MLA_NOPE = 64
MLA_ROPE = 32
MLA_QK = MLA_NOPE + MLA_ROPE
MLA_V = 64
MLA_WIDTH = MLA_HEADS * MLA_V
Q_RANK = 256
KV_RANK = 128
ROPE_THETA = 10000.0

RW_HEADS = 8
RW_HEAD = 64
RW_WIDTH = RW_HEADS * RW_HEAD
DECAY_LORA = 64
ICLR_LORA = 64
SHIFT_WIDTH = 3 * RW_WIDTH + DECAY_LORA + ICLR_LORA

O_CQ = Q_RANK
O_CKV = O_CQ + KV_RANK
O_KPE = O_CKV + MLA_ROPE
O_GA = O_KPE + MLA_WIDTH
O_SH = O_GA + SHIFT_WIDTH
O_GB = O_SH + RW_WIDTH
O_MA = O_GB + D_MODEL
N_IN = O_MA + D_MODEL
IN_SPLITS = (O_CQ, O_CKV, O_KPE, O_GA, O_SH, O_GB, O_MA)
SHIFT_SPLITS = (RW_WIDTH, 2 * RW_WIDTH, 3 * RW_WIDTH, 3 * RW_WIDTH + DECAY_LORA)

kernel_name = 'mla_rwkv7_gated_parallel_stream_step'


def _rmsnorm(x, g):
    xf = x.astype(jnp.float32)
    y = xf * lax.rsqrt(jnp.mean(xf * xf, axis=-1, keepdims=True) + EPS)
    return (y * g.astype(jnp.float32)).astype(x.dtype)


def _rope(x, pos):
    half = MLA_ROPE // 2
    inv = ROPE_THETA ** (-jnp.arange(half, dtype=jnp.float32) / half)
    ang = pos.astype(jnp.float32)[:, None] * inv[None, :]
    shape = (1, pos.shape[0]) + (1,) * (x.ndim - 3) + (half,)
    cos = jnp.cos(ang).reshape(shape)
    sin = jnp.sin(ang).reshape(shape)
    xf = x.astype(jnp.float32)
    x1, x2 = xf[..., :half], xf[..., half:]
    return jnp.concatenate([x1 * cos - x2 * sin, x2 * cos + x1 * sin], axis=-1).astype(x.dtype)


def _chunk_attention(q_nope, q_pe, k_nope, k_pe, v, q_pos, k_pos):
    B, Tq, H, _ = q_nope.shape
    scale = MLA_QK ** -0.5
    kn = k_nope.astype(jnp.float32)
    kr = k_pe.astype(jnp.float32)
    vf = v.astype(jnp.float32)
    k_chunk = k_pos // CHUNK

    def block(args):
        qn, qr, qp = args
        s = (jnp.einsum('bqhd,bkhd->bhqk', qn.astype(jnp.float32), kn)
             + jnp.einsum('bqhr,bkr->bhqk', qr.astype(jnp.float32), kr)) * scale
        allowed = k_chunk[None, :] <= (qp // CHUNK)[:, None]
        s = jnp.where(allowed[None, None], s, -jnp.inf)
        p = jax.nn.softmax(s, axis=-1)
        return jnp.einsum('bhqk,bkhd->bqhd', p, vf)

    if Tq > QBLOCK:
        nb = Tq // QBLOCK
        qn_b = jnp.moveaxis(q_nope.reshape(B, nb, QBLOCK, H, MLA_NOPE), 1, 0)
        qr_b = jnp.moveaxis(q_pe.reshape(B, nb, QBLOCK, H, MLA_ROPE), 1, 0)
        o = lax.map(block, (qn_b, qr_b, q_pos.reshape(nb, QBLOCK)))
        o = jnp.moveaxis(o, 0, 1).reshape(B, Tq, H, MLA_V)
    else:
        o = block((q_nope, q_pe, q_pos))
    return o.astype(q_nope.dtype)


def _wkv7(r, w, k, v, a, b, s0):
    def step(s, inp):
        rt, wt, kt, vt, at, bt = inp
        sa = jnp.einsum('bhvk,bhk->bhv', s, at)
        s = s * wt[:, :, None, :] + sa[..., None] * bt[:, :, None, :] + vt[..., None] * kt[:, :, None, :]
        return s, jnp.einsum('bhvk,bhk->bhv', s, rt)
    xs = (jnp.moveaxis(r, 1, 0), jnp.moveaxis(w, 1, 0), jnp.moveaxis(k, 1, 0),
          jnp.moveaxis(v, 1, 0), jnp.moveaxis(a, 1, 0), jnp.moveaxis(b, 1, 0))
    s_final, ys = lax.scan(step, s0, xs)
    return jnp.moveaxis(ys, 0, 1), s_final


def _l2norm_heads(x):
    B, T, _ = x.shape
    xh = x.reshape(B, T, RW_HEADS, RW_HEAD)
    n = jnp.sqrt(jnp.sum(xh * xh, axis=-1, keepdims=True))
    return (xh / jnp.maximum(n, 1e-12)).reshape(B, T, RW_WIDTH)


def _head_groupnorm(y, g, bias):
    B, T = y.shape[0], y.shape[1]
    mu = jnp.mean(y, axis=-1, keepdims=True)
    var = jnp.mean(jnp.square(y - mu), axis=-1, keepdims=True)
    yn = ((y - mu) * lax.rsqrt(var + GN_EPS)).reshape(B, T, RW_WIDTH)
    return yn * g.astype(jnp.float32) + bias.astype(jnp.float32)


def _mixer_layer(x, ckv_past, kpe_past, wkv0, shift0, lw):
    (norm_w, w_in, q_norm_w, kv_norm_w, w_uq, w_ukv, qn_nope, qn_rope, kn_nope, kn_rope,
     mu_shift, w0, w2, a0, a2, k_k, k_a, r_k, lnx_w, lnx_b, w_out_a, w_out_b, w_o) = lw
    B, T, _ = x.shape
    P = ckv_past.shape[1]
    dt = x.dtype
    f32 = jnp.float32
    q_pos = P + jnp.arange(T, dtype=jnp.int32)
    k_pos = jnp.arange(P + T, dtype=jnp.int32)

    h = _rmsnorm(x, norm_w)
    z = h @ w_in
    c_q, kv_lat, k_pe, gate_a, zs, gate_b, merge_a, merge_b = jnp.split(z, IN_SPLITS, axis=-1)

    q = (_rmsnorm(c_q, q_norm_w) @ w_uq).reshape(B, T, MLA_HEADS, MLA_QK)
    q_nope = _rmsnorm(q[..., :MLA_NOPE], qn_nope)
    q_pe = _rope(_rmsnorm(q[..., MLA_NOPE:], qn_rope), q_pos)
    c_kv = _rmsnorm(kv_lat, kv_norm_w)
    k_pe = _rope(_rmsnorm(k_pe, kn_rope), q_pos)
    ckv_all = jnp.concatenate([ckv_past.astype(dt), c_kv], axis=1)
    kpe_all = jnp.concatenate([kpe_past.astype(dt), k_pe], axis=1)
    kv = (ckv_all @ w_ukv).reshape(B, P + T, MLA_HEADS, MLA_NOPE + MLA_V)
    k_nope = _rmsnorm(kv[..., :MLA_NOPE], kn_nope)
    v_a = kv[..., MLA_NOPE:]
    o_a = _chunk_attention(q_nope, q_pe, k_nope, kpe_all, v_a, q_pos, k_pos)
    o_a = o_a.reshape(B, T, MLA_WIDTH) * jax.nn.silu(gate_a)

    zs_prev = jnp.concatenate([shift0.astype(dt), zs[:, :-1]], axis=1)
    zm = (zs + (zs_prev - zs) * mu_shift).astype(f32)
    r, k, v, wd, ad = jnp.split(zm, SHIFT_SPLITS, axis=-1)
    log_w = -jax.nn.softplus(-(w0 + jnp.tanh(wd) @ w2)) - 0.5
    decay = jnp.exp(-jnp.exp(log_w.astype(f32)))
    a = jax.nn.sigmoid(a0 + ad @ a2).astype(f32)
    kk = _l2norm_heads(k * k_k)
    k = k * (1.0 + (a - 1.0) * k_a)
    hs = lambda t: t.astype(f32).reshape(B, T, RW_HEADS, RW_HEAD)
    y, wkv_final = _wkv7(hs(r), hs(decay), hs(k), hs(v), hs(-kk), hs(kk * a), wkv0.astype(f32))
    y = _head_groupnorm(y, lnx_w, lnx_b)
    bonus = jnp.sum(hs(r) * hs(k) * r_k.astype(f32), axis=-1, keepdims=True) * hs(v)
    o_b = (y + bonus.reshape(B, T, RW_WIDTH)).astype(dt) * jax.nn.silu(gate_b)

    m = jax.nn.sigmoid(merge_a) * (o_a @ w_out_a) + jax.nn.sigmoid(merge_b) * (o_b @ w_out_b)
    out = x + m @ w_o
    return out, c_kv, k_pe, wkv_final.astype(dt), zs[:, -1:]


def setup_inputs(seed: int = 0) -> dict:
    key = jax.random.key(seed)
    ks = jax.random.split(key, 32)
    f = jnp.float32
    n = jax.random.normal

    def gain(k, shape):
        return 1.0 + 0.02 * n(k, shape, f)

    return {
        'x_prompt': n(ks[0], (BATCH, SEQ, D_MODEL), f),
        'x_sample': n(ks[1], (DEC_BATCH, DEC_SEQ, D_MODEL), f),
        'cache_ckv': n(ks[2], (DEPTH, DEC_BATCH, PAST_LEN, KV_RANK), f),
        'cache_kpe': n(ks[3], (DEPTH, DEC_BATCH, PAST_LEN, MLA_ROPE), f),
        'state_wkv': 0.5 * n(ks[4], (DEPTH, DEC_BATCH, RW_HEADS, RW_HEAD, RW_HEAD), f),
        'state_shift': n(ks[5], (DEPTH, DEC_BATCH, 1, SHIFT_WIDTH), f),
        'norm_w': gain(ks[6], (DEPTH, D_MODEL)),
        'w_in': n(ks[7], (DEPTH, D_MODEL, N_IN), f) * D_MODEL ** -0.5,
        'q_norm_w': gain(ks[8], (DEPTH, Q_RANK)),
        'kv_norm_w': gain(ks[9], (DEPTH, KV_RANK)),
        'w_uq': n(ks[10], (DEPTH, Q_RANK, MLA_HEADS * MLA_QK), f) * Q_RANK ** -0.5,
        'w_ukv': n(ks[11], (DEPTH, KV_RANK, MLA_HEADS * (MLA_NOPE + MLA_V)), f) * KV_RANK ** -0.5,
        'qn_nope': gain(ks[12], (DEPTH, MLA_NOPE)),
        'qn_rope': gain(ks[13], (DEPTH, MLA_ROPE)),
        'kn_nope': gain(ks[14], (DEPTH, MLA_NOPE)),
        'kn_rope': gain(ks[15], (DEPTH, MLA_ROPE)),
        'mu_shift': jax.random.uniform(ks[16], (DEPTH, SHIFT_WIDTH), f),
        'w0': jax.random.uniform(ks[17], (DEPTH, RW_WIDTH), f, -6.0, 1.0),
        'w2': 0.5 * n(ks[18], (DEPTH, DECAY_LORA, RW_WIDTH), f) * DECAY_LORA ** -0.5,
        'a0': 0.5 * n(ks[19], (DEPTH, RW_WIDTH), f),
        'a2': 0.5 * n(ks[20], (DEPTH, ICLR_LORA, RW_WIDTH), f) * ICLR_LORA ** -0.5,
        'k_k': 1.0 + 0.1 * n(ks[21], (DEPTH, RW_WIDTH), f),
        'k_a': 1.0 + 0.1 * n(ks[22], (DEPTH, RW_WIDTH), f),
        'r_k': 0.1 * n(ks[23], (DEPTH, RW_HEADS, RW_HEAD), f),
        'lnx_w': gain(ks[24], (DEPTH, RW_WIDTH)),
        'lnx_b': 0.02 * n(ks[25], (DEPTH, RW_WIDTH), f),
        'w_out_a': n(ks[26], (DEPTH, MLA_WIDTH, D_MODEL), f) * MLA_WIDTH ** -0.5,
        'w_out_b': n(ks[27], (DEPTH, RW_WIDTH, D_MODEL), f) * RW_WIDTH ** -0.5,
        'w_o': 0.5 * n(ks[28], (DEPTH, D_MODEL, D_MODEL), f) * D_MODEL ** -0.5,
    }


def reference(x_prompt, x_sample, cache_ckv, cache_kpe, state_wkv, state_shift,
              norm_w, w_in, q_norm_w, kv_norm_w, w_uq, w_ukv, qn_nope, qn_rope, kn_nope, kn_rope,
              mu_shift, w0, w2, a0, a2, k_k, k_a, r_k, lnx_w, lnx_b, w_out_a, w_out_b, w_o):
    B = x_prompt.shape[0]
    dt = x_prompt.dtype
    empty_ckv = jnp.zeros((B, 0, KV_RANK), dt)
    empty_kpe = jnp.zeros((B, 0, MLA_ROPE), dt)
    zero_wkv = jnp.zeros((B, RW_HEADS, RW_HEAD, RW_HEAD), jnp.float32)
    zero_shift = jnp.zeros((B, 1, SHIFT_WIDTH), dt)

    yp, ys = x_prompt, x_sample
    ckv_p, kpe_p, wkv_p, sh_p = [], [], [], []
    ckv_s, kpe_s, wkv_s, sh_s = [], [], [], []
    for i in range(DEPTH):
        lw = (norm_w[i], w_in[i], q_norm_w[i], kv_norm_w[i], w_uq[i], w_ukv[i], qn_nope[i], qn_rope[i],
              kn_nope[i], kn_rope[i], mu_shift[i], w0[i], w2[i], a0[i], a2[i], k_k[i], k_a[i], r_k[i],
              lnx_w[i], lnx_b[i], w_out_a[i], w_out_b[i], w_o[i])
        yp, c1, c2, c3, c4 = _mixer_layer(yp, empty_ckv, empty_kpe, zero_wkv, zero_shift, lw)
        ckv_p.append(c1); kpe_p.append(c2); wkv_p.append(c3); sh_p.append(c4)
        ys, d1, d2, d3, d4 = _mixer_layer(ys, cache_ckv[i], cache_kpe[i], state_wkv[i], state_shift[i], lw)
        ckv_s.append(d1); kpe_s.append(d2); wkv_s.append(d3); sh_s.append(d4)

    return (yp, ys,
            jnp.stack(ckv_p), jnp.stack(kpe_p), jnp.stack(wkv_p), jnp.stack(sh_p),
            jnp.stack(ckv_s), jnp.stack(kpe_s), jnp.stack(wkv_s), jnp.stack(sh_s))
```

```cpp
#include <hip/hip_runtime.h>
#include <hip/hip_cooperative_groups.h>
#include <cstdio>
namespace cg = cooperative_groups;

#define DI __device__ __forceinline__
typedef unsigned short u16;
typedef __attribute__((ext_vector_type(8))) short bf16x8;
typedef __attribute__((ext_vector_type(4))) short s16x4;
typedef __attribute__((ext_vector_type(2))) __bf16 bf2_t;
typedef __attribute__((ext_vector_type(2))) float f2_t;
typedef __attribute__((ext_vector_type(16))) float f32x16;
typedef __attribute__((ext_vector_type(4))) unsigned u32x4;
typedef __attribute__((ext_vector_type(2))) unsigned u32x2;
typedef __attribute__((ext_vector_type(4))) float f32x4;
#define MFMA32(a, b, c) __builtin_amdgcn_mfma_f32_32x32x16_bf16((a), (b), (c), 0, 0, 0)

constexpr int NP = 16384;
constexpr int NSM = 1024;
constexpr int NT = NP + NSM;
constexpr int NZ = 5248;
constexpr int ZC_KV = 256, ZC_KPE = 384, ZC_GA = 512, ZC_ZS = 1024, ZC_GB = 2688, ZC_MA = 3200, ZC_MB = 4224;
constexpr float EPS = 1e-6f;
constexpr float GN_EPS = 64e-5f;
constexpr int SHW = 1664;

constexpr size_t OFF_CKV_P = 17825792;
constexpr size_t OFF_KPE_P = 26214400;
constexpr size_t OFF_WKV_P = 28311552;
constexpr size_t OFF_SH_P = 28442624;
constexpr size_t OFF_CKV_S = 28449280;
constexpr size_t OFF_KPE_S = 28973568;
constexpr size_t OFF_WKV_S = 29104640;
constexpr size_t OFF_SH_S = 31201792;

constexpr size_t WL_STRIDE = 15728640;
constexpr size_t W_IN = 0, W_UQ = 10747904, W_UKV = 11141120, W_W2 = 11403264, W_A2 = 11468800, W_OA = 11534336, W_OB = 12582912, W_O = 13631488;
constexpr size_t WS_H = 62914560;
constexpr size_t WS_Z = WS_H + 35651584;
constexpr size_t WS_Q = WS_Z + 182714368;
constexpr size_t WS_CKVB = WS_Q + 26738688;
constexpr size_t WS_KPEB = WS_CKVB + 4456448;
constexpr size_t WS_KN = WS_KPEB + 1114112;
constexpr size_t WS_VT = WS_KN + 16777216;
constexpr size_t WS_WKVIN = WS_VT + 16777216;
constexpr size_t WS_OA = WS_WKVIN + 106954752;
constexpr size_t WS_Y = WS_OA + 17825792;
constexpr size_t WS_CTR = WS_Y + 35651584;
constexpr size_t WS_BAR = WS_CTR + 16384;
constexpr size_t WS_SH0 = WS_BAR + 16384;
constexpr size_t WS_TOTAL = WS_SH0 + 65536;
static_assert(WS_TOTAL < 536870912, "ws");

constexpr int SMEM_BYTES = 39424 + 128 * 136 * 2;

struct Params {
  const float *x_prompt, *x_sample, *cache_ckv, *cache_kpe, *state_wkv, *state_shift;
  const float *norm_w, *w_in, *q_norm_w, *kv_norm_w, *w_uq, *w_ukv, *qn_nope, *qn_rope, *kn_nope, *kn_rope;
  const float *mu_shift, *w0, *w2, *a0, *a2, *k_k, *k_a, *r_k, *lnx_w, *lnx_b, *w_out_a, *w_out_b, *w_o;
  float* out;
  char* ws;
};

__device__ const float ROPE_INV[16] = {1.0f, 0.5623413324356079f, 0.3162277638912201f, 0.17782793939113617f, 0.10000000149011612f, 0.05623413249850273f, 0.03162277489900589f, 0.017782794311642647f, 0.009999999776482582f, 0.005623413249850273f, 0.003162277629598975f, 0.0017782794311642647f, 0.0010000000474974513f, 0.000562341301701963f, 0.0003162277571391314f, 0.00017782794020604342f};

DI int tidx() { int t = threadIdx.x; asm volatile("" : "+v"(t)); return t; }
DI float bf2f(u16 h) { return __uint_as_float(((unsigned)h) << 16); }
DI unsigned pk2(float a, float b) { f2_t v = {a, b}; bf2_t r = __builtin_convertvector(v, bf2_t); return __builtin_bit_cast(unsigned, r); }
DI u16 f2bf(float a) { return (u16)(pk2(a, 0.f) & 0xffffu); }
DI float lo2f(unsigned u) { return __uint_as_float(u << 16); }
DI float hi2f(unsigned u) { return __uint_as_float(u & 0xffff0000u); }
DI float wave_sum(float v) {
  v += __builtin_bit_cast(float, __builtin_amdgcn_update_dpp(0, __builtin_bit_cast(int, v), 0x128, 0xF, 0xF, false));
  v += __builtin_bit_cast(float, __builtin_amdgcn_update_dpp(0, __builtin_bit_cast(int, v), 0x124, 0xF, 0xF, false));
  v += __builtin_bit_cast(float, __builtin_amdgcn_update_dpp(0, __builtin_bit_cast(int, v), 0x122, 0xF, 0xF, false));
  v += __builtin_bit_cast(float, __builtin_amdgcn_update_dpp(0, __builtin_bit_cast(int, v), 0x121, 0xF, 0xF, false));
  const int iv = __builtin_bit_cast(int, v);
  const float s0 = __builtin_bit_cast(float, __builtin_amdgcn_readlane(iv, 0)), s1 = __builtin_bit_cast(float, __builtin_amdgcn_readlane(iv, 16));
  const float s2 = __builtin_bit_cast(float, __builtin_amdgcn_readlane(iv, 32)), s3 = __builtin_bit_cast(float, __builtin_amdgcn_readlane(iv, 48));
  return (s0 + s1) + (s2 + s3);
}
DI float xor32(float v) { return __shfl_xor(v, 32); }
DI int crow(int reg, int h) { return (reg & 3) + 8 * (reg >> 2) + 4 * h; }
DI float sigmoidf_(float x) { return 1.f / (1.f + __expf(-x)); }
DI float siluf_(float x) { return x / (1.f + __expf(-x)); }
DI void rope_sincos(int pos, int i, float& s, float& c) {
  float ang = (float)pos * ROPE_INV[i];
  double rev = (double)ang * 0.15915494309189533577;
  double fr = rev - rint(rev);
  float f = (float)fr;
  s = __builtin_amdgcn_sinf(f);
  c = __builtin_amdgcn_cosf(f);
}
DI const float* xrow(const Params& p, int layer, int t) {
  if (layer == 0) return (t < NP) ? p.x_prompt + (size_t)t * 1024 : p.x_sample + (size_t)(t - NP) * 1024;
  return p.out + (size_t)t * 1024;
}
DI int tok_pos(int t) { return (t < NP) ? t : 4096 + ((t - NP) & 63); }

DI void conv_tile(const float* __restrict__ src, int N, u16* __restrict__ dst, int K, int k0, int n0, int kind, float* sm) {
  const int tid = tidx();
  const int nl = tid & 63, kb = tid >> 6;
  const int np_ = n0 + nl;
  int sc = np_;
  if (kind == 1) sc = (np_ < 416) ? np_ : ((np_ < 512) ? -1 : np_ - 96);
#pragma unroll
  for (int i = 0; i < 16; ++i) {
    const int kl = kb + 4 * i;
    float v = 0.f;
    if (sc >= 0) v = src[(size_t)(k0 + kl) * N + sc];
    sm[kl * 65 + nl] = v;
  }
  __syncthreads();
  const int nr = tid >> 2, kc = (tid & 3) * 16;
  unsigned o[8];
#pragma unroll
  for (int j = 0; j < 8; ++j) o[j] = pk2(sm[(kc + 2 * j) * 65 + nr], sm[(kc + 2 * j + 1) * 65 + nr]);
  uint4* d = (uint4*)(dst + (size_t)(n0 + nr) * K + k0 + kc);
  d[0] = make_uint4(o[0], o[1], o[2], o[3]);
  d[1] = make_uint4(o[4], o[5], o[6], o[7]);
  __syncthreads();
}

DI void phase_convert(const Params& p, char* smem) {
  float* sm = (float*)smem;
  for (int it = blockIdx.x; it < 4 * 1920; it += gridDim.x) {
    const int layer = it / 1920;
    int r = it % 1920;
    const float* src; u16* dst; int K, N, kind = 0, nt;
    char* wl = p.ws + (size_t)layer * WL_STRIDE;
    if (r < 1312) { src = p.w_in + (size_t)layer * 1024 * 5152; dst = (u16*)(wl + W_IN); K = 1024; N = 5152; kind = 1; nt = 82; }
    else if (r < 1360) { r -= 1312; src = p.w_uq + (size_t)layer * 256 * 768; dst = (u16*)(wl + W_UQ); K = 256; N = 768; nt = 12; }
    else if (r < 1392) { r -= 1360; src = p.w_ukv + (size_t)layer * 128 * 1024; dst = (u16*)(wl + W_UKV); K = 128; N = 1024; nt = 16; }
    else if (r < 1400) { r -= 1392; src = p.w2 + (size_t)layer * 64 * 512; dst = (u16*)(wl + W_W2); K = 64; N = 512; nt = 8; }
    else if (r < 1408) { r -= 1400; src = p.a2 + (size_t)layer * 64 * 512; dst = (u16*)(wl + W_A2); K = 64; N = 512; nt = 8; }
    else if (r < 1536) { r -= 1408; src = p.w_out_a + (size_t)layer * 512 * 1024; dst = (u16*)(wl + W_OA); K = 512; N = 1024; nt = 16; }
    else if (r < 1664) { r -= 1536; src = p.w_out_b + (size_t)layer * 512 * 1024; dst = (u16*)(wl + W_OB); K = 512; N = 1024; nt = 16; }
    else { r -= 1664; src = p.w_o + (size_t)layer * 1024 * 1024; dst = (u16*)(wl + W_O); K = 1024; N = 1024; nt = 16; }
    const int kt = r / nt, ntile = r % nt;
    conv_tile(src, N, dst, K, kt * 64, ntile * 64, kind, sm);
  }
}

DI void phase_rmsnorm(const Params& p, int layer) {
  const int wave = tidx() >> 6, lane = tidx() & 63;
  u16* H = (u16*)(p.ws + WS_H);
  const float* g = p.norm_w + layer * 1024;
  if (blockIdx.x == gridDim.x - 1) {
    u16* sh0 = (u16*)(p.ws + WS_SH0);
    for (int i = tidx(); i < 17 * SHW; i += 256) {
      const int r = i / SHW, c = i - r * SHW;
      sh0[i] = (r == 0) ? (u16)0 : f2bf(p.state_shift[((size_t)layer * 16 + (r - 1)) * SHW + c]);
    }
  }
  for (int t = blockIdx.x * 4 + wave; t < NT; t += gridDim.x * 4) {
    const float* xr = xrow(p, layer, t);
    float4 v[4];
    float ss = 0.f;
#pragma unroll
    for (int i = 0; i < 4; ++i) {
      v[i] = *(const float4*)(xr + i * 256 + lane * 4);
      ss += v[i].x * v[i].x + v[i].y * v[i].y + v[i].z * v[i].z + v[i].w * v[i].w;
    }
    ss = wave_sum(ss);
    const float rinv = rsqrtf(ss * (1.f / 1024.f) + EPS);
#pragma unroll
    for (int i = 0; i < 4; ++i) {
      const float4 g4 = *(const float4*)(g + i * 256 + lane * 4);
      uint2 o;
      o.x = pk2(v[i].x * rinv * g4.x, v[i].y * rinv * g4.y);
      o.y = pk2(v[i].z * rinv * g4.z, v[i].w * rinv * g4.w);
      *(uint2*)(H + (size_t)t * 1024 + i * 256 + lane * 4) = o;
    }
  }
}

DI void gemm_mainloop(const u16* __restrict__ R, int ldr, const u16* __restrict__ C, int ldc, int K, char* smem, f32x16 (&acc)[2][2]) {
  const int tid = tidx(), lane = tid & 63, w = tid >> 6, wr = w >> 1, wc = w & 1;
  const int l31 = lane & 31, h = lane >> 5;
  const int lrow = tid >> 3, lkc = (tid & 7) * 8;
  u32x4 rr[4], rc[4];
  const int nk = K >> 6;
#pragma unroll
  for (int i = 0; i < 4; ++i) {
    rr[i] = *(const u32x4*)(R + (size_t)(lrow + 32 * i) * ldr + lkc);
    rc[i] = *(const u32x4*)(C + (size_t)(lrow + 32 * i) * ldc + lkc);
  }
  __syncthreads();
  {
    u16* sR = (u16*)smem;
    u16* sC = sR + 128 * 72;
#pragma unroll
    for (int i = 0; i < 4; ++i) {
      *(u32x4*)(sR + (lrow + 32 * i) * 72 + lkc) = rr[i];
      *(u32x4*)(sC + (lrow + 32 * i) * 72 + lkc) = rc[i];
    }
  }
  if (nk > 1) {
#pragma unroll
    for (int i = 0; i < 4; ++i) {
      rr[i] = *(const u32x4*)(R + (size_t)(lrow + 32 * i) * ldr + 64 + lkc);
      rc[i] = *(const u32x4*)(C + (size_t)(lrow + 32 * i) * ldc + 64 + lkc);
    }
  }
  __syncthreads();
  for (int kt = 0; kt < nk; ++kt) {
    const u16* sR = (const u16*)smem + (kt & 1) * (2 * 128 * 72);
    const u16* sC = sR + 128 * 72;
    if (kt + 1 < nk) {
      u16* nR = (u16*)smem + ((kt + 1) & 1) * (2 * 128 * 72);
      u16* nC = nR + 128 * 72;
#pragma unroll
      for (int i = 0; i < 4; ++i) {
        *(u32x4*)(nR + (lrow + 32 * i) * 72 + lkc) = rr[i];
        *(u32x4*)(nC + (lrow + 32 * i) * 72 + lkc) = rc[i];
      }
    }
    if (kt + 2 < nk) {
      const int k0 = (kt + 2) * 64;
#pragma unroll
      for (int i = 0; i < 4; ++i) {
        rr[i] = *(const u32x4*)(R + (size_t)(lrow + 32 * i) * ldr + k0 + lkc);
        rc[i] = *(const u32x4*)(C + (size_t)(lrow + 32 * i) * ldc + k0 + lkc);
      }
    }
#pragma unroll
    for (int ks = 0; ks < 4; ++ks) {
      bf16x8 a[2], b[2];
#pragma unroll
      for (int mi = 0; mi < 2; ++mi) a[mi] = *(const bf16x8*)(sR + (wr * 64 + mi * 32 + l31) * 72 + ks * 16 + h * 8);
#pragma unroll
      for (int ni = 0; ni < 2; ++ni) b[ni] = *(const bf16x8*)(sC + (wc * 64 + ni * 32 + l31) * 72 + ks * 16 + h * 8);
#pragma unroll
      for (int mi = 0; mi < 2; ++mi)
#pragma unroll
        for (int ni = 0; ni < 2; ++ni) acc[mi][ni] = MFMA32(a[mi], b[ni], acc[mi][ni]);
    }
    __syncthreads();
  }
}
DI void zero_acc(f32x16 (&acc)[2][2]) {
#pragma unroll
  for (int mi = 0; mi < 2; ++mi)
#pragma unroll
    for (int ni = 0; ni < 2; ++ni)
#pragma unroll
      for (int r = 0; r < 16; ++r) acc[mi][ni][r] = 0.f;
}
DI void acc_to_lds(const f32x16 (&acc)[2][2], char* smem) {
  float* sT = (float*)smem;
  const int lane = tidx() & 63, w = tidx() >> 6;
  const int l31 = lane & 31, h = lane >> 5, wr = w >> 1, wc = w & 1;
  __syncthreads();
#pragma unroll
  for (int mi = 0; mi < 2; ++mi)
#pragma unroll
    for (int ni = 0; ni < 2; ++ni)
#pragma unroll
      for (int reg = 0; reg < 16; ++reg) sT[(wr * 64 + mi * 32 + crow(reg, h)) * 132 + wc * 64 + ni * 32 + l31] = acc[mi][ni][reg];
  __syncthreads();
}
#define EPI_ROWS(...)                                                          \
  {                                                                            \
    const float* sT_ = (const float*)smem;                                     \
    _Pragma("unroll 2") for (int it_ = 0; it_ < 16; ++it_) {                   \
      const int row = it_ * 8 + (tidx() >> 5), col = (tidx() & 31) * 4; \
      const f32x4 v = *(const f32x4*)(sT_ + row * 132 + col);                  \
      __VA_ARGS__                                                              \
    }                                                                          \
  }

DI void gemm64_mainloop(const u16* __restrict__ R, int ldr, const u16* __restrict__ C, int ldc, int K, char* smem, f32x16& acc) {
  const int tid = tidx(), lane = tid & 63, w = tid >> 6, wr = w >> 1, wc = w & 1;
  const int l31 = lane & 31, h = lane >> 5;
  const int lrow = tid >> 3, lkc = (tid & 7) * 8;
  u32x4 rr[2][2], rc[2][2];
  const int nk = K >> 6;
#define G64_GLOAD(SET, KT)                                                                    \
  {                                                                                           \
    const int k0_ = (KT) * 64;                                                                \
    _Pragma("unroll") for (int i = 0; i < 2; ++i) {                                           \
      rr[SET][i] = *(const u32x4*)(R + (size_t)(lrow + 32 * i) * ldr + k0_ + lkc);            \
      rc[SET][i] = *(const u32x4*)(C + (size_t)(lrow + 32 * i) * ldc + k0_ + lkc);            \
    }                                                                                         \
  }
#define G64_LSTORE(SET, BUF)                                                                  \
  {                                                                                           \
    u16* nR_ = (u16*)smem + (BUF) * (2 * 64 * 72);                                            \
    u16* nC_ = nR_ + 64 * 72;                                                                 \
    _Pragma("unroll") for (int i = 0; i < 2; ++i) {                                           \
      *(u32x4*)(nR_ + (lrow + 32 * i) * 72 + lkc) = rr[SET][i];                               \
      *(u32x4*)(nC_ + (lrow + 32 * i) * 72 + lkc) = rc[SET][i];                               \
    }                                                                                         \
  }
  G64_GLOAD(0, 0)
  G64_GLOAD(1, 1)
  __syncthreads();
  G64_LSTORE(0, 0)
  G64_GLOAD(0, 2)
  __syncthreads();
  for (int kt0 = 0; kt0 < nk; kt0 += 2) {
#pragma unroll
    for (int u = 0; u < 2; ++u) {
      const int kt = kt0 + u;
      const u16* sR = (const u16*)smem + u * (2 * 64 * 72);
      const u16* sC = sR + 64 * 72;
      if (kt + 1 < nk) G64_LSTORE(1 - u, 1 - u)
      if (kt + 3 < nk) G64_GLOAD(1 - u, kt + 3)
#pragma unroll
      for (int ks = 0; ks < 4; ++ks) {
        const bf16x8 a = *(const bf16x8*)(sR + (wr * 32 + l31) * 72 + ks * 16 + h * 8);
        const bf16x8 b = *(const bf16x8*)(sC + (wc * 32 + l31) * 72 + ks * 16 + h * 8);
        acc = MFMA32(a, b, acc);
      }
      __syncthreads();
    }
  }
#undef G64_GLOAD
#undef G64_LSTORE
}
DI void acc64_to_lds(const f32x16& acc, char* smem) {
  float* sT = (float*)smem;
  const int lane = tidx() & 63, w = tidx() >> 6;
  const int l31 = lane & 31, h = lane >> 5, wr = w >> 1, wc = w & 1;
  __syncthreads();
#pragma unroll
  for (int reg = 0; reg < 16; ++reg) sT[(wr * 32 + crow(reg, h)) * 68 + wc * 32 + l31] = acc[reg];
  __syncthreads();
}
#define EPI64_ROWS(...)                                                        \
  {                                                                            \
    const float* sT_ = (const float*)smem;                                     \
    _Pragma("unroll") for (int it_ = 0; it_ < 4; ++it_) {                      \
      const int row = it_ * 16 + (tidx() >> 4), col = (tidx() & 15) * 4;       \
      const f32x4 v = *(const f32x4*)(sT_ + row * 68 + col);                   \
      __VA_ARGS__                                                              \
    }                                                                          \
  }

DI void phase_g1(const Params& p, int layer, char* smem) {
  const u16* H = (const u16*)(p.ws + WS_H);
  const u16* W = (const u16*)(p.ws + (size_t)layer * WL_STRIDE + W_IN);
  u16* Z = (u16*)(p.ws + WS_Z);
  const int xcd = blockIdx.x & 7, jb = blockIdx.x >> 3, nb = (gridDim.x + 7 - xcd) >> 3;
  for (int m = jb; m < 17 * 41; m += nb) {
    const int ft = m / 17, tt = xcd + 8 * (m % 17);
    f32x16 acc[2][2];
    zero_acc(acc);
    gemm_mainloop(H + (size_t)tt * 128 * 1024, 1024, W + (size_t)ft * 128 * 1024, 1024, 1024, smem, acc);
    acc_to_lds(acc, smem);
    EPI_ROWS({ *(u32x2*)(Z + (size_t)(tt * 128 + row) * NZ + ft * 128 + col) = u32x2{pk2(v.x, v.y), pk2(v.z, v.w)}; })
  }
}

DI void norms_token(const Params& p, int layer, int t, int lane) {
  const u16* zr = (const u16*)(p.ws + WS_Z) + (size_t)t * NZ;
  u16* CQN = (u16*)(p.ws + WS_H);
  u16* CKVB = (u16*)(p.ws + WS_CKVB);
  u16* KPEB = (u16*)(p.ws + WS_KPEB);
  {
    const uint2 raw = *(const uint2*)(zr + lane * 4);
    const float c0 = lo2f(raw.x), c1 = hi2f(raw.x), c2 = lo2f(raw.y), c3 = hi2f(raw.y);
    float ss = wave_sum(c0 * c0 + c1 * c1 + c2 * c2 + c3 * c3);
    const float rinv = rsqrtf(ss * (1.f / 256.f) + EPS);
    const float4 g = *(const float4*)(p.q_norm_w + layer * 256 + lane * 4);
    uint2 o;
    o.x = pk2(c0 * rinv * g.x, c1 * rinv * g.y);
    o.y = pk2(c2 * rinv * g.z, c3 * rinv * g.w);
    *(uint2*)(CQN + (size_t)t * 256 + lane * 4) = o;
  }
  {
    const unsigned raw = *(const unsigned*)(zr + ZC_KV + lane * 2);
    const float c0 = lo2f(raw), c1 = hi2f(raw);
    float ss = wave_sum(c0 * c0 + c1 * c1);
    const float rinv = rsqrtf(ss * (1.f / 128.f) + EPS);
    const float2 g = *(const float2*)(p.kv_norm_w + layer * 128 + lane * 2);
    const float o0 = c0 * rinv * g.x, o1 = c1 * rinv * g.y;
    float* dst = (t < NP) ? p.out + OFF_CKV_P + ((size_t)layer * NP + t) * 128 : p.out + OFF_CKV_S + ((size_t)layer * NSM + (t - NP)) * 128;
    *(float2*)(dst + lane * 2) = make_float2(o0, o1);
    *(unsigned*)(CKVB + (size_t)t * 128 + lane * 2) = pk2(o0, o1);
  }
  {
    float v = (lane < 32) ? bf2f(zr[ZC_KPE + lane]) : 0.f;
    float ss = wave_sum(v * v);
    const float rinv = rsqrtf(ss * (1.f / 32.f) + EPS);
    v = v * rinv * p.kn_rope[layer * 32 + (lane & 31)];
    const float pr = __shfl_xor(v, 16);
    float s, c;
    rope_sincos(tok_pos(t), lane & 15, s, c);
    const float o = ((lane & 16) == 0) ? (v * c - pr * s) : (v * c + pr * s);
    if (lane < 32) {
      float* dst = (t < NP) ? p.out + OFF_KPE_P + ((size_t)layer * NP + t) * 32 : p.out + OFF_KPE_S + ((size_t)layer * NSM + (t - NP)) * 32;
      dst[lane] = o;
      KPEB[(size_t)t * 32 + lane] = f2bf(o);
    }
  }
  float* sh = nullptr;
  if (t == NP - 1) sh = p.out + OFF_SH_P + (size_t)layer * SHW;
  else if (t >= NP && ((t - NP) & 63) == 63) sh = p.out + OFF_SH_S + ((size_t)layer * 16 + ((t - NP) >> 6)) * SHW;
  if (sh) {
#pragma unroll 1
    for (int c = lane; c < SHW; c += 64) sh[c] = bf2f(zr[ZC_ZS + c]);
  }
}

DI void zm4(const Params& p, int layer, int t, int c, float (&o)[4]) {
  const u16* zr = (const u16*)(p.ws + WS_Z) + (size_t)t * NZ + ZC_ZS + c;
  const u32x2 a = *(const u32x2*)zr;
  const bool first = (t < NP) ? (t == 0) : (((t - NP) & 63) == 0);
  const int srow = (t < NP) ? 0 : 1 + ((t - NP) >> 6);
  const u16* pr = first ? (const u16*)(p.ws + WS_SH0) + srow * SHW + c : zr - NZ;
  const u32x2 b = *(const u32x2*)pr;
  const f32x4 mu = *(const f32x4*)(p.mu_shift + layer * SHW + c);
  const float c0 = lo2f(a.x), c1 = hi2f(a.x), c2 = lo2f(a.y), c3 = hi2f(a.y);
  o[0] = c0 + (lo2f(b.x) - c0) * mu.x;
  o[1] = c1 + (hi2f(b.x) - c1) * mu.y;
  o[2] = c2 + (lo2f(b.y) - c2) * mu.z;
  o[3] = c3 + (hi2f(b.y) - c3) * mu.w;
}
DI float tanhf_(float x) {
  const float t = __expf(-2.f * fabsf(x));
  const float r = (1.f - t) / (1.f + t);
  return x < 0.f ? -r : r;
}

constexpr int WPS = 900;
DI void zml(const u16* sz, int row, int col, const float* mu, float (&o)[4]) {
  const u32x2 a = *(const u32x2*)(sz + (row + 1) * WPS + col);
  const u32x2 b = *(const u32x2*)(sz + row * WPS + col);
  const f32x4 m4 = *(const f32x4*)mu;
  const float c0 = lo2f(a.x), c1 = hi2f(a.x), c2 = lo2f(a.y), c3 = hi2f(a.y);
  o[0] = c0 + (lo2f(b.x) - c0) * m4.x;
  o[1] = c1 + (hi2f(b.x) - c1) * m4.y;
  o[2] = c2 + (lo2f(b.y) - c2) * m4.z;
  o[3] = c3 + (hi2f(b.y) - c3) * m4.w;
}
DI void wkvprep_block(const Params& p, int layer, int tt, int hg, char* smem) {
  u16* sz = (u16*)smem;
  const int tid = tidx(), lane = tid & 63, w = tid >> 6, l31 = lane & 31, h = lane >> 5;
  const int t0 = tt * 32;
  const int hd = hg * 4 + w;
  const u16* Z = (const u16*)(p.ws + WS_Z);
  const bool seq_start = (t0 < NP) ? (t0 == 0) : (((t0 - NP) & 63) == 0);
  const u16* prevrow = seq_start ? (const u16*)(p.ws + WS_SH0) + ((t0 < NP) ? 0 : 1 + ((t0 - NP) >> 6)) * SHW : Z + (size_t)(t0 - 1) * NZ + ZC_ZS;
  __syncthreads();
  for (int ci = tid; ci < 33 * 112; ci += 256) {
    const int row = ci / 112, cc = ci - row * 112;
    int scol, lcol;
    if (cc < 16) { scol = 1536 + cc * 8; lcol = cc * 8; }
    else {
      const int j = cc - 16, ww = j / 24, r2 = j - ww * 24, part = r2 >> 3, o = (r2 & 7) * 8;
      scol = part * 512 + (hg * 4 + ww) * 64 + o;
      lcol = 128 + ww * 192 + part * 64 + o;
    }
    const u16* src = (row == 0) ? prevrow + scol : Z + (size_t)(t0 + row - 1) * NZ + ZC_ZS + scol;
    const u32x4 v = *(const u32x4*)src;
    u32x2* d = (u32x2*)(sz + row * WPS + lcol);
    d[0] = u32x2{v.x, v.y};
    d[1] = u32x2{v.z, v.w};
  }
  __syncthreads();
  const int tok = t0 + l31;
  const u16* W2T = (const u16*)(p.ws + (size_t)layer * WL_STRIDE + W_W2);
  const u16* A2T = (const u16*)(p.ws + (size_t)layer * WL_STRIDE + W_A2);
  const float* mu = p.mu_shift + layer * SHW;
  u16* WK = (u16*)(p.ws + WS_WKVIN) + ((size_t)hd * NT + tok) * 384;
  f32x16 accW[2], accA[2];
#pragma unroll
  for (int m = 0; m < 2; ++m)
#pragma unroll
    for (int r = 0; r < 16; ++r) { accW[m][r] = 0.f; accA[m][r] = 0.f; }
#pragma unroll
  for (int ks = 0; ks < 4; ++ks) {
    const int c0 = ks * 16 + 8 * h;
    float t0a[4], t1a[4], u0[4], u1[4];
    zml(sz, l31, c0, mu + 1536 + c0, t0a);
    zml(sz, l31, c0 + 4, mu + 1536 + c0 + 4, t1a);
    zml(sz, l31, 64 + c0, mu + 1600 + c0, u0);
    zml(sz, l31, 64 + c0 + 4, mu + 1600 + c0 + 4, u1);
    u32x4 bw, ba;
    bw.x = pk2(tanhf_(t0a[0]), tanhf_(t0a[1])); bw.y = pk2(tanhf_(t0a[2]), tanhf_(t0a[3]));
    bw.z = pk2(tanhf_(t1a[0]), tanhf_(t1a[1])); bw.w = pk2(tanhf_(t1a[2]), tanhf_(t1a[3]));
    ba.x = pk2(u0[0], u0[1]); ba.y = pk2(u0[2], u0[3]); ba.z = pk2(u1[0], u1[1]); ba.w = pk2(u1[2], u1[3]);
    const bf16x8 bwf = __builtin_bit_cast(bf16x8, bw), baf = __builtin_bit_cast(bf16x8, ba);
#pragma unroll
    for (int m = 0; m < 2; ++m) {
      const bf16x8 aw = *(const bf16x8*)(W2T + (size_t)(hd * 64 + m * 32 + l31) * 64 + ks * 16 + h * 8);
      const bf16x8 aa = *(const bf16x8*)(A2T + (size_t)(hd * 64 + m * 32 + l31) * 64 + ks * 16 + h * 8);
      accW[m] = MFMA32(aw, bwf, accW[m]);
      accA[m] = MFMA32(aa, baf, accA[m]);
    }
  }
  const int hb = 128 + w * 192;
  float ss = 0.f;
#pragma unroll
  for (int m = 0; m < 2; ++m)
#pragma unroll
    for (int q = 0; q < 4; ++q) {
      const int f0 = m * 32 + 8 * q + 4 * h, F = hd * 64 + f0;
      float k4[4];
      zml(sz, l31, hb + 64 + f0, mu + 512 + F, k4);
      const float4 kk_ = *(const float4*)(p.k_k + layer * 512 + F);
      const float a = k4[0] * kk_.x, b = k4[1] * kk_.y, c = k4[2] * kk_.z, d = k4[3] * kk_.w;
      ss += a * a + b * b + c * c + d * d;
    }
  ss += xor32(ss);
  const float rn = 1.f / fmaxf(sqrtf(ss), 1e-12f);
#pragma unroll
  for (int m = 0; m < 2; ++m)
#pragma unroll
    for (int q = 0; q < 4; ++q) {
      const int f0 = m * 32 + 8 * q + 4 * h, F = hd * 64 + f0;
      float r4[4], k4[4], v4[4];
      zml(sz, l31, hb + f0, mu + F, r4);
      zml(sz, l31, hb + 64 + f0, mu + 512 + F, k4);
      zml(sz, l31, hb + 128 + f0, mu + 1024 + F, v4);
      const float4 w0 = *(const float4*)(p.w0 + layer * 512 + F);
      const float4 a0 = *(const float4*)(p.a0 + layer * 512 + F);
      const float4 kk_ = *(const float4*)(p.k_k + layer * 512 + F);
      const float4 ka_ = *(const float4*)(p.k_a + layer * 512 + F);
      const float w0a[4] = {w0.x, w0.y, w0.z, w0.w}, a0a[4] = {a0.x, a0.y, a0.z, a0.w};
      const float kka[4] = {kk_.x, kk_.y, kk_.z, kk_.w}, kaa[4] = {ka_.x, ka_.y, ka_.z, ka_.w};
      float e4[4], kp4[4], kn4[4], b4[4];
#pragma unroll
      for (int j = 0; j < 4; ++j) {
        const float lw = w0a[j] + accW[m][4 * q + j];
        const float nx = -lw;
        const float sp = fmaxf(nx, 0.f) + __logf(1.f + __expf(-fabsf(nx)));
        e4[j] = __expf(-sp - 0.5f);
        const float a = sigmoidf_(a0a[j] + accA[m][4 * q + j]);
        kn4[j] = k4[j] * kka[j] * rn;
        b4[j] = kn4[j] * a;
        kp4[j] = k4[j] * (1.f + (a - 1.f) * kaa[j]);
      }
      *(u32x2*)(WK + 0 * 64 + f0) = u32x2{pk2(r4[0], r4[1]), pk2(r4[2], r4[3])};
      *(u32x2*)(WK + 1 * 64 + f0) = u32x2{pk2(e4[0], e4[1]), pk2(e4[2], e4[3])};
      *(u32x2*)(WK + 2 * 64 + f0) = u32x2{pk2(kp4[0], kp4[1]), pk2(kp4[2], kp4[3])};
      *(u32x2*)(WK + 3 * 64 + f0) = u32x2{pk2(v4[0], v4[1]), pk2(v4[2], v4[3])};
      *(u32x2*)(WK + 4 * 64 + f0) = u32x2{pk2(kn4[0], kn4[1]), pk2(kn4[2], kn4[3])};
      *(u32x2*)(WK + 5 * 64 + f0) = u32x2{pk2(b4[0], b4[1]), pk2(b4[2], b4[3])};
    }
}

DI void qproj_item(const Params& p, int layer, int tt, int hd, int lane);
DI void kvproj_item(const Params& p, int layer, int tt, int hd, int lane);
DI void phase_norms_prep(const Params& p, int layer, char* smem, int* s_item) {
  int* ctr = (int*)(p.ws + WS_CTR) + 4 + layer;
  const int wave = tidx() >> 6, lane = tidx() & 63;
  for (;;) {
    __syncthreads();
    if (tidx() == 0) *s_item = atomicAdd(ctr, 1);
    __syncthreads();
    const int it = *s_item;
    if (it >= 1088 + 2112 + 272) break;
    if (it < 1088) { wkvprep_block(p, layer, it >> 1, it & 1, smem); continue; }
    if (it < 1088 + 2112) {
      const int wi = (it - 1088) * 4 + wave;
      if (wi < 544 * 8) qproj_item(p, layer, wi >> 3, wi & 7, lane);
      else { const int j = wi - 544 * 8; kvproj_item(p, layer, j >> 3, j & 7, lane); }
      continue;
    }
    const int tb = (it - 1088 - 2112) * 64 + wave * 16;
    for (int j = 0; j < 16; ++j) norms_token(p, layer, tb + j, lane);
  }
}

DI bf16x8 normed_frag(const u16* zsrc, const float* g, float& ssq) {
  const u32x4 raw = *(const u32x4*)zsrc;
  const f32x4 g0 = *(const f32x4*)g, g1 = *(const f32x4*)(g + 4);
  const float f0 = lo2f(raw.x), f1 = hi2f(raw.x), f2 = lo2f(raw.y), f3 = hi2f(raw.y);
  const float f4 = lo2f(raw.z), f5 = hi2f(raw.z), f6 = lo2f(raw.w), f7 = hi2f(raw.w);
  ssq += (f0 * f0 + f1 * f1) + (f2 * f2 + f3 * f3) + (f4 * f4 + f5 * f5) + (f6 * f6 + f7 * f7);
  const u32x4 o = {pk2(f0 * g0.x, f1 * g0.y), pk2(f2 * g0.z, f3 * g0.w), pk2(f4 * g1.x, f5 * g1.y), pk2(f6 * g1.z, f7 * g1.w)};
  return __builtin_bit_cast(bf16x8, o);
}
DI void qproj_item(const Params& p, int layer, int tt, int hd, int lane) {
  const int l31 = lane & 31, h = lane >> 5;
  const int tok = tt * 32 + l31;
  const u16* zq = (const u16*)(p.ws + WS_Z) + (size_t)tok * NZ;
  const float* gq = p.q_norm_w + layer * 256;
  float ssq = 0.f;
  const u16* WT = (const u16*)(p.ws + (size_t)layer * WL_STRIDE + W_UQ);
  u16* Q = (u16*)(p.ws + WS_Q);
  f32x16 acc[3];
#pragma unroll
  for (int m = 0; m < 3; ++m)
#pragma unroll
    for (int r = 0; r < 16; ++r) acc[m][r] = 0.f;
#pragma unroll 4
  for (int ks = 0; ks < 16; ++ks) {
    const bf16x8 bfr = normed_frag(zq + ks * 16 + h * 8, gq + ks * 16 + h * 8, ssq);
#pragma unroll
    for (int m = 0; m < 3; ++m) {
      const bf16x8 afr = *(const bf16x8*)(WT + (size_t)(hd * 96 + m * 32 + l31) * 256 + ks * 16 + h * 8);
      acc[m] = MFMA32(afr, bfr, acc[m]);
    }
  }
  {
    ssq += xor32(ssq);
    const float rinv = rsqrtf(ssq * (1.f / 256.f) + EPS);
#pragma unroll
    for (int m = 0; m < 3; ++m)
#pragma unroll
      for (int r = 0; r < 16; ++r) acc[m][r] *= rinv;
  }
  const float qs = 0.10206207261596577f * 1.4426950408889634f;
  float ss = 0.f;
#pragma unroll
  for (int m = 0; m < 2; ++m)
#pragma unroll
    for (int r = 0; r < 16; ++r) ss += acc[m][r] * acc[m][r];
  ss += xor32(ss);
  const float rn = rsqrtf(ss * (1.f / 64.f) + EPS) * qs;
  u16* qd = Q + (size_t)tok * 768 + hd * 96;
#pragma unroll
  for (int m = 0; m < 2; ++m)
#pragma unroll
    for (int q = 0; q < 4; ++q) {
      const int f0 = m * 32 + 8 * q + 4 * h;
      const float4 g = *(const float4*)(p.qn_nope + layer * 64 + f0);
      *(uint2*)(qd + f0) = make_uint2(pk2(acc[m][4 * q] * rn * g.x, acc[m][4 * q + 1] * rn * g.y), pk2(acc[m][4 * q + 2] * rn * g.z, acc[m][4 * q + 3] * rn * g.w));
    }
  float sr = 0.f;
#pragma unroll
  for (int r = 0; r < 16; ++r) sr += acc[2][r] * acc[2][r];
  sr += xor32(sr);
  const float rr = rsqrtf(sr * (1.f / 32.f) + EPS);
  const int pos = tok_pos(tok);
  float o1[8], o2[8];
#pragma unroll
  for (int r = 0; r < 8; ++r) {
    const int i = crow(r, h);
    const float x1 = acc[2][r] * rr * p.qn_rope[layer * 32 + i];
    const float x2 = acc[2][r + 8] * rr * p.qn_rope[layer * 32 + i + 16];
    float s, c;
    rope_sincos(pos, i, s, c);
    o1[r] = (x1 * c - x2 * s) * qs;
    o2[r] = (x2 * c + x1 * s) * qs;
  }
#pragma unroll
  for (int q = 0; q < 2; ++q) {
    const int i0 = 8 * q + 4 * h;
    *(uint2*)(qd + 64 + i0) = make_uint2(pk2(o1[4 * q], o1[4 * q + 1]), pk2(o1[4 * q + 2], o1[4 * q + 3]));
    *(uint2*)(qd + 64 + 16 + i0) = make_uint2(pk2(o2[4 * q], o2[4 * q + 1]), pk2(o2[4 * q + 2], o2[4 * q + 3]));
  }
}

DI void kvproj_item(const Params& p, int layer, int tt, int hd, int lane) {
  const int l31 = lane & 31, h = lane >> 5;
  const int tok = tt * 32 + l31;
  const u16* zk = (const u16*)(p.ws + WS_Z) + (size_t)tok * NZ + ZC_KV;
  const float* gk = p.kv_norm_w + layer * 128;
  float ssq = 0.f;
  const u16* WT = (const u16*)(p.ws + (size_t)layer * WL_STRIDE + W_UKV);
  u16* KN = (u16*)(p.ws + WS_KN);
  u16* VT = (u16*)(p.ws + WS_VT);
  f32x16 acc[4];
#pragma unroll
  for (int m = 0; m < 4; ++m)
#pragma unroll
    for (int r = 0; r < 16; ++r) acc[m][r] = 0.f;
#pragma unroll 4
  for (int ks = 0; ks < 8; ++ks) {
    const bf16x8 bfr = normed_frag(zk + ks * 16 + h * 8, gk + ks * 16 + h * 8, ssq);
#pragma unroll
    for (int m = 0; m < 4; ++m) {
      const bf16x8 afr = *(const bf16x8*)(WT + (size_t)(hd * 128 + m * 32 + l31) * 128 + ks * 16 + h * 8);
      acc[m] = MFMA32(afr, bfr, acc[m]);
    }
  }
  {
    ssq += xor32(ssq);
    const float rinv = rsqrtf(ssq * (1.f / 128.f) + EPS);
#pragma unroll
    for (int m = 0; m < 4; ++m)
#pragma unroll
      for (int r = 0; r < 16; ++r) acc[m][r] *= rinv;
  }
  float ss = 0.f;
#pragma unroll
  for (int m = 0; m < 2; ++m)
#pragma unroll
    for (int r = 0; r < 16; ++r) ss += acc[m][r] * acc[m][r];
  ss += xor32(ss);
  const float rn = rsqrtf(ss * (1.f / 64.f) + EPS);
  u16* kd = KN + ((size_t)hd * NP + tok) * 64;
#pragma unroll
  for (int m = 0; m < 2; ++m)
#pragma unroll
    for (int q = 0; q < 4; ++q) {
      const int f0 = m * 32 + 8 * q + 4 * h;
      const float4 g = *(const float4*)(p.kn_nope + layer * 64 + f0);
      *(uint2*)(kd + f0) = make_uint2(pk2(acc[m][4 * q] * rn * g.x, acc[m][4 * q + 1] * rn * g.y), pk2(acc[m][4 * q + 2] * rn * g.z, acc[m][4 * q + 3] * rn * g.w));
    }
#pragma unroll
  for (int m = 0; m < 2; ++m)
#pragma unroll
    for (int r = 0; r < 16; ++r) {
      const int d = m * 32 + crow(r, h);
      VT[((size_t)hd * 64 + d) * NP + tok] = f2bf(acc[2 + m][r]);
    }
}

DI void phase_proj(const Params& p, int layer) {
  const int wave = tidx() >> 6, lane = tidx() & 63;
  const int nw = gridDim.x * 4, gw = blockIdx.x * 4 + wave;
  for (int it = gw; it < 544 * 8 + 512 * 8; it += nw) {
    if (it < 544 * 8) qproj_item(p, layer, it >> 3, it & 7, lane);
    else { const int j = it - 544 * 8; kvproj_item(p, layer, j >> 3, j & 7, lane); }
  }
}

DI float wave_max(float v) {
#pragma unroll
  for (int o = 32; o > 0; o >>= 1) v = fmaxf(v, __shfl_xor(v, o));
  return v;
}
DI float attn_bound(const Params& p, int layer, int lane) {
  const float gqn = wave_max(fabsf(p.qn_nope[layer * 64 + lane])), gkn = wave_max(fabsf(p.kn_nope[layer * 64 + lane]));
  const float gqr = wave_max(fabsf(p.qn_rope[layer * 32 + (lane & 31)])), gkr = wave_max(fabsf(p.kn_rope[layer * 32 + (lane & 31)]));
  const float qs = 0.10206207261596577f * 1.4426950408889634f;
  return 1.02f * qs * (64.f * gqn * gkn + 32.f * gqr * gkr) + 0.25f;
}
template <int NSUB>
DI void attn_tile(const bf16x8 (&qf)[6], const u16* sK, const u16* sVT, int ksub0, f32x16 (&o)[2], float& l, float negB, int l31, int h) {
  f32x16 s[NSUB];
  {
    bf16x8 kf[NSUB][6];
#pragma unroll
    for (int i = 0; i < NSUB; ++i)
#pragma unroll
      for (int ks = 0; ks < 6; ++ks) kf[i][ks] = *(const bf16x8*)(sK + ((ksub0 + i) * 32 + l31) * 104 + ks * 16 + h * 8);
#pragma unroll
    for (int i = 0; i < NSUB; ++i)
#pragma unroll
      for (int r = 0; r < 16; ++r) s[i][r] = negB;
    __builtin_amdgcn_s_setprio(1);
#pragma unroll
    for (int i = 0; i < NSUB; ++i)
#pragma unroll
      for (int ks = 0; ks < 6; ++ks) s[i] = MFMA32(kf[i][ks], qf[ks], s[i]);
    __builtin_amdgcn_s_setprio(0);
    __builtin_amdgcn_sched_group_barrier(0x100, 6 * NSUB, 0);
    __builtin_amdgcn_sched_group_barrier(0x008, 6 * NSUB, 0);
  }
  bf16x8 vf[NSUB][2][2];
#pragma unroll
  for (int i = 0; i < NSUB; ++i)
#pragma unroll
    for (int st = 0; st < 2; ++st)
#pragma unroll
      for (int md = 0; md < 2; ++md) {
        const u16* vp = sVT + (md * 32 + l31) * 68 + (ksub0 + i) * 32 + 16 * st + 4 * h;
        const s16x4 lo = *(const s16x4*)vp;
        const s16x4 hi = *(const s16x4*)(vp + 8);
        vf[i][st][md] = __builtin_shufflevector(lo, hi, 0, 1, 2, 3, 4, 5, 6, 7);
      }
  float ps = 0.f;
#pragma unroll
  for (int i = 0; i < NSUB; ++i)
#pragma unroll
    for (int r = 0; r < 16; ++r) {
      const float pv = __builtin_amdgcn_exp2f(s[i][r]);
      ps += pv;
      s[i][r] = pv;
    }
  l += ps;
#pragma unroll
  for (int i = 0; i < NSUB; ++i)
#pragma unroll
    for (int st = 0; st < 2; ++st) {
      u32x4 pu;
      pu.x = pk2(s[i][8 * st + 0], s[i][8 * st + 1]);
      pu.y = pk2(s[i][8 * st + 2], s[i][8 * st + 3]);
      pu.z = pk2(s[i][8 * st + 4], s[i][8 * st + 5]);
      pu.w = pk2(s[i][8 * st + 6], s[i][8 * st + 7]);
      const bf16x8 pf = __builtin_bit_cast(bf16x8, pu);
      __builtin_amdgcn_s_setprio(1);
#pragma unroll
      for (int md = 0; md < 2; ++md) o[md] = MFMA32(vf[i][st][md], pf, o[md]);
      __builtin_amdgcn_s_setprio(0);
    }
}

DI void attn_store(const Params& p, int tok, int hd, const f32x16 (&o)[2], float linv, int h) {
  const u16* gz = (const u16*)(p.ws + WS_Z) + (size_t)tok * NZ + ZC_GA + hd * 64;
  u16* OA = (u16*)(p.ws + WS_OA) + (size_t)tok * 512 + hd * 64;
#pragma unroll
  for (int md = 0; md < 2; ++md)
#pragma unroll
    for (int q = 0; q < 4; ++q) {
      const int d0 = md * 32 + 8 * q + 4 * h;
      const uint2 g = *(const uint2*)(gz + d0);
      const float v0 = o[md][4 * q] * linv * siluf_(lo2f(g.x));
      const float v1 = o[md][4 * q + 1] * linv * siluf_(hi2f(g.x));
      const float v2 = o[md][4 * q + 2] * linv * siluf_(lo2f(g.y));
      const float v3 = o[md][4 * q + 3] * linv * siluf_(hi2f(g.y));
      *(uint2*)(OA + d0) = make_uint2(pk2(v0, v1), pk2(v2, v3));
    }
}

DI void attn_prompt_item(const Params& p, int layer, int qt, int hd, char* smem) {
  u16* sK = (u16*)smem;
  u16* sVT = (u16*)(smem + 13312);
  const int tid = tidx(), lane = tid & 63, w = tid >> 6, l31 = lane & 31, h = lane >> 5;
  const int tok = qt * 128 + w * 32 + l31;
  const u16* Q = (const u16*)(p.ws + WS_Q);
  const u16* KN = (const u16*)(p.ws + WS_KN) + (size_t)hd * NP * 64;
  const u16* KPEB = (const u16*)(p.ws + WS_KPEB);
  const u16* VT = (const u16*)(p.ws + WS_VT) + (size_t)hd * 64 * NP;
  bf16x8 qf[6];
#pragma unroll
  for (int ks = 0; ks < 6; ++ks) qf[ks] = *(const bf16x8*)(Q + (size_t)tok * 768 + hd * 96 + ks * 16 + h * 8);
  f32x16 o[2];
#pragma unroll
  for (int d = 0; d < 2; ++d)
#pragma unroll
    for (int r = 0; r < 16; ++r) o[d][r] = 0.f;
  float l = 0.f;
  const float negB = -attn_bound(p, layer, lane);
  const int nkt = 2 * qt + 2;
  const int my_nkt = (w < 2) ? nkt - 1 : nkt;
  u32x4 pk[2][2], pr[2], pv[2][2];
#define PA_GLOAD(SET, KT)                                                                        \
  {                                                                                              \
    const int key0_ = (KT) * 64;                                                                 \
    _Pragma("unroll") for (int i = 0; i < 2; ++i) {                                              \
      const int c = tid + 256 * i;                                                               \
      pk[SET][i] = *(const u32x4*)(KN + (size_t)(key0_ + (c >> 3)) * 64 + (c & 7) * 8);          \
      pv[SET][i] = *(const u32x4*)(VT + (size_t)(c >> 3) * NP + key0_ + (c & 7) * 8);            \
    }                                                                                            \
    pr[SET] = *(const u32x4*)(KPEB + (size_t)(key0_ + (tid >> 2)) * 32 + (tid & 3) * 8);         \
  }
  PA_GLOAD(0, 0)
  PA_GLOAD(1, 1)
  for (int kt0 = 0; kt0 < nkt; kt0 += 2) {
#pragma unroll
    for (int u = 0; u < 2; ++u) {
      const int kt = kt0 + u;
      __syncthreads();
#pragma unroll
      for (int i = 0; i < 2; ++i) {
        const int c = tid + 256 * i;
        *(u32x4*)(sK + (c >> 3) * 104 + (c & 7) * 8) = pk[u][i];
        u32x2* vd = (u32x2*)(sVT + (c >> 3) * 68 + (c & 7) * 8);
        vd[0] = u32x2{pv[u][i].x, pv[u][i].y};
        vd[1] = u32x2{pv[u][i].z, pv[u][i].w};
      }
      *(u32x4*)(sK + (tid >> 2) * 104 + 64 + (tid & 3) * 8) = pr[u];
      __syncthreads();
      if (kt + 2 < nkt) PA_GLOAD(u, kt + 2)
      if (kt < my_nkt) attn_tile<2>(qf, sK, sVT, 0, o, l, negB, l31, h);
    }
  }
#undef PA_GLOAD
  l += xor32(l);
  attn_store(p, tok, hd, o, 1.f / l, h);
}

DI void attn_sample_item(const Params& p, int layer, int b, int hd, char* smem) {
  u16* sC = (u16*)smem;
  u16* sK = (u16*)(smem + 17408);
  u16* sVT = (u16*)(smem + 17408 + 13312);
  u16* sW = (u16*)(smem + 39424);
  const int tid = tidx(), lane = tid & 63, w = tid >> 6, l31 = lane & 31, h = lane >> 5;
  const int khu = w & 1, part = w >> 1;
  const int qh = w >> 1, kh = w & 1;
  const int tok = NP + b * 64 + qh * 32 + l31;
  const u16* Q = (const u16*)(p.ws + WS_Q);
  const u16* WT = (const u16*)(p.ws + (size_t)layer * WL_STRIDE + W_UKV) + (size_t)hd * 128 * 128;
  __syncthreads();
#pragma unroll
  for (int i = 0; i < 8; ++i) {
    const int c = tid + 256 * i;
    *(u32x4*)(sW + (c >> 4) * 136 + (c & 15) * 8) = *(const u32x4*)(WT + (size_t)c * 8);
  }
  bf16x8 qf[6];
#pragma unroll
  for (int ks = 0; ks < 6; ++ks) qf[ks] = *(const bf16x8*)(Q + (size_t)tok * 768 + hd * 96 + ks * 16 + h * 8);
  f32x16 o[2];
#pragma unroll
  for (int d = 0; d < 2; ++d)
#pragma unroll
    for (int r = 0; r < 16; ++r) o[d][r] = 0.f;
  float l = 0.f;
  const float negB = -attn_bound(p, layer, lane);
  const float* cck = p.cache_ckv + ((size_t)layer * 16 + b) * 4096 * 128;
  const float* ckp = p.cache_kpe + ((size_t)layer * 16 + b) * 4096 * 32;
  const float* nck = p.out + OFF_CKV_S + ((size_t)layer * 16 + b) * 64 * 128;
  const float* nkp = p.out + OFF_KPE_S + ((size_t)layer * 16 + b) * 64 * 32;
  f32x4 pc[8], pp[2];
#define SA_GLOAD(KT)                                                                      \
  {                                                                                       \
    const float* s1_ = ((KT) < 64) ? cck + (size_t)(KT) * 64 * 128 : nck;                 \
    const float* s2_ = ((KT) < 64) ? ckp + (size_t)(KT) * 64 * 32 : nkp;                  \
    _Pragma("unroll") for (int i = 0; i < 8; ++i) pc[i] = *(const f32x4*)(s1_ + (size_t)(tid + 256 * i) * 4); \
    _Pragma("unroll") for (int i = 0; i < 2; ++i) pp[i] = *(const f32x4*)(s2_ + (size_t)(tid + 256 * i) * 4); \
  }
  SA_GLOAD(0)
  for (int kt = 0; kt < 65; ++kt) {
    __syncthreads();
#pragma unroll
    for (int i = 0; i < 8; ++i) {
      const int c = tid + 256 * i;
      *(u32x2*)(sC + (c >> 5) * 136 + (c & 31) * 4) = u32x2{pk2(pc[i].x, pc[i].y), pk2(pc[i].z, pc[i].w)};
    }
#pragma unroll
    for (int i = 0; i < 2; ++i) {
      const int c = tid + 256 * i;
      *(u32x2*)(sK + (c >> 3) * 104 + 64 + (c & 7) * 4) = u32x2{pk2(pp[i].x, pp[i].y), pk2(pp[i].z, pp[i].w)};
    }
    __syncthreads();
    if (kt + 1 < 65) SA_GLOAD(kt + 1)
    {
      f32x16 acc[2];
#pragma unroll
      for (int mt = 0; mt < 2; ++mt)
#pragma unroll
        for (int r = 0; r < 16; ++r) acc[mt][r] = 0.f;
      bf16x8 cfa[8];
#pragma unroll
      for (int ks = 0; ks < 8; ++ks) cfa[ks] = *(const bf16x8*)(sC + (khu * 32 + l31) * 136 + ks * 16 + h * 8);
#pragma unroll
      for (int mt = 0; mt < 2; ++mt) {
        bf16x8 wfa[8];
#pragma unroll
        for (int ks = 0; ks < 8; ++ks) wfa[ks] = *(const bf16x8*)(sW + (part * 64 + mt * 32 + l31) * 136 + ks * 16 + h * 8);
#pragma unroll
        for (int ks = 0; ks < 8; ++ks) acc[mt] = MFMA32(wfa[ks], cfa[ks], acc[mt]);
      }
      if (part == 0) {
        float ss = 0.f;
#pragma unroll
        for (int mt = 0; mt < 2; ++mt)
#pragma unroll
          for (int r = 0; r < 16; ++r) ss += acc[mt][r] * acc[mt][r];
        ss += xor32(ss);
        const float rn = rsqrtf(ss * (1.f / 64.f) + EPS);
#pragma unroll
        for (int mt = 0; mt < 2; ++mt)
#pragma unroll
          for (int q = 0; q < 4; ++q) {
            const int f0 = mt * 32 + 8 * q + 4 * h;
            const float4 g = *(const float4*)(p.kn_nope + layer * 64 + f0);
            *(u32x2*)(sK + (khu * 32 + l31) * 104 + f0) = u32x2{pk2(acc[mt][4 * q] * rn * g.x, acc[mt][4 * q + 1] * rn * g.y), pk2(acc[mt][4 * q + 2] * rn * g.z, acc[mt][4 * q + 3] * rn * g.w)};
          }
      } else {
#pragma unroll
        for (int mt = 0; mt < 2; ++mt)
#pragma unroll
          for (int r = 0; r < 16; ++r) sVT[(mt * 32 + crow(r, h)) * 68 + khu * 32 + l31] = f2bf(acc[mt][r]);
      }
    }
    __syncthreads();
    attn_tile<1>(qf, sK, sVT, kh, o, l, negB, l31, h);
  }
#undef SA_GLOAD
  __syncthreads();
  float* cb = (float*)smem;
  if (kh == 1) {
    float* d = cb + (qh * 64 + lane) * 34;
#pragma unroll
    for (int r = 0; r < 16; ++r) { d[r] = o[0][r]; d[16 + r] = o[1][r]; }
    d[32] = l;
  }
  __syncthreads();
  if (kh == 0) {
    const float* d = cb + (qh * 64 + lane) * 34;
#pragma unroll
    for (int r = 0; r < 16; ++r) { o[0][r] += d[r]; o[1][r] += d[16 + r]; }
    l += d[32];
    l += xor32(l);
    attn_store(p, tok, hd, o, 1.f / l, h);
  }
}

template <int N> DI void fmac_bc(float& acc, float srcvec, float other) {
  asm("v_fmac_f32_dpp %0, %1, %2 row_newbcast:%3 row_mask:0xf bank_mask:0xf" : "+v"(acc) : "v"(srcvec), "v"(other), "n"(N));
}
template <int N> DI float mul_bc(float srcvec, float other) {
  float r;
  asm("v_mul_f32_dpp %0, %1, %2 row_newbcast:%3 row_mask:0xf bank_mask:0xf" : "=v"(r) : "v"(srcvec), "v"(other), "n"(N));
  return r;
}
struct RplRaw { u32x2 r, e, k, a, b; unsigned v; };
template <int MODE> DI void rpl_load(RplRaw& q, const u16* s, int n, int lane) {
  q.e = *(const u32x2*)(s + 64 + 4 * n);
  q.a = *(const u32x2*)(s + 256 + 4 * n);
  q.b = *(const u32x2*)(s + 320 + 4 * n);
  if (MODE >= 1) { q.k = *(const u32x2*)(s + 128 + 4 * n); q.v = s[192 + lane]; }
  if (MODE == 2) q.r = *(const u32x2*)(s + 4 * n);
}
template <int MODE>
DI void rpl_item(const Params& p, int hd, int tok0, int nsteps, const float* Sinit, float* Sout, float* Yg, int lane) {
  const int n = lane & 15;
  float S[64];
  if (MODE == 0) {
#pragma unroll
    for (int k = 0; k < 64; ++k) S[k] = (k == lane) ? 1.f : 0.f;
  } else if (MODE == 1) {
#pragma unroll
    for (int k = 0; k < 64; ++k) S[k] = 0.f;
  } else {
#pragma unroll
    for (int k = 0; k < 64; k += 4) {
      const f32x4 t = *(const f32x4*)(Sinit + (size_t)lane * 64 + k);
      S[k] = t.x; S[k + 1] = t.y; S[k + 2] = t.z; S[k + 3] = t.w;
    }
  }
  const u16* src = (const u16*)(p.ws + WS_WKVIN) + ((size_t)hd * NT + tok0) * 384;
  RplRaw c0, c1, c2;
  rpl_load<MODE>(c0, src, n, lane);
  rpl_load<MODE>(c1, src + 384, n, lane);
  for (int t = 0; t < nsteps; ++t) {
    if (t + 2 < nsteps) rpl_load<MODE>(c2, src + (size_t)(t + 2) * 384, n, lane);
    float A0 = -lo2f(c0.a.x), A1 = -hi2f(c0.a.x), A2 = -lo2f(c0.a.y), A3 = -hi2f(c0.a.y);
    float W0 = __expf(-lo2f(c0.e.x)), W1 = __expf(-hi2f(c0.e.x)), W2 = __expf(-lo2f(c0.e.y)), W3 = __expf(-hi2f(c0.e.y));
    float B0 = lo2f(c0.b.x), B1 = hi2f(c0.b.x), B2 = lo2f(c0.b.y), B3 = hi2f(c0.b.y);
    float K0 = 0.f, K1 = 0.f, K2 = 0.f, K3 = 0.f, R0 = 0.f, R1 = 0.f, R2 = 0.f, R3 = 0.f, vv = 0.f;
    if (MODE >= 1) { K0 = lo2f(c0.k.x); K1 = hi2f(c0.k.x); K2 = lo2f(c0.k.y); K3 = hi2f(c0.k.y); vv = lo2f(c0.v); }
    if (MODE == 2) { R0 = lo2f(c0.r.x); R1 = hi2f(c0.r.x); R2 = lo2f(c0.r.y); R3 = hi2f(c0.r.y); }
    asm volatile("s_nop 1" : "+v"(A0), "+v"(A1), "+v"(A2), "+v"(A3), "+v"(W0), "+v"(W1), "+v"(W2), "+v"(W3), "+v"(B0), "+v"(B1), "+v"(B2), "+v"(B3));
    asm volatile("s_nop 1" : "+v"(K0), "+v"(K1), "+v"(K2), "+v"(K3), "+v"(R0), "+v"(R1), "+v"(R2), "+v"(R3));
    float sa0 = 0.f, sa1 = 0.f, sa2 = 0.f, sa3 = 0.f;
    fmac_bc<0>(sa0, A0, S[0]);
    fmac_bc<0>(sa1, A1, S[1]);
    fmac_bc<0>(sa2, A2, S[2]);
    fmac_bc<0>(sa3, A3, S[3]);
    fmac_bc<1>(sa0, A0, S[4]);
    fmac_bc<1>(sa1, A1, S[5]);
    fmac_bc<1>(sa2, A2, S[6]);
    fmac_bc<1>(sa3, A3, S[7]);
    fmac_bc<2>(sa0, A0, S[8]);
    fmac_bc<2>(sa1, A1, S[9]);
    fmac_bc<2>(sa2, A2, S[10]);
    fmac_bc<2>(sa3, A3, S[11]);
    fmac_bc<3>(sa0, A0, S[12]);
    fmac_bc<3>(sa1, A1, S[13]);
    fmac_bc<3>(sa2, A2, S[14]);
    fmac_bc<3>(sa3, A3, S[15]);
    fmac_bc<4>(sa0, A0, S[16]);
    fmac_bc<4>(sa1, A1, S[17]);
    fmac_bc<4>(sa2, A2, S[18]);
    fmac_bc<4>(sa3, A3, S[19]);
    fmac_bc<5>(sa0, A0, S[20]);
    fmac_bc<5>(sa1, A1, S[21]);
    fmac_bc<5>(sa2, A2, S[22]);
    fmac_bc<5>(sa3, A3, S[23]);
    fmac_bc<6>(sa0, A0, S[24]);
    fmac_bc<6>(sa1, A1, S[25]);
    fmac_bc<6>(sa2, A2, S[26]);
    fmac_bc<6>(sa3, A3, S[27]);
    fmac_bc<7>(sa0, A0, S[28]);
    fmac_bc<7>(sa1, A1, S[29]);
    fmac_bc<7>(sa2, A2, S[30]);
    fmac_bc<7>(sa3, A3, S[31]);
    fmac_bc<8>(sa0, A0, S[32]);
    fmac_bc<8>(sa1, A1, S[33]);
    fmac_bc<8>(sa2, A2, S[34]);
    fmac_bc<8>(sa3, A3, S[35]);
    fmac_bc<9>(sa0, A0, S[36]);
    fmac_bc<9>(sa1, A1, S[37]);
    fmac_bc<9>(sa2, A2, S[38]);
    fmac_bc<9>(sa3, A3, S[39]);
    fmac_bc<10>(sa0, A0, S[40]);
    fmac_bc<10>(sa1, A1, S[41]);
    fmac_bc<10>(sa2, A2, S[42]);
    fmac_bc<10>(sa3, A3, S[43]);
    fmac_bc<11>(sa0, A0, S[44]);
    fmac_bc<11>(sa1, A1, S[45]);
    fmac_bc<11>(sa2, A2, S[46]);
    fmac_bc<11>(sa3, A3, S[47]);
    fmac_bc<12>(sa0, A0, S[48]);
    fmac_bc<12>(sa1, A1, S[49]);
    fmac_bc<12>(sa2, A2, S[50]);
    fmac_bc<12>(sa3, A3, S[51]);
    fmac_bc<13>(sa0, A0, S[52]);
    fmac_bc<13>(sa1, A1, S[53]);
    fmac_bc<13>(sa2, A2, S[54]);
    fmac_bc<13>(sa3, A3, S[55]);
    fmac_bc<14>(sa0, A0, S[56]);
    fmac_bc<14>(sa1, A1, S[57]);
    fmac_bc<14>(sa2, A2, S[58]);
    fmac_bc<14>(sa3, A3, S[59]);
    fmac_bc<15>(sa0, A0, S[60]);
    fmac_bc<15>(sa1, A1, S[61]);
    fmac_bc<15>(sa2, A2, S[62]);
    fmac_bc<15>(sa3, A3, S[63]);
    const float sa = (sa0 + sa1) + (sa2 + sa3);
    float y0 = 0.f, y1 = 0.f, y2 = 0.f, y3 = 0.f;
    S[0] = mul_bc<0>(W0, S[0]);
    S[1] = mul_bc<0>(W1, S[1]);
    S[2] = mul_bc<0>(W2, S[2]);
    S[3] = mul_bc<0>(W3, S[3]);
    S[4] = mul_bc<1>(W0, S[4]);
    S[5] = mul_bc<1>(W1, S[5]);
    S[6] = mul_bc<1>(W2, S[6]);
    S[7] = mul_bc<1>(W3, S[7]);
    if (MODE >= 1) {
      fmac_bc<0>(S[0], K0, vv);
      fmac_bc<0>(S[1], K1, vv);
      fmac_bc<0>(S[2], K2, vv);
      fmac_bc<0>(S[3], K3, vv);
      fmac_bc<1>(S[4], K0, vv);
      fmac_bc<1>(S[5], K1, vv);
      fmac_bc<1>(S[6], K2, vv);
      fmac_bc<1>(S[7], K3, vv);
    }
    fmac_bc<0>(S[0], B0, sa);
    fmac_bc<0>(S[1], B1, sa);
    fmac_bc<0>(S[2], B2, sa);
    fmac_bc<0>(S[3], B3, sa);
    fmac_bc<1>(S[4], B0, sa);
    fmac_bc<1>(S[5], B1, sa);
    fmac_bc<1>(S[6], B2, sa);
    fmac_bc<1>(S[7], B3, sa);
    if (MODE == 2) {
      fmac_bc<0>(y0, R0, S[0]);
      fmac_bc<0>(y1, R1, S[1]);
      fmac_bc<0>(y2, R2, S[2]);
      fmac_bc<0>(y3, R3, S[3]);
      fmac_bc<1>(y0, R0, S[4]);
      fmac_bc<1>(y1, R1, S[5]);
      fmac_bc<1>(y2, R2, S[6]);
      fmac_bc<1>(y3, R3, S[7]);
    }
    S[8] = mul_bc<2>(W0, S[8]);
    S[9] = mul_bc<2>(W1, S[9]);
    S[10] = mul_bc<2>(W2, S[10]);
    S[11] = mul_bc<2>(W3, S[11]);
    S[12] = mul_bc<3>(W0, S[12]);
    S[13] = mul_bc<3>(W1, S[13]);
    S[14] = mul_bc<3>(W2, S[14]);
    S[15] = mul_bc<3>(W3, S[15]);
    if (MODE >= 1) {
      fmac_bc<2>(S[8], K0, vv);
      fmac_bc<2>(S[9], K1, vv);
      fmac_bc<2>(S[10], K2, vv);
      fmac_bc<2>(S[11], K3, vv);
      fmac_bc<3>(S[12], K0, vv);
      fmac_bc<3>(S[13], K1, vv);
      fmac_bc<3>(S[14], K2, vv);
      fmac_bc<3>(S[15], K3, vv);
    }
    fmac_bc<2>(S[8], B0, sa);
    fmac_bc<2>(S[9], B1, sa);
    fmac_bc<2>(S[10], B2, sa);
    fmac_bc<2>(S[11], B3, sa);
    fmac_bc<3>(S[12], B0, sa);
    fmac_bc<3>(S[13], B1, sa);
    fmac_bc<3>(S[14], B2, sa);
    fmac_bc<3>(S[15], B3, sa);
    if (MODE == 2) {
      fmac_bc<2>(y0, R0, S[8]);
      fmac_bc<2>(y1, R1, S[9]);
      fmac_bc<2>(y2, R2, S[10]);
      fmac_bc<2>(y3, R3, S[11]);
      fmac_bc<3>(y0, R0, S[12]);
      fmac_bc<3>(y1, R1, S[13]);
      fmac_bc<3>(y2, R2, S[14]);
      fmac_bc<3>(y3, R3, S[15]);
    }
    S[16] = mul_bc<4>(W0, S[16]);
    S[17] = mul_bc<4>(W1, S[17]);
    S[18] = mul_bc<4>(W2, S[18]);
    S[19] = mul_bc<4>(W3, S[19]);
    S[20] = mul_bc<5>(W0, S[20]);
    S[21] = mul_bc<5>(W1, S[21]);
    S[22] = mul_bc<5>(W2, S[22]);
    S[23] = mul_bc<5>(W3, S[23]);
    if (MODE >= 1) {
      fmac_bc<4>(S[16], K0, vv);
      fmac_bc<4>(S[17], K1, vv);
      fmac_bc<4>(S[18], K2, vv);
      fmac_bc<4>(S[19], K3, vv);
      fmac_bc<5>(S[20], K0, vv);
      fmac_bc<5>(S[21], K1, vv);
      fmac_bc<5>(S[22], K2, vv);
      fmac_bc<5>(S[23], K3, vv);
    }
    fmac_bc<4>(S[16], B0, sa);
    fmac_bc<4>(S[17], B1, sa);
    fmac_bc<4>(S[18], B2, sa);
    fmac_bc<4>(S[19], B3, sa);
    fmac_bc<5>(S[20], B0, sa);
    fmac_bc<5>(S[21], B1, sa);
    fmac_bc<5>(S[22], B2, sa);
    fmac_bc<5>(S[23], B3, sa);
    if (MODE == 2) {
      fmac_bc<4>(y0, R0, S[16]);
      fmac_bc<4>(y1, R1, S[17]);
      fmac_bc<4>(y2, R2, S[18]);
      fmac_bc<4>(y3, R3, S[19]);
      fmac_bc<5>(y0, R0, S[20]);
      fmac_bc<5>(y1, R1, S[21]);
      fmac_bc<5>(y2, R2, S[22]);
      fmac_bc<5>(y3, R3, S[23]);
    }
    S[24] = mul_bc<6>(W0, S[24]);
    S[25] = mul_bc<6>(W1, S[25]);
    S[26] = mul_bc<6>(W2, S[26]);
    S[27] = mul_bc<6>(W3, S[27]);
    S[28] = mul_bc<7>(W0, S[28]);
    S[29] = mul_bc<7>(W1, S[29]);
    S[30] = mul_bc<7>(W2, S[30]);
    S[31] = mul_bc<7>(W3, S[31]);
    if (MODE >= 1) {
      fmac_bc<6>(S[24], K0, vv);
      fmac_bc<6>(S[25], K1, vv);
      fmac_bc<6>(S[26], K2, vv);
      fmac_bc<6>(S[27], K3, vv);
      fmac_bc<7>(S[28], K0, vv);
      fmac_bc<7>(S[29], K1, vv);
      fmac_bc<7>(S[30], K2, vv);
      fmac_bc<7>(S[31], K3, vv);
    }
    fmac_bc<6>(S[24], B0, sa);
    fmac_bc<6>(S[25], B1, sa);
    fmac_bc<6>(S[26], B2, sa);
    fmac_bc<6>(S[27], B3, sa);
    fmac_bc<7>(S[28], B0, sa);
    fmac_bc<7>(S[29], B1, sa);
    fmac_bc<7>(S[30], B2, sa);
    fmac_bc<7>(S[31], B3, sa);
    if (MODE == 2) {
      fmac_bc<6>(y0, R0, S[24]);
      fmac_bc<6>(y1, R1, S[25]);
      fmac_bc<6>(y2, R2, S[26]);
      fmac_bc<6>(y3, R3, S[27]);
      fmac_bc<7>(y0, R0, S[28]);
      fmac_bc<7>(y1, R1, S[29]);
      fmac_bc<7>(y2, R2, S[30]);
      fmac_bc<7>(y3, R3, S[31]);
    }
    S[32] = mul_bc<8>(W0, S[32]);
    S[33] = mul_bc<8>(W1, S[33]);
    S[34] = mul_bc<8>(W2, S[34]);
    S[35] = mul_bc<8>(W3, S[35]);
    S[36] = mul_bc<9>(W0, S[36]);
    S[37] = mul_bc<9>(W1, S[37]);
    S[38] = mul_bc<9>(W2, S[38]);
    S[39] = mul_bc<9>(W3, S[39]);
    if (MODE >= 1) {
      fmac_bc<8>(S[32], K0, vv);
      fmac_bc<8>(S[33], K1, vv);
      fmac_bc<8>(S[34], K2, vv);
      fmac_bc<8>(S[35], K3, vv);
      fmac_bc<9>(S[36], K0, vv);
      fmac_bc<9>(S[37], K1, vv);
      fmac_bc<9>(S[38], K2, vv);
      fmac_bc<9>(S[39], K3, vv);
    }
    fmac_bc<8>(S[32], B0, sa);
    fmac_bc<8>(S[33], B1, sa);
    fmac_bc<8>(S[34], B2, sa);
    fmac_bc<8>(S[35], B3, sa);
    fmac_bc<9>(S[36], B0, sa);
    fmac_bc<9>(S[37], B1, sa);
    fmac_bc<9>(S[38], B2, sa);
    fmac_bc<9>(S[39], B3, sa);
    if (MODE == 2) {
      fmac_bc<8>(y0, R0, S[32]);
      fmac_bc<8>(y1, R1, S[33]);
      fmac_bc<8>(y2, R2, S[34]);
      fmac_bc<8>(y3, R3, S[35]);
      fmac_bc<9>(y0, R0, S[36]);
      fmac_bc<9>(y1, R1, S[37]);
      fmac_bc<9>(y2, R2, S[38]);
      fmac_bc<9>(y3, R3, S[39]);
    }
    S[40] = mul_bc<10>(W0, S[40]);
    S[41] = mul_bc<10>(W1, S[41]);
    S[42] = mul_bc<10>(W2, S[42]);
    S[43] = mul_bc<10>(W3, S[43]);
    S[44] = mul_bc<11>(W0, S[44]);
    S[45] = mul_bc<11>(W1, S[45]);
    S[46] = mul_bc<11>(W2, S[46]);
    S[47] = mul_bc<11>(W3, S[47]);
    if (MODE >= 1) {
      fmac_bc<10>(S[40], K0, vv);
      fmac_bc<10>(S[41], K1, vv);
      fmac_bc<10>(S[42], K2, vv);
      fmac_bc<10>(S[43], K3, vv);
      fmac_bc<11>(S[44], K0, vv);
      fmac_bc<11>(S[45], K1, vv);
      fmac_bc<11>(S[46], K2, vv);
      fmac_bc<11>(S[47], K3, vv);
    }
    fmac_bc<10>(S[40], B0, sa);
    fmac_bc<10>(S[41], B1, sa);
    fmac_bc<10>(S[42], B2, sa);
    fmac_bc<10>(S[43], B3, sa);
    fmac_bc<11>(S[44], B0, sa);
    fmac_bc<11>(S[45], B1, sa);
    fmac_bc<11>(S[46], B2, sa);
    fmac_bc<11>(S[47], B3, sa);
    if (MODE == 2) {
      fmac_bc<10>(y0, R0, S[40]);
      fmac_bc<10>(y1, R1, S[41]);
      fmac_bc<10>(y2, R2, S[42]);
      fmac_bc<10>(y3, R3, S[43]);
      fmac_bc<11>(y0, R0, S[44]);
      fmac_bc<11>(y1, R1, S[45]);
      fmac_bc<11>(y2, R2, S[46]);
      fmac_bc<11>(y3, R3, S[47]);
    }
    S[48] = mul_bc<12>(W0, S[48]);
    S[49] = mul_bc<12>(W1, S[49]);
    S[50] = mul_bc<12>(W2, S[50]);
    S[51] = mul_bc<12>(W3, S[51]);
    S[52] = mul_bc<13>(W0, S[52]);
    S[53] = mul_bc<13>(W1, S[53]);
    S[54] = mul_bc<13>(W2, S[54]);
    S[55] = mul_bc<13>(W3, S[55]);
    if (MODE >= 1) {
      fmac_bc<12>(S[48], K0, vv);
      fmac_bc<12>(S[49], K1, vv);
      fmac_bc<12>(S[50], K2, vv);
      fmac_bc<12>(S[51], K3, vv);
      fmac_bc<13>(S[52], K0, vv);
      fmac_bc<13>(S[53], K1, vv);
      fmac_bc<13>(S[54], K2, vv);
      fmac_bc<13>(S[55], K3, vv);
    }
    fmac_bc<12>(S[48], B0, sa);
    fmac_bc<12>(S[49], B1, sa);
    fmac_bc<12>(S[50], B2, sa);
    fmac_bc<12>(S[51], B3, sa);
    fmac_bc<13>(S[52], B0, sa);
    fmac_bc<13>(S[53], B1, sa);
    fmac_bc<13>(S[54], B2, sa);
    fmac_bc<13>(S[55], B3, sa);
    if (MODE == 2) {
      fmac_bc<12>(y0, R0, S[48]);
      fmac_bc<12>(y1, R1, S[49]);
      fmac_bc<12>(y2, R2, S[50]);
      fmac_bc<12>(y3, R3, S[51]);
      fmac_bc<13>(y0, R0, S[52]);
      fmac_bc<13>(y1, R1, S[53]);
      fmac_bc<13>(y2, R2, S[54]);
      fmac_bc<13>(y3, R3, S[55]);
    }
    S[56] = mul_bc<14>(W0, S[56]);
    S[57] = mul_bc<14>(W1, S[57]);
    S[58] = mul_bc<14>(W2, S[58]);
    S[59] = mul_bc<14>(W3, S[59]);
    S[60] = mul_bc<15>(W0, S[60]);
    S[61] = mul_bc<15>(W1, S[61]);
    S[62] = mul_bc<15>(W2, S[62]);
    S[63] = mul_bc<15>(W3, S[63]);
    if (MODE >= 1) {
      fmac_bc<14>(S[56], K0, vv);
      fmac_bc<14>(S[57], K1, vv);
      fmac_bc<14>(S[58], K2, vv);
      fmac_bc<14>(S[59], K3, vv);
      fmac_bc<15>(S[60], K0, vv);
      fmac_bc<15>(S[61], K1, vv);
      fmac_bc<15>(S[62], K2, vv);
      fmac_bc<15>(S[63], K3, vv);
    }
    fmac_bc<14>(S[56], B0, sa);
    fmac_bc<14>(S[57], B1, sa);
    fmac_bc<14>(S[58], B2, sa);
    fmac_bc<14>(S[59], B3, sa);
    fmac_bc<15>(S[60], B0, sa);
    fmac_bc<15>(S[61], B1, sa);
    fmac_bc<15>(S[62], B2, sa);
    fmac_bc<15>(S[63], B3, sa);
    if (MODE == 2) {
      fmac_bc<14>(y0, R0, S[56]);
      fmac_bc<14>(y1, R1, S[57]);
      fmac_bc<14>(y2, R2, S[58]);
      fmac_bc<14>(y3, R3, S[59]);
      fmac_bc<15>(y0, R0, S[60]);
      fmac_bc<15>(y1, R1, S[61]);
      fmac_bc<15>(y2, R2, S[62]);
      fmac_bc<15>(y3, R3, S[63]);
    }
    if (MODE == 2) Yg[(size_t)t * 512 + lane] = (y0 + y1) + (y2 + y3);
    c0 = c1; c1 = c2;
  }
  if (Sout) {
#pragma unroll
    for (int k = 0; k < 64; k += 4) *(f32x4*)(Sout + (size_t)lane * 64 + k) = f32x4{S[k], S[k + 1], S[k + 2], S[k + 3]};
  }
}

constexpr int RC = 128;
constexpr int NCH = NP / RC;
DI void seqs_item(const Params& p, int layer, int hd, char* smem) {
  float* sS = (float*)smem;
  const int tid = tidx(), lane = tid & 63, w = tid >> 6, l31 = lane & 31, h = lane >> 5, wr = w >> 1, wc = w & 1;
  const float* PQ = (const float*)(p.ws + WS_Y) + (size_t)hd * NCH * 8192;
  float* SS = (float*)(p.ws + WS_H) + (size_t)hd * NCH * 4096;
  const unsigned* pqflag = (const unsigned*)(p.ws + WS_CTR) + 1024 + (layer * 8 + hd) * 64;
  __syncthreads();
  for (int i = tid; i < 64 * 65; i += 256) sS[i] = 0.f;
  for (int i = tid; i < 4096; i += 256) SS[i] = 0.f;
  if (tid == 0) {
    for (int j = 0; j < 5; ++j)
      while (__hip_atomic_load((unsigned*)pqflag + j, __ATOMIC_RELAXED, __HIP_MEMORY_SCOPE_AGENT) == 0u) __builtin_amdgcn_s_sleep(4);
    __builtin_amdgcn_fence(__ATOMIC_ACQUIRE, "agent");
    asm volatile("s_waitcnt vmcnt(0)" ::: "memory");
  }
  __syncthreads();
  float bP[32], bQ[16], nP[32], nQ[16];
#pragma unroll
  for (int ks = 0; ks < 32; ++ks) bP[ks] = PQ[(2 * ks + h) * 64 + 32 * wc + l31];
#pragma unroll
  for (int r = 0; r < 16; ++r) bQ[r] = PQ[4096 + (32 * wr + crow(r, h)) * 64 + 32 * wc + l31];
  for (int c = 0; c < NCH; ++c) {
    if ((c & 7) == 0 && c > 0) {
      if (tid == 0) {
        const int j0 = c >> 1, j1 = (c + 8 < NCH) ? j0 + 5 : j0 + 4;
        for (int j = j0; j < j1; ++j)
          while (__hip_atomic_load((unsigned*)pqflag + j, __ATOMIC_RELAXED, __HIP_MEMORY_SCOPE_AGENT) == 0u) __builtin_amdgcn_s_sleep(4);
        __builtin_amdgcn_fence(__ATOMIC_ACQUIRE, "agent");
        asm volatile("s_waitcnt vmcnt(0)" ::: "memory");
      }
      __syncthreads();
    }
    if (c + 1 < NCH) {
      const float* Pn = PQ + (size_t)(c + 1) * 8192;
#pragma unroll
      for (int ks = 0; ks < 32; ++ks) nP[ks] = Pn[(2 * ks + h) * 64 + 32 * wc + l31];
#pragma unroll
      for (int r = 0; r < 16; ++r) nQ[r] = Pn[4096 + (32 * wr + crow(r, h)) * 64 + 32 * wc + l31];
    }
    f32x16 acc;
#pragma unroll
    for (int r = 0; r < 16; ++r) acc[r] = bQ[r];
    float a[32];
#pragma unroll
    for (int ks = 0; ks < 32; ++ks) a[ks] = sS[(32 * wr + l31) * 65 + 2 * ks + h];
#pragma unroll
    for (int ks = 0; ks < 32; ++ks) acc = __builtin_amdgcn_mfma_f32_32x32x2f32(a[ks], bP[ks], acc, 0, 0, 0);
    __syncthreads();
    float* dst = (c + 1 < NCH) ? SS + (size_t)(c + 1) * 4096 : p.out + OFF_WKV_P + ((size_t)layer * 8 + hd) * 4096;
#pragma unroll
    for (int r = 0; r < 16; ++r) {
      const int row = 32 * wr + crow(r, h), col = 32 * wc + l31;
      sS[row * 65 + col] = acc[r];
      dst[row * 64 + col] = acc[r];
    }
    __syncthreads();
#pragma unroll
    for (int ks = 0; ks < 32; ++ks) bP[ks] = nP[ks];
#pragma unroll
    for (int r = 0; r < 16; ++r) bQ[r] = nQ[r];
  }
}

DI void phase_mix(const Params& p, int layer, char* smem, int* s_item) {
  constexpr int NQ_PQ = NCH * 2 / 4, NQ_SY = 4, NQ_SATT = 16, NQ_PATT = 128;
  int* qctr = (int*)(p.ws + WS_CTR) + 64 + layer * 8;
  int* actr = (int*)(p.ws + WS_CTR) + 192 + layer * 8;
  if (blockIdx.x < 8) { seqs_item(p, layer, blockIdx.x, smem); return; }
  const int home = blockIdx.x & 7;
  const int first = (blockIdx.x >> 3) & 1;
  for (int pass = 0; pass < 2; ++pass) {
    const int kind = pass ^ first;
    for (int qi = 0; qi < 8; ++qi) {
      const int hd = (home + qi) & 7;
      for (;;) {
        __syncthreads();
        if (tidx() == 0) *s_item = atomicAdd((kind == 0 ? qctr : actr) + hd, 1);
        __syncthreads();
        const int it = *s_item;
        const int wave = __builtin_amdgcn_readfirstlane(tidx() >> 6), lane = tidx() & 63;
        if (kind == 0) {
          if (it >= NQ_PQ + NQ_SY) break;
          if (it < NQ_PQ) {
            const int q = it * 4 + wave, mode = q & 1, ch = q >> 1;
            float* dstm = (float*)(p.ws + WS_Y) + ((size_t)(hd * NCH + ch) * 2 + mode) * 4096;
            if (mode == 0) rpl_item<0>(p, hd, ch * RC, RC, nullptr, dstm, nullptr, lane);
            else rpl_item<1>(p, hd, ch * RC, RC, nullptr, dstm, nullptr, lane);
            asm volatile("s_waitcnt vmcnt(0)" ::: "memory");
            __syncthreads();
            if (tidx() == 0) {
              __builtin_amdgcn_fence(__ATOMIC_RELEASE, "agent");
              asm volatile("s_waitcnt vmcnt(0)" ::: "memory");
              __hip_atomic_store((unsigned*)(p.ws + WS_CTR) + 1024 + (layer * 8 + hd) * 64 + it, 1u, __ATOMIC_RELAXED, __HIP_MEMORY_SCOPE_AGENT);
            }
            continue;
          }
          const int b = (it - NQ_PQ) * 4 + wave;
          rpl_item<2>(p, hd, NP + b * 64, 64, p.state_wkv + (((size_t)layer * 16 + b) * 8 + hd) * 4096,
                      p.out + OFF_WKV_S + (((size_t)layer * 16 + b) * 8 + hd) * 4096, (float*)(p.ws + WS_Y) + (size_t)(NP + b * 64) * 512 + hd * 64, lane);
        } else {
          if (it >= NQ_SATT + NQ_PATT) break;
          if (it < NQ_SATT) { attn_sample_item(p, layer, it, hd, smem); continue; }
          attn_prompt_item(p, layer, 127 - (it - NQ_SATT), hd, smem);
        }
      }
    }
  }
}
DI void phase_ypass(const Params& p, int layer) {
  const int wave = __builtin_amdgcn_readfirstlane(tidx() >> 6), lane = tidx() & 63;
  const int hd = blockIdx.x & 7, nb = (gridDim.x + 7 - hd) >> 3;
  for (int j = blockIdx.x >> 3; j < NCH / 4; j += nb) {
    const int ch = j * 4 + wave;
    rpl_item<2>(p, hd, ch * RC, RC, (const float*)(p.ws + WS_H) + (size_t)(hd * NCH + ch) * 4096, nullptr,
                (float*)(p.ws + WS_Y) + (size_t)(ch * RC) * 512 + hd * 64, lane);
  }
}

DI void phase_ob(const Params& p, int layer) {
  const int wave = tidx() >> 6, lane = tidx() & 63;
  const float* Y = (const float*)(p.ws + WS_Y);
  const u16* WK = (const u16*)(p.ws + WS_WKVIN);
  const u16* Z = (const u16*)(p.ws + WS_Z);
  u16* OB = (u16*)(p.ws + WS_Q);
  const int f = lane * 8, hd = lane >> 3, fl = (lane & 7) * 8;
  for (int t = blockIdx.x * 4 + wave; t < NT; t += gridDim.x * 4) {
    const float4 ya = *(const float4*)(Y + (size_t)t * 512 + f);
    const float4 yb = *(const float4*)(Y + (size_t)t * 512 + f + 4);
    float y[8] = {ya.x, ya.y, ya.z, ya.w, yb.x, yb.y, yb.z, yb.w};
    float s = 0.f;
#pragma unroll
    for (int j = 0; j < 8; ++j) s += y[j];
    s += __shfl_xor(s, 1); s += __shfl_xor(s, 2); s += __shfl_xor(s, 4);
    const float mu = s * (1.f / 64.f);
    float vs = 0.f;
#pragma unroll
    for (int j = 0; j < 8; ++j) { y[j] -= mu; vs += y[j] * y[j]; }
    vs += __shfl_xor(vs, 1); vs += __shfl_xor(vs, 2); vs += __shfl_xor(vs, 4);
    const float rs = rsqrtf(vs * (1.f / 64.f) + GN_EPS);
    const u16* wk = WK + ((size_t)hd * NT + t) * 384 + fl;
    const uint4 r8 = *(const uint4*)(wk + 0 * 64);
    const uint4 k8 = *(const uint4*)(wk + 2 * 64);
    const uint4 v8 = *(const uint4*)(wk + 3 * 64);
    const float rr[8] = {lo2f(r8.x), hi2f(r8.x), lo2f(r8.y), hi2f(r8.y), lo2f(r8.z), hi2f(r8.z), lo2f(r8.w), hi2f(r8.w)};
    const float kk[8] = {lo2f(k8.x), hi2f(k8.x), lo2f(k8.y), hi2f(k8.y), lo2f(k8.z), hi2f(k8.z), lo2f(k8.w), hi2f(k8.w)};
    const float vv[8] = {lo2f(v8.x), hi2f(v8.x), lo2f(v8.y), hi2f(v8.y), lo2f(v8.z), hi2f(v8.z), lo2f(v8.w), hi2f(v8.w)};
    const float4 rka = *(const float4*)(p.r_k + layer * 512 + f);
    const float4 rkb = *(const float4*)(p.r_k + layer * 512 + f + 4);
    const float rk[8] = {rka.x, rka.y, rka.z, rka.w, rkb.x, rkb.y, rkb.z, rkb.w};
    float bs = 0.f;
#pragma unroll
    for (int j = 0; j < 8; ++j) bs += rr[j] * kk[j] * rk[j];
    bs += __shfl_xor(bs, 1); bs += __shfl_xor(bs, 2); bs += __shfl_xor(bs, 4);
    const float4 lwa = *(const float4*)(p.lnx_w + layer * 512 + f);
    const float4 lwb = *(const float4*)(p.lnx_w + layer * 512 + f + 4);
    const float4 lba = *(const float4*)(p.lnx_b + layer * 512 + f);
    const float4 lbb = *(const float4*)(p.lnx_b + layer * 512 + f + 4);
    const float lw[8] = {lwa.x, lwa.y, lwa.z, lwa.w, lwb.x, lwb.y, lwb.z, lwb.w};
    const float lb[8] = {lba.x, lba.y, lba.z, lba.w, lbb.x, lbb.y, lbb.z, lbb.w};
    const uint4 g8 = *(const uint4*)(Z + (size_t)t * NZ + ZC_GB + f);
    const float gg[8] = {lo2f(g8.x), hi2f(g8.x), lo2f(g8.y), hi2f(g8.y), lo2f(g8.z), hi2f(g8.z), lo2f(g8.w), hi2f(g8.w)};
    float ov[8];
#pragma unroll
    for (int j = 0; j < 8; ++j) ov[j] = (y[j] * rs * lw[j] + lb[j] + bs * vv[j]) * siluf_(gg[j]);
    *(uint4*)(OB + (size_t)t * 512 + f) = make_uint4(pk2(ov[0], ov[1]), pk2(ov[2], ov[3]), pk2(ov[4], ov[5]), pk2(ov[6], ov[7]));
  }
}

DI void phase_merge(const Params& p, int layer, char* smem) {
  const u16* OA = (const u16*)(p.ws + WS_OA);
  const u16* OB = (const u16*)(p.ws + WS_Q);
  const u16* WA = (const u16*)(p.ws + (size_t)layer * WL_STRIDE + W_OA);
  const u16* WB = (const u16*)(p.ws + (size_t)layer * WL_STRIDE + W_OB);
  const u16* Z = (const u16*)(p.ws + WS_Z);
  u16* M = (u16*)(p.ws + WS_H);
  const int xcd = blockIdx.x & 7, jb = blockIdx.x >> 3, nb = (gridDim.x + 7 - xcd) >> 3;
  for (int m = jb; m < 16 * 8; m += nb) {
    const int tt = xcd + 8 * (m >> 3), ft = m & 7;
    f32x16 acc[2][2];
    zero_acc(acc);
    gemm_mainloop(OA + (size_t)tt * 128 * 512, 512, WA + (size_t)ft * 128 * 512, 512, 512, smem, acc);
    acc_to_lds(acc, smem);
    EPI_ROWS({
      const u32x2 g = *(const u32x2*)(Z + (size_t)(tt * 128 + row) * NZ + ZC_MA + ft * 128 + col);
      *(u32x2*)(M + (size_t)(tt * 128 + row) * 1024 + ft * 128 + col) =
          u32x2{pk2(v.x * sigmoidf_(lo2f(g.x)), v.y * sigmoidf_(hi2f(g.x))), pk2(v.z * sigmoidf_(lo2f(g.y)), v.w * sigmoidf_(hi2f(g.y)))};
    })
    zero_acc(acc);
    gemm_mainloop(OB + (size_t)tt * 128 * 512, 512, WB + (size_t)ft * 128 * 512, 512, 512, smem, acc);
    acc_to_lds(acc, smem);
    EPI_ROWS({
      const u32x2 g = *(const u32x2*)(Z + (size_t)(tt * 128 + row) * NZ + ZC_MB + ft * 128 + col);
      u32x2* mp = (u32x2*)(M + (size_t)(tt * 128 + row) * 1024 + ft * 128 + col);
      const u32x2 pm = *mp;
      *mp = u32x2{pk2(lo2f(pm.x) + v.x * sigmoidf_(lo2f(g.x)), hi2f(pm.x) + v.y * sigmoidf_(hi2f(g.x))),
                  pk2(lo2f(pm.y) + v.z * sigmoidf_(lo2f(g.y)), hi2f(pm.y) + v.w * sigmoidf_(hi2f(g.y)))};
    })
  }
  for (int m = jb; m < 2 * 16; m += nb) {
    const int r0 = (128 + xcd) * 128 + (m >> 4) * 64, c0 = (m & 15) * 64;
    f32x16 acc;
#pragma unroll
    for (int r = 0; r < 16; ++r) acc[r] = 0.f;
    gemm64_mainloop(OA + (size_t)r0 * 512, 512, WA + (size_t)c0 * 512, 512, 512, smem, acc);
    acc64_to_lds(acc, smem);
    EPI64_ROWS({
      const u32x2 g = *(const u32x2*)(Z + (size_t)(r0 + row) * NZ + ZC_MA + c0 + col);
      *(u32x2*)(M + (size_t)(r0 + row) * 1024 + c0 + col) =
          u32x2{pk2(v.x * sigmoidf_(lo2f(g.x)), v.y * sigmoidf_(hi2f(g.x))), pk2(v.z * sigmoidf_(lo2f(g.y)), v.w * sigmoidf_(hi2f(g.y)))};
    })
#pragma unroll
    for (int r = 0; r < 16; ++r) acc[r] = 0.f;
    gemm64_mainloop(OB + (size_t)r0 * 512, 512, WB + (size_t)c0 * 512, 512, 512, smem, acc);
    acc64_to_lds(acc, smem);
    EPI64_ROWS({
      const u32x2 g = *(const u32x2*)(Z + (size_t)(r0 + row) * NZ + ZC_MB + c0 + col);
      u32x2* mp = (u32x2*)(M + (size_t)(r0 + row) * 1024 + c0 + col);
      const u32x2 pm = *mp;
      *mp = u32x2{pk2(lo2f(pm.x) + v.x * sigmoidf_(lo2f(g.x)), hi2f(pm.x) + v.y * sigmoidf_(hi2f(g.x))),
                  pk2(lo2f(pm.y) + v.z * sigmoidf_(lo2f(g.y)), hi2f(pm.y) + v.w * sigmoidf_(hi2f(g.y)))};
    })
  }
}

DI void phase_out(const Params& p, int layer, char* smem) {
  const u16* M = (const u16*)(p.ws + WS_H);
  const u16* W = (const u16*)(p.ws + (size_t)layer * WL_STRIDE + W_O);
  const int xcd = blockIdx.x & 7, jb = blockIdx.x >> 3, nb = (gridDim.x + 7 - xcd) >> 3;
  for (int m = jb; m < 16 * 8; m += nb) {
    const int tt = xcd + 8 * (m >> 3), ft = m & 7;
    f32x16 acc[2][2];
    zero_acc(acc);
    gemm_mainloop(M + (size_t)tt * 128 * 1024, 1024, W + (size_t)ft * 128 * 1024, 1024, 1024, smem, acc);
    acc_to_lds(acc, smem);
    EPI_ROWS({
      const int t = tt * 128 + row, n = ft * 128 + col;
      const f32x4 xo = *(const f32x4*)(xrow(p, layer, t) + n);
      *(f32x4*)(p.out + (size_t)t * 1024 + n) = xo + v;
    })
  }
  for (int m = jb; m < 2 * 16; m += nb) {
    const int r0 = (128 + xcd) * 128 + (m >> 4) * 64, c0 = (m & 15) * 64;
    f32x16 acc;
#pragma unroll
    for (int r = 0; r < 16; ++r) acc[r] = 0.f;
    gemm64_mainloop(M + (size_t)r0 * 1024, 1024, W + (size_t)c0 * 1024, 1024, 1024, smem, acc);
    acc64_to_lds(acc, smem);
    EPI64_ROWS({
      const int t = r0 + row, n = c0 + col;
      const f32x4 xo = *(const f32x4*)(xrow(p, layer, t) + n);
      *(f32x4*)(p.out + (size_t)t * 1024 + n) = xo + v;
    })
  }
}

#define XB_TMO      128
#define XB_XCNT(j)  (256  + 64 * (j))
#define XB_XSUB(j)  (1280 + 64 * (j))
#define XB_XGEN(j)  (2304 + 64 * (j))
#define XB_TOP      3328
#define XB_TOPGEN   3392
#define XCD_BAR_WORDS 3456
#define XB_SPIN_CAP (1u << 22)
#define LAS __attribute__((address_space(3)))
DI unsigned xb_ld(unsigned* p) { return __hip_atomic_load(p, __ATOMIC_RELAXED, __HIP_MEMORY_SCOPE_AGENT); }
DI unsigned xb_add(unsigned* p, unsigned v) { return __hip_atomic_fetch_add(p, v, __ATOMIC_RELAXED, __HIP_MEMORY_SCOPE_AGENT); }
DI unsigned xb_xcc_id() { return (unsigned)__builtin_amdgcn_s_getreg((3 << 11) | 20) & 0xFu; }
#define XB_SPIN(cond, bar) do { unsigned _sp = 0; while (cond) { __builtin_amdgcn_s_sleep(1); \
    if ((++_sp & 255u) == 0u) { if (xb_ld(&(bar)[XB_TMO])) break; if (_sp > XB_SPIN_CAP) { atomicAdd(&(bar)[XB_TMO], 1u); break; } } } } while (0)
struct XcdBarrier { unsigned* bar; unsigned x; volatile LAS unsigned* st; };
DI XcdBarrier xcd_barrier_post(unsigned* bar, volatile LAS unsigned* st) {
  XcdBarrier b; b.bar = bar; b.x = xb_xcc_id(); b.st = st;
  if (threadIdx.x == 0) (void)xb_add(&bar[XB_XCNT(b.x)], 1u);
  return b;
}
DI void xcd_barrier_complete(unsigned* bar, unsigned x, unsigned& nloc, unsigned& nx) {
  const unsigned G = gridDim.x * gridDim.y * gridDim.z;
  unsigned sum, cnt, mine, sp = 0u;
  for (;;) {
    sum = 0u; cnt = 0u; mine = 0u;
#pragma unroll
    for (unsigned j = 0; j < 16; ++j) { const unsigned c = xb_ld(&bar[XB_XCNT(j)]); sum += c; cnt += (c > 0u) ? 1u : 0u; mine = (j == x) ? c : mine; }
    if (sum == G) break;
    __builtin_amdgcn_s_sleep(1);
    if ((++sp & 255u) == 0u) { if (xb_ld(&bar[XB_TMO])) break; if (sp > XB_SPIN_CAP) { atomicAdd(&bar[XB_TMO], 1u); break; } }
  }
  nloc = mine > 0u ? mine : 1u; nx = cnt > 0u ? cnt : 1u;
}
DI void xcd_barrier(const XcdBarrier& b) {
  asm volatile("s_waitcnt vmcnt(0)" ::: "memory");
  __syncthreads();
  if (threadIdx.x == 0) {
    unsigned* bar = b.bar;
    __builtin_amdgcn_s_waitcnt(0);
    unsigned nloc = b.st[0], nx = b.st[1];
    if (nloc == 0u) { xcd_barrier_complete(bar, b.x, nloc, nx); b.st[0] = nloc; b.st[1] = nx; }
    const unsigned old = xb_add(&bar[XB_XSUB(b.x)], 1u);
    const unsigned gen = old / nloc;
    if (old + 1u == (gen + 1u) * nloc) {
      __builtin_amdgcn_fence(__ATOMIC_RELEASE, "agent");
      asm volatile("s_waitcnt vmcnt(0)" ::: "memory");
      const unsigned og = xb_add(&bar[XB_TOP], 1u);
      const unsigned tg = og / nx;
      if (og + 1u == (tg + 1u) * nx) xb_add(&bar[XB_TOPGEN], 1u);
      else XB_SPIN(xb_ld(&bar[XB_TOPGEN]) == tg, bar);
      __builtin_amdgcn_fence(__ATOMIC_ACQUIRE, "agent");
      xb_add(&bar[XB_XGEN(b.x)], 1u);
      asm volatile("s_waitcnt vmcnt(0)" ::: "memory");
    } else {
      XB_SPIN(xb_ld(&bar[XB_XGEN(b.x)]) == gen, bar);
      __builtin_amdgcn_fence(__ATOMIC_ACQUIRE, "agent");
      asm volatile("s_waitcnt vmcnt(0)" ::: "memory");
    }
  }
  __syncthreads();
}

constexpr int PH_PER_LAYER = 8;
constexpr int N_PHASES = 1 + 4 * PH_PER_LAYER;

DI void run_phase(const Params& p, int ph, char* smem, int* s_item) {
#ifndef PHMASK
#define PHMASK 0x3FF
#endif
  if (ph == 0) { if (PHMASK & 0x100) phase_convert(p, smem); return; }
  const int layer = (ph - 1) / PH_PER_LAYER, sub = (ph - 1) % PH_PER_LAYER;
  switch (sub) {
    case 0: if (PHMASK & 1) phase_rmsnorm(p, layer); break;
    case 1: if (PHMASK & 2) phase_g1(p, layer, smem); break;
    case 2: if (PHMASK & 4) phase_norms_prep(p, layer, smem, s_item); break;
    case 3: if (PHMASK & 16) phase_mix(p, layer, smem, s_item); break;
    case 4: if (PHMASK & 16) phase_ypass(p, layer); break;
    case 5: if (PHMASK & 32) phase_ob(p, layer); break;
    case 6: if (PHMASK & 64) phase_merge(p, layer, smem); break;
    default: if (PHMASK & 128) phase_out(p, layer, smem); break;
  }
}

__global__ void __launch_bounds__(256, 2) mk_kernel(Params p, int ph0, int ph1, int coop) {
  __shared__ __attribute__((aligned(16))) char smem[SMEM_BYTES];
  __shared__ int s_item[4];
  __shared__ uint4 xb_words;
  if (threadIdx.x == 0) xb_words = make_uint4(0u, 0u, 0u, 0u);
  __syncthreads();
  XcdBarrier xb = xcd_barrier_post((unsigned*)(p.ws + WS_BAR), (volatile LAS unsigned*)&xb_words);
  for (int ph = ph0; ph < ph1; ++ph) {
    run_phase(p, ph, smem, s_item);
    if (coop && ph + 1 < ph1) {
      xcd_barrier(xb);
      if (coop == 0x5a5a5a) cg::this_grid().sync();
    }
  }
}

extern "C" void kernel_launch(void* const* d_in, const int* in_sizes, int n_in, void* d_out, int out_size, void* d_ws, size_t ws_size,
                              hipStream_t stream) {
  static int grid_blocks = 0;
  if (!grid_blocks) {
    int dev = 0, cus = 0, per_cu = 0;
    hipGetDevice(&dev);
    hipDeviceGetAttribute(&cus, hipDeviceAttributeMultiprocessorCount, dev);
    hipOccupancyMaxActiveBlocksPerMultiprocessor(&per_cu, mk_kernel, 256, 0);
    if (per_cu < 1) per_cu = 1;
    if (per_cu > 2) per_cu = 2;
    grid_blocks = cus * per_cu;
  }
  Params p{};
  const float** pp = (const float**)&p;
  for (int i = 0; i < 29; ++i) pp[i] = (const float*)d_in[i];
  p.out = (float*)d_out;
  p.ws = (char*)d_ws;
  const int ONE_LAUNCH = 1;
  hipMemsetAsync((char*)d_ws + WS_CTR, 0, 16384 + XCD_BAR_WORDS * 4, stream);
  if (ONE_LAUNCH) {
    int ph0 = 0, ph1 = N_PHASES, coop = 1;
    void* args[] = {&p, &ph0, &ph1, &coop};
    hipError_t e = hipLaunchCooperativeKernel((void*)mk_kernel, dim3(grid_blocks), dim3(256), args, 0, stream);
    if (e != hipSuccess) fprintf(stderr, "cooperative launch failed: %s (grid %d)\n", hipGetErrorString(e), grid_blocks);
  } else {
    for (int ph = 0; ph < N_PHASES; ++ph) mk_kernel<<<dim3(grid_blocks), dim3(256), 0, stream>>>(p, ph, ph + 1, 0);
  }
}
```

```cpp
#include <hip/hip_runtime.h>
#include <hip/hip_cooperative_groups.h>
#include <cstdio>
namespace cg = cooperative_groups;

#define DI __device__ __forceinline__
typedef unsigned short u16;
typedef __attribute__((ext_vector_type(8))) short bf16x8;
typedef __attribute__((ext_vector_type(4))) short s16x4;
typedef __attribute__((ext_vector_type(2))) __bf16 bf2_t;
typedef __attribute__((ext_vector_type(2))) float f2_t;
typedef __attribute__((ext_vector_type(16))) float f32x16;
typedef __attribute__((ext_vector_type(4))) unsigned u32x4;
typedef __attribute__((ext_vector_type(2))) unsigned u32x2;
typedef __attribute__((ext_vector_type(4))) float f32x4;
#define MFMA32(a, b, c) __builtin_amdgcn_mfma_f32_32x32x16_bf16((a), (b), (c), 0, 0, 0)

constexpr int NP = 16384;
constexpr int NSM = 1024;
constexpr int NT = NP + NSM;
constexpr int NZ = 5248;
constexpr int ZC_KV = 256, ZC_KPE = 384, ZC_GA = 512, ZC_ZS = 1024, ZC_GB = 2688, ZC_MA = 3200, ZC_MB = 4224;
constexpr float EPS = 1e-6f;
constexpr float GN_EPS = 64e-5f;
constexpr int SHW = 1664;

constexpr size_t OFF_CKV_P = 17825792;
constexpr size_t OFF_KPE_P = 26214400;
constexpr size_t OFF_WKV_P = 28311552;
constexpr size_t OFF_SH_P = 28442624;
constexpr size_t OFF_CKV_S = 28449280;
constexpr size_t OFF_KPE_S = 28973568;
constexpr size_t OFF_WKV_S = 29104640;
constexpr size_t OFF_SH_S = 31201792;

constexpr size_t WL_STRIDE = 15728640;
constexpr size_t W_IN = 0, W_UQ = 10747904, W_UKV = 11141120, W_W2 = 11403264, W_A2 = 11468800, W_OA = 11534336, W_OB = 12582912, W_O = 13631488;
constexpr size_t WS_H = 62914560;
constexpr size_t WS_Z = WS_H + 35651584;
constexpr size_t WS_Q = WS_Z + 182714368;
constexpr size_t WS_CKVB = WS_Q + 26738688;
constexpr size_t WS_KPEB = WS_CKVB + 4456448;
constexpr size_t WS_KN = WS_KPEB + 1114112;
constexpr size_t WS_VT = WS_KN + 16777216;
constexpr size_t WS_WKVIN = WS_VT + 16777216;
constexpr size_t WS_OA = WS_WKVIN + 106954752;
constexpr size_t WS_Y = WS_OA + 17825792;
constexpr size_t WS_CTR = WS_Y + 35651584;
constexpr size_t WS_BAR = WS_CTR + 16384;
constexpr size_t WS_SH0 = WS_BAR + 16384;
constexpr size_t WS_CKB = WS_SH0 + 65536;
constexpr size_t WS_KPB = WS_CKB + 16777216;
constexpr size_t WS_TOTAL = WS_KPB + 4194304;
static_assert(WS_TOTAL < 536870912, "ws");

constexpr int SMEM_BYTES = 39424 + 128 * 136 * 2;

struct Params {
  const float *x_prompt, *x_sample, *cache_ckv, *cache_kpe, *state_wkv, *state_shift;
  const float *norm_w, *w_in, *q_norm_w, *kv_norm_w, *w_uq, *w_ukv, *qn_nope, *qn_rope, *kn_nope, *kn_rope;
  const float *mu_shift, *w0, *w2, *a0, *a2, *k_k, *k_a, *r_k, *lnx_w, *lnx_b, *w_out_a, *w_out_b, *w_o;
  float* out;
  char* ws;
};

__device__ const float ROPE_INV[16] = {1.0f, 0.5623413324356079f, 0.3162277638912201f, 0.17782793939113617f, 0.10000000149011612f, 0.05623413249850273f, 0.03162277489900589f, 0.017782794311642647f, 0.009999999776482582f, 0.005623413249850273f, 0.003162277629598975f, 0.0017782794311642647f, 0.0010000000474974513f, 0.000562341301701963f, 0.0003162277571391314f, 0.00017782794020604342f};

DI int tidx() { int t = threadIdx.x; asm volatile("" : "+v"(t)); return t; }
DI float bf2f(u16 h) { return __uint_as_float(((unsigned)h) << 16); }
DI unsigned pk2(float a, float b) { f2_t v = {a, b}; bf2_t r = __builtin_convertvector(v, bf2_t); return __builtin_bit_cast(unsigned, r); }
DI u16 f2bf(float a) { return (u16)(pk2(a, 0.f) & 0xffffu); }
DI float lo2f(unsigned u) { return __uint_as_float(u << 16); }
DI float hi2f(unsigned u) { return __uint_as_float(u & 0xffff0000u); }
DI float wave_sum(float v) {
  v += __builtin_bit_cast(float, __builtin_amdgcn_update_dpp(0, __builtin_bit_cast(int, v), 0x128, 0xF, 0xF, false));
  v += __builtin_bit_cast(float, __builtin_amdgcn_update_dpp(0, __builtin_bit_cast(int, v), 0x124, 0xF, 0xF, false));
  v += __builtin_bit_cast(float, __builtin_amdgcn_update_dpp(0, __builtin_bit_cast(int, v), 0x122, 0xF, 0xF, false));
  v += __builtin_bit_cast(float, __builtin_amdgcn_update_dpp(0, __builtin_bit_cast(int, v), 0x121, 0xF, 0xF, false));
  const int iv = __builtin_bit_cast(int, v);
  const float s0 = __builtin_bit_cast(float, __builtin_amdgcn_readlane(iv, 0)), s1 = __builtin_bit_cast(float, __builtin_amdgcn_readlane(iv, 16));
  const float s2 = __builtin_bit_cast(float, __builtin_amdgcn_readlane(iv, 32)), s3 = __builtin_bit_cast(float, __builtin_amdgcn_readlane(iv, 48));
  return (s0 + s1) + (s2 + s3);
}
DI float xor32(float v) { return __shfl_xor(v, 32); }
DI int crow(int reg, int h) { return (reg & 3) + 8 * (reg >> 2) + 4 * h; }
DI float sigmoidf_(float x) { return 1.f / (1.f + __expf(-x)); }
DI float siluf_(float x) { return x / (1.f + __expf(-x)); }
DI void rope_sincos(int pos, int i, float& s, float& c) {
  float ang = (float)pos * ROPE_INV[i];
  double rev = (double)ang * 0.15915494309189533577;
  double fr = rev - rint(rev);
  float f = (float)fr;
  s = __builtin_amdgcn_sinf(f);
  c = __builtin_amdgcn_cosf(f);
}
DI const float* xrow(const Params& p, int layer, int t) {
  if (layer == 0) return (t < NP) ? p.x_prompt + (size_t)t * 1024 : p.x_sample + (size_t)(t - NP) * 1024;
  return p.out + (size_t)t * 1024;
}
DI int tok_pos(int t) { return (t < NP) ? t : 4096 + ((t - NP) & 63); }

DI void conv_tile(const float* __restrict__ src, int N, u16* __restrict__ dst, int K, int k0, int n0, int kind, float* sm) {
  const int tid = tidx();
  const int nl = tid & 63, kb = tid >> 6;
  const int np_ = n0 + nl;
  int sc = np_;
  if (kind == 1) sc = (np_ < 416) ? np_ : ((np_ < 512) ? -1 : np_ - 96);
#pragma unroll
  for (int i = 0; i < 16; ++i) {
    const int kl = kb + 4 * i;
    float v = 0.f;
    if (sc >= 0) v = src[(size_t)(k0 + kl) * N + sc];
    sm[kl * 65 + nl] = v;
  }
  __syncthreads();
  const int nr = tid >> 2, kc = (tid & 3) * 16;
  unsigned o[8];
#pragma unroll
  for (int j = 0; j < 8; ++j) o[j] = pk2(sm[(kc + 2 * j) * 65 + nr], sm[(kc + 2 * j + 1) * 65 + nr]);
  uint4* d = (uint4*)(dst + (size_t)(n0 + nr) * K + k0 + kc);
  d[0] = make_uint4(o[0], o[1], o[2], o[3]);
  d[1] = make_uint4(o[4], o[5], o[6], o[7]);
  __syncthreads();
}

DI void phase_convert(const Params& p, char* smem) {
  float* sm = (float*)smem;
  for (int it = blockIdx.x; it < 4 * 1920; it += gridDim.x) {
    const int layer = it / 1920;
    int r = it % 1920;
    const float* src; u16* dst; int K, N, kind = 0, nt;
    char* wl = p.ws + (size_t)layer * WL_STRIDE;
    if (r < 1312) { src = p.w_in + (size_t)layer * 1024 * 5152; dst = (u16*)(wl + W_IN); K = 1024; N = 5152; kind = 1; nt = 82; }
    else if (r < 1360) { r -= 1312; src = p.w_uq + (size_t)layer * 256 * 768; dst = (u16*)(wl + W_UQ); K = 256; N = 768; nt = 12; }
    else if (r < 1392) { r -= 1360; src = p.w_ukv + (size_t)layer * 128 * 1024; dst = (u16*)(wl + W_UKV); K = 128; N = 1024; nt = 16; }
    else if (r < 1400) { r -= 1392; src = p.w2 + (size_t)layer * 64 * 512; dst = (u16*)(wl + W_W2); K = 64; N = 512; nt = 8; }
    else if (r < 1408) { r -= 1400; src = p.a2 + (size_t)layer * 64 * 512; dst = (u16*)(wl + W_A2); K = 64; N = 512; nt = 8; }
    else if (r < 1536) { r -= 1408; src = p.w_out_a + (size_t)layer * 512 * 1024; dst = (u16*)(wl + W_OA); K = 512; N = 1024; nt = 16; }
    else if (r < 1664) { r -= 1536; src = p.w_out_b + (size_t)layer * 512 * 1024; dst = (u16*)(wl + W_OB); K = 512; N = 1024; nt = 16; }
    else { r -= 1664; src = p.w_o + (size_t)layer * 1024 * 1024; dst = (u16*)(wl + W_O); K = 1024; N = 1024; nt = 16; }
    const int kt = r / nt, ntile = r % nt;
    conv_tile(src, N, dst, K, kt * 64, ntile * 64, kind, sm);
  }
}

DI void phase_rmsnorm(const Params& p, int layer) {
  const int wave = tidx() >> 6, lane = tidx() & 63;
  u16* H = (u16*)(p.ws + WS_H);
  const float* g = p.norm_w + layer * 1024;
  if (blockIdx.x == gridDim.x - 1) {
    u16* sh0 = (u16*)(p.ws + WS_SH0);
    for (int i = tidx(); i < 17 * SHW; i += 256) {
      const int r = i / SHW, c = i - r * SHW;
      sh0[i] = (r == 0) ? (u16)0 : f2bf(p.state_shift[((size_t)layer * 16 + (r - 1)) * SHW + c]);
    }
  }
  {
    const float* c1 = p.cache_ckv + (size_t)layer * 16 * 4096 * 128;
    const float* c2 = p.cache_kpe + (size_t)layer * 16 * 4096 * 32;
    u16* d1 = (u16*)(p.ws + WS_CKB);
    u16* d2 = (u16*)(p.ws + WS_KPB);
    constexpr int N1 = 16 * 4096 * 128 / 8, N2 = 16 * 4096 * 32 / 8;
    for (int i = blockIdx.x * 256 + tidx(); i < N1 + N2; i += gridDim.x * 256) {
      const float* sp = (i < N1) ? c1 + (size_t)i * 8 : c2 + (size_t)(i - N1) * 8;
      u16* dp = (i < N1) ? d1 + (size_t)i * 8 : d2 + (size_t)(i - N1) * 8;
      const f32x4 a = *(const f32x4*)sp, b = *(const f32x4*)(sp + 4);
      *(u32x4*)dp = u32x4{pk2(a.x, a.y), pk2(a.z, a.w), pk2(b.x, b.y), pk2(b.z, b.w)};
    }
  }
  for (int t = blockIdx.x * 4 + wave; t < NT; t += gridDim.x * 4) {
    const float* xr = xrow(p, layer, t);
    float4 v[4];
    float ss = 0.f;
#pragma unroll
    for (int i = 0; i < 4; ++i) {
      v[i] = *(const float4*)(xr + i * 256 + lane * 4);
      ss += v[i].x * v[i].x + v[i].y * v[i].y + v[i].z * v[i].z + v[i].w * v[i].w;
    }
    ss = wave_sum(ss);
    const float rinv = rsqrtf(ss * (1.f / 1024.f) + EPS);
#pragma unroll
    for (int i = 0; i < 4; ++i) {
      const float4 g4 = *(const float4*)(g + i * 256 + lane * 4);
      uint2 o;
      o.x = pk2(v[i].x * rinv * g4.x, v[i].y * rinv * g4.y);
      o.y = pk2(v[i].z * rinv * g4.z, v[i].w * rinv * g4.w);
      *(uint2*)(H + (size_t)t * 1024 + i * 256 + lane * 4) = o;
    }
  }
}

DI void gemm_mainloop(const u16* __restrict__ R, int ldr, const u16* __restrict__ C, int ldc, int K, char* smem, f32x16 (&acc)[2][2]) {
  const int tid = tidx(), lane = tid & 63, w = tid >> 6, wr = w >> 1, wc = w & 1;
  const int l31 = lane & 31, h = lane >> 5;
  const int lrow = tid >> 3, lkc = (tid & 7) * 8;
  u32x4 rr[4], rc[4];
  const int nk = K >> 6;
#pragma unroll
  for (int i = 0; i < 4; ++i) {
    rr[i] = *(const u32x4*)(R + (size_t)(lrow + 32 * i) * ldr + lkc);
    rc[i] = *(const u32x4*)(C + (size_t)(lrow + 32 * i) * ldc + lkc);
  }
  __syncthreads();
  {
    u16* sR = (u16*)smem;
    u16* sC = sR + 128 * 72;
#pragma unroll
    for (int i = 0; i < 4; ++i) {
      *(u32x4*)(sR + (lrow + 32 * i) * 72 + lkc) = rr[i];
      *(u32x4*)(sC + (lrow + 32 * i) * 72 + lkc) = rc[i];
    }
  }
  if (nk > 1) {
#pragma unroll
    for (int i = 0; i < 4; ++i) {
      rr[i] = *(const u32x4*)(R + (size_t)(lrow + 32 * i) * ldr + 64 + lkc);
      rc[i] = *(const u32x4*)(C + (size_t)(lrow + 32 * i) * ldc + 64 + lkc);
    }
  }
  __syncthreads();
  for (int kt = 0; kt < nk; ++kt) {
    const u16* sR = (const u16*)smem + (kt & 1) * (2 * 128 * 72);
    const u16* sC = sR + 128 * 72;
    if (kt + 1 < nk) {
      u16* nR = (u16*)smem + ((kt + 1) & 1) * (2 * 128 * 72);
      u16* nC = nR + 128 * 72;
#pragma unroll
      for (int i = 0; i < 4; ++i) {
        *(u32x4*)(nR + (lrow + 32 * i) * 72 + lkc) = rr[i];
        *(u32x4*)(nC + (lrow + 32 * i) * 72 + lkc) = rc[i];
      }
    }
    if (kt + 2 < nk) {
      const int k0 = (kt + 2) * 64;
#pragma unroll
      for (int i = 0; i < 4; ++i) {
        rr[i] = *(const u32x4*)(R + (size_t)(lrow + 32 * i) * ldr + k0 + lkc);
        rc[i] = *(const u32x4*)(C + (size_t)(lrow + 32 * i) * ldc + k0 + lkc);
      }
    }
#pragma unroll
    for (int ks = 0; ks < 4; ++ks) {
      bf16x8 a[2], b[2];
#pragma unroll
      for (int mi = 0; mi < 2; ++mi) a[mi] = *(const bf16x8*)(sR + (wr * 64 + mi * 32 + l31) * 72 + ks * 16 + h * 8);
#pragma unroll
      for (int ni = 0; ni < 2; ++ni) b[ni] = *(const bf16x8*)(sC + (wc * 64 + ni * 32 + l31) * 72 + ks * 16 + h * 8);
#pragma unroll
      for (int mi = 0; mi < 2; ++mi)
#pragma unroll
        for (int ni = 0; ni < 2; ++ni) acc[mi][ni] = MFMA32(a[mi], b[ni], acc[mi][ni]);
    }
    __syncthreads();
  }
}
DI void zero_acc(f32x16 (&acc)[2][2]) {
#pragma unroll
  for (int mi = 0; mi < 2; ++mi)
#pragma unroll
    for (int ni = 0; ni < 2; ++ni)
#pragma unroll
      for (int r = 0; r < 16; ++r) acc[mi][ni][r] = 0.f;
}
DI void acc_to_lds(const f32x16 (&acc)[2][2], char* smem) {
  float* sT = (float*)smem;
  const int lane = tidx() & 63, w = tidx() >> 6;
  const int l31 = lane & 31, h = lane >> 5, wr = w >> 1, wc = w & 1;
  __syncthreads();
#pragma unroll
  for (int mi = 0; mi < 2; ++mi)
#pragma unroll
    for (int ni = 0; ni < 2; ++ni)
#pragma unroll
      for (int reg = 0; reg < 16; ++reg) sT[(wr * 64 + mi * 32 + crow(reg, h)) * 132 + wc * 64 + ni * 32 + l31] = acc[mi][ni][reg];
  __syncthreads();
}
#define EPI_ROWS(...)                                                          \
  {                                                                            \
    const float* sT_ = (const float*)smem;                                     \
    _Pragma("unroll 2") for (int it_ = 0; it_ < 16; ++it_) {                   \
      const int row = it_ * 8 + (tidx() >> 5), col = (tidx() & 31) * 4; \
      const f32x4 v = *(const f32x4*)(sT_ + row * 132 + col);                  \
      __VA_ARGS__                                                              \
    }                                                                          \
  }

DI void gemm64_mainloop(const u16* __restrict__ R, int ldr, const u16* __restrict__ C, int ldc, int K, char* smem, f32x16& acc) {
  const int tid = tidx(), lane = tid & 63, w = tid >> 6, wr = w >> 1, wc = w & 1;
  const int l31 = lane & 31, h = lane >> 5;
  const int lrow = tid >> 3, lkc = (tid & 7) * 8;
  u32x4 rr[2][2], rc[2][2];
  const int nk = K >> 6;
#define G64_GLOAD(SET, KT)                                                                    \
  {                                                                                           \
    const int k0_ = (KT) * 64;                                                                \
    _Pragma("unroll") for (int i = 0; i < 2; ++i) {                                           \
      rr[SET][i] = *(const u32x4*)(R + (size_t)(lrow + 32 * i) * ldr + k0_ + lkc);            \
      rc[SET][i] = *(const u32x4*)(C + (size_t)(lrow + 32 * i) * ldc + k0_ + lkc);            \
    }                                                                                         \
  }
#define G64_LSTORE(SET, BUF)                                                                  \
  {                                                                                           \
    u16* nR_ = (u16*)smem + (BUF) * (2 * 64 * 72);                                            \
    u16* nC_ = nR_ + 64 * 72;                                                                 \
    _Pragma("unroll") for (int i = 0; i < 2; ++i) {                                           \
      *(u32x4*)(nR_ + (lrow + 32 * i) * 72 + lkc) = rr[SET][i];                               \
      *(u32x4*)(nC_ + (lrow + 32 * i) * 72 + lkc) = rc[SET][i];                               \
    }                                                                                         \
  }
  G64_GLOAD(0, 0)
  G64_GLOAD(1, 1)
  __syncthreads();
  G64_LSTORE(0, 0)
  G64_GLOAD(0, 2)
  __syncthreads();
  for (int kt0 = 0; kt0 < nk; kt0 += 2) {
#pragma unroll
    for (int u = 0; u < 2; ++u) {
      const int kt = kt0 + u;
      const u16* sR = (const u16*)smem + u * (2 * 64 * 72);
      const u16* sC = sR + 64 * 72;
      if (kt + 1 < nk) G64_LSTORE(1 - u, 1 - u)
      if (kt + 3 < nk) G64_GLOAD(1 - u, kt + 3)
#pragma unroll
      for (int ks = 0; ks < 4; ++ks) {
        const bf16x8 a = *(const bf16x8*)(sR + (wr * 32 + l31) * 72 + ks * 16 + h * 8);
        const bf16x8 b = *(const bf16x8*)(sC + (wc * 32 + l31) * 72 + ks * 16 + h * 8);
        acc = MFMA32(a, b, acc);
      }
      __syncthreads();
    }
  }
#undef G64_GLOAD
#undef G64_LSTORE
}
DI void acc64_to_lds(const f32x16& acc, char* smem) {
  float* sT = (float*)smem;
  const int lane = tidx() & 63, w = tidx() >> 6;
  const int l31 = lane & 31, h = lane >> 5, wr = w >> 1, wc = w & 1;
  __syncthreads();
#pragma unroll
  for (int reg = 0; reg < 16; ++reg) sT[(wr * 32 + crow(reg, h)) * 68 + wc * 32 + l31] = acc[reg];
  __syncthreads();
}
#define EPI64_ROWS(...)                                                        \
  {                                                                            \
    const float* sT_ = (const float*)smem;                                     \
    _Pragma("unroll") for (int it_ = 0; it_ < 4; ++it_) {                      \
      const int row = it_ * 16 + (tidx() >> 4), col = (tidx() & 15) * 4;       \
      const f32x4 v = *(const f32x4*)(sT_ + row * 68 + col);                   \
      __VA_ARGS__                                                              \
    }                                                                          \
  }

DI void phase_g1(const Params& p, int layer, char* smem) {
  const u16* H = (const u16*)(p.ws + WS_H);
  const u16* W = (const u16*)(p.ws + (size_t)layer * WL_STRIDE + W_IN);
  u16* Z = (u16*)(p.ws + WS_Z);
  const int xcd = blockIdx.x & 7, jb = blockIdx.x >> 3, nb = (gridDim.x + 7 - xcd) >> 3;
  for (int m = jb; m < 17 * 41; m += nb) {
    const int ft = m / 17, tt = xcd + 8 * (m % 17);
    f32x16 acc[2][2];
    zero_acc(acc);
    gemm_mainloop(H + (size_t)tt * 128 * 1024, 1024, W + (size_t)ft * 128 * 1024, 1024, 1024, smem, acc);
    acc_to_lds(acc, smem);
    EPI_ROWS({ *(u32x2*)(Z + (size_t)(tt * 128 + row) * NZ + ft * 128 + col) = u32x2{pk2(v.x, v.y), pk2(v.z, v.w)}; })
  }
}

DI void norms_token(const Params& p, int layer, int t, int lane) {
  const u16* zr = (const u16*)(p.ws + WS_Z) + (size_t)t * NZ;
  u16* CQN = (u16*)(p.ws + WS_H);
  u16* CKVB = (u16*)(p.ws + WS_CKVB);
  u16* KPEB = (u16*)(p.ws + WS_KPEB);
  {
    const uint2 raw = *(const uint2*)(zr + lane * 4);
    const float c0 = lo2f(raw.x), c1 = hi2f(raw.x), c2 = lo2f(raw.y), c3 = hi2f(raw.y);
    float ss = wave_sum(c0 * c0 + c1 * c1 + c2 * c2 + c3 * c3);
    const float rinv = rsqrtf(ss * (1.f / 256.f) + EPS);
    const float4 g = *(const float4*)(p.q_norm_w + layer * 256 + lane * 4);
    uint2 o;
    o.x = pk2(c0 * rinv * g.x, c1 * rinv * g.y);
    o.y = pk2(c2 * rinv * g.z, c3 * rinv * g.w);
    *(uint2*)(CQN + (size_t)t * 256 + lane * 4) = o;
  }
  {
    const unsigned raw = *(const unsigned*)(zr + ZC_KV + lane * 2);
    const float c0 = lo2f(raw), c1 = hi2f(raw);
    float ss = wave_sum(c0 * c0 + c1 * c1);
    const float rinv = rsqrtf(ss * (1.f / 128.f) + EPS);
    const float2 g = *(const float2*)(p.kv_norm_w + layer * 128 + lane * 2);
    const float o0 = c0 * rinv * g.x, o1 = c1 * rinv * g.y;
    float* dst = (t < NP) ? p.out + OFF_CKV_P + ((size_t)layer * NP + t) * 128 : p.out + OFF_CKV_S + ((size_t)layer * NSM + (t - NP)) * 128;
    *(float2*)(dst + lane * 2) = make_float2(o0, o1);
    *(unsigned*)(CKVB + (size_t)t * 128 + lane * 2) = pk2(o0, o1);
  }
  {
    float v = (lane < 32) ? bf2f(zr[ZC_KPE + lane]) : 0.f;
    float ss = wave_sum(v * v);
    const float rinv = rsqrtf(ss * (1.f / 32.f) + EPS);
    v = v * rinv * p.kn_rope[layer * 32 + (lane & 31)];
    const float pr = __shfl_xor(v, 16);
    float s, c;
    rope_sincos(tok_pos(t), lane & 15, s, c);
    const float o = ((lane & 16) == 0) ? (v * c - pr * s) : (v * c + pr * s);
    if (lane < 32) {
      float* dst = (t < NP) ? p.out + OFF_KPE_P + ((size_t)layer * NP + t) * 32 : p.out + OFF_KPE_S + ((size_t)layer * NSM + (t - NP)) * 32;
      dst[lane] = o;
      KPEB[(size_t)t * 32 + lane] = f2bf(o);
    }
  }
  float* sh = nullptr;
  if (t == NP - 1) sh = p.out + OFF_SH_P + (size_t)layer * SHW;
  else if (t >= NP && ((t - NP) & 63) == 63) sh = p.out + OFF_SH_S + ((size_t)layer * 16 + ((t - NP) >> 6)) * SHW;
  if (sh) {
#pragma unroll 1
    for (int c = lane; c < SHW; c += 64) sh[c] = bf2f(zr[ZC_ZS + c]);
  }
}

DI void zm4(const Params& p, int layer, int t, int c, float (&o)[4]) {
  const u16* zr = (const u16*)(p.ws + WS_Z) + (size_t)t * NZ + ZC_ZS + c;
  const u32x2 a = *(const u32x2*)zr;
  const bool first = (t < NP) ? (t == 0) : (((t - NP) & 63) == 0);
  const int srow = (t < NP) ? 0 : 1 + ((t - NP) >> 6);
  const u16* pr = first ? (const u16*)(p.ws + WS_SH0) + srow * SHW + c : zr - NZ;
  const u32x2 b = *(const u32x2*)pr;
  const f32x4 mu = *(const f32x4*)(p.mu_shift + layer * SHW + c);
  const float c0 = lo2f(a.x), c1 = hi2f(a.x), c2 = lo2f(a.y), c3 = hi2f(a.y);
  o[0] = c0 + (lo2f(b.x) - c0) * mu.x;
  o[1] = c1 + (hi2f(b.x) - c1) * mu.y;
  o[2] = c2 + (lo2f(b.y) - c2) * mu.z;
  o[3] = c3 + (hi2f(b.y) - c3) * mu.w;
}
DI float tanhf_(float x) {
  const float t = __expf(-2.f * fabsf(x));
  const float r = (1.f - t) / (1.f + t);
  return x < 0.f ? -r : r;
}

constexpr int WPS = 900;
DI void zml(const u16* sz, int row, int col, const float* mu, float (&o)[4]) {
  const u32x2 a = *(const u32x2*)(sz + (row + 1) * WPS + col);
  const u32x2 b = *(const u32x2*)(sz + row * WPS + col);
  const f32x4 m4 = *(const f32x4*)mu;
  const float c0 = lo2f(a.x), c1 = hi2f(a.x), c2 = lo2f(a.y), c3 = hi2f(a.y);
  o[0] = c0 + (lo2f(b.x) - c0) * m4.x;
  o[1] = c1 + (hi2f(b.x) - c1) * m4.y;
  o[2] = c2 + (lo2f(b.y) - c2) * m4.z;
  o[3] = c3 + (hi2f(b.y) - c3) * m4.w;
}
DI void wkvprep_block(const Params& p, int layer, int tt, int hg, char* smem) {
  u16* sz = (u16*)smem;
  const int tid = tidx(), lane = tid & 63, w = tid >> 6, l31 = lane & 31, h = lane >> 5;
  const int t0 = tt * 32;
  const int hd = hg * 4 + w;
  const u16* Z = (const u16*)(p.ws + WS_Z);
  const bool seq_start = (t0 < NP) ? (t0 == 0) : (((t0 - NP) & 63) == 0);
  const u16* prevrow = seq_start ? (const u16*)(p.ws + WS_SH0) + ((t0 < NP) ? 0 : 1 + ((t0 - NP) >> 6)) * SHW : Z + (size_t)(t0 - 1) * NZ + ZC_ZS;
  __syncthreads();
  for (int ci = tid; ci < 33 * 112; ci += 256) {
    const int row = ci / 112, cc = ci - row * 112;
    int scol, lcol;
    if (cc < 16) { scol = 1536 + cc * 8; lcol = cc * 8; }
    else {
      const int j = cc - 16, ww = j / 24, r2 = j - ww * 24, part = r2 >> 3, o = (r2 & 7) * 8;
      scol = part * 512 + (hg * 4 + ww) * 64 + o;
      lcol = 128 + ww * 192 + part * 64 + o;
    }
    const u16* src = (row == 0) ? prevrow + scol : Z + (size_t)(t0 + row - 1) * NZ + ZC_ZS + scol;
    const u32x4 v = *(const u32x4*)src;
    u32x2* d = (u32x2*)(sz + row * WPS + lcol);
    d[0] = u32x2{v.x, v.y};
    d[1] = u32x2{v.z, v.w};
  }
  __syncthreads();
  const int tok = t0 + l31;
  const u16* W2T = (const u16*)(p.ws + (size_t)layer * WL_STRIDE + W_W2);
  const u16* A2T = (const u16*)(p.ws + (size_t)layer * WL_STRIDE + W_A2);
  const float* mu = p.mu_shift + layer * SHW;
  u16* WK = (u16*)(p.ws + WS_WKVIN) + ((size_t)hd * NT + tok) * 384;
  f32x16 accW[2], accA[2];
#pragma unroll
  for (int m = 0; m < 2; ++m)
#pragma unroll
    for (int r = 0; r < 16; ++r) { accW[m][r] = 0.f; accA[m][r] = 0.f; }
#pragma unroll
  for (int ks = 0; ks < 4; ++ks) {
    const int c0 = ks * 16 + 8 * h;
    float t0a[4], t1a[4], u0[4], u1[4];
    zml(sz, l31, c0, mu + 1536 + c0, t0a);
    zml(sz, l31, c0 + 4, mu + 1536 + c0 + 4, t1a);
    zml(sz, l31, 64 + c0, mu + 1600 + c0, u0);
    zml(sz, l31, 64 + c0 + 4, mu + 1600 + c0 + 4, u1);
    u32x4 bw, ba;
    bw.x = pk2(tanhf_(t0a[0]), tanhf_(t0a[1])); bw.y = pk2(tanhf_(t0a[2]), tanhf_(t0a[3]));
    bw.z = pk2(tanhf_(t1a[0]), tanhf_(t1a[1])); bw.w = pk2(tanhf_(t1a[2]), tanhf_(t1a[3]));
    ba.x = pk2(u0[0], u0[1]); ba.y = pk2(u0[2], u0[3]); ba.z = pk2(u1[0], u1[1]); ba.w = pk2(u1[2], u1[3]);
    const bf16x8 bwf = __builtin_bit_cast(bf16x8, bw), baf = __builtin_bit_cast(bf16x8, ba);
#pragma unroll
    for (int m = 0; m < 2; ++m) {
      const bf16x8 aw = *(const bf16x8*)(W2T + (size_t)(hd * 64 + m * 32 + l31) * 64 + ks * 16 + h * 8);
      const bf16x8 aa = *(const bf16x8*)(A2T + (size_t)(hd * 64 + m * 32 + l31) * 64 + ks * 16 + h * 8);
      accW[m] = MFMA32(aw, bwf, accW[m]);
      accA[m] = MFMA32(aa, baf, accA[m]);
    }
  }
  const int hb = 128 + w * 192;
  float ss = 0.f;
#pragma unroll
  for (int m = 0; m < 2; ++m)
#pragma unroll
    for (int q = 0; q < 4; ++q) {
      const int f0 = m * 32 + 8 * q + 4 * h, F = hd * 64 + f0;
      float k4[4];
      zml(sz, l31, hb + 64 + f0, mu + 512 + F, k4);
      const float4 kk_ = *(const float4*)(p.k_k + layer * 512 + F);
      const float a = k4[0] * kk_.x, b = k4[1] * kk_.y, c = k4[2] * kk_.z, d = k4[3] * kk_.w;
      ss += a * a + b * b + c * c + d * d;
    }
  ss += xor32(ss);
  const float rn = 1.f / fmaxf(sqrtf(ss), 1e-12f);
#pragma unroll
  for (int m = 0; m < 2; ++m)
#pragma unroll
    for (int q = 0; q < 4; ++q) {
      const int f0 = m * 32 + 8 * q + 4 * h, F = hd * 64 + f0;
      float r4[4], k4[4], v4[4];
      zml(sz, l31, hb + f0, mu + F, r4);
      zml(sz, l31, hb + 64 + f0, mu + 512 + F, k4);
      zml(sz, l31, hb + 128 + f0, mu + 1024 + F, v4);
      const float4 w0 = *(const float4*)(p.w0 + layer * 512 + F);
      const float4 a0 = *(const float4*)(p.a0 + layer * 512 + F);
      const float4 kk_ = *(const float4*)(p.k_k + layer * 512 + F);
      const float4 ka_ = *(const float4*)(p.k_a + layer * 512 + F);
      const float w0a[4] = {w0.x, w0.y, w0.z, w0.w}, a0a[4] = {a0.x, a0.y, a0.z, a0.w};
      const float kka[4] = {kk_.x, kk_.y, kk_.z, kk_.w}, kaa[4] = {ka_.x, ka_.y, ka_.z, ka_.w};
      float e4[4], kp4[4], kn4[4], b4[4];
#pragma unroll
      for (int j = 0; j < 4; ++j) {
        const float lw = w0a[j] + accW[m][4 * q + j];
        const float nx = -lw;
        const float sp = fmaxf(nx, 0.f) + __logf(1.f + __expf(-fabsf(nx)));
        e4[j] = __expf(-sp - 0.5f);
        const float a = sigmoidf_(a0a[j] + accA[m][4 * q + j]);
        kn4[j] = k4[j] * kka[j] * rn;
        b4[j] = kn4[j] * a;
        kp4[j] = k4[j] * (1.f + (a - 1.f) * kaa[j]);
      }
      *(u32x2*)(WK + 0 * 64 + f0) = u32x2{pk2(r4[0], r4[1]), pk2(r4[2], r4[3])};
      *(u32x2*)(WK + 1 * 64 + f0) = u32x2{pk2(e4[0], e4[1]), pk2(e4[2], e4[3])};
      *(u32x2*)(WK + 2 * 64 + f0) = u32x2{pk2(kp4[0], kp4[1]), pk2(kp4[2], kp4[3])};
      *(u32x2*)(WK + 3 * 64 + f0) = u32x2{pk2(v4[0], v4[1]), pk2(v4[2], v4[3])};
      *(u32x2*)(WK + 4 * 64 + f0) = u32x2{pk2(kn4[0], kn4[1]), pk2(kn4[2], kn4[3])};
      *(u32x2*)(WK + 5 * 64 + f0) = u32x2{pk2(b4[0], b4[1]), pk2(b4[2], b4[3])};
    }
}

DI void qproj_item(const Params& p, int layer, int tt, int hd, int lane);
DI void kvproj_item(const Params& p, int layer, int tt, int hd, int lane);
DI void phase_norms_prep(const Params& p, int layer, char* smem, int* s_item) {
  int* ctr = (int*)(p.ws + WS_CTR) + 4 + layer;
  const int wave = tidx() >> 6, lane = tidx() & 63;
  for (;;) {
    __syncthreads();
    if (tidx() == 0) *s_item = atomicAdd(ctr, 1);
    __syncthreads();
    const int it = *s_item;
    if (it >= 1088 + 2112 + 272) break;
    if (it < 1088) { wkvprep_block(p, layer, it >> 1, it & 1, smem); continue; }
    if (it < 1088 + 2112) {
      const int wi = (it - 1088) * 4 + wave;
      if (wi < 544 * 8) qproj_item(p, layer, wi >> 3, wi & 7, lane);
      else { const int j = wi - 544 * 8; kvproj_item(p, layer, j >> 3, j & 7, lane); }
      continue;
    }
    const int tb = (it - 1088 - 2112) * 64 + wave * 16;
    for (int j = 0; j < 16; ++j) norms_token(p, layer, tb + j, lane);
  }
}

DI bf16x8 normed_frag(const u16* zsrc, const float* g, float& ssq) {
  const u32x4 raw = *(const u32x4*)zsrc;
  const f32x4 g0 = *(const f32x4*)g, g1 = *(const f32x4*)(g + 4);
  const float f0 = lo2f(raw.x), f1 = hi2f(raw.x), f2 = lo2f(raw.y), f3 = hi2f(raw.y);
  const float f4 = lo2f(raw.z), f5 = hi2f(raw.z), f6 = lo2f(raw.w), f7 = hi2f(raw.w);
  ssq += (f0 * f0 + f1 * f1) + (f2 * f2 + f3 * f3) + (f4 * f4 + f5 * f5) + (f6 * f6 + f7 * f7);
  const u32x4 o = {pk2(f0 * g0.x, f1 * g0.y), pk2(f2 * g0.z, f3 * g0.w), pk2(f4 * g1.x, f5 * g1.y), pk2(f6 * g1.z, f7 * g1.w)};
  return __builtin_bit_cast(bf16x8, o);
}
DI void qproj_item(const Params& p, int layer, int tt, int hd, int lane) {
  const int l31 = lane & 31, h = lane >> 5;
  const int tok = tt * 32 + l31;
  const u16* zq = (const u16*)(p.ws + WS_Z) + (size_t)tok * NZ;
  const float* gq = p.q_norm_w + layer * 256;
  float ssq = 0.f;
  const u16* WT = (const u16*)(p.ws + (size_t)layer * WL_STRIDE + W_UQ);
  u16* Q = (u16*)(p.ws + WS_Q);
  f32x16 acc[3];
#pragma unroll
  for (int m = 0; m < 3; ++m)
#pragma unroll
    for (int r = 0; r < 16; ++r) acc[m][r] = 0.f;
#pragma unroll 4
  for (int ks = 0; ks < 16; ++ks) {
    const bf16x8 bfr = normed_frag(zq + ks * 16 + h * 8, gq + ks * 16 + h * 8, ssq);
#pragma unroll
    for (int m = 0; m < 3; ++m) {
      const bf16x8 afr = *(const bf16x8*)(WT + (size_t)(hd * 96 + m * 32 + l31) * 256 + ks * 16 + h * 8);
      acc[m] = MFMA32(afr, bfr, acc[m]);
    }
  }
  {
    ssq += xor32(ssq);
    const float rinv = rsqrtf(ssq * (1.f / 256.f) + EPS);
#pragma unroll
    for (int m = 0; m < 3; ++m)
#pragma unroll
      for (int r = 0; r < 16; ++r) acc[m][r] *= rinv;
  }
  const float qs = 0.10206207261596577f * 1.4426950408889634f;
  float ss = 0.f;
#pragma unroll
  for (int m = 0; m < 2; ++m)
#pragma unroll
    for (int r = 0; r < 16; ++r) ss += acc[m][r] * acc[m][r];
  ss += xor32(ss);
  const float rn = rsqrtf(ss * (1.f / 64.f) + EPS) * qs;
  u16* qd = Q + (size_t)tok * 768 + hd * 96;
#pragma unroll
  for (int m = 0; m < 2; ++m)
#pragma unroll
    for (int q = 0; q < 4; ++q) {
      const int f0 = m * 32 + 8 * q + 4 * h;
      const float4 g = *(const float4*)(p.qn_nope + layer * 64 + f0);
      *(uint2*)(qd + f0) = make_uint2(pk2(acc[m][4 * q] * rn * g.x, acc[m][4 * q + 1] * rn * g.y), pk2(acc[m][4 * q + 2] * rn * g.z, acc[m][4 * q + 3] * rn * g.w));
    }
  float sr = 0.f;
#pragma unroll
  for (int r = 0; r < 16; ++r) sr += acc[2][r] * acc[2][r];
  sr += xor32(sr);
  const float rr = rsqrtf(sr * (1.f / 32.f) + EPS);
  const int pos = tok_pos(tok);
  float o1[8], o2[8];
#pragma unroll
  for (int r = 0; r < 8; ++r) {
    const int i = crow(r, h);
    const float x1 = acc[2][r] * rr * p.qn_rope[layer * 32 + i];
    const float x2 = acc[2][r + 8] * rr * p.qn_rope[layer * 32 + i + 16];
    float s, c;
    rope_sincos(pos, i, s, c);
    o1[r] = (x1 * c - x2 * s) * qs;
    o2[r] = (x2 * c + x1 * s) * qs;
  }
#pragma unroll
  for (int q = 0; q < 2; ++q) {
    const int i0 = 8 * q + 4 * h;
    *(uint2*)(qd + 64 + i0) = make_uint2(pk2(o1[4 * q], o1[4 * q + 1]), pk2(o1[4 * q + 2], o1[4 * q + 3]));
    *(uint2*)(qd + 64 + 16 + i0) = make_uint2(pk2(o2[4 * q], o2[4 * q + 1]), pk2(o2[4 * q + 2], o2[4 * q + 3]));
  }
}

DI void kvproj_item(const Params& p, int layer, int tt, int hd, int lane) {
  const int l31 = lane & 31, h = lane >> 5;
  const int tok = tt * 32 + l31;
  const u16* zk = (const u16*)(p.ws + WS_Z) + (size_t)tok * NZ + ZC_KV;
  const float* gk = p.kv_norm_w + layer * 128;
  float ssq = 0.f;
  const u16* WT = (const u16*)(p.ws + (size_t)layer * WL_STRIDE + W_UKV);
  u16* KN = (u16*)(p.ws + WS_KN);
  u16* VT = (u16*)(p.ws + WS_VT);
  f32x16 acc[4];
#pragma unroll
  for (int m = 0; m < 4; ++m)
#pragma unroll
    for (int r = 0; r < 16; ++r) acc[m][r] = 0.f;
#pragma unroll 4
  for (int ks = 0; ks < 8; ++ks) {
    const bf16x8 bfr = normed_frag(zk + ks * 16 + h * 8, gk + ks * 16 + h * 8, ssq);
#pragma unroll
    for (int m = 0; m < 4; ++m) {
      const bf16x8 afr = *(const bf16x8*)(WT + (size_t)(hd * 128 + m * 32 + l31) * 128 + ks * 16 + h * 8);
      acc[m] = MFMA32(afr, bfr, acc[m]);
    }
  }
  {
    ssq += xor32(ssq);
    const float rinv = rsqrtf(ssq * (1.f / 128.f) + EPS);
#pragma unroll
    for (int m = 0; m < 4; ++m)
#pragma unroll
      for (int r = 0; r < 16; ++r) acc[m][r] *= rinv;
  }
  float ss = 0.f;
#pragma unroll
  for (int m = 0; m < 2; ++m)
#pragma unroll
    for (int r = 0; r < 16; ++r) ss += acc[m][r] * acc[m][r];
  ss += xor32(ss);
  const float rn = rsqrtf(ss * (1.f / 64.f) + EPS);
  u16* kd = KN + ((size_t)hd * NP + tok) * 64;
#pragma unroll
  for (int m = 0; m < 2; ++m)
#pragma unroll
    for (int q = 0; q < 4; ++q) {
      const int f0 = m * 32 + 8 * q + 4 * h;
      const float4 g = *(const float4*)(p.kn_nope + layer * 64 + f0);
      *(uint2*)(kd + f0) = make_uint2(pk2(acc[m][4 * q] * rn * g.x, acc[m][4 * q + 1] * rn * g.y), pk2(acc[m][4 * q + 2] * rn * g.z, acc[m][4 * q + 3] * rn * g.w));
    }
#pragma unroll
  for (int m = 0; m < 2; ++m)
#pragma unroll
    for (int r = 0; r < 16; ++r) {
      const int d = m * 32 + crow(r, h);
      VT[((size_t)hd * 64 + d) * NP + tok] = f2bf(acc[2 + m][r]);
    }
}

DI void phase_proj(const Params& p, int layer) {
  const int wave = tidx() >> 6, lane = tidx() & 63;
  const int nw = gridDim.x * 4, gw = blockIdx.x * 4 + wave;
  for (int it = gw; it < 544 * 8 + 512 * 8; it += nw) {
    if (it < 544 * 8) qproj_item(p, layer, it >> 3, it & 7, lane);
    else { const int j = it - 544 * 8; kvproj_item(p, layer, j >> 3, j & 7, lane); }
  }
}

DI float wave_max(float v) {
#pragma unroll
  for (int o = 32; o > 0; o >>= 1) v = fmaxf(v, __shfl_xor(v, o));
  return v;
}
DI float attn_bound(const Params& p, int layer, int lane) {
  const float gqn = wave_max(fabsf(p.qn_nope[layer * 64 + lane])), gkn = wave_max(fabsf(p.kn_nope[layer * 64 + lane]));
  const float gqr = wave_max(fabsf(p.qn_rope[layer * 32 + (lane & 31)])), gkr = wave_max(fabsf(p.kn_rope[layer * 32 + (lane & 31)]));
  const float qs = 0.10206207261596577f * 1.4426950408889634f;
  return 1.02f * qs * (64.f * gqn * gkn + 32.f * gqr * gkr) + 0.25f;
}
template <int NSUB>
DI void attn_tile(const bf16x8 (&qf)[6], const u16* sK, const u16* sVT, int ksub0, f32x16 (&o)[2], float& l, float negB, int l31, int h) {
  f32x16 s[NSUB];
  {
    bf16x8 kf[NSUB][6];
#pragma unroll
    for (int i = 0; i < NSUB; ++i)
#pragma unroll
      for (int ks = 0; ks < 6; ++ks) kf[i][ks] = *(const bf16x8*)(sK + ((ksub0 + i) * 32 + l31) * 104 + ks * 16 + h * 8);
#pragma unroll
    for (int i = 0; i < NSUB; ++i) {
#pragma unroll
      for (int r = 0; r < 16; ++r) s[i][r] = negB;
#pragma unroll
      for (int ks = 0; ks < 6; ++ks) s[i] = MFMA32(kf[i][ks], qf[ks], s[i]);
    }
    __builtin_amdgcn_sched_group_barrier(0x100, 6 * NSUB, 0);
    __builtin_amdgcn_sched_group_barrier(0x008, 6 * NSUB, 0);
  }
  bf16x8 vf[NSUB][2][2];
#pragma unroll
  for (int i = 0; i < NSUB; ++i)
#pragma unroll
    for (int st = 0; st < 2; ++st)
#pragma unroll
      for (int md = 0; md < 2; ++md) {
        const u16* vp = sVT + (md * 32 + l31) * 68 + (ksub0 + i) * 32 + 16 * st + 4 * h;
        const s16x4 lo = *(const s16x4*)vp;
        const s16x4 hi = *(const s16x4*)(vp + 8);
        vf[i][st][md] = __builtin_shufflevector(lo, hi, 0, 1, 2, 3, 4, 5, 6, 7);
      }
  float ps = 0.f;
#pragma unroll
  for (int i = 0; i < NSUB; ++i)
#pragma unroll
    for (int r = 0; r < 16; ++r) {
      const float pv = __builtin_amdgcn_exp2f(s[i][r]);
      ps += pv;
      s[i][r] = pv;
    }
  l += ps;
#pragma unroll
  for (int i = 0; i < NSUB; ++i)
#pragma unroll
    for (int st = 0; st < 2; ++st) {
      u32x4 pu;
      pu.x = pk2(s[i][8 * st + 0], s[i][8 * st + 1]);
      pu.y = pk2(s[i][8 * st + 2], s[i][8 * st + 3]);
      pu.z = pk2(s[i][8 * st + 4], s[i][8 * st + 5]);
      pu.w = pk2(s[i][8 * st + 6], s[i][8 * st + 7]);
      const bf16x8 pf = __builtin_bit_cast(bf16x8, pu);
#pragma unroll
      for (int md = 0; md < 2; ++md) o[md] = MFMA32(vf[i][st][md], pf, o[md]);
    }
}

DI void attn_store(const Params& p, int tok, int hd, const f32x16 (&o)[2], float linv, int h) {
  const u16* gz = (const u16*)(p.ws + WS_Z) + (size_t)tok * NZ + ZC_GA + hd * 64;
  u16* OA = (u16*)(p.ws + WS_OA) + (size_t)tok * 512 + hd * 64;
#pragma unroll
  for (int md = 0; md < 2; ++md)
#pragma unroll
    for (int q = 0; q < 4; ++q) {
      const int d0 = md * 32 + 8 * q + 4 * h;
      const uint2 g = *(const uint2*)(gz + d0);
      const float v0 = o[md][4 * q] * linv * siluf_(lo2f(g.x));
      const float v1 = o[md][4 * q + 1] * linv * siluf_(hi2f(g.x));
      const float v2 = o[md][4 * q + 2] * linv * siluf_(lo2f(g.y));
      const float v3 = o[md][4 * q + 3] * linv * siluf_(hi2f(g.y));
      *(uint2*)(OA + d0) = make_uint2(pk2(v0, v1), pk2(v2, v3));
    }
}

DI void attn_prompt_item(const Params& p, int layer, int qt, int hd, char* smem) {
  u16* sK = (u16*)smem;
  u16* sVT = (u16*)(smem + 13312);
  const int tid = tidx(), lane = tid & 63, w = tid >> 6, l31 = lane & 31, h = lane >> 5;
  const int tok = qt * 128 + w * 32 + l31;
  const u16* Q = (const u16*)(p.ws + WS_Q);
  const u16* KN = (const u16*)(p.ws + WS_KN) + (size_t)hd * NP * 64;
  const u16* KPEB = (const u16*)(p.ws + WS_KPEB);
  const u16* VT = (const u16*)(p.ws + WS_VT) + (size_t)hd * 64 * NP;
  bf16x8 qf[6];
#pragma unroll
  for (int ks = 0; ks < 6; ++ks) qf[ks] = *(const bf16x8*)(Q + (size_t)tok * 768 + hd * 96 + ks * 16 + h * 8);
  f32x16 o[2];
#pragma unroll
  for (int d = 0; d < 2; ++d)
#pragma unroll
    for (int r = 0; r < 16; ++r) o[d][r] = 0.f;
  float l = 0.f;
  const float negB = -attn_bound(p, layer, lane);
  const int nkt = 2 * qt + 2;
  const int my_nkt = (w < 2) ? nkt - 1 : nkt;
  u32x4 pk[2][2], pr[2], pv[2][2];
#define PA_GLOAD(SET, KT)                                                                        \
  {                                                                                              \
    const int key0_ = (KT) * 64;                                                                 \
    _Pragma("unroll") for (int i = 0; i < 2; ++i) {                                              \
      const int c = tid + 256 * i;                                                               \
      pk[SET][i] = *(const u32x4*)(KN + (size_t)(key0_ + (c >> 3)) * 64 + (c & 7) * 8);          \
      pv[SET][i] = *(const u32x4*)(VT + (size_t)(c >> 3) * NP + key0_ + (c & 7) * 8);            \
    }                                                                                            \
    pr[SET] = *(const u32x4*)(KPEB + (size_t)(key0_ + (tid >> 2)) * 32 + (tid & 3) * 8);         \
  }
  PA_GLOAD(0, 0)
  PA_GLOAD(1, 1)
  for (int kt0 = 0; kt0 < nkt; kt0 += 2) {
#pragma unroll
    for (int u = 0; u < 2; ++u) {
      const int kt = kt0 + u;
      __syncthreads();
#pragma unroll
      for (int i = 0; i < 2; ++i) {
        const int c = tid + 256 * i;
        *(u32x4*)(sK + (c >> 3) * 104 + (c & 7) * 8) = pk[u][i];
        u32x2* vd = (u32x2*)(sVT + (c >> 3) * 68 + (c & 7) * 8);
        vd[0] = u32x2{pv[u][i].x, pv[u][i].y};
        vd[1] = u32x2{pv[u][i].z, pv[u][i].w};
      }
      *(u32x4*)(sK + (tid >> 2) * 104 + 64 + (tid & 3) * 8) = pr[u];
      __syncthreads();
      if (kt + 2 < nkt) PA_GLOAD(u, kt + 2)
      if (kt < my_nkt) attn_tile<2>(qf, sK, sVT, 0, o, l, negB, l31, h);
    }
  }
#undef PA_GLOAD
  l += xor32(l);
  attn_store(p, tok, hd, o, 1.f / l, h);
}

DI void attn_sample_item(const Params& p, int layer, int b, int hd, char* smem) {
  u16* sC = (u16*)smem;
  u16* sK = (u16*)(smem + 17408);
  u16* sVT = (u16*)(smem + 17408 + 13312);
  u16* sW = (u16*)(smem + 39424);
  const int tid = tidx(), lane = tid & 63, w = tid >> 6, l31 = lane & 31, h = lane >> 5;
  const int khu = w & 1, part = w >> 1;
  const int qh = w >> 1, kh = w & 1;
  const int tok = NP + b * 64 + qh * 32 + l31;
  const u16* Q = (const u16*)(p.ws + WS_Q);
  const u16* WT = (const u16*)(p.ws + (size_t)layer * WL_STRIDE + W_UKV) + (size_t)hd * 128 * 128;
  __syncthreads();
#pragma unroll
  for (int i = 0; i < 8; ++i) {
    const int c = tid + 256 * i;
    *(u32x4*)(sW + (c >> 4) * 136 + (c & 15) * 8) = *(const u32x4*)(WT + (size_t)c * 8);
  }
  bf16x8 qf[6];
#pragma unroll
  for (int ks = 0; ks < 6; ++ks) qf[ks] = *(const bf16x8*)(Q + (size_t)tok * 768 + hd * 96 + ks * 16 + h * 8);
  f32x16 o[2];
#pragma unroll
  for (int d = 0; d < 2; ++d)
#pragma unroll
    for (int r = 0; r < 16; ++r) o[d][r] = 0.f;
  float l = 0.f;
  const float negB = -attn_bound(p, layer, lane);
  const u16* cck = (const u16*)(p.ws + WS_CKB) + (size_t)b * 4096 * 128;
  const u16* ckp = (const u16*)(p.ws + WS_KPB) + (size_t)b * 4096 * 32;
  const u16* nck = (const u16*)(p.ws + WS_CKVB) + (size_t)(NP + b * 64) * 128;
  const u16* nkp = (const u16*)(p.ws + WS_KPEB) + (size_t)(NP + b * 64) * 32;
  u32x4 pc[4], pp;
#define SA_GLOAD(KT)                                                                      \
  {                                                                                       \
    const u16* s1_ = ((KT) < 64) ? cck + (size_t)(KT) * 64 * 128 : nck;                   \
    const u16* s2_ = ((KT) < 64) ? ckp + (size_t)(KT) * 64 * 32 : nkp;                    \
    _Pragma("unroll") for (int i = 0; i < 4; ++i) pc[i] = *(const u32x4*)(s1_ + (size_t)(tid + 256 * i) * 8); \
    pp = *(const u32x4*)(s2_ + (size_t)tid * 8);                                          \
  }
  SA_GLOAD(0)
  for (int kt = 0; kt < 65; ++kt) {
    __syncthreads();
#pragma unroll
    for (int i = 0; i < 4; ++i) {
      const int c = tid + 256 * i;
      *(u32x4*)(sC + (c >> 4) * 136 + (c & 15) * 8) = pc[i];
    }
    *(u32x4*)(sK + (tid >> 2) * 104 + 64 + (tid & 3) * 8) = pp;
    __syncthreads();
    if (kt + 1 < 65) SA_GLOAD(kt + 1)
    {
      f32x16 acc[2];
#pragma unroll
      for (int mt = 0; mt < 2; ++mt)
#pragma unroll
        for (int r = 0; r < 16; ++r) acc[mt][r] = 0.f;
      bf16x8 cfa[8];
#pragma unroll
      for (int ks = 0; ks < 8; ++ks) cfa[ks] = *(const bf16x8*)(sC + (khu * 32 + l31) * 136 + ks * 16 + h * 8);
#pragma unroll
      for (int mt = 0; mt < 2; ++mt) {
        bf16x8 wfa[8];
#pragma unroll
        for (int ks = 0; ks < 8; ++ks) wfa[ks] = *(const bf16x8*)(sW + (part * 64 + mt * 32 + l31) * 136 + ks * 16 + h * 8);
#pragma unroll
        for (int ks = 0; ks < 8; ++ks) {
          if (part == 0) acc[mt] = MFMA32(wfa[ks], cfa[ks], acc[mt]);
          else acc[mt] = MFMA32(cfa[ks], wfa[ks], acc[mt]);
        }
      }
      if (part == 0) {
        float ss = 0.f;
#pragma unroll
        for (int mt = 0; mt < 2; ++mt)
#pragma unroll
          for (int r = 0; r < 16; ++r) ss += acc[mt][r] * acc[mt][r];
        ss += xor32(ss);
        const float rn = rsqrtf(ss * (1.f / 64.f) + EPS);
#pragma unroll
        for (int mt = 0; mt < 2; ++mt)
#pragma unroll
          for (int q = 0; q < 4; ++q) {
            const int f0 = mt * 32 + 8 * q + 4 * h;
            const float4 g = *(const float4*)(p.kn_nope + layer * 64 + f0);
            *(u32x2*)(sK + (khu * 32 + l31) * 104 + f0) = u32x2{pk2(acc[mt][4 * q] * rn * g.x, acc[mt][4 * q + 1] * rn * g.y), pk2(acc[mt][4 * q + 2] * rn * g.z, acc[mt][4 * q + 3] * rn * g.w)};
          }
      } else {
#pragma unroll
        for (int mt = 0; mt < 2; ++mt)
#pragma unroll
          for (int q = 0; q < 4; ++q)
            *(u32x2*)(sVT + (mt * 32 + l31) * 68 + khu * 32 + 8 * q + 4 * h) =
                u32x2{pk2(acc[mt][4 * q], acc[mt][4 * q + 1]), pk2(acc[mt][4 * q + 2], acc[mt][4 * q + 3])};
      }
    }
    __syncthreads();
    attn_tile<1>(qf, sK, sVT, kh, o, l, negB, l31, h);
  }
#undef SA_GLOAD
  __syncthreads();
  float* cb = (float*)smem;
  if (kh == 1) {
    float* d = cb + (qh * 64 + lane) * 34;
#pragma unroll
    for (int r = 0; r < 16; ++r) { d[r] = o[0][r]; d[16 + r] = o[1][r]; }
    d[32] = l;
  }
  __syncthreads();
  if (kh == 0) {
    const float* d = cb + (qh * 64 + lane) * 34;
#pragma unroll
    for (int r = 0; r < 16; ++r) { o[0][r] += d[r]; o[1][r] += d[16 + r]; }
    l += d[32];
    l += xor32(l);
    attn_store(p, tok, hd, o, 1.f / l, h);
  }
}

template <int N> DI void fmac_bc(float& acc, float srcvec, float other) {
  asm("v_fmac_f32_dpp %0, %1, %2 row_newbcast:%3 row_mask:0xf bank_mask:0xf" : "+v"(acc) : "v"(srcvec), "v"(other), "n"(N));
}
template <int N> DI float mul_bc(float srcvec, float other) {
  float r;
  asm("v_mul_f32_dpp %0, %1, %2 row_newbcast:%3 row_mask:0xf bank_mask:0xf" : "=v"(r) : "v"(srcvec), "v"(other), "n"(N));
  return r;
}
struct RplRaw { u32x2 r, e, k, a, b; unsigned v; };
template <int MODE> DI void rpl_load(RplRaw& q, const u16* s, int n, int lane) {
  q.e = *(const u32x2*)(s + 64 + 4 * n);
  q.a = *(const u32x2*)(s + 256 + 4 * n);
  q.b = *(const u32x2*)(s + 320 + 4 * n);
  if (MODE >= 1) { q.k = *(const u32x2*)(s + 128 + 4 * n); q.v = s[192 + lane]; }
  if (MODE == 2) q.r = *(const u32x2*)(s + 4 * n);
}
template <int MODE>
DI void rpl_item(const Params& p, int hd, int tok0, int nsteps, const float* Sinit, float* Sout, float* Yg, int lane) {
  const int n = lane & 15;
  float S[64];
  if (MODE == 0) {
#pragma unroll
    for (int k = 0; k < 64; ++k) S[k] = (k == lane) ? 1.f : 0.f;
  } else if (MODE == 1) {
#pragma unroll
    for (int k = 0; k < 64; ++k) S[k] = 0.f;
  } else {
#pragma unroll
    for (int k = 0; k < 64; k += 4) {
      const f32x4 t = *(const f32x4*)(Sinit + (size_t)lane * 64 + k);
      S[k] = t.x; S[k + 1] = t.y; S[k + 2] = t.z; S[k + 3] = t.w;
    }
  }
  const u16* src = (const u16*)(p.ws + WS_WKVIN) + ((size_t)hd * NT + tok0) * 384;
  RplRaw c0, c1, c2;
  rpl_load<MODE>(c0, src, n, lane);
  rpl_load<MODE>(c1, src + 384, n, lane);
  for (int t = 0; t < nsteps; ++t) {
    if (t + 2 < nsteps) rpl_load<MODE>(c2, src + (size_t)(t + 2) * 384, n, lane);
    float A0 = -lo2f(c0.a.x), A1 = -hi2f(c0.a.x), A2 = -lo2f(c0.a.y), A3 = -hi2f(c0.a.y);
    float W0 = __expf(-lo2f(c0.e.x)), W1 = __expf(-hi2f(c0.e.x)), W2 = __expf(-lo2f(c0.e.y)), W3 = __expf(-hi2f(c0.e.y));
    float B0 = lo2f(c0.b.x), B1 = hi2f(c0.b.x), B2 = lo2f(c0.b.y), B3 = hi2f(c0.b.y);
    float K0 = 0.f, K1 = 0.f, K2 = 0.f, K3 = 0.f, R0 = 0.f, R1 = 0.f, R2 = 0.f, R3 = 0.f, vv = 0.f;
    if (MODE >= 1) { K0 = lo2f(c0.k.x); K1 = hi2f(c0.k.x); K2 = lo2f(c0.k.y); K3 = hi2f(c0.k.y); vv = lo2f(c0.v); }
    if (MODE == 2) { R0 = lo2f(c0.r.x); R1 = hi2f(c0.r.x); R2 = lo2f(c0.r.y); R3 = hi2f(c0.r.y); }
    asm volatile("s_nop 1" : "+v"(A0), "+v"(A1), "+v"(A2), "+v"(A3), "+v"(W0), "+v"(W1), "+v"(W2), "+v"(W3), "+v"(B0), "+v"(B1), "+v"(B2), "+v"(B3));
    asm volatile("s_nop 1" : "+v"(K0), "+v"(K1), "+v"(K2), "+v"(K3), "+v"(R0), "+v"(R1), "+v"(R2), "+v"(R3));
    float sa0 = 0.f, sa1 = 0.f, sa2 = 0.f, sa3 = 0.f;
    fmac_bc<0>(sa0, A0, S[0]);
    fmac_bc<0>(sa1, A1, S[1]);
    fmac_bc<0>(sa2, A2, S[2]);
    fmac_bc<0>(sa3, A3, S[3]);
    fmac_bc<1>(sa0, A0, S[4]);
    fmac_bc<1>(sa1, A1, S[5]);
    fmac_bc<1>(sa2, A2, S[6]);
    fmac_bc<1>(sa3, A3, S[7]);
    fmac_bc<2>(sa0, A0, S[8]);
    fmac_bc<2>(sa1, A1, S[9]);
    fmac_bc<2>(sa2, A2, S[10]);
    fmac_bc<2>(sa3, A3, S[11]);
    fmac_bc<3>(sa0, A0, S[12]);
    fmac_bc<3>(sa1, A1, S[13]);
    fmac_bc<3>(sa2, A2, S[14]);
    fmac_bc<3>(sa3, A3, S[15]);
    fmac_bc<4>(sa0, A0, S[16]);
    fmac_bc<4>(sa1, A1, S[17]);
    fmac_bc<4>(sa2, A2, S[18]);
    fmac_bc<4>(sa3, A3, S[19]);
    fmac_bc<5>(sa0, A0, S[20]);
    fmac_bc<5>(sa1, A1, S[21]);
    fmac_bc<5>(sa2, A2, S[22]);
    fmac_bc<5>(sa3, A3, S[23]);
    fmac_bc<6>(sa0, A0, S[24]);
    fmac_bc<6>(sa1, A1, S[25]);
    fmac_bc<6>(sa2, A2, S[26]);
    fmac_bc<6>(sa3, A3, S[27]);
    fmac_bc<7>(sa0, A0, S[28]);
    fmac_bc<7>(sa1, A1, S[29]);
    fmac_bc<7>(sa2, A2, S[30]);
    fmac_bc<7>(sa3, A3, S[31]);
    fmac_bc<8>(sa0, A0, S[32]);
    fmac_bc<8>(sa1, A1, S[33]);
    fmac_bc<8>(sa2, A2, S[34]);
    fmac_bc<8>(sa3, A3, S[35]);
    fmac_bc<9>(sa0, A0, S[36]);
    fmac_bc<9>(sa1, A1, S[37]);
    fmac_bc<9>(sa2, A2, S[38]);
    fmac_bc<9>(sa3, A3, S[39]);
    fmac_bc<10>(sa0, A0, S[40]);
    fmac_bc<10>(sa1, A1, S[41]);
    fmac_bc<10>(sa2, A2, S[42]);
    fmac_bc<10>(sa3, A3, S[43]);
    fmac_bc<11>(sa0, A0, S[44]);
    fmac_bc<11>(sa1, A1, S[45]);
    fmac_bc<11>(sa2, A2, S[46]);
    fmac_bc<11>(sa3, A3, S[47]);
    fmac_bc<12>(sa0, A0, S[48]);
    fmac_bc<12>(sa1, A1, S[49]);
    fmac_bc<12>(sa2, A2, S[50]);
    fmac_bc<12>(sa3, A3, S[51]);
    fmac_bc<13>(sa0, A0, S[52]);
    fmac_bc<13>(sa1, A1, S[53]);
    fmac_bc<13>(sa2, A2, S[54]);
    fmac_bc<13>(sa3, A3, S[55]);
    fmac_bc<14>(sa0, A0, S[56]);
    fmac_bc<14>(sa1, A1, S[57]);
    fmac_bc<14>(sa2, A2, S[58]);
    fmac_bc<14>(sa3, A3, S[59]);
    fmac_bc<15>(sa0, A0, S[60]);
    fmac_bc<15>(sa1, A1, S[61]);
    fmac_bc<15>(sa2, A2, S[62]);
    fmac_bc<15>(sa3, A3, S[63]);
    const float sa = (sa0 + sa1) + (sa2 + sa3);
    float y0 = 0.f, y1 = 0.f, y2 = 0.f, y3 = 0.f;
    S[0] = mul_bc<0>(W0, S[0]);
    S[1] = mul_bc<0>(W1, S[1]);
    S[2] = mul_bc<0>(W2, S[2]);
    S[3] = mul_bc<0>(W3, S[3]);
    S[4] = mul_bc<1>(W0, S[4]);
    S[5] = mul_bc<1>(W1, S[5]);
    S[6] = mul_bc<1>(W2, S[6]);
    S[7] = mul_bc<1>(W3, S[7]);
    if (MODE >= 1) {
      fmac_bc<0>(S[0], K0, vv);
      fmac_bc<0>(S[1], K1, vv);
      fmac_bc<0>(S[2], K2, vv);
      fmac_bc<0>(S[3], K3, vv);
      fmac_bc<1>(S[4], K0, vv);
      fmac_bc<1>(S[5], K1, vv);
      fmac_bc<1>(S[6], K2, vv);
      fmac_bc<1>(S[7], K3, vv);
    }
    fmac_bc<0>(S[0], B0, sa);
    fmac_bc<0>(S[1], B1, sa);
    fmac_bc<0>(S[2], B2, sa);
    fmac_bc<0>(S[3], B3, sa);
    fmac_bc<1>(S[4], B0, sa);
    fmac_bc<1>(S[5], B1, sa);
    fmac_bc<1>(S[6], B2, sa);
    fmac_bc<1>(S[7], B3, sa);
    if (MODE == 2) {
      fmac_bc<0>(y0, R0, S[0]);
      fmac_bc<0>(y1, R1, S[1]);
      fmac_bc<0>(y2, R2, S[2]);
      fmac_bc<0>(y3, R3, S[3]);
      fmac_bc<1>(y0, R0, S[4]);
      fmac_bc<1>(y1, R1, S[5]);
      fmac_bc<1>(y2, R2, S[6]);
      fmac_bc<1>(y3, R3, S[7]);
    }
    S[8] = mul_bc<2>(W0, S[8]);
    S[9] = mul_bc<2>(W1, S[9]);
    S[10] = mul_bc<2>(W2, S[10]);
    S[11] = mul_bc<2>(W3, S[11]);
    S[12] = mul_bc<3>(W0, S[12]);
    S[13] = mul_bc<3>(W1, S[13]);
    S[14] = mul_bc<3>(W2, S[14]);
    S[15] = mul_bc<3>(W3, S[15]);
    if (MODE >= 1) {
      fmac_bc<2>(S[8], K0, vv);
      fmac_bc<2>(S[9], K1, vv);
      fmac_bc<2>(S[10], K2, vv);
      fmac_bc<2>(S[11], K3, vv);
      fmac_bc<3>(S[12], K0, vv);
      fmac_bc<3>(S[13], K1, vv);
      fmac_bc<3>(S[14], K2, vv);
      fmac_bc<3>(S[15], K3, vv);
    }
    fmac_bc<2>(S[8], B0, sa);
    fmac_bc<2>(S[9], B1, sa);
    fmac_bc<2>(S[10], B2, sa);
    fmac_bc<2>(S[11], B3, sa);
    fmac_bc<3>(S[12], B0, sa);
    fmac_bc<3>(S[13], B1, sa);
    fmac_bc<3>(S[14], B2, sa);
    fmac_bc<3>(S[15], B3, sa);
    if (MODE == 2) {
      fmac_bc<2>(y0, R0, S[8]);
      fmac_bc<2>(y1, R1, S[9]);
      fmac_bc<2>(y2, R2, S[10]);
      fmac_bc<2>(y3, R3, S[11]);
      fmac_bc<3>(y0, R0, S[12]);
      fmac_bc<3>(y1, R1, S[13]);
      fmac_bc<3>(y2, R2, S[14]);
      fmac_bc<3>(y3, R3, S[15]);
    }
    S[16] = mul_bc<4>(W0, S[16]);
    S[17] = mul_bc<4>(W1, S[17]);
    S[18] = mul_bc<4>(W2, S[18]);
    S[19] = mul_bc<4>(W3, S[19]);
    S[20] = mul_bc<5>(W0, S[20]);
    S[21] = mul_bc<5>(W1, S[21]);
    S[22] = mul_bc<5>(W2, S[22]);
    S[23] = mul_bc<5>(W3, S[23]);
    if (MODE >= 1) {
      fmac_bc<4>(S[16], K0, vv);
      fmac_bc<4>(S[17], K1, vv);
      fmac_bc<4>(S[18], K2, vv);
      fmac_bc<4>(S[19], K3, vv);
      fmac_bc<5>(S[20], K0, vv);
      fmac_bc<5>(S[21], K1, vv);
      fmac_bc<5>(S[22], K2, vv);
      fmac_bc<5>(S[23], K3, vv);
    }
    fmac_bc<4>(S[16], B0, sa);
    fmac_bc<4>(S[17], B1, sa);
    fmac_bc<4>(S[18], B2, sa);
    fmac_bc<4>(S[19], B3, sa);
    fmac_bc<5>(S[20], B0, sa);
    fmac_bc<5>(S[21], B1, sa);
    fmac_bc<5>(S[22], B2, sa);
    fmac_bc<5>(S[23], B3, sa);
    if (MODE == 2) {
      fmac_bc<4>(y0, R0, S[16]);
      fmac_bc<4>(y1, R1, S[17]);
      fmac_bc<4>(y2, R2, S[18]);
      fmac_bc<4>(y3, R3, S[19]);
      fmac_bc<5>(y0, R0, S[20]);
      fmac_bc<5>(y1, R1, S[21]);
      fmac_bc<5>(y2, R2, S[22]);
      fmac_bc<5>(y3, R3, S[23]);
    }
    S[24] = mul_bc<6>(W0, S[24]);
    S[25] = mul_bc<6>(W1, S[25]);
    S[26] = mul_bc<6>(W2, S[26]);
    S[27] = mul_bc<6>(W3, S[27]);
    S[28] = mul_bc<7>(W0, S[28]);
    S[29] = mul_bc<7>(W1, S[29]);
    S[30] = mul_bc<7>(W2, S[30]);
    S[31] = mul_bc<7>(W3, S[31]);
    if (MODE >= 1) {
      fmac_bc<6>(S[24], K0, vv);
      fmac_bc<6>(S[25], K1, vv);
      fmac_bc<6>(S[26], K2, vv);
      fmac_bc<6>(S[27], K3, vv);
      fmac_bc<7>(S[28], K0, vv);
      fmac_bc<7>(S[29], K1, vv);
      fmac_bc<7>(S[30], K2, vv);
      fmac_bc<7>(S[31], K3, vv);
    }
    fmac_bc<6>(S[24], B0, sa);
    fmac_bc<6>(S[25], B1, sa);
    fmac_bc<6>(S[26], B2, sa);
    fmac_bc<6>(S[27], B3, sa);
    fmac_bc<7>(S[28], B0, sa);
    fmac_bc<7>(S[29], B1, sa);
    fmac_bc<7>(S[30], B2, sa);
    fmac_bc<7>(S[31], B3, sa);
    if (MODE == 2) {
      fmac_bc<6>(y0, R0, S[24]);
      fmac_bc<6>(y1, R1, S[25]);
      fmac_bc<6>(y2, R2, S[26]);
      fmac_bc<6>(y3, R3, S[27]);
      fmac_bc<7>(y0, R0, S[28]);
      fmac_bc<7>(y1, R1, S[29]);
      fmac_bc<7>(y2, R2, S[30]);
      fmac_bc<7>(y3, R3, S[31]);
    }
    S[32] = mul_bc<8>(W0, S[32]);
    S[33] = mul_bc<8>(W1, S[33]);
    S[34] = mul_bc<8>(W2, S[34]);
    S[35] = mul_bc<8>(W3, S[35]);
    S[36] = mul_bc<9>(W0, S[36]);
    S[37] = mul_bc<9>(W1, S[37]);
    S[38] = mul_bc<9>(W2, S[38]);
    S[39] = mul_bc<9>(W3, S[39]);
    if (MODE >= 1) {
      fmac_bc<8>(S[32], K0, vv);
      fmac_bc<8>(S[33], K1, vv);
      fmac_bc<8>(S[34], K2, vv);
      fmac_bc<8>(S[35], K3, vv);
      fmac_bc<9>(S[36], K0, vv);
      fmac_bc<9>(S[37], K1, vv);
      fmac_bc<9>(S[38], K2, vv);
      fmac_bc<9>(S[39], K3, vv);
    }
    fmac_bc<8>(S[32], B0, sa);
    fmac_bc<8>(S[33], B1, sa);
    fmac_bc<8>(S[34], B2, sa);
    fmac_bc<8>(S[35], B3, sa);
    fmac_bc<9>(S[36], B0, sa);
    fmac_bc<9>(S[37], B1, sa);
    fmac_bc<9>(S[38], B2, sa);
    fmac_bc<9>(S[39], B3, sa);
    if (MODE == 2) {
      fmac_bc<8>(y0, R0, S[32]);
      fmac_bc<8>(y1, R1, S[33]);
      fmac_bc<8>(y2, R2, S[34]);
      fmac_bc<8>(y3, R3, S[35]);
      fmac_bc<9>(y0, R0, S[36]);
      fmac_bc<9>(y1, R1, S[37]);
      fmac_bc<9>(y2, R2, S[38]);
      fmac_bc<9>(y3, R3, S[39]);
    }
    S[40] = mul_bc<10>(W0, S[40]);
    S[41] = mul_bc<10>(W1, S[41]);
    S[42] = mul_bc<10>(W2, S[42]);
    S[43] = mul_bc<10>(W3, S[43]);
    S[44] = mul_bc<11>(W0, S[44]);
    S[45] = mul_bc<11>(W1, S[45]);
    S[46] = mul_bc<11>(W2, S[46]);
    S[47] = mul_bc<11>(W3, S[47]);
    if (MODE >= 1) {
      fmac_bc<10>(S[40], K0, vv);
      fmac_bc<10>(S[41], K1, vv);
      fmac_bc<10>(S[42], K2, vv);
      fmac_bc<10>(S[43], K3, vv);
      fmac_bc<11>(S[44], K0, vv);
      fmac_bc<11>(S[45], K1, vv);
      fmac_bc<11>(S[46], K2, vv);
      fmac_bc<11>(S[47], K3, vv);
    }
    fmac_bc<10>(S[40], B0, sa);
    fmac_bc<10>(S[41], B1, sa);
    fmac_bc<10>(S[42], B2, sa);
    fmac_bc<10>(S[43], B3, sa);
    fmac_bc<11>(S[44], B0, sa);
    fmac_bc<11>(S[45], B1, sa);
    fmac_bc<11>(S[46], B2, sa);
    fmac_bc<11>(S[47], B3, sa);
    if (MODE == 2) {
      fmac_bc<10>(y0, R0, S[40]);
      fmac_bc<10>(y1, R1, S[41]);
      fmac_bc<10>(y2, R2, S[42]);
      fmac_bc<10>(y3, R3, S[43]);
      fmac_bc<11>(y0, R0, S[44]);
      fmac_bc<11>(y1, R1, S[45]);
      fmac_bc<11>(y2, R2, S[46]);
      fmac_bc<11>(y3, R3, S[47]);
    }
    S[48] = mul_bc<12>(W0, S[48]);
    S[49] = mul_bc<12>(W1, S[49]);
    S[50] = mul_bc<12>(W2, S[50]);
    S[51] = mul_bc<12>(W3, S[51]);
    S[52] = mul_bc<13>(W0, S[52]);
    S[53] = mul_bc<13>(W1, S[53]);
    S[54] = mul_bc<13>(W2, S[54]);
    S[55] = mul_bc<13>(W3, S[55]);
    if (MODE >= 1) {
      fmac_bc<12>(S[48], K0, vv);
      fmac_bc<12>(S[49], K1, vv);
      fmac_bc<12>(S[50], K2, vv);
      fmac_bc<12>(S[51], K3, vv);
      fmac_bc<13>(S[52], K0, vv);
      fmac_bc<13>(S[53], K1, vv);
      fmac_bc<13>(S[54], K2, vv);
      fmac_bc<13>(S[55], K3, vv);
    }
    fmac_bc<12>(S[48], B0, sa);
    fmac_bc<12>(S[49], B1, sa);
    fmac_bc<12>(S[50], B2, sa);
    fmac_bc<12>(S[51], B3, sa);
    fmac_bc<13>(S[52], B0, sa);
    fmac_bc<13>(S[53], B1, sa);
    fmac_bc<13>(S[54], B2, sa);
    fmac_bc<13>(S[55], B3, sa);
    if (MODE == 2) {
      fmac_bc<12>(y0, R0, S[48]);
      fmac_bc<12>(y1, R1, S[49]);
      fmac_bc<12>(y2, R2, S[50]);
      fmac_bc<12>(y3, R3, S[51]);
      fmac_bc<13>(y0, R0, S[52]);
      fmac_bc<13>(y1, R1, S[53]);
      fmac_bc<13>(y2, R2, S[54]);
      fmac_bc<13>(y3, R3, S[55]);
    }
    S[56] = mul_bc<14>(W0, S[56]);
    S[57] = mul_bc<14>(W1, S[57]);
    S[58] = mul_bc<14>(W2, S[58]);
    S[59] = mul_bc<14>(W3, S[59]);
    S[60] = mul_bc<15>(W0, S[60]);
    S[61] = mul_bc<15>(W1, S[61]);
    S[62] = mul_bc<15>(W2, S[62]);
    S[63] = mul_bc<15>(W3, S[63]);
    if (MODE >= 1) {
      fmac_bc<14>(S[56], K0, vv);
      fmac_bc<14>(S[57], K1, vv);
      fmac_bc<14>(S[58], K2, vv);
      fmac_bc<14>(S[59], K3, vv);
      fmac_bc<15>(S[60], K0, vv);
      fmac_bc<15>(S[61], K1, vv);
      fmac_bc<15>(S[62], K2, vv);
      fmac_bc<15>(S[63], K3, vv);
    }
    fmac_bc<14>(S[56], B0, sa);
    fmac_bc<14>(S[57], B1, sa);
    fmac_bc<14>(S[58], B2, sa);
    fmac_bc<14>(S[59], B3, sa);
    fmac_bc<15>(S[60], B0, sa);
    fmac_bc<15>(S[61], B1, sa);
    fmac_bc<15>(S[62], B2, sa);
    fmac_bc<15>(S[63], B3, sa);
    if (MODE == 2) {
      fmac_bc<14>(y0, R0, S[56]);
      fmac_bc<14>(y1, R1, S[57]);
      fmac_bc<14>(y2, R2, S[58]);
      fmac_bc<14>(y3, R3, S[59]);
      fmac_bc<15>(y0, R0, S[60]);
      fmac_bc<15>(y1, R1, S[61]);
      fmac_bc<15>(y2, R2, S[62]);
      fmac_bc<15>(y3, R3, S[63]);
    }
    if (MODE == 2) Yg[(size_t)t * 512 + lane] = (y0 + y1) + (y2 + y3);
    c0 = c1; c1 = c2;
  }
  if (Sout) {
#pragma unroll
    for (int k = 0; k < 64; k += 4) *(f32x4*)(Sout + (size_t)lane * 64 + k) = f32x4{S[k], S[k + 1], S[k + 2], S[k + 3]};
  }
}

constexpr int RC = 128;
constexpr int NCH = NP / RC;
DI void seqs_item(const Params& p, int layer, int hd, char* smem) {
  float* sS = (float*)smem;
  const int tid = tidx(), lane = tid & 63, w = tid >> 6, l31 = lane & 31, h = lane >> 5, wr = w >> 1, wc = w & 1;
  const float* PQ = (const float*)(p.ws + WS_Y) + (size_t)hd * NCH * 8192;
  float* SS = (float*)(p.ws + WS_H) + (size_t)hd * NCH * 4096;
  const unsigned* pqflag = (const unsigned*)(p.ws + WS_CTR) + 1024 + (layer * 8 + hd) * 64;
  __syncthreads();
  for (int i = tid; i < 64 * 65; i += 256) sS[i] = 0.f;
  for (int i = tid; i < 4096; i += 256) SS[i] = 0.f;
  if (tid == 0) {
    for (int j = 0; j < 5; ++j)
      while (__hip_atomic_load((unsigned*)pqflag + j, __ATOMIC_RELAXED, __HIP_MEMORY_SCOPE_AGENT) == 0u) __builtin_amdgcn_s_sleep(4);
    __builtin_amdgcn_fence(__ATOMIC_ACQUIRE, "agent");
    asm volatile("s_waitcnt vmcnt(0)" ::: "memory");
  }
  __syncthreads();
  float bP[32], bQ[16], nP[32], nQ[16];
#pragma unroll
  for (int ks = 0; ks < 32; ++ks) bP[ks] = PQ[(2 * ks + h) * 64 + 32 * wc + l31];
#pragma unroll
  for (int r = 0; r < 16; ++r) bQ[r] = PQ[4096 + (32 * wr + crow(r, h)) * 64 + 32 * wc + l31];
  for (int c = 0; c < NCH; ++c) {
    if ((c & 7) == 0 && c > 0) {
      if (tid == 0) {
        const int j0 = c >> 1, j1 = (c + 8 < NCH) ? j0 + 5 : j0 + 4;
        for (int j = j0; j < j1; ++j)
          while (__hip_atomic_load((unsigned*)pqflag + j, __ATOMIC_RELAXED, __HIP_MEMORY_SCOPE_AGENT) == 0u) __builtin_amdgcn_s_sleep(4);
        __builtin_amdgcn_fence(__ATOMIC_ACQUIRE, "agent");
        asm volatile("s_waitcnt vmcnt(0)" ::: "memory");
      }
      __syncthreads();
    }
    if (c + 1 < NCH) {
      const float* Pn = PQ + (size_t)(c + 1) * 8192;
#pragma unroll
      for (int ks = 0; ks < 32; ++ks) nP[ks] = Pn[(2 * ks + h) * 64 + 32 * wc + l31];
#pragma unroll
      for (int r = 0; r < 16; ++r) nQ[r] = Pn[4096 + (32 * wr + crow(r, h)) * 64 + 32 * wc + l31];
    }
    f32x16 acc;
#pragma unroll
    for (int r = 0; r < 16; ++r) acc[r] = bQ[r];
    float a[32];
#pragma unroll
    for (int ks = 0; ks < 32; ++ks) a[ks] = sS[(32 * wr + l31) * 65 + 2 * ks + h];
#pragma unroll
    for (int ks = 0; ks < 32; ++ks) acc = __builtin_amdgcn_mfma_f32_32x32x2f32(a[ks], bP[ks], acc, 0, 0, 0);
    __syncthreads();
    float* dst = (c + 1 < NCH) ? SS + (size_t)(c + 1) * 4096 : p.out + OFF_WKV_P + ((size_t)layer * 8 + hd) * 4096;
#pragma unroll
    for (int r = 0; r < 16; ++r) {
      const int row = 32 * wr + crow(r, h), col = 32 * wc + l31;
      sS[row * 65 + col] = acc[r];
      dst[row * 64 + col] = acc[r];
    }
    __syncthreads();
#pragma unroll
    for (int ks = 0; ks < 32; ++ks) bP[ks] = nP[ks];
#pragma unroll
    for (int r = 0; r < 16; ++r) bQ[r] = nQ[r];
  }
}

DI void phase_mix(const Params& p, int layer, char* smem, int* s_item) {
  constexpr int NQ_PQ = NCH * 2 / 4, NQ_SY = 4, NQ_SATT = 16, NQ_PATT = 128;
  int* qctr = (int*)(p.ws + WS_CTR) + 64 + layer * 8;
  int* actr = (int*)(p.ws + WS_CTR) + 192 + layer * 8;
  if (blockIdx.x < 8) { seqs_item(p, layer, blockIdx.x, smem); return; }
  const int home = blockIdx.x & 7;
  const int first = (blockIdx.x >> 3) & 1;
  for (int pass = 0; pass < 2; ++pass) {
    const int kind = pass ^ first;
    for (int qi = 0; qi < 8; ++qi) {
      const int hd = (home + qi) & 7;
      for (;;) {
        __syncthreads();
        if (tidx() == 0) *s_item = atomicAdd((kind == 0 ? qctr : actr) + hd, 1);
        __syncthreads();
        const int it = *s_item;
        const int wave = __builtin_amdgcn_readfirstlane(tidx() >> 6), lane = tidx() & 63;
        if (kind == 0) {
          if (it >= NQ_PQ + NQ_SY) break;
          if (it < NQ_PQ) {
            const int q = it * 4 + wave, mode = q & 1, ch = q >> 1;
            float* dstm = (float*)(p.ws + WS_Y) + ((size_t)(hd * NCH + ch) * 2 + mode) * 4096;
            if (mode == 0) rpl_item<0>(p, hd, ch * RC, RC, nullptr, dstm, nullptr, lane);
            else rpl_item<1>(p, hd, ch * RC, RC, nullptr, dstm, nullptr, lane);
            asm volatile("s_waitcnt vmcnt(0)" ::: "memory");
            __syncthreads();
            if (tidx() == 0) {
              __builtin_amdgcn_fence(__ATOMIC_RELEASE, "agent");
              asm volatile("s_waitcnt vmcnt(0)" ::: "memory");
              __hip_atomic_store((unsigned*)(p.ws + WS_CTR) + 1024 + (layer * 8 + hd) * 64 + it, 1u, __ATOMIC_RELAXED, __HIP_MEMORY_SCOPE_AGENT);
            }
            continue;
          }
          const int b = (it - NQ_PQ) * 4 + wave;
          rpl_item<2>(p, hd, NP + b * 64, 64, p.state_wkv + (((size_t)layer * 16 + b) * 8 + hd) * 4096,
                      p.out + OFF_WKV_S + (((size_t)layer * 16 + b) * 8 + hd) * 4096, (float*)(p.ws + WS_Y) + (size_t)(NP + b * 64) * 512 + hd * 64, lane);
        } else {
          if (it >= NQ_SATT + NQ_PATT) break;
          if (it < NQ_SATT) { attn_sample_item(p, layer, it, hd, smem); continue; }
          attn_prompt_item(p, layer, 127 - (it - NQ_SATT), hd, smem);
        }
      }
    }
  }
}
DI void phase_ypass(const Params& p, int layer) {
  const int wave = __builtin_amdgcn_readfirstlane(tidx() >> 6), lane = tidx() & 63;
  const int hd = blockIdx.x & 7, nb = (gridDim.x + 7 - hd) >> 3;
  for (int j = blockIdx.x >> 3; j < NCH / 4; j += nb) {
    const int ch = j * 4 + wave;
    rpl_item<2>(p, hd, ch * RC, RC, (const float*)(p.ws + WS_H) + (size_t)(hd * NCH + ch) * 4096, nullptr,
                (float*)(p.ws + WS_Y) + (size_t)(ch * RC) * 512 + hd * 64, lane);
  }
}

DI void phase_ob(const Params& p, int layer) {
  const int wave = tidx() >> 6, lane = tidx() & 63;
  const float* Y = (const float*)(p.ws + WS_Y);
  const u16* WK = (const u16*)(p.ws + WS_WKVIN);
  const u16* Z = (const u16*)(p.ws + WS_Z);
  u16* OB = (u16*)(p.ws + WS_Q);
  const int f = lane * 8, hd = lane >> 3, fl = (lane & 7) * 8;
  for (int t = blockIdx.x * 4 + wave; t < NT; t += gridDim.x * 4) {
    const float4 ya = *(const float4*)(Y + (size_t)t * 512 + f);
    const float4 yb = *(const float4*)(Y + (size_t)t * 512 + f + 4);
    float y[8] = {ya.x, ya.y, ya.z, ya.w, yb.x, yb.y, yb.z, yb.w};
    float s = 0.f;
#pragma unroll
    for (int j = 0; j < 8; ++j) s += y[j];
    s += __shfl_xor(s, 1); s += __shfl_xor(s, 2); s += __shfl_xor(s, 4);
    const float mu = s * (1.f / 64.f);
    float vs = 0.f;
#pragma unroll
    for (int j = 0; j < 8; ++j) { y[j] -= mu; vs += y[j] * y[j]; }
    vs += __shfl_xor(vs, 1); vs += __shfl_xor(vs, 2); vs += __shfl_xor(vs, 4);
    const float rs = rsqrtf(vs * (1.f / 64.f) + GN_EPS);
    const u16* wk = WK + ((size_t)hd * NT + t) * 384 + fl;
    const uint4 r8 = *(const uint4*)(wk + 0 * 64);
    const uint4 k8 = *(const uint4*)(wk + 2 * 64);
    const uint4 v8 = *(const uint4*)(wk + 3 * 64);
    const float rr[8] = {lo2f(r8.x), hi2f(r8.x), lo2f(r8.y), hi2f(r8.y), lo2f(r8.z), hi2f(r8.z), lo2f(r8.w), hi2f(r8.w)};
    const float kk[8] = {lo2f(k8.x), hi2f(k8.x), lo2f(k8.y), hi2f(k8.y), lo2f(k8.z), hi2f(k8.z), lo2f(k8.w), hi2f(k8.w)};
    const float vv[8] = {lo2f(v8.x), hi2f(v8.x), lo2f(v8.y), hi2f(v8.y), lo2f(v8.z), hi2f(v8.z), lo2f(v8.w), hi2f(v8.w)};
    const float4 rka = *(const float4*)(p.r_k + layer * 512 + f);
    const float4 rkb = *(const float4*)(p.r_k + layer * 512 + f + 4);
    const float rk[8] = {rka.x, rka.y, rka.z, rka.w, rkb.x, rkb.y, rkb.z, rkb.w};
    float bs = 0.f;
#pragma unroll
    for (int j = 0; j < 8; ++j) bs += rr[j] * kk[j] * rk[j];
    bs += __shfl_xor(bs, 1); bs += __shfl_xor(bs, 2); bs += __shfl_xor(bs, 4);
    const float4 lwa = *(const float4*)(p.lnx_w + layer * 512 + f);
    const float4 lwb = *(const float4*)(p.lnx_w + layer * 512 + f + 4);
    const float4 lba = *(const float4*)(p.lnx_b + layer * 512 + f);
    const float4 lbb = *(const float4*)(p.lnx_b + layer * 512 + f + 4);
    const float lw[8] = {lwa.x, lwa.y, lwa.z, lwa.w, lwb.x, lwb.y, lwb.z, lwb.w};
    const float lb[8] = {lba.x, lba.y, lba.z, lba.w, lbb.x, lbb.y, lbb.z, lbb.w};
    const uint4 g8 = *(const uint4*)(Z + (size_t)t * NZ + ZC_GB + f);
    const float gg[8] = {lo2f(g8.x), hi2f(g8.x), lo2f(g8.y), hi2f(g8.y), lo2f(g8.z), hi2f(g8.z), lo2f(g8.w), hi2f(g8.w)};
    float ov[8];
#pragma unroll
    for (int j = 0; j < 8; ++j) ov[j] = (y[j] * rs * lw[j] + lb[j] + bs * vv[j]) * siluf_(gg[j]);
    *(uint4*)(OB + (size_t)t * 512 + f) = make_uint4(pk2(ov[0], ov[1]), pk2(ov[2], ov[3]), pk2(ov[4], ov[5]), pk2(ov[6], ov[7]));
  }
}

DI void phase_merge(const Params& p, int layer, char* smem) {
  const u16* OA = (const u16*)(p.ws + WS_OA);
  const u16* OB = (const u16*)(p.ws + WS_Q);
  const u16* WA = (const u16*)(p.ws + (size_t)layer * WL_STRIDE + W_OA);
  const u16* WB = (const u16*)(p.ws + (size_t)layer * WL_STRIDE + W_OB);
  const u16* Z = (const u16*)(p.ws + WS_Z);
  u16* M = (u16*)(p.ws + WS_H);
  const int xcd = blockIdx.x & 7, jb = blockIdx.x >> 3, nb = (gridDim.x + 7 - xcd) >> 3;
  for (int m = jb; m < 16 * 8; m += nb) {
    const int tt = xcd + 8 * (m >> 3), ft = m & 7;
    f32x16 acc[2][2];
    zero_acc(acc);
    gemm_mainloop(OA + (size_t)tt * 128 * 512, 512, WA + (size_t)ft * 128 * 512, 512, 512, smem, acc);
    acc_to_lds(acc, smem);
    EPI_ROWS({
      const u32x2 g = *(const u32x2*)(Z + (size_t)(tt * 128 + row) * NZ + ZC_MA + ft * 128 + col);
      *(u32x2*)(M + (size_t)(tt * 128 + row) * 1024 + ft * 128 + col) =
          u32x2{pk2(v.x * sigmoidf_(lo2f(g.x)), v.y * sigmoidf_(hi2f(g.x))), pk2(v.z * sigmoidf_(lo2f(g.y)), v.w * sigmoidf_(hi2f(g.y)))};
    })
    zero_acc(acc);
    gemm_mainloop(OB + (size_t)tt * 128 * 512, 512, WB + (size_t)ft * 128 * 512, 512, 512, smem, acc);
    acc_to_lds(acc, smem);
    EPI_ROWS({
      const u32x2 g = *(const u32x2*)(Z + (size_t)(tt * 128 + row) * NZ + ZC_MB + ft * 128 + col);
      u32x2* mp = (u32x2*)(M + (size_t)(tt * 128 + row) * 1024 + ft * 128 + col);
      const u32x2 pm = *mp;
      *mp = u32x2{pk2(lo2f(pm.x) + v.x * sigmoidf_(lo2f(g.x)), hi2f(pm.x) + v.y * sigmoidf_(hi2f(g.x))),
                  pk2(lo2f(pm.y) + v.z * sigmoidf_(lo2f(g.y)), hi2f(pm.y) + v.w * sigmoidf_(hi2f(g.y)))};
    })
  }
  for (int m = jb; m < 2 * 16; m += nb) {
    const int r0 = (128 + xcd) * 128 + (m >> 4) * 64, c0 = (m & 15) * 64;
    f32x16 acc;
#pragma unroll
    for (int r = 0; r < 16; ++r) acc[r] = 0.f;
    gemm64_mainloop(OA + (size_t)r0 * 512, 512, WA + (size_t)c0 * 512, 512, 512, smem, acc);
    acc64_to_lds(acc, smem);
    EPI64_ROWS({
      const u32x2 g = *(const u32x2*)(Z + (size_t)(r0 + row) * NZ + ZC_MA + c0 + col);
      *(u32x2*)(M + (size_t)(r0 + row) * 1024 + c0 + col) =
          u32x2{pk2(v.x * sigmoidf_(lo2f(g.x)), v.y * sigmoidf_(hi2f(g.x))), pk2(v.z * sigmoidf_(lo2f(g.y)), v.w * sigmoidf_(hi2f(g.y)))};
    })
#pragma unroll
    for (int r = 0; r < 16; ++r) acc[r] = 0.f;
    gemm64_mainloop(OB + (size_t)r0 * 512, 512, WB + (size_t)c0 * 512, 512, 512, smem, acc);
    acc64_to_lds(acc, smem);
    EPI64_ROWS({
      const u32x2 g = *(const u32x2*)(Z + (size_t)(r0 + row) * NZ + ZC_MB + c0 + col);
      u32x2* mp = (u32x2*)(M + (size_t)(r0 + row) * 1024 + c0 + col);
      const u32x2 pm = *mp;
      *mp = u32x2{pk2(lo2f(pm.x) + v.x * sigmoidf_(lo2f(g.x)), hi2f(pm.x) + v.y * sigmoidf_(hi2f(g.x))),
                  pk2(lo2f(pm.y) + v.z * sigmoidf_(lo2f(g.y)), hi2f(pm.y) + v.w * sigmoidf_(hi2f(g.y)))};
    })
  }
}

DI void phase_out(const Params& p, int layer, char* smem) {
  const u16* M = (const u16*)(p.ws + WS_H);
  const u16* W = (const u16*)(p.ws + (size_t)layer * WL_STRIDE + W_O);
  const int xcd = blockIdx.x & 7, jb = blockIdx.x >> 3, nb = (gridDim.x + 7 - xcd) >> 3;
  for (int m = jb; m < 16 * 8; m += nb) {
    const int tt = xcd + 8 * (m >> 3), ft = m & 7;
    f32x16 acc[2][2];
    zero_acc(acc);
    gemm_mainloop(M + (size_t)tt * 128 * 1024, 1024, W + (size_t)ft * 128 * 1024, 1024, 1024, smem, acc);
    acc_to_lds(acc, smem);
    EPI_ROWS({
      const int t = tt * 128 + row, n = ft * 128 + col;
      const f32x4 xo = *(const f32x4*)(xrow(p, layer, t) + n);
      *(f32x4*)(p.out + (size_t)t * 1024 + n) = xo + v;
    })
  }
  for (int m = jb; m < 2 * 16; m += nb) {
    const int r0 = (128 + xcd) * 128 + (m >> 4) * 64, c0 = (m & 15) * 64;
    f32x16 acc;
#pragma unroll
    for (int r = 0; r < 16; ++r) acc[r] = 0.f;
    gemm64_mainloop(M + (size_t)r0 * 1024, 1024, W + (size_t)c0 * 1024, 1024, 1024, smem, acc);
    acc64_to_lds(acc, smem);
    EPI64_ROWS({
      const int t = r0 + row, n = c0 + col;
      const f32x4 xo = *(const f32x4*)(xrow(p, layer, t) + n);
      *(f32x4*)(p.out + (size_t)t * 1024 + n) = xo + v;
    })
  }
}

#define XB_TMO      128
#define XB_XCNT(j)  (256  + 64 * (j))
#define XB_XSUB(j)  (1280 + 64 * (j))
#define XB_XGEN(j)  (2304 + 64 * (j))
#define XB_TOP      3328
#define XB_TOPGEN   3392
#define XCD_BAR_WORDS 3456
#define XB_SPIN_CAP (1u << 22)
#define LAS __attribute__((address_space(3)))
DI unsigned xb_ld(unsigned* p) { return __hip_atomic_load(p, __ATOMIC_RELAXED, __HIP_MEMORY_SCOPE_AGENT); }
DI unsigned xb_add(unsigned* p, unsigned v) { return __hip_atomic_fetch_add(p, v, __ATOMIC_RELAXED, __HIP_MEMORY_SCOPE_AGENT); }
DI unsigned xb_xcc_id() { return (unsigned)__builtin_amdgcn_s_getreg((3 << 11) | 20) & 0xFu; }
#define XB_SPIN(cond, bar) do { unsigned _sp = 0; while (cond) { __builtin_amdgcn_s_sleep(1); \
    if ((++_sp & 255u) == 0u) { if (xb_ld(&(bar)[XB_TMO])) break; if (_sp > XB_SPIN_CAP) { atomicAdd(&(bar)[XB_TMO], 1u); break; } } } } while (0)
struct XcdBarrier { unsigned* bar; unsigned x; volatile LAS unsigned* st; };
DI XcdBarrier xcd_barrier_post(unsigned* bar, volatile LAS unsigned* st) {
  XcdBarrier b; b.bar = bar; b.x = xb_xcc_id(); b.st = st;
  if (threadIdx.x == 0) (void)xb_add(&bar[XB_XCNT(b.x)], 1u);
  return b;
}
DI void xcd_barrier_complete(unsigned* bar, unsigned x, unsigned& nloc, unsigned& nx) {
  const unsigned G = gridDim.x * gridDim.y * gridDim.z;
  unsigned sum, cnt, mine, sp = 0u;
  for (;;) {
    sum = 0u; cnt = 0u; mine = 0u;
#pragma unroll
    for (unsigned j = 0; j < 16; ++j) { const unsigned c = xb_ld(&bar[XB_XCNT(j)]); sum += c; cnt += (c > 0u) ? 1u : 0u; mine = (j == x) ? c : mine; }
    if (sum == G) break;
    __builtin_amdgcn_s_sleep(1);
    if ((++sp & 255u) == 0u) { if (xb_ld(&bar[XB_TMO])) break; if (sp > XB_SPIN_CAP) { atomicAdd(&bar[XB_TMO], 1u); break; } }
  }
  nloc = mine > 0u ? mine : 1u; nx = cnt > 0u ? cnt : 1u;
}
DI void xcd_barrier(const XcdBarrier& b) {
  asm volatile("s_waitcnt vmcnt(0)" ::: "memory");
  __syncthreads();
  if (threadIdx.x == 0) {
    unsigned* bar = b.bar;
    __builtin_amdgcn_s_waitcnt(0);
    unsigned nloc = b.st[0], nx = b.st[1];
    if (nloc == 0u) { xcd_barrier_complete(bar, b.x, nloc, nx); b.st[0] = nloc; b.st[1] = nx; }
    const unsigned old = xb_add(&bar[XB_XSUB(b.x)], 1u);
    const unsigned gen = old / nloc;
    if (old + 1u == (gen + 1u) * nloc) {
      __builtin_amdgcn_fence(__ATOMIC_RELEASE, "agent");
      asm volatile("s_waitcnt vmcnt(0)" ::: "memory");
      const unsigned og = xb_add(&bar[XB_TOP], 1u);
      const unsigned tg = og / nx;
      if (og + 1u == (tg + 1u) * nx) xb_add(&bar[XB_TOPGEN], 1u);
      else XB_SPIN(xb_ld(&bar[XB_TOPGEN]) == tg, bar);
      __builtin_amdgcn_fence(__ATOMIC_ACQUIRE, "agent");
      xb_add(&bar[XB_XGEN(b.x)], 1u);
      asm volatile("s_waitcnt vmcnt(0)" ::: "memory");
    } else {
      XB_SPIN(xb_ld(&bar[XB_XGEN(b.x)]) == gen, bar);
      __builtin_amdgcn_fence(__ATOMIC_ACQUIRE, "agent");
      asm volatile("s_waitcnt vmcnt(0)" ::: "memory");
    }
  }
  __syncthreads();
}

constexpr int PH_PER_LAYER = 8;
constexpr int N_PHASES = 1 + 4 * PH_PER_LAYER;

DI void run_phase(const Params& p, int ph, char* smem, int* s_item) {
#ifndef PHMASK
#define PHMASK 0x3FF
#endif
  if (ph == 0) { if (PHMASK & 0x100) phase_convert(p, smem); return; }
  const int layer = (ph - 1) / PH_PER_LAYER, sub = (ph - 1) % PH_PER_LAYER;
  switch (sub) {
    case 0: if (PHMASK & 1) phase_rmsnorm(p, layer); break;
    case 1: if (PHMASK & 2) phase_g1(p, layer, smem); break;
    case 2: if (PHMASK & 4) phase_norms_prep(p, layer, smem, s_item); break;
    case 3: if (PHMASK & 16) phase_mix(p, layer, smem, s_item); break;
    case 4: if (PHMASK & 16) phase_ypass(p, layer); break;
    case 5: if (PHMASK & 32) phase_ob(p, layer); break;
    case 6: if (PHMASK & 64) phase_merge(p, layer, smem); break;
    default: if (PHMASK & 128) phase_out(p, layer, smem); break;
  }
}

__global__ void __launch_bounds__(256, 2) mk_kernel(Params p, int ph0, int ph1, int coop) {
  __shared__ __attribute__((aligned(16))) char smem[SMEM_BYTES];
  __shared__ int s_item[4];
  __shared__ uint4 xb_words;
  if (threadIdx.x == 0) xb_words = make_uint4(0u, 0u, 0u, 0u);
  __syncthreads();
  XcdBarrier xb = xcd_barrier_post((unsigned*)(p.ws + WS_BAR), (volatile LAS unsigned*)&xb_words);
  for (int ph = ph0; ph < ph1; ++ph) {
    run_phase(p, ph, smem, s_item);
    if (coop && ph + 1 < ph1) {
      xcd_barrier(xb);
      if (coop == 0x5a5a5a) cg::this_grid().sync();
    }
  }
}

extern "C" void kernel_launch(void* const* d_in, const int* in_sizes, int n_in, void* d_out, int out_size, void* d_ws, size_t ws_size,
                              hipStream_t stream) {
  static int grid_blocks = 0;
  if (!grid_blocks) {
    int dev = 0, cus = 0, per_cu = 0;
    hipGetDevice(&dev);
    hipDeviceGetAttribute(&cus, hipDeviceAttributeMultiprocessorCount, dev);
    hipOccupancyMaxActiveBlocksPerMultiprocessor(&per_cu, mk_kernel, 256, 0);
    if (per_cu < 1) per_cu = 1;
    if (per_cu > 2) per_cu = 2;
    grid_blocks = cus * per_cu;
  }
  Params p{};
  const float** pp = (const float**)&p;
  for (int i = 0; i < 29; ++i) pp[i] = (const float*)d_in[i];
  p.out = (float*)d_out;
  p.ws = (char*)d_ws;
  const int ONE_LAUNCH = 1;
  hipMemsetAsync((char*)d_ws + WS_CTR, 0, 16384 + XCD_BAR_WORDS * 4, stream);
  if (ONE_LAUNCH) {
    int ph0 = 0, ph1 = N_PHASES, coop = 1;
    void* args[] = {&p, &ph0, &ph1, &coop};
    hipError_t e = hipLaunchCooperativeKernel((void*)mk_kernel, dim3(grid_blocks), dim3(256), args, 0, stream);
    if (e != hipSuccess) fprintf(stderr, "cooperative launch failed: %s (grid %d)\n", hipGetErrorString(e), grid_blocks);
  } else {
    for (int ph = 0; ph < N_PHASES; ++ph) mk_kernel<<<dim3(grid_blocks), dim3(256), 0, stream>>>(p, ph, ph + 1, 0);
  }
}
```

```cpp
#include <hip/hip_runtime.h>
#include <hip/hip_cooperative_groups.h>
#include <cstdio>
namespace cg = cooperative_groups;

#define DI __device__ __forceinline__
typedef unsigned short u16;
typedef __attribute__((ext_vector_type(8))) short bf16x8;
typedef __attribute__((ext_vector_type(4))) short s16x4;
typedef __attribute__((ext_vector_type(2))) __bf16 bf2_t;
typedef __attribute__((ext_vector_type(2))) float f2_t;
typedef __attribute__((ext_vector_type(16))) float f32x16;
typedef __attribute__((ext_vector_type(4))) unsigned u32x4;
typedef __attribute__((ext_vector_type(2))) unsigned u32x2;
typedef __attribute__((ext_vector_type(4))) float f32x4;
#define MFMA32(a, b, c) __builtin_amdgcn_mfma_f32_32x32x16_bf16((a), (b), (c), 0, 0, 0)

constexpr int NP = 16384;
constexpr int NSM = 1024;
constexpr int NT = NP + NSM;
constexpr int NZ = 5248;
constexpr int ZC_KV = 256, ZC_KPE = 384, ZC_GA = 512, ZC_ZS = 1024, ZC_GB = 2688, ZC_MA = 3200, ZC_MB = 4224;
constexpr float EPS = 1e-6f;
constexpr float GN_EPS = 64e-5f;
constexpr int SHW = 1664;

constexpr size_t OFF_CKV_P = 17825792;
constexpr size_t OFF_KPE_P = 26214400;
constexpr size_t OFF_WKV_P = 28311552;
constexpr size_t OFF_SH_P = 28442624;
constexpr size_t OFF_CKV_S = 28449280;
constexpr size_t OFF_KPE_S = 28973568;
constexpr size_t OFF_WKV_S = 29104640;
constexpr size_t OFF_SH_S = 31201792;

constexpr size_t WL_STRIDE = 15728640;
constexpr size_t W_IN = 0, W_UQ = 10747904, W_UKV = 11141120, W_W2 = 11403264, W_A2 = 11468800, W_OA = 11534336, W_OB = 12582912, W_O = 13631488;
constexpr size_t WS_H = 62914560;
constexpr size_t WS_Z = WS_H + 35651584;
constexpr size_t WS_Q = WS_Z + 182714368;
constexpr size_t WS_CKVB = WS_Q + 26738688;
constexpr size_t WS_KPEB = WS_CKVB + 4456448;
constexpr size_t WS_KN = WS_KPEB + 1114112;
constexpr size_t WS_VT = WS_KN + 16777216;
constexpr size_t WS_WKVIN = WS_VT + 16777216;
constexpr size_t WS_OA = WS_WKVIN + 106954752;
constexpr size_t WS_Y = WS_OA + 17825792;
constexpr size_t WS_CTR = WS_Y + 35651584;
constexpr size_t WS_BAR = WS_CTR + 16384;
constexpr size_t WS_SH0 = WS_BAR + 16384;
constexpr size_t WS_CKB = WS_SH0 + 65536;
constexpr size_t WS_KPB = WS_CKB + 16777216;
constexpr size_t WS_TOTAL = WS_KPB + 4194304;
static_assert(WS_TOTAL < 536870912, "ws");

constexpr int SMEM_BYTES = 39424 + 128 * 136 * 2;

struct Params {
  const float *x_prompt, *x_sample, *cache_ckv, *cache_kpe, *state_wkv, *state_shift;
  const float *norm_w, *w_in, *q_norm_w, *kv_norm_w, *w_uq, *w_ukv, *qn_nope, *qn_rope, *kn_nope, *kn_rope;
  const float *mu_shift, *w0, *w2, *a0, *a2, *k_k, *k_a, *r_k, *lnx_w, *lnx_b, *w_out_a, *w_out_b, *w_o;
  float* out;
  char* ws;
};

__device__ const float ROPE_INV[16] = {1.0f, 0.5623413324356079f, 0.3162277638912201f, 0.17782793939113617f, 0.10000000149011612f, 0.05623413249850273f, 0.03162277489900589f, 0.017782794311642647f, 0.009999999776482582f, 0.005623413249850273f, 0.003162277629598975f, 0.0017782794311642647f, 0.0010000000474974513f, 0.000562341301701963f, 0.0003162277571391314f, 0.00017782794020604342f};

DI int tidx() { int t = threadIdx.x; asm volatile("" : "+v"(t)); return t; }
DI float bf2f(u16 h) { return __uint_as_float(((unsigned)h) << 16); }
DI unsigned pk2(float a, float b) { f2_t v = {a, b}; bf2_t r = __builtin_convertvector(v, bf2_t); return __builtin_bit_cast(unsigned, r); }
DI u16 f2bf(float a) { return (u16)(pk2(a, 0.f) & 0xffffu); }
DI float lo2f(unsigned u) { return __uint_as_float(u << 16); }
DI float hi2f(unsigned u) { return __uint_as_float(u & 0xffff0000u); }
DI float wave_sum(float v) {
  v += __builtin_bit_cast(float, __builtin_amdgcn_update_dpp(0, __builtin_bit_cast(int, v), 0x128, 0xF, 0xF, false));
  v += __builtin_bit_cast(float, __builtin_amdgcn_update_dpp(0, __builtin_bit_cast(int, v), 0x124, 0xF, 0xF, false));
  v += __builtin_bit_cast(float, __builtin_amdgcn_update_dpp(0, __builtin_bit_cast(int, v), 0x122, 0xF, 0xF, false));
  v += __builtin_bit_cast(float, __builtin_amdgcn_update_dpp(0, __builtin_bit_cast(int, v), 0x121, 0xF, 0xF, false));
  const int iv = __builtin_bit_cast(int, v);
  const float s0 = __builtin_bit_cast(float, __builtin_amdgcn_readlane(iv, 0)), s1 = __builtin_bit_cast(float, __builtin_amdgcn_readlane(iv, 16));
  const float s2 = __builtin_bit_cast(float, __builtin_amdgcn_readlane(iv, 32)), s3 = __builtin_bit_cast(float, __builtin_amdgcn_readlane(iv, 48));
  return (s0 + s1) + (s2 + s3);
}
DI float xor32(float v) { return __shfl_xor(v, 32); }
DI int crow(int reg, int h) { return (reg & 3) + 8 * (reg >> 2) + 4 * h; }
DI float sigmoidf_(float x) { return __builtin_amdgcn_rcpf(1.f + __expf(-x)); }
DI float siluf_(float x) { return x * __builtin_amdgcn_rcpf(1.f + __expf(-x)); }
DI void rope_sincos(int pos, int i, float& s, float& c) {
  float ang = (float)pos * ROPE_INV[i];
  double rev = (double)ang * 0.15915494309189533577;
  double fr = rev - rint(rev);
  float f = (float)fr;
  s = __builtin_amdgcn_sinf(f);
  c = __builtin_amdgcn_cosf(f);
}
DI const float* xrow(const Params& p, int layer, int t) {
  if (layer == 0) return (t < NP) ? p.x_prompt + (size_t)t * 1024 : p.x_sample + (size_t)(t - NP) * 1024;
  return p.out + (size_t)t * 1024;
}
DI int tok_pos(int t) { return (t < NP) ? t : 4096 + ((t - NP) & 63); }

DI void conv_tile(const float* __restrict__ src, int N, u16* __restrict__ dst, int K, int k0, int n0, int kind, float* sm) {
  const int tid = tidx();
  const int nl = tid & 63, kb = tid >> 6;
  const int np_ = n0 + nl;
  int sc = np_;
  if (kind == 1) sc = (np_ < 416) ? np_ : ((np_ < 512) ? -1 : np_ - 96);
#pragma unroll
  for (int i = 0; i < 16; ++i) {
    const int kl = kb + 4 * i;
    float v = 0.f;
    if (sc >= 0) v = src[(size_t)(k0 + kl) * N + sc];
    sm[kl * 65 + nl] = v;
  }
  __syncthreads();
  const int nr = tid >> 2, kc = (tid & 3) * 16;
  unsigned o[8];
#pragma unroll
  for (int j = 0; j < 8; ++j) o[j] = pk2(sm[(kc + 2 * j) * 65 + nr], sm[(kc + 2 * j + 1) * 65 + nr]);
  uint4* d = (uint4*)(dst + (size_t)(n0 + nr) * K + k0 + kc);
  d[0] = make_uint4(o[0], o[1], o[2], o[3]);
  d[1] = make_uint4(o[4], o[5], o[6], o[7]);
  __syncthreads();
}

DI void phase_convert(const Params& p, char* smem) {
  float* sm = (float*)smem;
  for (int it = blockIdx.x; it < 4 * 1920; it += gridDim.x) {
    const int layer = it / 1920;
    int r = it % 1920;
    const float* src; u16* dst; int K, N, kind = 0, nt;
    char* wl = p.ws + (size_t)layer * WL_STRIDE;
    if (r < 1312) { src = p.w_in + (size_t)layer * 1024 * 5152; dst = (u16*)(wl + W_IN); K = 1024; N = 5152; kind = 1; nt = 82; }
    else if (r < 1360) { r -= 1312; src = p.w_uq + (size_t)layer * 256 * 768; dst = (u16*)(wl + W_UQ); K = 256; N = 768; nt = 12; }
    else if (r < 1392) { r -= 1360; src = p.w_ukv + (size_t)layer * 128 * 1024; dst = (u16*)(wl + W_UKV); K = 128; N = 1024; nt = 16; }
    else if (r < 1400) { r -= 1392; src = p.w2 + (size_t)layer * 64 * 512; dst = (u16*)(wl + W_W2); K = 64; N = 512; nt = 8; }
    else if (r < 1408) { r -= 1400; src = p.a2 + (size_t)layer * 64 * 512; dst = (u16*)(wl + W_A2); K = 64; N = 512; nt = 8; }
    else if (r < 1536) { r -= 1408; src = p.w_out_a + (size_t)layer * 512 * 1024; dst = (u16*)(wl + W_OA); K = 512; N = 1024; nt = 16; }
    else if (r < 1664) { r -= 1536; src = p.w_out_b + (size_t)layer * 512 * 1024; dst = (u16*)(wl + W_OB); K = 512; N = 1024; nt = 16; }
    else { r -= 1664; src = p.w_o + (size_t)layer * 1024 * 1024; dst = (u16*)(wl + W_O); K = 1024; N = 1024; nt = 16; }
    const int kt = r / nt, ntile = r % nt;
    conv_tile(src, N, dst, K, kt * 64, ntile * 64, kind, sm);
  }
}

DI void phase_rmsnorm(const Params& p, int layer) {
  const int wave = tidx() >> 6, lane = tidx() & 63;
  u16* H = (u16*)(p.ws + WS_H);
  const float* g = p.norm_w + layer * 1024;
  if (blockIdx.x == gridDim.x - 1) {
    u16* sh0 = (u16*)(p.ws + WS_SH0);
    for (int i = tidx(); i < 17 * SHW; i += 256) {
      const int r = i / SHW, c = i - r * SHW;
      sh0[i] = (r == 0) ? (u16)0 : f2bf(p.state_shift[((size_t)layer * 16 + (r - 1)) * SHW + c]);
    }
  }
  {
    const float* c1 = p.cache_ckv + (size_t)layer * 16 * 4096 * 128;
    const float* c2 = p.cache_kpe + (size_t)layer * 16 * 4096 * 32;
    u16* d1 = (u16*)(p.ws + WS_CKB);
    u16* d2 = (u16*)(p.ws + WS_KPB);
    constexpr int N1 = 16 * 4096 * 128 / 8, N2 = 16 * 4096 * 32 / 8;
    for (int i = blockIdx.x * 256 + tidx(); i < N1 + N2; i += gridDim.x * 256) {
      const float* sp = (i < N1) ? c1 + (size_t)i * 8 : c2 + (size_t)(i - N1) * 8;
      u16* dp = (i < N1) ? d1 + (size_t)i * 8 : d2 + (size_t)(i - N1) * 8;
      const f32x4 a = *(const f32x4*)sp, b = *(const f32x4*)(sp + 4);
      *(u32x4*)dp = u32x4{pk2(a.x, a.y), pk2(a.z, a.w), pk2(b.x, b.y), pk2(b.z, b.w)};
    }
  }
  for (int t = blockIdx.x * 4 + wave; t < NT; t += gridDim.x * 4) {
    const float* xr = xrow(p, layer, t);
    float4 v[4];
    float ss = 0.f;
#pragma unroll
    for (int i = 0; i < 4; ++i) {
      v[i] = *(const float4*)(xr + i * 256 + lane * 4);
      ss += v[i].x * v[i].x + v[i].y * v[i].y + v[i].z * v[i].z + v[i].w * v[i].w;
    }
    ss = wave_sum(ss);
    const float rinv = rsqrtf(ss * (1.f / 1024.f) + EPS);
#pragma unroll
    for (int i = 0; i < 4; ++i) {
      const float4 g4 = *(const float4*)(g + i * 256 + lane * 4);
      uint2 o;
      o.x = pk2(v[i].x * rinv * g4.x, v[i].y * rinv * g4.y);
      o.y = pk2(v[i].z * rinv * g4.z, v[i].w * rinv * g4.w);
      *(uint2*)(H + (size_t)t * 1024 + i * 256 + lane * 4) = o;
    }
  }
}

DI void gemm_mainloop(const u16* __restrict__ R, int ldr, const u16* __restrict__ C, int ldc, int K, char* smem, f32x16 (&acc)[2][2]) {
  const int tid = tidx(), lane = tid & 63, w = tid >> 6, wr = w >> 1, wc = w & 1;
  const int l31 = lane & 31, h = lane >> 5;
  const int lrow = tid >> 3, lkc = (tid & 7) * 8;
  u32x4 rr[4], rc[4];
  const int nk = K >> 6;
#pragma unroll
  for (int i = 0; i < 4; ++i) {
    rr[i] = *(const u32x4*)(R + (size_t)(lrow + 32 * i) * ldr + lkc);
    rc[i] = *(const u32x4*)(C + (size_t)(lrow + 32 * i) * ldc + lkc);
  }
  __syncthreads();
  {
    u16* sR = (u16*)smem;
    u16* sC = sR + 128 * 72;
#pragma unroll
    for (int i = 0; i < 4; ++i) {
      *(u32x4*)(sR + (lrow + 32 * i) * 72 + lkc) = rr[i];
      *(u32x4*)(sC + (lrow + 32 * i) * 72 + lkc) = rc[i];
    }
  }
  if (nk > 1) {
#pragma unroll
    for (int i = 0; i < 4; ++i) {
      rr[i] = *(const u32x4*)(R + (size_t)(lrow + 32 * i) * ldr + 64 + lkc);
      rc[i] = *(const u32x4*)(C + (size_t)(lrow + 32 * i) * ldc + 64 + lkc);
    }
  }
  __syncthreads();
  for (int kt = 0; kt < nk; ++kt) {
    const u16* sR = (const u16*)smem + (kt & 1) * (2 * 128 * 72);
    const u16* sC = sR + 128 * 72;
    if (kt + 1 < nk) {
      u16* nR = (u16*)smem + ((kt + 1) & 1) * (2 * 128 * 72);
      u16* nC = nR + 128 * 72;
#pragma unroll
      for (int i = 0; i < 4; ++i) {
        *(u32x4*)(nR + (lrow + 32 * i) * 72 + lkc) = rr[i];
        *(u32x4*)(nC + (lrow + 32 * i) * 72 + lkc) = rc[i];
      }
    }
    if (kt + 2 < nk) {
      const int k0 = (kt + 2) * 64;
#pragma unroll
      for (int i = 0; i < 4; ++i) {
        rr[i] = *(const u32x4*)(R + (size_t)(lrow + 32 * i) * ldr + k0 + lkc);
        rc[i] = *(const u32x4*)(C + (size_t)(lrow + 32 * i) * ldc + k0 + lkc);
      }
    }
#pragma unroll
    for (int ks = 0; ks < 4; ++ks) {
      bf16x8 a[2], b[2];
#pragma unroll
      for (int mi = 0; mi < 2; ++mi) a[mi] = *(const bf16x8*)(sR + (wr * 64 + mi * 32 + l31) * 72 + ks * 16 + h * 8);
#pragma unroll
      for (int ni = 0; ni < 2; ++ni) b[ni] = *(const bf16x8*)(sC + (wc * 64 + ni * 32 + l31) * 72 + ks * 16 + h * 8);
#pragma unroll
      for (int mi = 0; mi < 2; ++mi)
#pragma unroll
        for (int ni = 0; ni < 2; ++ni) acc[mi][ni] = MFMA32(a[mi], b[ni], acc[mi][ni]);
    }
    __syncthreads();
  }
}
DI void zero_acc(f32x16 (&acc)[2][2]) {
#pragma unroll
  for (int mi = 0; mi < 2; ++mi)
#pragma unroll
    for (int ni = 0; ni < 2; ++ni)
#pragma unroll
      for (int r = 0; r < 16; ++r) acc[mi][ni][r] = 0.f;
}
DI void acc_to_lds(const f32x16 (&acc)[2][2], char* smem) {
  float* sT = (float*)smem;
  const int lane = tidx() & 63, w = tidx() >> 6;
  const int l31 = lane & 31, h = lane >> 5, wr = w >> 1, wc = w & 1;
  __syncthreads();
#pragma unroll
  for (int mi = 0; mi < 2; ++mi)
#pragma unroll
    for (int ni = 0; ni < 2; ++ni)
#pragma unroll
      for (int reg = 0; reg < 16; ++reg) sT[(wr * 64 + mi * 32 + crow(reg, h)) * 132 + wc * 64 + ni * 32 + l31] = acc[mi][ni][reg];
  __syncthreads();
}
#define EPI_ROWS(...)                                                          \
  {                                                                            \
    const float* sT_ = (const float*)smem;                                     \
    _Pragma("unroll 2") for (int it_ = 0; it_ < 16; ++it_) {                   \
      const int row = it_ * 8 + (tidx() >> 5), col = (tidx() & 31) * 4; \
      const f32x4 v = *(const f32x4*)(sT_ + row * 132 + col);                  \
      __VA_ARGS__                                                              \
    }                                                                          \
  }

DI void gemm64_mainloop(const u16* __restrict__ R, int ldr, const u16* __restrict__ C, int ldc, int K, char* smem, f32x16& acc) {
  const int tid = tidx(), lane = tid & 63, w = tid >> 6, wr = w >> 1, wc = w & 1;
  const int l31 = lane & 31, h = lane >> 5;
  const int lrow = tid >> 3, lkc = (tid & 7) * 8;
  u32x4 rr[2][2], rc[2][2];
  const int nk = K >> 6;
#define G64_GLOAD(SET, KT)                                                                    \
  {                                                                                           \
    const int k0_ = (KT) * 64;                                                                \
    _Pragma("unroll") for (int i = 0; i < 2; ++i) {                                           \
      rr[SET][i] = *(const u32x4*)(R + (size_t)(lrow + 32 * i) * ldr + k0_ + lkc);            \
      rc[SET][i] = *(const u32x4*)(C + (size_t)(lrow + 32 * i) * ldc + k0_ + lkc);            \
    }                                                                                         \
  }
#define G64_LSTORE(SET, BUF)                                                                  \
  {                                                                                           \
    u16* nR_ = (u16*)smem + (BUF) * (2 * 64 * 72);                                            \
    u16* nC_ = nR_ + 64 * 72;                                                                 \
    _Pragma("unroll") for (int i = 0; i < 2; ++i) {                                           \
      *(u32x4*)(nR_ + (lrow + 32 * i) * 72 + lkc) = rr[SET][i];                               \
      *(u32x4*)(nC_ + (lrow + 32 * i) * 72 + lkc) = rc[SET][i];                               \
    }                                                                                         \
  }
  G64_GLOAD(0, 0)
  G64_GLOAD(1, 1)
  __syncthreads();
  G64_LSTORE(0, 0)
  G64_GLOAD(0, 2)
  __syncthreads();
  for (int kt0 = 0; kt0 < nk; kt0 += 2) {
#pragma unroll
    for (int u = 0; u < 2; ++u) {
      const int kt = kt0 + u;
      const u16* sR = (const u16*)smem + u * (2 * 64 * 72);
      const u16* sC = sR + 64 * 72;
      if (kt + 1 < nk) G64_LSTORE(1 - u, 1 - u)
      if (kt + 3 < nk) G64_GLOAD(1 - u, kt + 3)
#pragma unroll
      for (int ks = 0; ks < 4; ++ks) {
        const bf16x8 a = *(const bf16x8*)(sR + (wr * 32 + l31) * 72 + ks * 16 + h * 8);
        const bf16x8 b = *(const bf16x8*)(sC + (wc * 32 + l31) * 72 + ks * 16 + h * 8);
        acc = MFMA32(a, b, acc);
      }
      __syncthreads();
    }
  }
#undef G64_GLOAD
#undef G64_LSTORE
}
DI void acc64_to_lds(const f32x16& acc, char* smem) {
  float* sT = (float*)smem;
  const int lane = tidx() & 63, w = tidx() >> 6;
  const int l31 = lane & 31, h = lane >> 5, wr = w >> 1, wc = w & 1;
  __syncthreads();
#pragma unroll
  for (int reg = 0; reg < 16; ++reg) sT[(wr * 32 + crow(reg, h)) * 68 + wc * 32 + l31] = acc[reg];
  __syncthreads();
}
#define EPI64_ROWS(...)                                                        \
  {                                                                            \
    const float* sT_ = (const float*)smem;                                     \
    _Pragma("unroll") for (int it_ = 0; it_ < 4; ++it_) {                      \
      const int row = it_ * 16 + (tidx() >> 4), col = (tidx() & 15) * 4;       \
      const f32x4 v = *(const f32x4*)(sT_ + row * 68 + col);                   \
      __VA_ARGS__                                                              \
    }                                                                          \
  }

DI void phase_g1(const Params& p, int layer, char* smem) {
  const u16* H = (const u16*)(p.ws + WS_H);
  const u16* W = (const u16*)(p.ws + (size_t)layer * WL_STRIDE + W_IN);
  u16* Z = (u16*)(p.ws + WS_Z);
  const int xcd = blockIdx.x & 7, jb = blockIdx.x >> 3, nb = (gridDim.x + 7 - xcd) >> 3;
  for (int m = jb; m < 17 * 41; m += nb) {
    const int ft = m / 17, tt = xcd + 8 * (m % 17);
    f32x16 acc[2][2];
    zero_acc(acc);
    gemm_mainloop(H + (size_t)tt * 128 * 1024, 1024, W + (size_t)ft * 128 * 1024, 1024, 1024, smem, acc);
    acc_to_lds(acc, smem);
    EPI_ROWS({ *(u32x2*)(Z + (size_t)(tt * 128 + row) * NZ + ft * 128 + col) = u32x2{pk2(v.x, v.y), pk2(v.z, v.w)}; })
  }
}

DI void norms_token(const Params& p, int layer, int t, int lane) {
  const u16* zr = (const u16*)(p.ws + WS_Z) + (size_t)t * NZ;
  u16* CQN = (u16*)(p.ws + WS_H);
  u16* CKVB = (u16*)(p.ws + WS_CKVB);
  u16* KPEB = (u16*)(p.ws + WS_KPEB);
  {
    const uint2 raw = *(const uint2*)(zr + lane * 4);
    const float c0 = lo2f(raw.x), c1 = hi2f(raw.x), c2 = lo2f(raw.y), c3 = hi2f(raw.y);
    float ss = wave_sum(c0 * c0 + c1 * c1 + c2 * c2 + c3 * c3);
    const float rinv = rsqrtf(ss * (1.f / 256.f) + EPS);
    const float4 g = *(const float4*)(p.q_norm_w + layer * 256 + lane * 4);
    uint2 o;
    o.x = pk2(c0 * rinv * g.x, c1 * rinv * g.y);
    o.y = pk2(c2 * rinv * g.z, c3 * rinv * g.w);
    *(uint2*)(CQN + (size_t)t * 256 + lane * 4) = o;
  }
  {
    const unsigned raw = *(const unsigned*)(zr + ZC_KV + lane * 2);
    const float c0 = lo2f(raw), c1 = hi2f(raw);
    float ss = wave_sum(c0 * c0 + c1 * c1);
    const float rinv = rsqrtf(ss * (1.f / 128.f) + EPS);
    const float2 g = *(const float2*)(p.kv_norm_w + layer * 128 + lane * 2);
    const float o0 = c0 * rinv * g.x, o1 = c1 * rinv * g.y;
    float* dst = (t < NP) ? p.out + OFF_CKV_P + ((size_t)layer * NP + t) * 128 : p.out + OFF_CKV_S + ((size_t)layer * NSM + (t - NP)) * 128;
    *(float2*)(dst + lane * 2) = make_float2(o0, o1);
    *(unsigned*)(CKVB + (size_t)t * 128 + lane * 2) = pk2(o0, o1);
  }
  {
    float v = (lane < 32) ? bf2f(zr[ZC_KPE + lane]) : 0.f;
    float ss = wave_sum(v * v);
    const float rinv = rsqrtf(ss * (1.f / 32.f) + EPS);
    v = v * rinv * p.kn_rope[layer * 32 + (lane & 31)];
    const float pr = __shfl_xor(v, 16);
    float s, c;
    rope_sincos(tok_pos(t), lane & 15, s, c);
    const float o = ((lane & 16) == 0) ? (v * c - pr * s) : (v * c + pr * s);
    if (lane < 32) {
      float* dst = (t < NP) ? p.out + OFF_KPE_P + ((size_t)layer * NP + t) * 32 : p.out + OFF_KPE_S + ((size_t)layer * NSM + (t - NP)) * 32;
      dst[lane] = o;
      KPEB[(size_t)t * 32 + lane] = f2bf(o);
    }
  }
  float* sh = nullptr;
  if (t == NP - 1) sh = p.out + OFF_SH_P + (size_t)layer * SHW;
  else if (t >= NP && ((t - NP) & 63) == 63) sh = p.out + OFF_SH_S + ((size_t)layer * 16 + ((t - NP) >> 6)) * SHW;
  if (sh) {
#pragma unroll 1
    for (int c = lane; c < SHW; c += 64) sh[c] = bf2f(zr[ZC_ZS + c]);
  }
}

DI void zm4(const Params& p, int layer, int t, int c, float (&o)[4]) {
  const u16* zr = (const u16*)(p.ws + WS_Z) + (size_t)t * NZ + ZC_ZS + c;
  const u32x2 a = *(const u32x2*)zr;
  const bool first = (t < NP) ? (t == 0) : (((t - NP) & 63) == 0);
  const int srow = (t < NP) ? 0 : 1 + ((t - NP) >> 6);
  const u16* pr = first ? (const u16*)(p.ws + WS_SH0) + srow * SHW + c : zr - NZ;
  const u32x2 b = *(const u32x2*)pr;
  const f32x4 mu = *(const f32x4*)(p.mu_shift + layer * SHW + c);
  const float c0 = lo2f(a.x), c1 = hi2f(a.x), c2 = lo2f(a.y), c3 = hi2f(a.y);
  o[0] = c0 + (lo2f(b.x) - c0) * mu.x;
  o[1] = c1 + (hi2f(b.x) - c1) * mu.y;
  o[2] = c2 + (lo2f(b.y) - c2) * mu.z;
  o[3] = c3 + (hi2f(b.y) - c3) * mu.w;
}
DI float tanhf_(float x) {
  const float t = __expf(-2.f * fabsf(x));
  const float r = (1.f - t) * __builtin_amdgcn_rcpf(1.f + t);
  return x < 0.f ? -r : r;
}

constexpr int WPS = 900;
DI void zml(const u16* sz, int row, int col, const float* mu, float (&o)[4]) {
  const u32x2 a = *(const u32x2*)(sz + (row + 1) * WPS + col);
  const u32x2 b = *(const u32x2*)(sz + row * WPS + col);
  const f32x4 m4 = *(const f32x4*)mu;
  const float c0 = lo2f(a.x), c1 = hi2f(a.x), c2 = lo2f(a.y), c3 = hi2f(a.y);
  o[0] = c0 + (lo2f(b.x) - c0) * m4.x;
  o[1] = c1 + (hi2f(b.x) - c1) * m4.y;
  o[2] = c2 + (lo2f(b.y) - c2) * m4.z;
  o[3] = c3 + (hi2f(b.y) - c3) * m4.w;
}
DI void wkvprep_block(const Params& p, int layer, int tt, int hg, char* smem) {
  u16* sz = (u16*)smem;
  const int tid = tidx(), lane = tid & 63, w = tid >> 6, l31 = lane & 31, h = lane >> 5;
  const int t0 = tt * 32;
  const int hd = hg * 4 + w;
  const u16* Z = (const u16*)(p.ws + WS_Z);
  const bool seq_start = (t0 < NP) ? (t0 == 0) : (((t0 - NP) & 63) == 0);
  const u16* prevrow = seq_start ? (const u16*)(p.ws + WS_SH0) + ((t0 < NP) ? 0 : 1 + ((t0 - NP) >> 6)) * SHW : Z + (size_t)(t0 - 1) * NZ + ZC_ZS;
  __syncthreads();
  for (int ci = tid; ci < 33 * 112; ci += 256) {
    const int row = ci / 112, cc = ci - row * 112;
    int scol, lcol;
    if (cc < 16) { scol = 1536 + cc * 8; lcol = cc * 8; }
    else {
      const int j = cc - 16, ww = j / 24, r2 = j - ww * 24, part = r2 >> 3, o = (r2 & 7) * 8;
      scol = part * 512 + (hg * 4 + ww) * 64 + o;
      lcol = 128 + ww * 192 + part * 64 + o;
    }
    const u16* src = (row == 0) ? prevrow + scol : Z + (size_t)(t0 + row - 1) * NZ + ZC_ZS + scol;
    const u32x4 v = *(const u32x4*)src;
    u32x2* d = (u32x2*)(sz + row * WPS + lcol);
    d[0] = u32x2{v.x, v.y};
    d[1] = u32x2{v.z, v.w};
  }
  __syncthreads();
  const int tok = t0 + l31;
  const u16* W2T = (const u16*)(p.ws + (size_t)layer * WL_STRIDE + W_W2);
  const u16* A2T = (const u16*)(p.ws + (size_t)layer * WL_STRIDE + W_A2);
  const float* mu = p.mu_shift + layer * SHW;
  u16* WK = (u16*)(p.ws + WS_WKVIN) + ((size_t)hd * NT + tok) * 384;
  f32x16 accW[2], accA[2];
#pragma unroll
  for (int m = 0; m < 2; ++m)
#pragma unroll
    for (int r = 0; r < 16; ++r) { accW[m][r] = 0.f; accA[m][r] = 0.f; }
#pragma unroll
  for (int ks = 0; ks < 4; ++ks) {
    const int c0 = ks * 16 + 8 * h;
    float t0a[4], t1a[4], u0[4], u1[4];
    zml(sz, l31, c0, mu + 1536 + c0, t0a);
    zml(sz, l31, c0 + 4, mu + 1536 + c0 + 4, t1a);
    zml(sz, l31, 64 + c0, mu + 1600 + c0, u0);
    zml(sz, l31, 64 + c0 + 4, mu + 1600 + c0 + 4, u1);
    u32x4 bw, ba;
    bw.x = pk2(tanhf_(t0a[0]), tanhf_(t0a[1])); bw.y = pk2(tanhf_(t0a[2]), tanhf_(t0a[3]));
    bw.z = pk2(tanhf_(t1a[0]), tanhf_(t1a[1])); bw.w = pk2(tanhf_(t1a[2]), tanhf_(t1a[3]));
    ba.x = pk2(u0[0], u0[1]); ba.y = pk2(u0[2], u0[3]); ba.z = pk2(u1[0], u1[1]); ba.w = pk2(u1[2], u1[3]);
    const bf16x8 bwf = __builtin_bit_cast(bf16x8, bw), baf = __builtin_bit_cast(bf16x8, ba);
#pragma unroll
    for (int m = 0; m < 2; ++m) {
      const bf16x8 aw = *(const bf16x8*)(W2T + (size_t)(hd * 64 + m * 32 + l31) * 64 + ks * 16 + h * 8);
      const bf16x8 aa = *(const bf16x8*)(A2T + (size_t)(hd * 64 + m * 32 + l31) * 64 + ks * 16 + h * 8);
      accW[m] = MFMA32(aw, bwf, accW[m]);
      accA[m] = MFMA32(aa, baf, accA[m]);
    }
  }
  const int hb = 128 + w * 192;
  float ss = 0.f;
#pragma unroll
  for (int m = 0; m < 2; ++m)
#pragma unroll
    for (int q = 0; q < 4; ++q) {
      const int f0 = m * 32 + 8 * q + 4 * h, F = hd * 64 + f0;
      float k4[4];
      zml(sz, l31, hb + 64 + f0, mu + 512 + F, k4);
      const float4 kk_ = *(const float4*)(p.k_k + layer * 512 + F);
      const float a = k4[0] * kk_.x, b = k4[1] * kk_.y, c = k4[2] * kk_.z, d = k4[3] * kk_.w;
      ss += a * a + b * b + c * c + d * d;
    }
  ss += xor32(ss);
  const float rn = 1.f / fmaxf(sqrtf(ss), 1e-12f);
#pragma unroll
  for (int m = 0; m < 2; ++m)
#pragma unroll
    for (int q = 0; q < 4; ++q) {
      const int f0 = m * 32 + 8 * q + 4 * h, F = hd * 64 + f0;
      float r4[4], k4[4], v4[4];
      zml(sz, l31, hb + f0, mu + F, r4);
      zml(sz, l31, hb + 64 + f0, mu + 512 + F, k4);
      zml(sz, l31, hb + 128 + f0, mu + 1024 + F, v4);
      const float4 w0 = *(const float4*)(p.w0 + layer * 512 + F);
      const float4 a0 = *(const float4*)(p.a0 + layer * 512 + F);
      const float4 kk_ = *(const float4*)(p.k_k + layer * 512 + F);
      const float4 ka_ = *(const float4*)(p.k_a + layer * 512 + F);
      const float w0a[4] = {w0.x, w0.y, w0.z, w0.w}, a0a[4] = {a0.x, a0.y, a0.z, a0.w};
      const float kka[4] = {kk_.x, kk_.y, kk_.z, kk_.w}, kaa[4] = {ka_.x, ka_.y, ka_.z, ka_.w};
      float e4[4], kp4[4], kn4[4], b4[4];
#pragma unroll
      for (int j = 0; j < 4; ++j) {
        const float lw = w0a[j] + accW[m][4 * q + j];
        const float nx = -lw;
        const float sp = fmaxf(nx, 0.f) + __logf(1.f + __expf(-fabsf(nx)));
        e4[j] = __expf(-sp - 0.5f);
        const float a = sigmoidf_(a0a[j] + accA[m][4 * q + j]);
        kn4[j] = k4[j] * kka[j] * rn;
        b4[j] = kn4[j] * a;
        kp4[j] = k4[j] * (1.f + (a - 1.f) * kaa[j]);
      }
      *(u32x2*)(WK + 0 * 64 + f0) = u32x2{pk2(r4[0], r4[1]), pk2(r4[2], r4[3])};
      *(u32x2*)(WK + 1 * 64 + f0) = u32x2{pk2(e4[0], e4[1]), pk2(e4[2], e4[3])};
      *(u32x2*)(WK + 2 * 64 + f0) = u32x2{pk2(kp4[0], kp4[1]), pk2(kp4[2], kp4[3])};
      *(u32x2*)(WK + 3 * 64 + f0) = u32x2{pk2(v4[0], v4[1]), pk2(v4[2], v4[3])};
      *(u32x2*)(WK + 4 * 64 + f0) = u32x2{pk2(kn4[0], kn4[1]), pk2(kn4[2], kn4[3])};
      *(u32x2*)(WK + 5 * 64 + f0) = u32x2{pk2(b4[0], b4[1]), pk2(b4[2], b4[3])};
    }
}

DI void qproj_item(const Params& p, int layer, int tt, int hd, int lane);
DI void kvproj_item(const Params& p, int layer, int tt, int hd, int lane);
DI void phase_norms_prep(const Params& p, int layer, char* smem, int* s_item) {
  int* ctr = (int*)(p.ws + WS_CTR) + 4 + layer;
  const int wave = tidx() >> 6, lane = tidx() & 63;
  for (;;) {
    __syncthreads();
    if (tidx() == 0) *s_item = atomicAdd(ctr, 1);
    __syncthreads();
    const int it = *s_item;
    if (it >= 1088 + 2112 + 272) break;
    if (it < 1088) { wkvprep_block(p, layer, it >> 1, it & 1, smem); continue; }
    if (it < 1088 + 2112) {
      const int wi = (it - 1088) * 4 + wave;
      if (wi < 544 * 8) qproj_item(p, layer, wi >> 3, wi & 7, lane);
      else { const int j = wi - 544 * 8; kvproj_item(p, layer, j >> 3, j & 7, lane); }
      continue;
    }
    const int tb = (it - 1088 - 2112) * 64 + wave * 16;
    for (int j = 0; j < 16; ++j) norms_token(p, layer, tb + j, lane);
  }
}

DI bf16x8 normed_frag(const u16* zsrc, const float* g, float& ssq) {
  const u32x4 raw = *(const u32x4*)zsrc;
  const f32x4 g0 = *(const f32x4*)g, g1 = *(const f32x4*)(g + 4);
  const float f0 = lo2f(raw.x), f1 = hi2f(raw.x), f2 = lo2f(raw.y), f3 = hi2f(raw.y);
  const float f4 = lo2f(raw.z), f5 = hi2f(raw.z), f6 = lo2f(raw.w), f7 = hi2f(raw.w);
  ssq += (f0 * f0 + f1 * f1) + (f2 * f2 + f3 * f3) + (f4 * f4 + f5 * f5) + (f6 * f6 + f7 * f7);
  const u32x4 o = {pk2(f0 * g0.x, f1 * g0.y), pk2(f2 * g0.z, f3 * g0.w), pk2(f4 * g1.x, f5 * g1.y), pk2(f6 * g1.z, f7 * g1.w)};
  return __builtin_bit_cast(bf16x8, o);
}
DI void qproj_item(const Params& p, int layer, int tt, int hd, int lane) {
  const int l31 = lane & 31, h = lane >> 5;
  const int tok = tt * 32 + l31;
  const u16* zq = (const u16*)(p.ws + WS_Z) + (size_t)tok * NZ;
  const float* gq = p.q_norm_w + layer * 256;
  float ssq = 0.f;
  const u16* WT = (const u16*)(p.ws + (size_t)layer * WL_STRIDE + W_UQ);
  u16* Q = (u16*)(p.ws + WS_Q);
  f32x16 acc[3];
#pragma unroll
  for (int m = 0; m < 3; ++m)
#pragma unroll
    for (int r = 0; r < 16; ++r) acc[m][r] = 0.f;
#pragma unroll 4
  for (int ks = 0; ks < 16; ++ks) {
    const bf16x8 bfr = normed_frag(zq + ks * 16 + h * 8, gq + ks * 16 + h * 8, ssq);
#pragma unroll
    for (int m = 0; m < 3; ++m) {
      const bf16x8 afr = *(const bf16x8*)(WT + (size_t)(hd * 96 + m * 32 + l31) * 256 + ks * 16 + h * 8);
      acc[m] = MFMA32(afr, bfr, acc[m]);
    }
  }
  {
    ssq += xor32(ssq);
    const float rinv = rsqrtf(ssq * (1.f / 256.f) + EPS);
#pragma unroll
    for (int m = 0; m < 3; ++m)
#pragma unroll
      for (int r = 0; r < 16; ++r) acc[m][r] *= rinv;
  }
  const float qs = 0.10206207261596577f * 1.4426950408889634f;
  float ss = 0.f;
#pragma unroll
  for (int m = 0; m < 2; ++m)
#pragma unroll
    for (int r = 0; r < 16; ++r) ss += acc[m][r] * acc[m][r];
  ss += xor32(ss);
  const float rn = rsqrtf(ss * (1.f / 64.f) + EPS) * qs;
  u16* qd = Q + (size_t)tok * 768 + hd * 96;
#pragma unroll
  for (int m = 0; m < 2; ++m)
#pragma unroll
    for (int q = 0; q < 4; ++q) {
      const int f0 = m * 32 + 8 * q + 4 * h;
      const float4 g = *(const float4*)(p.qn_nope + layer * 64 + f0);
      *(uint2*)(qd + f0) = make_uint2(pk2(acc[m][4 * q] * rn * g.x, acc[m][4 * q + 1] * rn * g.y), pk2(acc[m][4 * q + 2] * rn * g.z, acc[m][4 * q + 3] * rn * g.w));
    }
  float sr = 0.f;
#pragma unroll
  for (int r = 0; r < 16; ++r) sr += acc[2][r] * acc[2][r];
  sr += xor32(sr);
  const float rr = rsqrtf(sr * (1.f / 32.f) + EPS);
  const int pos = tok_pos(tok);
  float o1[8], o2[8];
#pragma unroll
  for (int r = 0; r < 8; ++r) {
    const int i = crow(r, h);
    const float x1 = acc[2][r] * rr * p.qn_rope[layer * 32 + i];
    const float x2 = acc[2][r + 8] * rr * p.qn_rope[layer * 32 + i + 16];
    float s, c;
    rope_sincos(pos, i, s, c);
    o1[r] = (x1 * c - x2 * s) * qs;
    o2[r] = (x2 * c + x1 * s) * qs;
  }
#pragma unroll
  for (int q = 0; q < 2; ++q) {
    const int i0 = 8 * q + 4 * h;
    *(uint2*)(qd + 64 + i0) = make_uint2(pk2(o1[4 * q], o1[4 * q + 1]), pk2(o1[4 * q + 2], o1[4 * q + 3]));
    *(uint2*)(qd + 64 + 16 + i0) = make_uint2(pk2(o2[4 * q], o2[4 * q + 1]), pk2(o2[4 * q + 2], o2[4 * q + 3]));
  }
}

DI void kvproj_item(const Params& p, int layer, int tt, int hd, int lane) {
  const int l31 = lane & 31, h = lane >> 5;
  const int tok = tt * 32 + l31;
  const u16* zk = (const u16*)(p.ws + WS_Z) + (size_t)tok * NZ + ZC_KV;
  const float* gk = p.kv_norm_w + layer * 128;
  float ssq = 0.f;
  const u16* WT = (const u16*)(p.ws + (size_t)layer * WL_STRIDE + W_UKV);
  u16* KN = (u16*)(p.ws + WS_KN);
  u16* VT = (u16*)(p.ws + WS_VT);
  f32x16 acc[4];
#pragma unroll
  for (int m = 0; m < 4; ++m)
#pragma unroll
    for (int r = 0; r < 16; ++r) acc[m][r] = 0.f;
#pragma unroll 4
  for (int ks = 0; ks < 8; ++ks) {
    const bf16x8 bfr = normed_frag(zk + ks * 16 + h * 8, gk + ks * 16 + h * 8, ssq);
#pragma unroll
    for (int m = 0; m < 4; ++m) {
      const bf16x8 afr = *(const bf16x8*)(WT + (size_t)(hd * 128 + m * 32 + l31) * 128 + ks * 16 + h * 8);
      acc[m] = MFMA32(afr, bfr, acc[m]);
    }
  }
  {
    ssq += xor32(ssq);
    const float rinv = rsqrtf(ssq * (1.f / 128.f) + EPS);
#pragma unroll
    for (int m = 0; m < 4; ++m)
#pragma unroll
      for (int r = 0; r < 16; ++r) acc[m][r] *= rinv;
  }
  float ss = 0.f;
#pragma unroll
  for (int m = 0; m < 2; ++m)
#pragma unroll
    for (int r = 0; r < 16; ++r) ss += acc[m][r] * acc[m][r];
  ss += xor32(ss);
  const float rn = rsqrtf(ss * (1.f / 64.f) + EPS);
  u16* kd = KN + ((size_t)hd * NP + tok) * 64;
#pragma unroll
  for (int m = 0; m < 2; ++m)
#pragma unroll
    for (int q = 0; q < 4; ++q) {
      const int f0 = m * 32 + 8 * q + 4 * h;
      const float4 g = *(const float4*)(p.kn_nope + layer * 64 + f0);
      *(uint2*)(kd + f0) = make_uint2(pk2(acc[m][4 * q] * rn * g.x, acc[m][4 * q + 1] * rn * g.y), pk2(acc[m][4 * q + 2] * rn * g.z, acc[m][4 * q + 3] * rn * g.w));
    }
#pragma unroll
  for (int m = 0; m < 2; ++m)
#pragma unroll
    for (int r = 0; r < 16; ++r) {
      const int d = m * 32 + crow(r, h);
      VT[((size_t)hd * 64 + d) * NP + tok] = f2bf(acc[2 + m][r]);
    }
}

DI void phase_proj(const Params& p, int layer) {
  const int wave = tidx() >> 6, lane = tidx() & 63;
  const int nw = gridDim.x * 4, gw = blockIdx.x * 4 + wave;
  for (int it = gw; it < 544 * 8 + 512 * 8; it += nw) {
    if (it < 544 * 8) qproj_item(p, layer, it >> 3, it & 7, lane);
    else { const int j = it - 544 * 8; kvproj_item(p, layer, j >> 3, j & 7, lane); }
  }
}

DI float wave_max(float v) {
#pragma unroll
  for (int o = 32; o > 0; o >>= 1) v = fmaxf(v, __shfl_xor(v, o));
  return v;
}
DI float attn_bound(const Params& p, int layer, int lane) {
  const float gqn = wave_max(fabsf(p.qn_nope[layer * 64 + lane])), gkn = wave_max(fabsf(p.kn_nope[layer * 64 + lane]));
  const float gqr = wave_max(fabsf(p.qn_rope[layer * 32 + (lane & 31)])), gkr = wave_max(fabsf(p.kn_rope[layer * 32 + (lane & 31)]));
  const float qs = 0.10206207261596577f * 1.4426950408889634f;
  return 1.02f * qs * (64.f * gqn * gkn + 32.f * gqr * gkr) + 0.25f;
}
template <int NSUB>
DI void attn_tile(const bf16x8 (&qf)[6], const u16* sK, const u16* sVT, int ksub0, f32x16 (&o)[2], float& l, float negB, int l31, int h) {
  f32x16 s[NSUB];
  {
    bf16x8 kf[NSUB][6];
#pragma unroll
    for (int i = 0; i < NSUB; ++i)
#pragma unroll
      for (int ks = 0; ks < 6; ++ks) kf[i][ks] = *(const bf16x8*)(sK + ((ksub0 + i) * 32 + l31) * 104 + ks * 16 + h * 8);
#pragma unroll
    for (int i = 0; i < NSUB; ++i) {
#pragma unroll
      for (int r = 0; r < 16; ++r) s[i][r] = negB;
#pragma unroll
      for (int ks = 0; ks < 6; ++ks) s[i] = MFMA32(kf[i][ks], qf[ks], s[i]);
    }
    __builtin_amdgcn_sched_group_barrier(0x100, 6 * NSUB, 0);
    __builtin_amdgcn_sched_group_barrier(0x008, 6 * NSUB, 0);
  }
  bf16x8 vf[NSUB][2][2];
#pragma unroll
  for (int i = 0; i < NSUB; ++i)
#pragma unroll
    for (int st = 0; st < 2; ++st)
#pragma unroll
      for (int md = 0; md < 2; ++md) {
        const u16* vp = sVT + (md * 32 + l31) * 68 + (ksub0 + i) * 32 + 16 * st + 4 * h;
        const s16x4 lo = *(const s16x4*)vp;
        const s16x4 hi = *(const s16x4*)(vp + 8);
        vf[i][st][md] = __builtin_shufflevector(lo, hi, 0, 1, 2, 3, 4, 5, 6, 7);
      }
  float ps = 0.f;
#pragma unroll
  for (int i = 0; i < NSUB; ++i)
#pragma unroll
    for (int r = 0; r < 16; ++r) {
      const float pv = __builtin_amdgcn_exp2f(s[i][r]);
      ps += pv;
      s[i][r] = pv;
    }
  l += ps;
#pragma unroll
  for (int i = 0; i < NSUB; ++i)
#pragma unroll
    for (int st = 0; st < 2; ++st) {
      u32x4 pu;
      pu.x = pk2(s[i][8 * st + 0], s[i][8 * st + 1]);
      pu.y = pk2(s[i][8 * st + 2], s[i][8 * st + 3]);
      pu.z = pk2(s[i][8 * st + 4], s[i][8 * st + 5]);
      pu.w = pk2(s[i][8 * st + 6], s[i][8 * st + 7]);
      const bf16x8 pf = __builtin_bit_cast(bf16x8, pu);
#pragma unroll
      for (int md = 0; md < 2; ++md) o[md] = MFMA32(vf[i][st][md], pf, o[md]);
    }
}

DI void attn_store(const Params& p, int tok, int hd, const f32x16 (&o)[2], float linv, int h) {
  const u16* gz = (const u16*)(p.ws + WS_Z) + (size_t)tok * NZ + ZC_GA + hd * 64;
  u16* OA = (u16*)(p.ws + WS_OA) + (size_t)tok * 512 + hd * 64;
#pragma unroll
  for (int md = 0; md < 2; ++md)
#pragma unroll
    for (int q = 0; q < 4; ++q) {
      const int d0 = md * 32 + 8 * q + 4 * h;
      const uint2 g = *(const uint2*)(gz + d0);
      const float v0 = o[md][4 * q] * linv * siluf_(lo2f(g.x));
      const float v1 = o[md][4 * q + 1] * linv * siluf_(hi2f(g.x));
      const float v2 = o[md][4 * q + 2] * linv * siluf_(lo2f(g.y));
      const float v3 = o[md][4 * q + 3] * linv * siluf_(hi2f(g.y));
      *(uint2*)(OA + d0) = make_uint2(pk2(v0, v1), pk2(v2, v3));
    }
}

DI void attn_prompt_item(const Params& p, int layer, int qt, int hd, char* smem) {
  u16* sK = (u16*)smem;
  u16* sVT = (u16*)(smem + 13312);
  const int tid = tidx(), lane = tid & 63, w = tid >> 6, l31 = lane & 31, h = lane >> 5;
  const int tok = qt * 128 + w * 32 + l31;
  const u16* Q = (const u16*)(p.ws + WS_Q);
  const u16* KN = (const u16*)(p.ws + WS_KN) + (size_t)hd * NP * 64;
  const u16* KPEB = (const u16*)(p.ws + WS_KPEB);
  const u16* VT = (const u16*)(p.ws + WS_VT) + (size_t)hd * 64 * NP;
  bf16x8 qf[6];
#pragma unroll
  for (int ks = 0; ks < 6; ++ks) qf[ks] = *(const bf16x8*)(Q + (size_t)tok * 768 + hd * 96 + ks * 16 + h * 8);
  f32x16 o[2];
#pragma unroll
  for (int d = 0; d < 2; ++d)
#pragma unroll
    for (int r = 0; r < 16; ++r) o[d][r] = 0.f;
  float l = 0.f;
  const float negB = -attn_bound(p, layer, lane);
  const int nkt = 2 * qt + 2;
  const int my_nkt = (w < 2) ? nkt - 1 : nkt;
  u32x4 pk[2][2], pr[2], pv[2][2];
#define PA_GLOAD(SET, KT)                                                                        \
  {                                                                                              \
    const int key0_ = (KT) * 64;                                                                 \
    _Pragma("unroll") for (int i = 0; i < 2; ++i) {                                              \
      const int c = tid + 256 * i;                                                               \
      pk[SET][i] = *(const u32x4*)(KN + (size_t)(key0_ + (c >> 3)) * 64 + (c & 7) * 8);          \
      pv[SET][i] = *(const u32x4*)(VT + (size_t)(c >> 3) * NP + key0_ + (c & 7) * 8);            \
    }                                                                                            \
    pr[SET] = *(const u32x4*)(KPEB + (size_t)(key0_ + (tid >> 2)) * 32 + (tid & 3) * 8);         \
  }
  PA_GLOAD(0, 0)
  PA_GLOAD(1, 1)
  for (int kt0 = 0; kt0 < nkt; kt0 += 2) {
#pragma unroll
    for (int u = 0; u < 2; ++u) {
      const int kt = kt0 + u;
      __syncthreads();
#pragma unroll
      for (int i = 0; i < 2; ++i) {
        const int c = tid + 256 * i;
        *(u32x4*)(sK + (c >> 3) * 104 + (c & 7) * 8) = pk[u][i];
        u32x2* vd = (u32x2*)(sVT + (c >> 3) * 68 + (c & 7) * 8);
        vd[0] = u32x2{pv[u][i].x, pv[u][i].y};
        vd[1] = u32x2{pv[u][i].z, pv[u][i].w};
      }
      *(u32x4*)(sK + (tid >> 2) * 104 + 64 + (tid & 3) * 8) = pr[u];
      __syncthreads();
      if (kt + 2 < nkt) PA_GLOAD(u, kt + 2)
      if (kt < my_nkt) attn_tile<2>(qf, sK, sVT, 0, o, l, negB, l31, h);
    }
  }
#undef PA_GLOAD
  l += xor32(l);
  attn_store(p, tok, hd, o, 1.f / l, h);
}

DI void attn_sample_item(const Params& p, int layer, int b, int hd, char* smem) {
  u16* sC = (u16*)smem;
  u16* sK = (u16*)(smem + 17408);
  u16* sVT = (u16*)(smem + 17408 + 13312);
  u16* sW = (u16*)(smem + 39424);
  const int tid = tidx(), lane = tid & 63, w = tid >> 6, l31 = lane & 31, h = lane >> 5;
  const int khu = w & 1, part = w >> 1;
  const int qh = w >> 1, kh = w & 1;
  const int tok = NP + b * 64 + qh * 32 + l31;
  const u16* Q = (const u16*)(p.ws + WS_Q);
  const u16* WT = (const u16*)(p.ws + (size_t)layer * WL_STRIDE + W_UKV) + (size_t)hd * 128 * 128;
  __syncthreads();
#pragma unroll
  for (int i = 0; i < 8; ++i) {
    const int c = tid + 256 * i;
    *(u32x4*)(sW + (c >> 4) * 136 + (c & 15) * 8) = *(const u32x4*)(WT + (size_t)c * 8);
  }
  bf16x8 qf[6];
#pragma unroll
  for (int ks = 0; ks < 6; ++ks) qf[ks] = *(const bf16x8*)(Q + (size_t)tok * 768 + hd * 96 + ks * 16 + h * 8);
  f32x16 o[2];
#pragma unroll
  for (int d = 0; d < 2; ++d)
#pragma unroll
    for (int r = 0; r < 16; ++r) o[d][r] = 0.f;
  float l = 0.f;
  const float negB = -attn_bound(p, layer, lane);
  const u16* cck = (const u16*)(p.ws + WS_CKB) + (size_t)b * 4096 * 128;
  const u16* ckp = (const u16*)(p.ws + WS_KPB) + (size_t)b * 4096 * 32;
  const u16* nck = (const u16*)(p.ws + WS_CKVB) + (size_t)(NP + b * 64) * 128;
  const u16* nkp = (const u16*)(p.ws + WS_KPEB) + (size_t)(NP + b * 64) * 32;
  u32x4 pc[4], pp;
#define SA_GLOAD(KT)                                                                      \
  {                                                                                       \
    const u16* s1_ = ((KT) < 64) ? cck + (size_t)(KT) * 64 * 128 : nck;                   \
    const u16* s2_ = ((KT) < 64) ? ckp + (size_t)(KT) * 64 * 32 : nkp;                    \
    _Pragma("unroll") for (int i = 0; i < 4; ++i) pc[i] = *(const u32x4*)(s1_ + (size_t)(tid + 256 * i) * 8); \
    pp = *(const u32x4*)(s2_ + (size_t)tid * 8);                                          \
  }
  SA_GLOAD(0)
  for (int kt = 0; kt < 65; ++kt) {
    __syncthreads();
#pragma unroll
    for (int i = 0; i < 4; ++i) {
      const int c = tid + 256 * i;
      *(u32x4*)(sC + (c >> 4) * 136 + (c & 15) * 8) = pc[i];
    }
    *(u32x4*)(sK + (tid >> 2) * 104 + 64 + (tid & 3) * 8) = pp;
    __syncthreads();
    if (kt + 1 < 65) SA_GLOAD(kt + 1)
    {
      f32x16 acc[2];
#pragma unroll
      for (int mt = 0; mt < 2; ++mt)
#pragma unroll
        for (int r = 0; r < 16; ++r) acc[mt][r] = 0.f;
      bf16x8 cfa[8];
#pragma unroll
      for (int ks = 0; ks < 8; ++ks) cfa[ks] = *(const bf16x8*)(sC + (khu * 32 + l31) * 136 + ks * 16 + h * 8);
#pragma unroll
      for (int mt = 0; mt < 2; ++mt) {
        bf16x8 wfa[8];
#pragma unroll
        for (int ks = 0; ks < 8; ++ks) wfa[ks] = *(const bf16x8*)(sW + (part * 64 + mt * 32 + l31) * 136 + ks * 16 + h * 8);
#pragma unroll
        for (int ks = 0; ks < 8; ++ks) {
          if (part == 0) acc[mt] = MFMA32(wfa[ks], cfa[ks], acc[mt]);
          else acc[mt] = MFMA32(cfa[ks], wfa[ks], acc[mt]);
        }
      }
      if (part == 0) {
        float ss = 0.f;
#pragma unroll
        for (int mt = 0; mt < 2; ++mt)
#pragma unroll
          for (int r = 0; r < 16; ++r) ss += acc[mt][r] * acc[mt][r];
        ss += xor32(ss);
        const float rn = rsqrtf(ss * (1.f / 64.f) + EPS);
#pragma unroll
        for (int mt = 0; mt < 2; ++mt)
#pragma unroll
          for (int q = 0; q < 4; ++q) {
            const int f0 = mt * 32 + 8 * q + 4 * h;
            const float4 g = *(const float4*)(p.kn_nope + layer * 64 + f0);
            *(u32x2*)(sK + (khu * 32 + l31) * 104 + f0) = u32x2{pk2(acc[mt][4 * q] * rn * g.x, acc[mt][4 * q + 1] * rn * g.y), pk2(acc[mt][4 * q + 2] * rn * g.z, acc[mt][4 * q + 3] * rn * g.w)};
          }
      } else {
#pragma unroll
        for (int mt = 0; mt < 2; ++mt)
#pragma unroll
          for (int q = 0; q < 4; ++q)
            *(u32x2*)(sVT + (mt * 32 + l31) * 68 + khu * 32 + 8 * q + 4 * h) =
                u32x2{pk2(acc[mt][4 * q], acc[mt][4 * q + 1]), pk2(acc[mt][4 * q + 2], acc[mt][4 * q + 3])};
      }
    }
    __syncthreads();
    attn_tile<1>(qf, sK, sVT, kh, o, l, negB, l31, h);
  }
#undef SA_GLOAD
  __syncthreads();
  float* cb = (float*)smem;
  if (kh == 1) {
    float* d = cb + (qh * 64 + lane) * 34;
#pragma unroll
    for (int r = 0; r < 16; ++r) { d[r] = o[0][r]; d[16 + r] = o[1][r]; }
    d[32] = l;
  }
  __syncthreads();
  if (kh == 0) {
    const float* d = cb + (qh * 64 + lane) * 34;
#pragma unroll
    for (int r = 0; r < 16; ++r) { o[0][r] += d[r]; o[1][r] += d[16 + r]; }
    l += d[32];
    l += xor32(l);
    attn_store(p, tok, hd, o, 1.f / l, h);
  }
}

template <int N> DI void fmac_bc(float& acc, float srcvec, float other) {
  asm("v_fmac_f32_dpp %0, %1, %2 row_newbcast:%3 row_mask:0xf bank_mask:0xf" : "+v"(acc) : "v"(srcvec), "v"(other), "n"(N));
}
template <int N> DI float mul_bc(float srcvec, float other) {
  float r;
  asm("v_mul_f32_dpp %0, %1, %2 row_newbcast:%3 row_mask:0xf bank_mask:0xf" : "=v"(r) : "v"(srcvec), "v"(other), "n"(N));
  return r;
}
struct RplRaw { u32x2 r, e, k, a, b; unsigned v; };
template <int MODE> DI void rpl_load(RplRaw& q, const u16* s, int n, int lane) {
  q.e = *(const u32x2*)(s + 64 + 4 * n);
  q.a = *(const u32x2*)(s + 256 + 4 * n);
  q.b = *(const u32x2*)(s + 320 + 4 * n);
  if (MODE >= 1) { q.k = *(const u32x2*)(s + 128 + 4 * n); q.v = s[192 + lane]; }
  if (MODE == 2) q.r = *(const u32x2*)(s + 4 * n);
}
template <int MODE>
DI void rpl_item(const Params& p, int hd, int tok0, int nsteps, const float* Sinit, float* Sout, float* Yg, int lane) {
  const int n = lane & 15;
  float S[64];
  if (MODE == 0) {
#pragma unroll
    for (int k = 0; k < 64; ++k) S[k] = (k == lane) ? 1.f : 0.f;
  } else if (MODE == 1) {
#pragma unroll
    for (int k = 0; k < 64; ++k) S[k] = 0.f;
  } else {
#pragma unroll
    for (int k = 0; k < 64; k += 4) {
      const f32x4 t = *(const f32x4*)(Sinit + (size_t)lane * 64 + k);
      S[k] = t.x; S[k + 1] = t.y; S[k + 2] = t.z; S[k + 3] = t.w;
    }
  }
  const u16* src = (const u16*)(p.ws + WS_WKVIN) + ((size_t)hd * NT + tok0) * 384;
  RplRaw c0, c1, c2;
  rpl_load<MODE>(c0, src, n, lane);
  rpl_load<MODE>(c1, src + 384, n, lane);
  for (int t = 0; t < nsteps; ++t) {
    if (t + 2 < nsteps) rpl_load<MODE>(c2, src + (size_t)(t + 2) * 384, n, lane);
    float A0 = -lo2f(c0.a.x), A1 = -hi2f(c0.a.x), A2 = -lo2f(c0.a.y), A3 = -hi2f(c0.a.y);
    float W0 = __expf(-lo2f(c0.e.x)), W1 = __expf(-hi2f(c0.e.x)), W2 = __expf(-lo2f(c0.e.y)), W3 = __expf(-hi2f(c0.e.y));
    float B0 = lo2f(c0.b.x), B1 = hi2f(c0.b.x), B2 = lo2f(c0.b.y), B3 = hi2f(c0.b.y);
    float K0 = 0.f, K1 = 0.f, K2 = 0.f, K3 = 0.f, R0 = 0.f, R1 = 0.f, R2 = 0.f, R3 = 0.f, vv = 0.f;
    if (MODE >= 1) { K0 = lo2f(c0.k.x); K1 = hi2f(c0.k.x); K2 = lo2f(c0.k.y); K3 = hi2f(c0.k.y); vv = lo2f(c0.v); }
    if (MODE == 2) { R0 = lo2f(c0.r.x); R1 = hi2f(c0.r.x); R2 = lo2f(c0.r.y); R3 = hi2f(c0.r.y); }
    asm volatile("s_nop 1" : "+v"(A0), "+v"(A1), "+v"(A2), "+v"(A3), "+v"(W0), "+v"(W1), "+v"(W2), "+v"(W3), "+v"(B0), "+v"(B1), "+v"(B2), "+v"(B3));
    asm volatile("s_nop 1" : "+v"(K0), "+v"(K1), "+v"(K2), "+v"(K3), "+v"(R0), "+v"(R1), "+v"(R2), "+v"(R3));
    float sa0 = 0.f, sa1 = 0.f, sa2 = 0.f, sa3 = 0.f;
    fmac_bc<0>(sa0, A0, S[0]);
    fmac_bc<0>(sa1, A1, S[1]);
    fmac_bc<0>(sa2, A2, S[2]);
    fmac_bc<0>(sa3, A3, S[3]);
    fmac_bc<1>(sa0, A0, S[4]);
    fmac_bc<1>(sa1, A1, S[5]);
    fmac_bc<1>(sa2, A2, S[6]);
    fmac_bc<1>(sa3, A3, S[7]);
    fmac_bc<2>(sa0, A0, S[8]);
    fmac_bc<2>(sa1, A1, S[9]);
    fmac_bc<2>(sa2, A2, S[10]);
    fmac_bc<2>(sa3, A3, S[11]);
    fmac_bc<3>(sa0, A0, S[12]);
    fmac_bc<3>(sa1, A1, S[13]);
    fmac_bc<3>(sa2, A2, S[14]);
    fmac_bc<3>(sa3, A3, S[15]);
    fmac_bc<4>(sa0, A0, S[16]);
    fmac_bc<4>(sa1, A1, S[17]);
    fmac_bc<4>(sa2, A2, S[18]);
    fmac_bc<4>(sa3, A3, S[19]);
    fmac_bc<5>(sa0, A0, S[20]);
    fmac_bc<5>(sa1, A1, S[21]);
    fmac_bc<5>(sa2, A2, S[22]);
    fmac_bc<5>(sa3, A3, S[23]);
    fmac_bc<6>(sa0, A0, S[24]);
    fmac_bc<6>(sa1, A1, S[25]);
    fmac_bc<6>(sa2, A2, S[26]);
    fmac_bc<6>(sa3, A3, S[27]);
    fmac_bc<7>(sa0, A0, S[28]);
    fmac_bc<7>(sa1, A1, S[29]);
    fmac_bc<7>(sa2, A2, S[30]);
    fmac_bc<7>(sa3, A3, S[31]);
    fmac_bc<8>(sa0, A0, S[32]);
    fmac_bc<8>(sa1, A1, S[33]);
    fmac_bc<8>(sa2, A2, S[34]);
    fmac_bc<8>(sa3, A3, S[35]);
    fmac_bc<9>(sa0, A0, S[36]);
    fmac_bc<9>(sa1, A1, S[37]);
    fmac_bc<9>(sa2, A2, S[38]);
    fmac_bc<9>(sa3, A3, S[39]);
    fmac_bc<10>(sa0, A0, S[40]);
    fmac_bc<10>(sa1, A1, S[41]);
    fmac_bc<10>(sa2, A2, S[42]);
    fmac_bc<10>(sa3, A3, S[43]);
    fmac_bc<11>(sa0, A0, S[44]);
    fmac_bc<11>(sa1, A1, S[45]);
    fmac_bc<11>(sa2, A2, S[46]);
    fmac_bc<11>(sa3, A3, S[47]);
    fmac_bc<12>(sa0, A0, S[48]);
    fmac_bc<12>(sa1, A1, S[49]);
    fmac_bc<12>(sa2, A2, S[50]);
    fmac_bc<12>(sa3, A3, S[51]);
    fmac_bc<13>(sa0, A0, S[52]);
    fmac_bc<13>(sa1, A1, S[53]);
    fmac_bc<13>(sa2, A2, S[54]);
    fmac_bc<13>(sa3, A3, S[55]);
    fmac_bc<14>(sa0, A0, S[56]);
    fmac_bc<14>(sa1, A1, S[57]);
    fmac_bc<14>(sa2, A2, S[58]);
    fmac_bc<14>(sa3, A3, S[59]);
    fmac_bc<15>(sa0, A0, S[60]);
    fmac_bc<15>(sa1, A1, S[61]);
    fmac_bc<15>(sa2, A2, S[62]);
    fmac_bc<15>(sa3, A3, S[63]);
    const float sa = (sa0 + sa1) + (sa2 + sa3);
    float y0 = 0.f, y1 = 0.f, y2 = 0.f, y3 = 0.f;
    S[0] = mul_bc<0>(W0, S[0]);
    S[1] = mul_bc<0>(W1, S[1]);
    S[2] = mul_bc<0>(W2, S[2]);
    S[3] = mul_bc<0>(W3, S[3]);
    S[4] = mul_bc<1>(W0, S[4]);
    S[5] = mul_bc<1>(W1, S[5]);
    S[6] = mul_bc<1>(W2, S[6]);
    S[7] = mul_bc<1>(W3, S[7]);
    if (MODE >= 1) {
      fmac_bc<0>(S[0], K0, vv);
      fmac_bc<0>(S[1], K1, vv);
      fmac_bc<0>(S[2], K2, vv);
      fmac_bc<0>(S[3], K3, vv);
      fmac_bc<1>(S[4], K0, vv);
      fmac_bc<1>(S[5], K1, vv);
      fmac_bc<1>(S[6], K2, vv);
      fmac_bc<1>(S[7], K3, vv);
    }
    fmac_bc<0>(S[0], B0, sa);
    fmac_bc<0>(S[1], B1, sa);
    fmac_bc<0>(S[2], B2, sa);
    fmac_bc<0>(S[3], B3, sa);
    fmac_bc<1>(S[4], B0, sa);
    fmac_bc<1>(S[5], B1, sa);
    fmac_bc<1>(S[6], B2, sa);
    fmac_bc<1>(S[7], B3, sa);
    if (MODE == 2) {
      fmac_bc<0>(y0, R0, S[0]);
      fmac_bc<0>(y1, R1, S[1]);
      fmac_bc<0>(y2, R2, S[2]);
      fmac_bc<0>(y3, R3, S[3]);
      fmac_bc<1>(y0, R0, S[4]);
      fmac_bc<1>(y1, R1, S[5]);
      fmac_bc<1>(y2, R2, S[6]);
      fmac_bc<1>(y3, R3, S[7]);
    }
    S[8] = mul_bc<2>(W0, S[8]);
    S[9] = mul_bc<2>(W1, S[9]);
    S[10] = mul_bc<2>(W2, S[10]);
    S[11] = mul_bc<2>(W3, S[11]);
    S[12] = mul_bc<3>(W0, S[12]);
    S[13] = mul_bc<3>(W1, S[13]);
    S[14] = mul_bc<3>(W2, S[14]);
    S[15] = mul_bc<3>(W3, S[15]);
    if (MODE >= 1) {
      fmac_bc<2>(S[8], K0, vv);
      fmac_bc<2>(S[9], K1, vv);
      fmac_bc<2>(S[10], K2, vv);
      fmac_bc<2>(S[11], K3, vv);
      fmac_bc<3>(S[12], K0, vv);
      fmac_bc<3>(S[13], K1, vv);
      fmac_bc<3>(S[14], K2, vv);
      fmac_bc<3>(S[15], K3, vv);
    }
    fmac_bc<2>(S[8], B0, sa);
    fmac_bc<2>(S[9], B1, sa);
    fmac_bc<2>(S[10], B2, sa);
    fmac_bc<2>(S[11], B3, sa);
    fmac_bc<3>(S[12], B0, sa);
    fmac_bc<3>(S[13], B1, sa);
    fmac_bc<3>(S[14], B2, sa);
    fmac_bc<3>(S[15], B3, sa);
    if (MODE == 2) {
      fmac_bc<2>(y0, R0, S[8]);
      fmac_bc<2>(y1, R1, S[9]);
      fmac_bc<2>(y2, R2, S[10]);
      fmac_bc<2>(y3, R3, S[11]);
      fmac_bc<3>(y0, R0, S[12]);
      fmac_bc<3>(y1, R1, S[13]);
      fmac_bc<3>(y2, R2, S[14]);
      fmac_bc<3>(y3, R3, S[15]);
    }
    S[16] = mul_bc<4>(W0, S[16]);
    S[17] = mul_bc<4>(W1, S[17]);
    S[18] = mul_bc<4>(W2, S[18]);
    S[19] = mul_bc<4>(W3, S[19]);
    S[20] = mul_bc<5>(W0, S[20]);
    S[21] = mul_bc<5>(W1, S[21]);
    S[22] = mul_bc<5>(W2, S[22]);
    S[23] = mul_bc<5>(W3, S[23]);
    if (MODE >= 1) {
      fmac_bc<4>(S[16], K0, vv);
      fmac_bc<4>(S[17], K1, vv);
      fmac_bc<4>(S[18], K2, vv);
      fmac_bc<4>(S[19], K3, vv);
      fmac_bc<5>(S[20], K0, vv);
      fmac_bc<5>(S[21], K1, vv);
      fmac_bc<5>(S[22], K2, vv);
      fmac_bc<5>(S[23], K3, vv);
    }
    fmac_bc<4>(S[16], B0, sa);
    fmac_bc<4>(S[17], B1, sa);
    fmac_bc<4>(S[18], B2, sa);
    fmac_bc<4>(S[19], B3, sa);
    fmac_bc<5>(S[20], B0, sa);
    fmac_bc<5>(S[21], B1, sa);
    fmac_bc<5>(S[22], B2, sa);
    fmac_bc<5>(S[23], B3, sa);
    if (MODE == 2) {
      fmac_bc<4>(y0, R0, S[16]);
      fmac_bc<4>(y1, R1, S[17]);
      fmac_bc<4>(y2, R2, S[18]);
      fmac_bc<4>(y3, R3, S[19]);
      fmac_bc<5>(y0, R0, S[20]);
      fmac_bc<5>(y1, R1, S[21]);
      fmac_bc<5>(y2, R2, S[22]);
      fmac_bc<5>(y3, R3, S[23]);
    }
    S[24] = mul_bc<6>(W0, S[24]);
    S[25] = mul_bc<6>(W1, S[25]);
    S[26] = mul_bc<6>(W2, S[26]);
    S[27] = mul_bc<6>(W3, S[27]);
    S[28] = mul_bc<7>(W0, S[28]);
    S[29] = mul_bc<7>(W1, S[29]);
    S[30] = mul_bc<7>(W2, S[30]);
    S[31] = mul_bc<7>(W3, S[31]);
    if (MODE >= 1) {
      fmac_bc<6>(S[24], K0, vv);
      fmac_bc<6>(S[25], K1, vv);
      fmac_bc<6>(S[26], K2, vv);
      fmac_bc<6>(S[27], K3, vv);
      fmac_bc<7>(S[28], K0, vv);
      fmac_bc<7>(S[29], K1, vv);
      fmac_bc<7>(S[30], K2, vv);
      fmac_bc<7>(S[31], K3, vv);
    }
    fmac_bc<6>(S[24], B0, sa);
    fmac_bc<6>(S[25], B1, sa);
    fmac_bc<6>(S[26], B2, sa);
    fmac_bc<6>(S[27], B3, sa);
    fmac_bc<7>(S[28], B0, sa);
    fmac_bc<7>(S[29], B1, sa);
    fmac_bc<7>(S[30], B2, sa);
    fmac_bc<7>(S[31], B3, sa);
    if (MODE == 2) {
      fmac_bc<6>(y0, R0, S[24]);
      fmac_bc<6>(y1, R1, S[25]);
      fmac_bc<6>(y2, R2, S[26]);
      fmac_bc<6>(y3, R3, S[27]);
      fmac_bc<7>(y0, R0, S[28]);
      fmac_bc<7>(y1, R1, S[29]);
      fmac_bc<7>(y2, R2, S[30]);
      fmac_bc<7>(y3, R3, S[31]);
    }
    S[32] = mul_bc<8>(W0, S[32]);
    S[33] = mul_bc<8>(W1, S[33]);
    S[34] = mul_bc<8>(W2, S[34]);
    S[35] = mul_bc<8>(W3, S[35]);
    S[36] = mul_bc<9>(W0, S[36]);
    S[37] = mul_bc<9>(W1, S[37]);
    S[38] = mul_bc<9>(W2, S[38]);
    S[39] = mul_bc<9>(W3, S[39]);
    if (MODE >= 1) {
      fmac_bc<8>(S[32], K0, vv);
      fmac_bc<8>(S[33], K1, vv);
      fmac_bc<8>(S[34], K2, vv);
      fmac_bc<8>(S[35], K3, vv);
      fmac_bc<9>(S[36], K0, vv);
      fmac_bc<9>(S[37], K1, vv);
      fmac_bc<9>(S[38], K2, vv);
      fmac_bc<9>(S[39], K3, vv);
    }
    fmac_bc<8>(S[32], B0, sa);
    fmac_bc<8>(S[33], B1, sa);
    fmac_bc<8>(S[34], B2, sa);
    fmac_bc<8>(S[35], B3, sa);
    fmac_bc<9>(S[36], B0, sa);
    fmac_bc<9>(S[37], B1, sa);
    fmac_bc<9>(S[38], B2, sa);
    fmac_bc<9>(S[39], B3, sa);
    if (MODE == 2) {
      fmac_bc<8>(y0, R0, S[32]);
      fmac_bc<8>(y1, R1, S[33]);
      fmac_bc<8>(y2, R2, S[34]);
      fmac_bc<8>(y3, R3, S[35]);
      fmac_bc<9>(y0, R0, S[36]);
      fmac_bc<9>(y1, R1, S[37]);
      fmac_bc<9>(y2, R2, S[38]);
      fmac_bc<9>(y3, R3, S[39]);
    }
    S[40] = mul_bc<10>(W0, S[40]);
    S[41] = mul_bc<10>(W1, S[41]);
    S[42] = mul_bc<10>(W2, S[42]);
    S[43] = mul_bc<10>(W3, S[43]);
    S[44] = mul_bc<11>(W0, S[44]);
    S[45] = mul_bc<11>(W1, S[45]);
    S[46] = mul_bc<11>(W2, S[46]);
    S[47] = mul_bc<11>(W3, S[47]);
    if (MODE >= 1) {
      fmac_bc<10>(S[40], K0, vv);
      fmac_bc<10>(S[41], K1, vv);
      fmac_bc<10>(S[42], K2, vv);
      fmac_bc<10>(S[43], K3, vv);
      fmac_bc<11>(S[44], K0, vv);
      fmac_bc<11>(S[45], K1, vv);
      fmac_bc<11>(S[46], K2, vv);
      fmac_bc<11>(S[47], K3, vv);
    }
    fmac_bc<10>(S[40], B0, sa);
    fmac_bc<10>(S[41], B1, sa);
    fmac_bc<10>(S[42], B2, sa);
    fmac_bc<10>(S[43], B3, sa);
    fmac_bc<11>(S[44], B0, sa);
    fmac_bc<11>(S[45], B1, sa);
    fmac_bc<11>(S[46], B2, sa);
    fmac_bc<11>(S[47], B3, sa);
    if (MODE == 2) {
      fmac_bc<10>(y0, R0, S[40]);
      fmac_bc<10>(y1, R1, S[41]);
      fmac_bc<10>(y2, R2, S[42]);
      fmac_bc<10>(y3, R3, S[43]);
      fmac_bc<11>(y0, R0, S[44]);
      fmac_bc<11>(y1, R1, S[45]);
      fmac_bc<11>(y2, R2, S[46]);
      fmac_bc<11>(y3, R3, S[47]);
    }
    S[48] = mul_bc<12>(W0, S[48]);
    S[49] = mul_bc<12>(W1, S[49]);
    S[50] = mul_bc<12>(W2, S[50]);
    S[51] = mul_bc<12>(W3, S[51]);
    S[52] = mul_bc<13>(W0, S[52]);
    S[53] = mul_bc<13>(W1, S[53]);
    S[54] = mul_bc<13>(W2, S[54]);
    S[55] = mul_bc<13>(W3, S[55]);
    if (MODE >= 1) {
      fmac_bc<12>(S[48], K0, vv);
      fmac_bc<12>(S[49], K1, vv);
      fmac_bc<12>(S[50], K2, vv);
      fmac_bc<12>(S[51], K3, vv);
      fmac_bc<13>(S[52], K0, vv);
      fmac_bc<13>(S[53], K1, vv);
      fmac_bc<13>(S[54], K2, vv);
      fmac_bc<13>(S[55], K3, vv);
    }
    fmac_bc<12>(S[48], B0, sa);
    fmac_bc<12>(S[49], B1, sa);
    fmac_bc<12>(S[50], B2, sa);
    fmac_bc<12>(S[51], B3, sa);
    fmac_bc<13>(S[52], B0, sa);
    fmac_bc<13>(S[53], B1, sa);
    fmac_bc<13>(S[54], B2, sa);
    fmac_bc<13>(S[55], B3, sa);
    if (MODE == 2) {
      fmac_bc<12>(y0, R0, S[48]);
      fmac_bc<12>(y1, R1, S[49]);
      fmac_bc<12>(y2, R2, S[50]);
      fmac_bc<12>(y3, R3, S[51]);
      fmac_bc<13>(y0, R0, S[52]);
      fmac_bc<13>(y1, R1, S[53]);
      fmac_bc<13>(y2, R2, S[54]);
      fmac_bc<13>(y3, R3, S[55]);
    }
    S[56] = mul_bc<14>(W0, S[56]);
    S[57] = mul_bc<14>(W1, S[57]);
    S[58] = mul_bc<14>(W2, S[58]);
    S[59] = mul_bc<14>(W3, S[59]);
    S[60] = mul_bc<15>(W0, S[60]);
    S[61] = mul_bc<15>(W1, S[61]);
    S[62] = mul_bc<15>(W2, S[62]);
    S[63] = mul_bc<15>(W3, S[63]);
    if (MODE >= 1) {
      fmac_bc<14>(S[56], K0, vv);
      fmac_bc<14>(S[57], K1, vv);
      fmac_bc<14>(S[58], K2, vv);
      fmac_bc<14>(S[59], K3, vv);
      fmac_bc<15>(S[60], K0, vv);
      fmac_bc<15>(S[61], K1, vv);
      fmac_bc<15>(S[62], K2, vv);
      fmac_bc<15>(S[63], K3, vv);
    }
    fmac_bc<14>(S[56], B0, sa);
    fmac_bc<14>(S[57], B1, sa);
    fmac_bc<14>(S[58], B2, sa);
    fmac_bc<14>(S[59], B3, sa);
    fmac_bc<15>(S[60], B0, sa);
    fmac_bc<15>(S[61], B1, sa);
    fmac_bc<15>(S[62], B2, sa);
    fmac_bc<15>(S[63], B3, sa);
    if (MODE == 2) {
      fmac_bc<14>(y0, R0, S[56]);
      fmac_bc<14>(y1, R1, S[57]);
      fmac_bc<14>(y2, R2, S[58]);
      fmac_bc<14>(y3, R3, S[59]);
      fmac_bc<15>(y0, R0, S[60]);
      fmac_bc<15>(y1, R1, S[61]);
      fmac_bc<15>(y2, R2, S[62]);
      fmac_bc<15>(y3, R3, S[63]);
    }
    if (MODE == 2) Yg[(size_t)t * 512 + lane] = (y0 + y1) + (y2 + y3);
    c0 = c1; c1 = c2;
  }
  if (Sout) {
#pragma unroll
    for (int k = 0; k < 64; k += 4) *(f32x4*)(Sout + (size_t)lane * 64 + k) = f32x4{S[k], S[k + 1], S[k + 2], S[k + 3]};
  }
}

constexpr int RC = 128;
constexpr int NCH = NP / RC;
DI void seqs_item(const Params& p, int layer, int hd, char* smem) {
  float* sS = (float*)smem;
  const int tid = tidx(), lane = tid & 63, w = tid >> 6, l31 = lane & 31, h = lane >> 5, wr = w >> 1, wc = w & 1;
  const float* PQ = (const float*)(p.ws + WS_Y) + (size_t)hd * NCH * 8192;
  float* SS = (float*)(p.ws + WS_H) + (size_t)hd * NCH * 4096;
  const unsigned* pqflag = (const unsigned*)(p.ws + WS_CTR) + 1024 + (layer * 8 + hd) * 64;
  __syncthreads();
  for (int i = tid; i < 64 * 65; i += 256) sS[i] = 0.f;
  for (int i = tid; i < 4096; i += 256) SS[i] = 0.f;
  if (tid == 0) {
    for (int j = 0; j < 5; ++j)
      while (__hip_atomic_load((unsigned*)pqflag + j, __ATOMIC_RELAXED, __HIP_MEMORY_SCOPE_AGENT) == 0u) __builtin_amdgcn_s_sleep(4);
    __builtin_amdgcn_fence(__ATOMIC_ACQUIRE, "agent");
    asm volatile("s_waitcnt vmcnt(0)" ::: "memory");
  }
  __syncthreads();
  float bP[32], bQ[16], nP[32], nQ[16];
#pragma unroll
  for (int ks = 0; ks < 32; ++ks) bP[ks] = PQ[(2 * ks + h) * 64 + 32 * wc + l31];
#pragma unroll
  for (int r = 0; r < 16; ++r) bQ[r] = PQ[4096 + (32 * wr + crow(r, h)) * 64 + 32 * wc + l31];
  for (int c = 0; c < NCH; ++c) {
    if ((c & 7) == 0 && c > 0) {
      if (tid == 0) {
        const int j0 = c >> 1, j1 = (c + 8 < NCH) ? j0 + 5 : j0 + 4;
        for (int j = j0; j < j1; ++j)
          while (__hip_atomic_load((unsigned*)pqflag + j, __ATOMIC_RELAXED, __HIP_MEMORY_SCOPE_AGENT) == 0u) __builtin_amdgcn_s_sleep(4);
        __builtin_amdgcn_fence(__ATOMIC_ACQUIRE, "agent");
        asm volatile("s_waitcnt vmcnt(0)" ::: "memory");
      }
      __syncthreads();
    }
    if (c + 1 < NCH) {
      const float* Pn = PQ + (size_t)(c + 1) * 8192;
#pragma unroll
      for (int ks = 0; ks < 32; ++ks) nP[ks] = Pn[(2 * ks + h) * 64 + 32 * wc + l31];
#pragma unroll
      for (int r = 0; r < 16; ++r) nQ[r] = Pn[4096 + (32 * wr + crow(r, h)) * 64 + 32 * wc + l31];
    }
    f32x16 acc;
#pragma unroll
    for (int r = 0; r < 16; ++r) acc[r] = bQ[r];
    float a[32];
#pragma unroll
    for (int ks = 0; ks < 32; ++ks) a[ks] = sS[(32 * wr + l31) * 65 + 2 * ks + h];
#pragma unroll
    for (int ks = 0; ks < 32; ++ks) acc = __builtin_amdgcn_mfma_f32_32x32x2f32(a[ks], bP[ks], acc, 0, 0, 0);
    __syncthreads();
    float* dst = (c + 1 < NCH) ? SS + (size_t)(c + 1) * 4096 : p.out + OFF_WKV_P + ((size_t)layer * 8 + hd) * 4096;
#pragma unroll
    for (int r = 0; r < 16; ++r) {
      const int row = 32 * wr + crow(r, h), col = 32 * wc + l31;
      sS[row * 65 + col] = acc[r];
      dst[row * 64 + col] = acc[r];
    }
    __syncthreads();
#pragma unroll
    for (int ks = 0; ks < 32; ++ks) bP[ks] = nP[ks];
#pragma unroll
    for (int r = 0; r < 16; ++r) bQ[r] = nQ[r];
  }
}

DI void phase_mix(const Params& p, int layer, char* smem, int* s_item) {
  constexpr int NQ_PQ = NCH * 2 / 4, NQ_SY = 4, NQ_SATT = 16, NQ_PATT = 128;
  int* qctr = (int*)(p.ws + WS_CTR) + 64 + layer * 8;
  int* actr = (int*)(p.ws + WS_CTR) + 192 + layer * 8;
  if (blockIdx.x < 8) { seqs_item(p, layer, blockIdx.x, smem); return; }
  const int home = blockIdx.x & 7;
  const int first = (blockIdx.x >> 3) & 1;
  for (int pass = 0; pass < 2; ++pass) {
    const int kind = pass ^ first;
    for (int qi = 0; qi < 8; ++qi) {
      const int hd = (home + qi) & 7;
      for (;;) {
        __syncthreads();
        if (tidx() == 0) *s_item = atomicAdd((kind == 0 ? qctr : actr) + hd, 1);
        __syncthreads();
        const int it = *s_item;
        const int wave = __builtin_amdgcn_readfirstlane(tidx() >> 6), lane = tidx() & 63;
        if (kind == 0) {
          if (it >= NQ_PQ + NQ_SY) break;
          if (it < NQ_PQ) {
            const int q = it * 4 + wave, mode = q & 1, ch = q >> 1;
            float* dstm = (float*)(p.ws + WS_Y) + ((size_t)(hd * NCH + ch) * 2 + mode) * 4096;
            if (mode == 0) rpl_item<0>(p, hd, ch * RC, RC, nullptr, dstm, nullptr, lane);
            else rpl_item<1>(p, hd, ch * RC, RC, nullptr, dstm, nullptr, lane);
            asm volatile("s_waitcnt vmcnt(0)" ::: "memory");
            __syncthreads();
            if (tidx() == 0) {
              __builtin_amdgcn_fence(__ATOMIC_RELEASE, "agent");
              asm volatile("s_waitcnt vmcnt(0)" ::: "memory");
              __hip_atomic_store((unsigned*)(p.ws + WS_CTR) + 1024 + (layer * 8 + hd) * 64 + it, 1u, __ATOMIC_RELAXED, __HIP_MEMORY_SCOPE_AGENT);
            }
            continue;
          }
          const int b = (it - NQ_PQ) * 4 + wave;
          rpl_item<2>(p, hd, NP + b * 64, 64, p.state_wkv + (((size_t)layer * 16 + b) * 8 + hd) * 4096,
                      p.out + OFF_WKV_S + (((size_t)layer * 16 + b) * 8 + hd) * 4096, (float*)(p.ws + WS_Y) + (size_t)(NP + b * 64) * 512 + hd * 64, lane);
        } else {
          if (it >= NQ_SATT + NQ_PATT) break;
          if (it < NQ_SATT) { attn_sample_item(p, layer, it, hd, smem); continue; }
          attn_prompt_item(p, layer, 127 - (it - NQ_SATT), hd, smem);
        }
      }
    }
  }
}
DI void phase_ypass(const Params& p, int layer) {
  const int wave = __builtin_amdgcn_readfirstlane(tidx() >> 6), lane = tidx() & 63;
  const int hd = blockIdx.x & 7, nb = (gridDim.x + 7 - hd) >> 3;
  for (int j = blockIdx.x >> 3; j < NCH / 4; j += nb) {
    const int ch = j * 4 + wave;
    rpl_item<2>(p, hd, ch * RC, RC, (const float*)(p.ws + WS_H) + (size_t)(hd * NCH + ch) * 4096, nullptr,
                (float*)(p.ws + WS_Y) + (size_t)(ch * RC) * 512 + hd * 64, lane);
  }
}

DI void phase_ob(const Params& p, int layer) {
  const int wave = tidx() >> 6, lane = tidx() & 63;
  const float* Y = (const float*)(p.ws + WS_Y);
  const u16* WK = (const u16*)(p.ws + WS_WKVIN);
  const u16* Z = (const u16*)(p.ws + WS_Z);
  u16* OB = (u16*)(p.ws + WS_Q);
  const int f = lane * 8, hd = lane >> 3, fl = (lane & 7) * 8;
  for (int t = blockIdx.x * 4 + wave; t < NT; t += gridDim.x * 4) {
    const float4 ya = *(const float4*)(Y + (size_t)t * 512 + f);
    const float4 yb = *(const float4*)(Y + (size_t)t * 512 + f + 4);
    float y[8] = {ya.x, ya.y, ya.z, ya.w, yb.x, yb.y, yb.z, yb.w};
    float s = 0.f;
#pragma unroll
    for (int j = 0; j < 8; ++j) s += y[j];
    s += __shfl_xor(s, 1); s += __shfl_xor(s, 2); s += __shfl_xor(s, 4);
    const float mu = s * (1.f / 64.f);
    float vs = 0.f;
#pragma unroll
    for (int j = 0; j < 8; ++j) { y[j] -= mu; vs += y[j] * y[j]; }
    vs += __shfl_xor(vs, 1); vs += __shfl_xor(vs, 2); vs += __shfl_xor(vs, 4);
    const float rs = rsqrtf(vs * (1.f / 64.f) + GN_EPS);
    const u16* wk = WK + ((size_t)hd * NT + t) * 384 + fl;
    const uint4 r8 = *(const uint4*)(wk + 0 * 64);
    const uint4 k8 = *(const uint4*)(wk + 2 * 64);
    const uint4 v8 = *(const uint4*)(wk + 3 * 64);
    const float rr[8] = {lo2f(r8.x), hi2f(r8.x), lo2f(r8.y), hi2f(r8.y), lo2f(r8.z), hi2f(r8.z), lo2f(r8.w), hi2f(r8.w)};
    const float kk[8] = {lo2f(k8.x), hi2f(k8.x), lo2f(k8.y), hi2f(k8.y), lo2f(k8.z), hi2f(k8.z), lo2f(k8.w), hi2f(k8.w)};
    const float vv[8] = {lo2f(v8.x), hi2f(v8.x), lo2f(v8.y), hi2f(v8.y), lo2f(v8.z), hi2f(v8.z), lo2f(v8.w), hi2f(v8.w)};
    const float4 rka = *(const float4*)(p.r_k + layer * 512 + f);
    const float4 rkb = *(const float4*)(p.r_k + layer * 512 + f + 4);
    const float rk[8] = {rka.x, rka.y, rka.z, rka.w, rkb.x, rkb.y, rkb.z, rkb.w};
    float bs = 0.f;
#pragma unroll
    for (int j = 0; j < 8; ++j) bs += rr[j] * kk[j] * rk[j];
    bs += __shfl_xor(bs, 1); bs += __shfl_xor(bs, 2); bs += __shfl_xor(bs, 4);
    const float4 lwa = *(const float4*)(p.lnx_w + layer * 512 + f);
    const float4 lwb = *(const float4*)(p.lnx_w + layer * 512 + f + 4);
    const float4 lba = *(const float4*)(p.lnx_b + layer * 512 + f);
    const float4 lbb = *(const float4*)(p.lnx_b + layer * 512 + f + 4);
    const float lw[8] = {lwa.x, lwa.y, lwa.z, lwa.w, lwb.x, lwb.y, lwb.z, lwb.w};
    const float lb[8] = {lba.x, lba.y, lba.z, lba.w, lbb.x, lbb.y, lbb.z, lbb.w};
    const uint4 g8 = *(const uint4*)(Z + (size_t)t * NZ + ZC_GB + f);
    const float gg[8] = {lo2f(g8.x), hi2f(g8.x), lo2f(g8.y), hi2f(g8.y), lo2f(g8.z), hi2f(g8.z), lo2f(g8.w), hi2f(g8.w)};
    float ov[8];
#pragma unroll
    for (int j = 0; j < 8; ++j) ov[j] = (y[j] * rs * lw[j] + lb[j] + bs * vv[j]) * siluf_(gg[j]);
    *(uint4*)(OB + (size_t)t * 512 + f) = make_uint4(pk2(ov[0], ov[1]), pk2(ov[2], ov[3]), pk2(ov[4], ov[5]), pk2(ov[6], ov[7]));
  }
}

DI void phase_merge(const Params& p, int layer, char* smem) {
  const u16* OA = (const u16*)(p.ws + WS_OA);
  const u16* OB = (const u16*)(p.ws + WS_Q);
  const u16* WA = (const u16*)(p.ws + (size_t)layer * WL_STRIDE + W_OA);
  const u16* WB = (const u16*)(p.ws + (size_t)layer * WL_STRIDE + W_OB);
  const u16* Z = (const u16*)(p.ws + WS_Z);
  u16* M = (u16*)(p.ws + WS_H);
  const int xcd = blockIdx.x & 7, jb = blockIdx.x >> 3, nb = (gridDim.x + 7 - xcd) >> 3;
  for (int m = jb; m < 16 * 8; m += nb) {
    const int tt = xcd + 8 * (m >> 3), ft = m & 7;
    f32x16 acc[2][2];
    zero_acc(acc);
    gemm_mainloop(OA + (size_t)tt * 128 * 512, 512, WA + (size_t)ft * 128 * 512, 512, 512, smem, acc);
    acc_to_lds(acc, smem);
    EPI_ROWS({
      const u32x2 g = *(const u32x2*)(Z + (size_t)(tt * 128 + row) * NZ + ZC_MA + ft * 128 + col);
      *(u32x2*)(M + (size_t)(tt * 128 + row) * 1024 + ft * 128 + col) =
          u32x2{pk2(v.x * sigmoidf_(lo2f(g.x)), v.y * sigmoidf_(hi2f(g.x))), pk2(v.z * sigmoidf_(lo2f(g.y)), v.w * sigmoidf_(hi2f(g.y)))};
    })
    zero_acc(acc);
    gemm_mainloop(OB + (size_t)tt * 128 * 512, 512, WB + (size_t)ft * 128 * 512, 512, 512, smem, acc);
    acc_to_lds(acc, smem);
    EPI_ROWS({
      const u32x2 g = *(const u32x2*)(Z + (size_t)(tt * 128 + row) * NZ + ZC_MB + ft * 128 + col);
      u32x2* mp = (u32x2*)(M + (size_t)(tt * 128 + row) * 1024 + ft * 128 + col);
      const u32x2 pm = *mp;
      *mp = u32x2{pk2(lo2f(pm.x) + v.x * sigmoidf_(lo2f(g.x)), hi2f(pm.x) + v.y * sigmoidf_(hi2f(g.x))),
                  pk2(lo2f(pm.y) + v.z * sigmoidf_(lo2f(g.y)), hi2f(pm.y) + v.w * sigmoidf_(hi2f(g.y)))};
    })
  }
  for (int m = jb; m < 2 * 16; m += nb) {
    const int r0 = (128 + xcd) * 128 + (m >> 4) * 64, c0 = (m & 15) * 64;
    f32x16 acc;
#pragma unroll
    for (int r = 0; r < 16; ++r) acc[r] = 0.f;
    gemm64_mainloop(OA + (size_t)r0 * 512, 512, WA + (size_t)c0 * 512, 512, 512, smem, acc);
    acc64_to_lds(acc, smem);
    EPI64_ROWS({
      const u32x2 g = *(const u32x2*)(Z + (size_t)(r0 + row) * NZ + ZC_MA + c0 + col);
      *(u32x2*)(M + (size_t)(r0 + row) * 1024 + c0 + col) =
          u32x2{pk2(v.x * sigmoidf_(lo2f(g.x)), v.y * sigmoidf_(hi2f(g.x))), pk2(v.z * sigmoidf_(lo2f(g.y)), v.w * sigmoidf_(hi2f(g.y)))};
    })
#pragma unroll
    for (int r = 0; r < 16; ++r) acc[r] = 0.f;
    gemm64_mainloop(OB + (size_t)r0 * 512, 512, WB + (size_t)c0 * 512, 512, 512, smem, acc);
    acc64_to_lds(acc, smem);
    EPI64_ROWS({
      const u32x2 g = *(const u32x2*)(Z + (size_t)(r0 + row) * NZ + ZC_MB + c0 + col);
      u32x2* mp = (u32x2*)(M + (size_t)(r0 + row) * 1024 + c0 + col);
      const u32x2 pm = *mp;
      *mp = u32x2{pk2(lo2f(pm.x) + v.x * sigmoidf_(lo2f(g.x)), hi2f(pm.x) + v.y * sigmoidf_(hi2f(g.x))),
                  pk2(lo2f(pm.y) + v.z * sigmoidf_(lo2f(g.y)), hi2f(pm.y) + v.w * sigmoidf_(hi2f(g.y)))};
    })
  }
}

DI void phase_out(const Params& p, int layer, char* smem) {
  const u16* M = (const u16*)(p.ws + WS_H);
  const u16* W = (const u16*)(p.ws + (size_t)layer * WL_STRIDE + W_O);
  const int xcd = blockIdx.x & 7, jb = blockIdx.x >> 3, nb = (gridDim.x + 7 - xcd) >> 3;
  for (int m = jb; m < 16 * 8; m += nb) {
    const int tt = xcd + 8 * (m >> 3), ft = m & 7;
    f32x16 acc[2][2];
    zero_acc(acc);
    gemm_mainloop(M + (size_t)tt * 128 * 1024, 1024, W + (size_t)ft * 128 * 1024, 1024, 1024, smem, acc);
    acc_to_lds(acc, smem);
    EPI_ROWS({
      const int t = tt * 128 + row, n = ft * 128 + col;
      const f32x4 xo = *(const f32x4*)(xrow(p, layer, t) + n);
      *(f32x4*)(p.out + (size_t)t * 1024 + n) = xo + v;
    })
  }
  for (int m = jb; m < 2 * 16; m += nb) {
    const int r0 = (128 + xcd) * 128 + (m >> 4) * 64, c0 = (m & 15) * 64;
    f32x16 acc;
#pragma unroll
    for (int r = 0; r < 16; ++r) acc[r] = 0.f;
    gemm64_mainloop(M + (size_t)r0 * 1024, 1024, W + (size_t)c0 * 1024, 1024, 1024, smem, acc);
    acc64_to_lds(acc, smem);
    EPI64_ROWS({
      const int t = r0 + row, n = c0 + col;
      const f32x4 xo = *(const f32x4*)(xrow(p, layer, t) + n);
      *(f32x4*)(p.out + (size_t)t * 1024 + n) = xo + v;
    })
  }
}

#define XB_TMO      128
#define XB_XCNT(j)  (256  + 64 * (j))
#define XB_XSUB(j)  (1280 + 64 * (j))
#define XB_XGEN(j)  (2304 + 64 * (j))
#define XB_TOP      3328
#define XB_TOPGEN   3392
#define XCD_BAR_WORDS 3456
#define XB_SPIN_CAP (1u << 22)
#define LAS __attribute__((address_space(3)))
DI unsigned xb_ld(unsigned* p) { return __hip_atomic_load(p, __ATOMIC_RELAXED, __HIP_MEMORY_SCOPE_AGENT); }
DI unsigned xb_add(unsigned* p, unsigned v) { return __hip_atomic_fetch_add(p, v, __ATOMIC_RELAXED, __HIP_MEMORY_SCOPE_AGENT); }
DI unsigned xb_xcc_id() { return (unsigned)__builtin_amdgcn_s_getreg((3 << 11) | 20) & 0xFu; }
#define XB_SPIN(cond, bar) do { unsigned _sp = 0; while (cond) { __builtin_amdgcn_s_sleep(1); \
    if ((++_sp & 255u) == 0u) { if (xb_ld(&(bar)[XB_TMO])) break; if (_sp > XB_SPIN_CAP) { atomicAdd(&(bar)[XB_TMO], 1u); break; } } } } while (0)
struct XcdBarrier { unsigned* bar; unsigned x; volatile LAS unsigned* st; };
DI XcdBarrier xcd_barrier_post(unsigned* bar, volatile LAS unsigned* st) {
  XcdBarrier b; b.bar = bar; b.x = xb_xcc_id(); b.st = st;
  if (threadIdx.x == 0) (void)xb_add(&bar[XB_XCNT(b.x)], 1u);
  return b;
}
DI void xcd_barrier_complete(unsigned* bar, unsigned x, unsigned& nloc, unsigned& nx) {
  const unsigned G = gridDim.x * gridDim.y * gridDim.z;
  unsigned sum, cnt, mine, sp = 0u;
  for (;;) {
    sum = 0u; cnt = 0u; mine = 0u;
#pragma unroll
    for (unsigned j = 0; j < 16; ++j) { const unsigned c = xb_ld(&bar[XB_XCNT(j)]); sum += c; cnt += (c > 0u) ? 1u : 0u; mine = (j == x) ? c : mine; }
    if (sum == G) break;
    __builtin_amdgcn_s_sleep(1);
    if ((++sp & 255u) == 0u) { if (xb_ld(&bar[XB_TMO])) break; if (sp > XB_SPIN_CAP) { atomicAdd(&bar[XB_TMO], 1u); break; } }
  }
  nloc = mine > 0u ? mine : 1u; nx = cnt > 0u ? cnt : 1u;
}
DI void xcd_barrier(const XcdBarrier& b) {
  asm volatile("s_waitcnt vmcnt(0)" ::: "memory");
  __syncthreads();
  if (threadIdx.x == 0) {
    unsigned* bar = b.bar;
    __builtin_amdgcn_s_waitcnt(0);
    unsigned nloc = b.st[0], nx = b.st[1];
    if (nloc == 0u) { xcd_barrier_complete(bar, b.x, nloc, nx); b.st[0] = nloc; b.st[1] = nx; }
    const unsigned old = xb_add(&bar[XB_XSUB(b.x)], 1u);
    const unsigned gen = old / nloc;
    if (old + 1u == (gen + 1u) * nloc) {
      __builtin_amdgcn_fence(__ATOMIC_RELEASE, "agent");
      asm volatile("s_waitcnt vmcnt(0)" ::: "memory");
      const unsigned og = xb_add(&bar[XB_TOP], 1u);
      const unsigned tg = og / nx;
      if (og + 1u == (tg + 1u) * nx) xb_add(&bar[XB_TOPGEN], 1u);
      else XB_SPIN(xb_ld(&bar[XB_TOPGEN]) == tg, bar);
      __builtin_amdgcn_fence(__ATOMIC_ACQUIRE, "agent");
      xb_add(&bar[XB_XGEN(b.x)], 1u);
      asm volatile("s_waitcnt vmcnt(0)" ::: "memory");
    } else {
      XB_SPIN(xb_ld(&bar[XB_XGEN(b.x)]) == gen, bar);
      __builtin_amdgcn_fence(__ATOMIC_ACQUIRE, "agent");
      asm volatile("s_waitcnt vmcnt(0)" ::: "memory");
    }
  }
  __syncthreads();
}

constexpr int PH_PER_LAYER = 8;
constexpr int N_PHASES = 1 + 4 * PH_PER_LAYER;

DI void run_phase(const Params& p, int ph, char* smem, int* s_item) {
#ifndef PHMASK
#define PHMASK 0x3FF
#endif
  if (ph == 0) { if (PHMASK & 0x100) phase_convert(p, smem); return; }
  const int layer = (ph - 1) / PH_PER_LAYER, sub = (ph - 1) % PH_PER_LAYER;
  switch (sub) {
    case 0: if (PHMASK & 1) phase_rmsnorm(p, layer); break;
    case 1: if (PHMASK & 2) phase_g1(p, layer, smem); break;
    case 2: if (PHMASK & 4) phase_norms_prep(p, layer, smem, s_item); break;
    case 3: if (PHMASK & 16) phase_mix(p, layer, smem, s_item); break;
    case 4: if (PHMASK & 16) phase_ypass(p, layer); break;
    case 5: if (PHMASK & 32) phase_ob(p, layer); break;
    case 6: if (PHMASK & 64) phase_merge(p, layer, smem); break;
    default: if (PHMASK & 128) phase_out(p, layer, smem); break;
  }
}

__global__ void __launch_bounds__(256, 2) mk_kernel(Params p, int ph0, int ph1, int coop) {
  __shared__ __attribute__((aligned(16))) char smem[SMEM_BYTES];
  __shared__ int s_item[4];
  __shared__ uint4 xb_words;
  if (threadIdx.x == 0) xb_words = make_uint4(0u, 0u, 0u, 0u);
  __syncthreads();
  XcdBarrier xb = xcd_barrier_post((unsigned*)(p.ws + WS_BAR), (volatile LAS unsigned*)&xb_words);
  for (int ph = ph0; ph < ph1; ++ph) {
    run_phase(p, ph, smem, s_item);
    if (coop && ph + 1 < ph1) {
      xcd_barrier(xb);
      if (coop == 0x5a5a5a) cg::this_grid().sync();
    }
  }
}

extern "C" void kernel_launch(void* const* d_in, const int* in_sizes, int n_in, void* d_out, int out_size, void* d_ws, size_t ws_size,
                              hipStream_t stream) {
  static int grid_blocks = 0;
  if (!grid_blocks) {
    int dev = 0, cus = 0, per_cu = 0;
    hipGetDevice(&dev);
    hipDeviceGetAttribute(&cus, hipDeviceAttributeMultiprocessorCount, dev);
    hipOccupancyMaxActiveBlocksPerMultiprocessor(&per_cu, mk_kernel, 256, 0);
    if (per_cu < 1) per_cu = 1;
    if (per_cu > 2) per_cu = 2;
    grid_blocks = cus * per_cu;
  }
  Params p{};
  const float** pp = (const float**)&p;
  for (int i = 0; i < 29; ++i) pp[i] = (const float*)d_in[i];
  p.out = (float*)d_out;
  p.ws = (char*)d_ws;
  const int ONE_LAUNCH = 1;
  hipMemsetAsync((char*)d_ws + WS_CTR, 0, 16384 + XCD_BAR_WORDS * 4, stream);
  if (ONE_LAUNCH) {
    int ph0 = 0, ph1 = N_PHASES, coop = 1;
    void* args[] = {&p, &ph0, &ph1, &coop};
    hipError_t e = hipLaunchCooperativeKernel((void*)mk_kernel, dim3(grid_blocks), dim3(256), args, 0, stream);
    if (e != hipSuccess) fprintf(stderr, "cooperative launch failed: %s (grid %d)\n", hipGetErrorString(e), grid_blocks);
  } else {
    for (int ph = 0; ph < N_PHASES; ++ph) mk_kernel<<<dim3(grid_blocks), dim3(256), 0, stream>>>(p, ph, ph + 1, 0);
  }
}
```

```cpp
#include <hip/hip_runtime.h>
#include <hip/hip_cooperative_groups.h>
#include <cstdio>
namespace cg = cooperative_groups;

#define DI __device__ __forceinline__
typedef unsigned short u16;
typedef __attribute__((ext_vector_type(8))) short bf16x8;
typedef __attribute__((ext_vector_type(4))) short s16x4;
typedef __attribute__((ext_vector_type(2))) __bf16 bf2_t;
typedef __attribute__((ext_vector_type(2))) float f2_t;
typedef __attribute__((ext_vector_type(16))) float f32x16;
typedef __attribute__((ext_vector_type(4))) unsigned u32x4;
typedef __attribute__((ext_vector_type(2))) unsigned u32x2;
typedef __attribute__((ext_vector_type(4))) float f32x4;
#define MFMA32(a, b, c) __builtin_amdgcn_mfma_f32_32x32x16_bf16((a), (b), (c), 0, 0, 0)

constexpr int NP = 16384;
constexpr int NSM = 1024;
constexpr int NT = NP + NSM;
constexpr int NZ = 5248;
constexpr int ZC_KV = 256, ZC_KPE = 384, ZC_GA = 512, ZC_ZS = 1024, ZC_GB = 2688, ZC_MA = 3200, ZC_MB = 4224;
constexpr float EPS = 1e-6f;
constexpr float GN_EPS = 64e-5f;
constexpr int SHW = 1664;

constexpr size_t OFF_CKV_P = 17825792;
constexpr size_t OFF_KPE_P = 26214400;
constexpr size_t OFF_WKV_P = 28311552;
constexpr size_t OFF_SH_P = 28442624;
constexpr size_t OFF_CKV_S = 28449280;
constexpr size_t OFF_KPE_S = 28973568;
constexpr size_t OFF_WKV_S = 29104640;
constexpr size_t OFF_SH_S = 31201792;

constexpr size_t WL_STRIDE = 15728640;
constexpr size_t W_IN = 0, W_UQ = 10747904, W_UKV = 11141120, W_W2 = 11403264, W_A2 = 11468800, W_OA = 11534336, W_OB = 12582912, W_O = 13631488;
constexpr size_t WS_H = 62914560;
constexpr size_t WS_Z = WS_H + 35651584;
constexpr size_t WS_Q = WS_Z + 182714368;
constexpr size_t WS_CKVB = WS_Q + 26738688;
constexpr size_t WS_KPEB = WS_CKVB + 4456448;
constexpr size_t WS_KN = WS_KPEB + 1114112;
constexpr size_t WS_VT = WS_KN + 16777216;
constexpr size_t WS_WKVIN = WS_VT + 16777216;
constexpr size_t WS_OA = WS_WKVIN + 106954752;
constexpr size_t WS_Y = WS_OA + 17825792;
constexpr size_t WS_CTR = WS_Y + 35651584;
constexpr size_t WS_BAR = WS_CTR + 16384;
constexpr size_t WS_SH0 = WS_BAR + 16384;
constexpr size_t WS_CKB = WS_SH0 + 65536;
constexpr size_t WS_KPB = WS_CKB + 16777216;
constexpr size_t WS_TOTAL = WS_KPB + 4194304;
static_assert(WS_TOTAL < 536870912, "ws");

constexpr int SMEM_BYTES = 39424 + 128 * 136 * 2;

struct Params {
  const float *x_prompt, *x_sample, *cache_ckv, *cache_kpe, *state_wkv, *state_shift;
  const float *norm_w, *w_in, *q_norm_w, *kv_norm_w, *w_uq, *w_ukv, *qn_nope, *qn_rope, *kn_nope, *kn_rope;
  const float *mu_shift, *w0, *w2, *a0, *a2, *k_k, *k_a, *r_k, *lnx_w, *lnx_b, *w_out_a, *w_out_b, *w_o;
  float* out;
  char* ws;
};

__device__ const float ROPE_INV[16] = {1.0f, 0.5623413324356079f, 0.3162277638912201f, 0.17782793939113617f, 0.10000000149011612f, 0.05623413249850273f, 0.03162277489900589f, 0.017782794311642647f, 0.009999999776482582f, 0.005623413249850273f, 0.003162277629598975f, 0.0017782794311642647f, 0.0010000000474974513f, 0.000562341301701963f, 0.0003162277571391314f, 0.00017782794020604342f};

DI int tidx() { int t = threadIdx.x; asm volatile("" : "+v"(t)); return t; }
DI float bf2f(u16 h) { return __uint_as_float(((unsigned)h) << 16); }
DI unsigned pk2(float a, float b) { f2_t v = {a, b}; bf2_t r = __builtin_convertvector(v, bf2_t); return __builtin_bit_cast(unsigned, r); }
DI u16 f2bf(float a) { return (u16)(pk2(a, 0.f) & 0xffffu); }
DI float lo2f(unsigned u) { return __uint_as_float(u << 16); }
DI float hi2f(unsigned u) { return __uint_as_float(u & 0xffff0000u); }
DI float wave_sum(float v) {
  v += __builtin_bit_cast(float, __builtin_amdgcn_update_dpp(0, __builtin_bit_cast(int, v), 0x128, 0xF, 0xF, false));
  v += __builtin_bit_cast(float, __builtin_amdgcn_update_dpp(0, __builtin_bit_cast(int, v), 0x124, 0xF, 0xF, false));
  v += __builtin_bit_cast(float, __builtin_amdgcn_update_dpp(0, __builtin_bit_cast(int, v), 0x122, 0xF, 0xF, false));
  v += __builtin_bit_cast(float, __builtin_amdgcn_update_dpp(0, __builtin_bit_cast(int, v), 0x121, 0xF, 0xF, false));
  const int iv = __builtin_bit_cast(int, v);
  const float s0 = __builtin_bit_cast(float, __builtin_amdgcn_readlane(iv, 0)), s1 = __builtin_bit_cast(float, __builtin_amdgcn_readlane(iv, 16));
  const float s2 = __builtin_bit_cast(float, __builtin_amdgcn_readlane(iv, 32)), s3 = __builtin_bit_cast(float, __builtin_amdgcn_readlane(iv, 48));
  return (s0 + s1) + (s2 + s3);
}
DI float xor32(float v) { return __shfl_xor(v, 32); }
DI int crow(int reg, int h) { return (reg & 3) + 8 * (reg >> 2) + 4 * h; }
DI float sigmoidf_(float x) { return __builtin_amdgcn_rcpf(1.f + __expf(-x)); }
DI float siluf_(float x) { return x * __builtin_amdgcn_rcpf(1.f + __expf(-x)); }
DI void rope_sincos(int pos, int i, float& s, float& c) {
  float ang = (float)pos * ROPE_INV[i];
  double rev = (double)ang * 0.15915494309189533577;
  double fr = rev - rint(rev);
  float f = (float)fr;
  s = __builtin_amdgcn_sinf(f);
  c = __builtin_amdgcn_cosf(f);
}
DI const float* xrow(const Params& p, int layer, int t) {
  if (layer == 0) return (t < NP) ? p.x_prompt + (size_t)t * 1024 : p.x_sample + (size_t)(t - NP) * 1024;
  return p.out + (size_t)t * 1024;
}
DI int tok_pos(int t) { return (t < NP) ? t : 4096 + ((t - NP) & 63); }

DI void conv_tile(const float* __restrict__ src, int N, u16* __restrict__ dst, int K, int k0, int n0, int kind, float* sm) {
  const int tid = tidx();
  const int nl = tid & 63, kb = tid >> 6;
  const int np_ = n0 + nl;
  int sc = np_;
  if (kind == 1) sc = (np_ < 416) ? np_ : ((np_ < 512) ? -1 : np_ - 96);
#pragma unroll
  for (int i = 0; i < 16; ++i) {
    const int kl = kb + 4 * i;
    float v = 0.f;
    if (sc >= 0) v = src[(size_t)(k0 + kl) * N + sc];
    sm[kl * 65 + nl] = v;
  }
  __syncthreads();
  const int nr = tid >> 2, kc = (tid & 3) * 16;
  unsigned o[8];
#pragma unroll
  for (int j = 0; j < 8; ++j) o[j] = pk2(sm[(kc + 2 * j) * 65 + nr], sm[(kc + 2 * j + 1) * 65 + nr]);
  uint4* d = (uint4*)(dst + (size_t)(n0 + nr) * K + k0 + kc);
  d[0] = make_uint4(o[0], o[1], o[2], o[3]);
  d[1] = make_uint4(o[4], o[5], o[6], o[7]);
  __syncthreads();
}

DI void phase_convert(const Params& p, char* smem) {
  float* sm = (float*)smem;
  for (int it = blockIdx.x; it < 4 * 1920; it += gridDim.x) {
    const int layer = it / 1920;
    int r = it % 1920;
    const float* src; u16* dst; int K, N, kind = 0, nt;
    char* wl = p.ws + (size_t)layer * WL_STRIDE;
    if (r < 1312) { src = p.w_in + (size_t)layer * 1024 * 5152; dst = (u16*)(wl + W_IN); K = 1024; N = 5152; kind = 1; nt = 82; }
    else if (r < 1360) { r -= 1312; src = p.w_uq + (size_t)layer * 256 * 768; dst = (u16*)(wl + W_UQ); K = 256; N = 768; nt = 12; }
    else if (r < 1392) { r -= 1360; src = p.w_ukv + (size_t)layer * 128 * 1024; dst = (u16*)(wl + W_UKV); K = 128; N = 1024; nt = 16; }
    else if (r < 1400) { r -= 1392; src = p.w2 + (size_t)layer * 64 * 512; dst = (u16*)(wl + W_W2); K = 64; N = 512; nt = 8; }
    else if (r < 1408) { r -= 1400; src = p.a2 + (size_t)layer * 64 * 512; dst = (u16*)(wl + W_A2); K = 64; N = 512; nt = 8; }
    else if (r < 1536) { r -= 1408; src = p.w_out_a + (size_t)layer * 512 * 1024; dst = (u16*)(wl + W_OA); K = 512; N = 1024; nt = 16; }
    else if (r < 1664) { r -= 1536; src = p.w_out_b + (size_t)layer * 512 * 1024; dst = (u16*)(wl + W_OB); K = 512; N = 1024; nt = 16; }
    else { r -= 1664; src = p.w_o + (size_t)layer * 1024 * 1024; dst = (u16*)(wl + W_O); K = 1024; N = 1024; nt = 16; }
    const int kt = r / nt, ntile = r % nt;
    conv_tile(src, N, dst, K, kt * 64, ntile * 64, kind, sm);
  }
}

DI void phase_rmsnorm(const Params& p, int layer) {
  const int wave = tidx() >> 6, lane = tidx() & 63;
  u16* H = (u16*)(p.ws + WS_H);
  const float* g = p.norm_w + layer * 1024;
  if (blockIdx.x == gridDim.x - 1) {
    u16* sh0 = (u16*)(p.ws + WS_SH0);
    for (int i = tidx(); i < 17 * SHW; i += 256) {
      const int r = i / SHW, c = i - r * SHW;
      sh0[i] = (r == 0) ? (u16)0 : f2bf(p.state_shift[((size_t)layer * 16 + (r - 1)) * SHW + c]);
    }
  }
  {
    const float* c1 = p.cache_ckv + (size_t)layer * 16 * 4096 * 128;
    const float* c2 = p.cache_kpe + (size_t)layer * 16 * 4096 * 32;
    u16* d1 = (u16*)(p.ws + WS_CKB);
    u16* d2 = (u16*)(p.ws + WS_KPB);
    constexpr int N1 = 16 * 4096 * 128 / 8, N2 = 16 * 4096 * 32 / 8;
    for (int i = blockIdx.x * 256 + tidx(); i < N1 + N2; i += gridDim.x * 256) {
      const float* sp = (i < N1) ? c1 + (size_t)i * 8 : c2 + (size_t)(i - N1) * 8;
      u16* dp = (i < N1) ? d1 + (size_t)i * 8 : d2 + (size_t)(i - N1) * 8;
      const f32x4 a = *(const f32x4*)sp, b = *(const f32x4*)(sp + 4);
      *(u32x4*)dp = u32x4{pk2(a.x, a.y), pk2(a.z, a.w), pk2(b.x, b.y), pk2(b.z, b.w)};
    }
  }
  for (int t = blockIdx.x * 4 + wave; t < NT; t += gridDim.x * 4) {
    const float* xr = xrow(p, layer, t);
    float4 v[4];
    float ss = 0.f;
#pragma unroll
    for (int i = 0; i < 4; ++i) {
      v[i] = *(const float4*)(xr + i * 256 + lane * 4);
      ss += v[i].x * v[i].x + v[i].y * v[i].y + v[i].z * v[i].z + v[i].w * v[i].w;
    }
    ss = wave_sum(ss);
    const float rinv = rsqrtf(ss * (1.f / 1024.f) + EPS);
#pragma unroll
    for (int i = 0; i < 4; ++i) {
      const float4 g4 = *(const float4*)(g + i * 256 + lane * 4);
      uint2 o;
      o.x = pk2(v[i].x * rinv * g4.x, v[i].y * rinv * g4.y);
      o.y = pk2(v[i].z * rinv * g4.z, v[i].w * rinv * g4.w);
      *(uint2*)(H + (size_t)t * 1024 + i * 256 + lane * 4) = o;
    }
  }
}

DI void gemm_mainloop(const u16* __restrict__ R, int ldr, const u16* __restrict__ C, int ldc, int K, char* smem, f32x16 (&acc)[2][2]) {
  const int tid = tidx(), lane = tid & 63, w = tid >> 6, wr = w >> 1, wc = w & 1;
  const int l31 = lane & 31, h = lane >> 5;
  const int lrow = tid >> 3, lkc = (tid & 7) * 8;
  u32x4 rr[4], rc[4];
  const int nk = K >> 6;
#pragma unroll
  for (int i = 0; i < 4; ++i) {
    rr[i] = *(const u32x4*)(R + (size_t)(lrow + 32 * i) * ldr + lkc);
    rc[i] = *(const u32x4*)(C + (size_t)(lrow + 32 * i) * ldc + lkc);
  }
  __syncthreads();
  {
    u16* sR = (u16*)smem;
    u16* sC = sR + 128 * 72;
#pragma unroll
    for (int i = 0; i < 4; ++i) {
      *(u32x4*)(sR + (lrow + 32 * i) * 72 + lkc) = rr[i];
      *(u32x4*)(sC + (lrow + 32 * i) * 72 + lkc) = rc[i];
    }
  }
  if (nk > 1) {
#pragma unroll
    for (int i = 0; i < 4; ++i) {
      rr[i] = *(const u32x4*)(R + (size_t)(lrow + 32 * i) * ldr + 64 + lkc);
      rc[i] = *(const u32x4*)(C + (size_t)(lrow + 32 * i) * ldc + 64 + lkc);
    }
  }
  __syncthreads();
  for (int kt = 0; kt < nk; ++kt) {
    const u16* sR = (const u16*)smem + (kt & 1) * (2 * 128 * 72);
    const u16* sC = sR + 128 * 72;
    if (kt + 1 < nk) {
      u16* nR = (u16*)smem + ((kt + 1) & 1) * (2 * 128 * 72);
      u16* nC = nR + 128 * 72;
#pragma unroll
      for (int i = 0; i < 4; ++i) {
        *(u32x4*)(nR + (lrow + 32 * i) * 72 + lkc) = rr[i];
        *(u32x4*)(nC + (lrow + 32 * i) * 72 + lkc) = rc[i];
      }
    }
    if (kt + 2 < nk) {
      const int k0 = (kt + 2) * 64;
#pragma unroll
      for (int i = 0; i < 4; ++i) {
        rr[i] = *(const u32x4*)(R + (size_t)(lrow + 32 * i) * ldr + k0 + lkc);
        rc[i] = *(const u32x4*)(C + (size_t)(lrow + 32 * i) * ldc + k0 + lkc);
      }
    }
#pragma unroll
    for (int ks = 0; ks < 4; ++ks) {
      bf16x8 a[2], b[2];
#pragma unroll
      for (int mi = 0; mi < 2; ++mi) a[mi] = *(const bf16x8*)(sR + (wr * 64 + mi * 32 + l31) * 72 + ks * 16 + h * 8);
#pragma unroll
      for (int ni = 0; ni < 2; ++ni) b[ni] = *(const bf16x8*)(sC + (wc * 64 + ni * 32 + l31) * 72 + ks * 16 + h * 8);
#pragma unroll
      for (int mi = 0; mi < 2; ++mi)
#pragma unroll
        for (int ni = 0; ni < 2; ++ni) acc[mi][ni] = MFMA32(a[mi], b[ni], acc[mi][ni]);
    }
    __syncthreads();
  }
}
DI void zero_acc(f32x16 (&acc)[2][2]) {
#pragma unroll
  for (int mi = 0; mi < 2; ++mi)
#pragma unroll
    for (int ni = 0; ni < 2; ++ni)
#pragma unroll
      for (int r = 0; r < 16; ++r) acc[mi][ni][r] = 0.f;
}
DI void acc_to_lds(const f32x16 (&acc)[2][2], char* smem) {
  float* sT = (float*)smem;
  const int lane = tidx() & 63, w = tidx() >> 6;
  const int l31 = lane & 31, h = lane >> 5, wr = w >> 1, wc = w & 1;
  __syncthreads();
#pragma unroll
  for (int mi = 0; mi < 2; ++mi)
#pragma unroll
    for (int ni = 0; ni < 2; ++ni)
#pragma unroll
      for (int reg = 0; reg < 16; ++reg) sT[(wr * 64 + mi * 32 + crow(reg, h)) * 132 + wc * 64 + ni * 32 + l31] = acc[mi][ni][reg];
  __syncthreads();
}
#define EPI_ROWS(...)                                                          \
  {                                                                            \
    const float* sT_ = (const float*)smem;                                     \
    _Pragma("unroll 2") for (int it_ = 0; it_ < 16; ++it_) {                   \
      const int row = it_ * 8 + (tidx() >> 5), col = (tidx() & 31) * 4; \
      const f32x4 v = *(const f32x4*)(sT_ + row * 132 + col);                  \
      __VA_ARGS__                                                              \
    }                                                                          \
  }

DI void gemm64_mainloop(const u16* __restrict__ R, int ldr, const u16* __restrict__ C, int ldc, int K, char* smem, f32x16& acc) {
  const int tid = tidx(), lane = tid & 63, w = tid >> 6, wr = w >> 1, wc = w & 1;
  const int l31 = lane & 31, h = lane >> 5;
  const int lrow = tid >> 3, lkc = (tid & 7) * 8;
  u32x4 rr[2][2], rc[2][2];
  const int nk = K >> 6;
#define G64_GLOAD(SET, KT)                                                                    \
  {                                                                                           \
    const int k0_ = (KT) * 64;                                                                \
    _Pragma("unroll") for (int i = 0; i < 2; ++i) {                                           \
      rr[SET][i] = *(const u32x4*)(R + (size_t)(lrow + 32 * i) * ldr + k0_ + lkc);            \
      rc[SET][i] = *(const u32x4*)(C + (size_t)(lrow + 32 * i) * ldc + k0_ + lkc);            \
    }                                                                                         \
  }
#define G64_LSTORE(SET, BUF)                                                                  \
  {                                                                                           \
    u16* nR_ = (u16*)smem + (BUF) * (2 * 64 * 72);                                            \
    u16* nC_ = nR_ + 64 * 72;                                                                 \
    _Pragma("unroll") for (int i = 0; i < 2; ++i) {                                           \
      *(u32x4*)(nR_ + (lrow + 32 * i) * 72 + lkc) = rr[SET][i];                               \
      *(u32x4*)(nC_ + (lrow + 32 * i) * 72 + lkc) = rc[SET][i];                               \
    }                                                                                         \
  }
  G64_GLOAD(0, 0)
  G64_GLOAD(1, 1)
  __syncthreads();
  G64_LSTORE(0, 0)
  G64_GLOAD(0, 2)
  __syncthreads();
  for (int kt0 = 0; kt0 < nk; kt0 += 2) {
#pragma unroll
    for (int u = 0; u < 2; ++u) {
      const int kt = kt0 + u;
      const u16* sR = (const u16*)smem + u * (2 * 64 * 72);
      const u16* sC = sR + 64 * 72;
      if (kt + 1 < nk) G64_LSTORE(1 - u, 1 - u)
      if (kt + 3 < nk) G64_GLOAD(1 - u, kt + 3)
#pragma unroll
      for (int ks = 0; ks < 4; ++ks) {
        const bf16x8 a = *(const bf16x8*)(sR + (wr * 32 + l31) * 72 + ks * 16 + h * 8);
        const bf16x8 b = *(const bf16x8*)(sC + (wc * 32 + l31) * 72 + ks * 16 + h * 8);
        acc = MFMA32(a, b, acc);
      }
      __syncthreads();
    }
  }
#undef G64_GLOAD
#undef G64_LSTORE
}
DI void acc64_to_lds(const f32x16& acc, char* smem) {
  float* sT = (float*)smem;
  const int lane = tidx() & 63, w = tidx() >> 6;
  const int l31 = lane & 31, h = lane >> 5, wr = w >> 1, wc = w & 1;
  __syncthreads();
#pragma unroll
  for (int reg = 0; reg < 16; ++reg) sT[(wr * 32 + crow(reg, h)) * 68 + wc * 32 + l31] = acc[reg];
  __syncthreads();
}
#define EPI64_ROWS(...)                                                        \
  {                                                                            \
    const float* sT_ = (const float*)smem;                                     \
    _Pragma("unroll") for (int it_ = 0; it_ < 4; ++it_) {                      \
      const int row = it_ * 16 + (tidx() >> 4), col = (tidx() & 15) * 4;       \
      const f32x4 v = *(const f32x4*)(sT_ + row * 68 + col);                   \
      __VA_ARGS__                                                              \
    }                                                                          \
  }

DI void phase_g1(const Params& p, int layer, char* smem) {
  const u16* H = (const u16*)(p.ws + WS_H);
  const u16* W = (const u16*)(p.ws + (size_t)layer * WL_STRIDE + W_IN);
  u16* Z = (u16*)(p.ws + WS_Z);
  const int xcd = blockIdx.x & 7, jb = blockIdx.x >> 3, nb = (gridDim.x + 7 - xcd) >> 3;
  for (int m = jb; m < 17 * 41; m += nb) {
    const int ft = m / 17, tt = xcd + 8 * (m % 17);
    f32x16 acc[2][2];
    zero_acc(acc);
    gemm_mainloop(H + (size_t)tt * 128 * 1024, 1024, W + (size_t)ft * 128 * 1024, 1024, 1024, smem, acc);
    acc_to_lds(acc, smem);
    EPI_ROWS({ *(u32x2*)(Z + (size_t)(tt * 128 + row) * NZ + ft * 128 + col) = u32x2{pk2(v.x, v.y), pk2(v.z, v.w)}; })
  }
}

DI void norms_token(const Params& p, int layer, int t, int lane) {
  const u16* zr = (const u16*)(p.ws + WS_Z) + (size_t)t * NZ;
  u16* CQN = (u16*)(p.ws + WS_H);
  u16* CKVB = (u16*)(p.ws + WS_CKVB);
  u16* KPEB = (u16*)(p.ws + WS_KPEB);
  {
    const uint2 raw = *(const uint2*)(zr + lane * 4);
    const float c0 = lo2f(raw.x), c1 = hi2f(raw.x), c2 = lo2f(raw.y), c3 = hi2f(raw.y);
    float ss = wave_sum(c0 * c0 + c1 * c1 + c2 * c2 + c3 * c3);
    const float rinv = rsqrtf(ss * (1.f / 256.f) + EPS);
    const float4 g = *(const float4*)(p.q_norm_w + layer * 256 + lane * 4);
    uint2 o;
    o.x = pk2(c0 * rinv * g.x, c1 * rinv * g.y);
    o.y = pk2(c2 * rinv * g.z, c3 * rinv * g.w);
    *(uint2*)(CQN + (size_t)t * 256 + lane * 4) = o;
  }
  {
    const unsigned raw = *(const unsigned*)(zr + ZC_KV + lane * 2);
    const float c0 = lo2f(raw), c1 = hi2f(raw);
    float ss = wave_sum(c0 * c0 + c1 * c1);
    const float rinv = rsqrtf(ss * (1.f / 128.f) + EPS);
    const float2 g = *(const float2*)(p.kv_norm_w + layer * 128 + lane * 2);
    const float o0 = c0 * rinv * g.x, o1 = c1 * rinv * g.y;
    float* dst = (t < NP) ? p.out + OFF_CKV_P + ((size_t)layer * NP + t) * 128 : p.out + OFF_CKV_S + ((size_t)layer * NSM + (t - NP)) * 128;
    *(float2*)(dst + lane * 2) = make_float2(o0, o1);
    *(unsigned*)(CKVB + (size_t)t * 128 + lane * 2) = pk2(o0, o1);
  }
  {
    float v = (lane < 32) ? bf2f(zr[ZC_KPE + lane]) : 0.f;
    float ss = wave_sum(v * v);
    const float rinv = rsqrtf(ss * (1.f / 32.f) + EPS);
    v = v * rinv * p.kn_rope[layer * 32 + (lane & 31)];
    const float pr = __shfl_xor(v, 16);
    float s, c;
    rope_sincos(tok_pos(t), lane & 15, s, c);
    const float o = ((lane & 16) == 0) ? (v * c - pr * s) : (v * c + pr * s);
    if (lane < 32) {
      float* dst = (t < NP) ? p.out + OFF_KPE_P + ((size_t)layer * NP + t) * 32 : p.out + OFF_KPE_S + ((size_t)layer * NSM + (t - NP)) * 32;
      dst[lane] = o;
      KPEB[(size_t)t * 32 + lane] = f2bf(o);
    }
  }
  float* sh = nullptr;
  if (t == NP - 1) sh = p.out + OFF_SH_P + (size_t)layer * SHW;
  else if (t >= NP && ((t - NP) & 63) == 63) sh = p.out + OFF_SH_S + ((size_t)layer * 16 + ((t - NP) >> 6)) * SHW;
  if (sh) {
#pragma unroll 1
    for (int c = lane; c < SHW; c += 64) sh[c] = bf2f(zr[ZC_ZS + c]);
  }
}

DI void zm4(const Params& p, int layer, int t, int c, float (&o)[4]) {
  const u16* zr = (const u16*)(p.ws + WS_Z) + (size_t)t * NZ + ZC_ZS + c;
  const u32x2 a = *(const u32x2*)zr;
  const bool first = (t < NP) ? (t == 0) : (((t - NP) & 63) == 0);
  const int srow = (t < NP) ? 0 : 1 + ((t - NP) >> 6);
  const u16* pr = first ? (const u16*)(p.ws + WS_SH0) + srow * SHW + c : zr - NZ;
  const u32x2 b = *(const u32x2*)pr;
  const f32x4 mu = *(const f32x4*)(p.mu_shift + layer * SHW + c);
  const float c0 = lo2f(a.x), c1 = hi2f(a.x), c2 = lo2f(a.y), c3 = hi2f(a.y);
  o[0] = c0 + (lo2f(b.x) - c0) * mu.x;
  o[1] = c1 + (hi2f(b.x) - c1) * mu.y;
  o[2] = c2 + (lo2f(b.y) - c2) * mu.z;
  o[3] = c3 + (hi2f(b.y) - c3) * mu.w;
}
DI float tanhf_(float x) {
  const float t = __expf(-2.f * fabsf(x));
  const float r = (1.f - t) * __builtin_amdgcn_rcpf(1.f + t);
  return x < 0.f ? -r : r;
}

constexpr int WPS = 900;
DI void zml(const u16* sz, int row, int col, const float* mu, float (&o)[4]) {
  const u32x2 a = *(const u32x2*)(sz + (row + 1) * WPS + col);
  const u32x2 b = *(const u32x2*)(sz + row * WPS + col);
  const f32x4 m4 = *(const f32x4*)mu;
  const float c0 = lo2f(a.x), c1 = hi2f(a.x), c2 = lo2f(a.y), c3 = hi2f(a.y);
  o[0] = c0 + (lo2f(b.x) - c0) * m4.x;
  o[1] = c1 + (hi2f(b.x) - c1) * m4.y;
  o[2] = c2 + (lo2f(b.y) - c2) * m4.z;
  o[3] = c3 + (hi2f(b.y) - c3) * m4.w;
}
DI void wkvprep_block(const Params& p, int layer, int tt, int hg, char* smem) {
  u16* sz = (u16*)smem;
  const int tid = tidx(), lane = tid & 63, w = tid >> 6, l31 = lane & 31, h = lane >> 5;
  const int t0 = tt * 32;
  const int hd = hg * 4 + w;
  const u16* Z = (const u16*)(p.ws + WS_Z);
  const bool seq_start = (t0 < NP) ? (t0 == 0) : (((t0 - NP) & 63) == 0);
  const u16* prevrow = seq_start ? (const u16*)(p.ws + WS_SH0) + ((t0 < NP) ? 0 : 1 + ((t0 - NP) >> 6)) * SHW : Z + (size_t)(t0 - 1) * NZ + ZC_ZS;
  __syncthreads();
  for (int ci = tid; ci < 33 * 112; ci += 256) {
    const int row = ci / 112, cc = ci - row * 112;
    int scol, lcol;
    if (cc < 16) { scol = 1536 + cc * 8; lcol = cc * 8; }
    else {
      const int j = cc - 16, ww = j / 24, r2 = j - ww * 24, part = r2 >> 3, o = (r2 & 7) * 8;
      scol = part * 512 + (hg * 4 + ww) * 64 + o;
      lcol = 128 + ww * 192 + part * 64 + o;
    }
    const u16* src = (row == 0) ? prevrow + scol : Z + (size_t)(t0 + row - 1) * NZ + ZC_ZS + scol;
    const u32x4 v = *(const u32x4*)src;
    u32x2* d = (u32x2*)(sz + row * WPS + lcol);
    d[0] = u32x2{v.x, v.y};
    d[1] = u32x2{v.z, v.w};
  }
  __syncthreads();
  const int tok = t0 + l31;
  const u16* W2T = (const u16*)(p.ws + (size_t)layer * WL_STRIDE + W_W2);
  const u16* A2T = (const u16*)(p.ws + (size_t)layer * WL_STRIDE + W_A2);
  const float* mu = p.mu_shift + layer * SHW;
  u16* WK = (u16*)(p.ws + WS_WKVIN) + ((size_t)hd * NT + tok) * 384;
  f32x16 accW[2], accA[2];
#pragma unroll
  for (int m = 0; m < 2; ++m)
#pragma unroll
    for (int r = 0; r < 16; ++r) { accW[m][r] = 0.f; accA[m][r] = 0.f; }
#pragma unroll
  for (int ks = 0; ks < 4; ++ks) {
    const int c0 = ks * 16 + 8 * h;
    float t0a[4], t1a[4], u0[4], u1[4];
    zml(sz, l31, c0, mu + 1536 + c0, t0a);
    zml(sz, l31, c0 + 4, mu + 1536 + c0 + 4, t1a);
    zml(sz, l31, 64 + c0, mu + 1600 + c0, u0);
    zml(sz, l31, 64 + c0 + 4, mu + 1600 + c0 + 4, u1);
    u32x4 bw, ba;
    bw.x = pk2(tanhf_(t0a[0]), tanhf_(t0a[1])); bw.y = pk2(tanhf_(t0a[2]), tanhf_(t0a[3]));
    bw.z = pk2(tanhf_(t1a[0]), tanhf_(t1a[1])); bw.w = pk2(tanhf_(t1a[2]), tanhf_(t1a[3]));
    ba.x = pk2(u0[0], u0[1]); ba.y = pk2(u0[2], u0[3]); ba.z = pk2(u1[0], u1[1]); ba.w = pk2(u1[2], u1[3]);
    const bf16x8 bwf = __builtin_bit_cast(bf16x8, bw), baf = __builtin_bit_cast(bf16x8, ba);
#pragma unroll
    for (int m = 0; m < 2; ++m) {
      const bf16x8 aw = *(const bf16x8*)(W2T + (size_t)(hd * 64 + m * 32 + l31) * 64 + ks * 16 + h * 8);
      const bf16x8 aa = *(const bf16x8*)(A2T + (size_t)(hd * 64 + m * 32 + l31) * 64 + ks * 16 + h * 8);
      accW[m] = MFMA32(aw, bwf, accW[m]);
      accA[m] = MFMA32(aa, baf, accA[m]);
    }
  }
  const int hb = 128 + w * 192;
  float ss = 0.f;
#pragma unroll
  for (int m = 0; m < 2; ++m)
#pragma unroll
    for (int q = 0; q < 4; ++q) {
      const int f0 = m * 32 + 8 * q + 4 * h, F = hd * 64 + f0;
      float k4[4];
      zml(sz, l31, hb + 64 + f0, mu + 512 + F, k4);
      const float4 kk_ = *(const float4*)(p.k_k + layer * 512 + F);
      const float a = k4[0] * kk_.x, b = k4[1] * kk_.y, c = k4[2] * kk_.z, d = k4[3] * kk_.w;
      ss += a * a + b * b + c * c + d * d;
    }
  ss += xor32(ss);
  const float rn = 1.f / fmaxf(sqrtf(ss), 1e-12f);
#pragma unroll
  for (int m = 0; m < 2; ++m)
#pragma unroll
    for (int q = 0; q < 4; ++q) {
      const int f0 = m * 32 + 8 * q + 4 * h, F = hd * 64 + f0;
      float r4[4], k4[4], v4[4];
      zml(sz, l31, hb + f0, mu + F, r4);
      zml(sz, l31, hb + 64 + f0, mu + 512 + F, k4);
      zml(sz, l31, hb + 128 + f0, mu + 1024 + F, v4);
      const float4 w0 = *(const float4*)(p.w0 + layer * 512 + F);
      const float4 a0 = *(const float4*)(p.a0 + layer * 512 + F);
      const float4 kk_ = *(const float4*)(p.k_k + layer * 512 + F);
      const float4 ka_ = *(const float4*)(p.k_a + layer * 512 + F);
      const float w0a[4] = {w0.x, w0.y, w0.z, w0.w}, a0a[4] = {a0.x, a0.y, a0.z, a0.w};
      const float kka[4] = {kk_.x, kk_.y, kk_.z, kk_.w}, kaa[4] = {ka_.x, ka_.y, ka_.z, ka_.w};
      float e4[4], kp4[4], kn4[4], b4[4];
#pragma unroll
      for (int j = 0; j < 4; ++j) {
        const float lw = w0a[j] + accW[m][4 * q + j];
        const float nx = -lw;
        const float sp = fmaxf(nx, 0.f) + __logf(1.f + __expf(-fabsf(nx)));
        e4[j] = __expf(-sp - 0.5f);
        const float a = sigmoidf_(a0a[j] + accA[m][4 * q + j]);
        kn4[j] = k4[j] * kka[j] * rn;
        b4[j] = kn4[j] * a;
        kp4[j] = k4[j] * (1.f + (a - 1.f) * kaa[j]);
      }
      *(u32x2*)(WK + 0 * 64 + f0) = u32x2{pk2(r4[0], r4[1]), pk2(r4[2], r4[3])};
      *(u32x2*)(WK + 1 * 64 + f0) = u32x2{pk2(e4[0], e4[1]), pk2(e4[2], e4[3])};
      *(u32x2*)(WK + 2 * 64 + f0) = u32x2{pk2(kp4[0], kp4[1]), pk2(kp4[2], kp4[3])};
      *(u32x2*)(WK + 3 * 64 + f0) = u32x2{pk2(v4[0], v4[1]), pk2(v4[2], v4[3])};
      *(u32x2*)(WK + 4 * 64 + f0) = u32x2{pk2(kn4[0], kn4[1]), pk2(kn4[2], kn4[3])};
      *(u32x2*)(WK + 5 * 64 + f0) = u32x2{pk2(b4[0], b4[1]), pk2(b4[2], b4[3])};
    }
}

DI void qproj_item(const Params& p, int layer, int tt, int hd, int lane);
DI void kvproj_item(const Params& p, int layer, int tt, int hd, int lane);
DI void phase_norms_prep(const Params& p, int layer, char* smem, int* s_item) {
  int* ctr = (int*)(p.ws + WS_CTR) + 4 + layer;
  const int wave = tidx() >> 6, lane = tidx() & 63;
  for (;;) {
    __syncthreads();
    if (tidx() == 0) *s_item = atomicAdd(ctr, 1);
    __syncthreads();
    const int it = *s_item;
    if (it >= 1088 + 2112 + 272) break;
    if (it < 1088) { wkvprep_block(p, layer, it >> 1, it & 1, smem); continue; }
    if (it < 1088 + 2112) {
      const int wi = (it - 1088) * 4 + wave;
      if (wi < 544 * 8) qproj_item(p, layer, wi >> 3, wi & 7, lane);
      else { const int j = wi - 544 * 8; kvproj_item(p, layer, j >> 3, j & 7, lane); }
      continue;
    }
    const int tb = (it - 1088 - 2112) * 64 + wave * 16;
    for (int j = 0; j < 16; ++j) norms_token(p, layer, tb + j, lane);
  }
}

DI bf16x8 normed_frag(const u16* zsrc, const float* g, float& ssq) {
  const u32x4 raw = *(const u32x4*)zsrc;
  const f32x4 g0 = *(const f32x4*)g, g1 = *(const f32x4*)(g + 4);
  const float f0 = lo2f(raw.x), f1 = hi2f(raw.x), f2 = lo2f(raw.y), f3 = hi2f(raw.y);
  const float f4 = lo2f(raw.z), f5 = hi2f(raw.z), f6 = lo2f(raw.w), f7 = hi2f(raw.w);
  ssq += (f0 * f0 + f1 * f1) + (f2 * f2 + f3 * f3) + (f4 * f4 + f5 * f5) + (f6 * f6 + f7 * f7);
  const u32x4 o = {pk2(f0 * g0.x, f1 * g0.y), pk2(f2 * g0.z, f3 * g0.w), pk2(f4 * g1.x, f5 * g1.y), pk2(f6 * g1.z, f7 * g1.w)};
  return __builtin_bit_cast(bf16x8, o);
}
DI void qproj_item(const Params& p, int layer, int tt, int hd, int lane) {
  const int l31 = lane & 31, h = lane >> 5;
  const int tok = tt * 32 + l31;
  const u16* zq = (const u16*)(p.ws + WS_Z) + (size_t)tok * NZ;
  const float* gq = p.q_norm_w + layer * 256;
  float ssq = 0.f;
  const u16* WT = (const u16*)(p.ws + (size_t)layer * WL_STRIDE + W_UQ);
  u16* Q = (u16*)(p.ws + WS_Q);
  f32x16 acc[3];
#pragma unroll
  for (int m = 0; m < 3; ++m)
#pragma unroll
    for (int r = 0; r < 16; ++r) acc[m][r] = 0.f;
#pragma unroll 4
  for (int ks = 0; ks < 16; ++ks) {
    const bf16x8 bfr = normed_frag(zq + ks * 16 + h * 8, gq + ks * 16 + h * 8, ssq);
#pragma unroll
    for (int m = 0; m < 3; ++m) {
      const bf16x8 afr = *(const bf16x8*)(WT + (size_t)(hd * 96 + m * 32 + l31) * 256 + ks * 16 + h * 8);
      acc[m] = MFMA32(afr, bfr, acc[m]);
    }
  }
  {
    ssq += xor32(ssq);
    const float rinv = rsqrtf(ssq * (1.f / 256.f) + EPS);
#pragma unroll
    for (int m = 0; m < 3; ++m)
#pragma unroll
      for (int r = 0; r < 16; ++r) acc[m][r] *= rinv;
  }
  const float qs = 0.10206207261596577f * 1.4426950408889634f;
  float ss = 0.f;
#pragma unroll
  for (int m = 0; m < 2; ++m)
#pragma unroll
    for (int r = 0; r < 16; ++r) ss += acc[m][r] * acc[m][r];
  ss += xor32(ss);
  const float rn = rsqrtf(ss * (1.f / 64.f) + EPS) * qs;
  u16* qd = Q + (size_t)tok * 768 + hd * 96;
#pragma unroll
  for (int m = 0; m < 2; ++m)
#pragma unroll
    for (int q = 0; q < 4; ++q) {
      const int f0 = m * 32 + 8 * q + 4 * h;
      const float4 g = *(const float4*)(p.qn_nope + layer * 64 + f0);
      *(uint2*)(qd + f0) = make_uint2(pk2(acc[m][4 * q] * rn * g.x, acc[m][4 * q + 1] * rn * g.y), pk2(acc[m][4 * q + 2] * rn * g.z, acc[m][4 * q + 3] * rn * g.w));
    }
  float sr = 0.f;
#pragma unroll
  for (int r = 0; r < 16; ++r) sr += acc[2][r] * acc[2][r];
  sr += xor32(sr);
  const float rr = rsqrtf(sr * (1.f / 32.f) + EPS);
  const int pos = tok_pos(tok);
  float o1[8], o2[8];
#pragma unroll
  for (int r = 0; r < 8; ++r) {
    const int i = crow(r, h);
    const float x1 = acc[2][r] * rr * p.qn_rope[layer * 32 + i];
    const float x2 = acc[2][r + 8] * rr * p.qn_rope[layer * 32 + i + 16];
    float s, c;
    rope_sincos(pos, i, s, c);
    o1[r] = (x1 * c - x2 * s) * qs;
    o2[r] = (x2 * c + x1 * s) * qs;
  }
#pragma unroll
  for (int q = 0; q < 2; ++q) {
    const int i0 = 8 * q + 4 * h;
    *(uint2*)(qd + 64 + i0) = make_uint2(pk2(o1[4 * q], o1[4 * q + 1]), pk2(o1[4 * q + 2], o1[4 * q + 3]));
    *(uint2*)(qd + 64 + 16 + i0) = make_uint2(pk2(o2[4 * q], o2[4 * q + 1]), pk2(o2[4 * q + 2], o2[4 * q + 3]));
  }
}

DI void kvproj_item(const Params& p, int layer, int tt, int hd, int lane) {
  const int l31 = lane & 31, h = lane >> 5;
  const int tok = tt * 32 + l31;
  const u16* zk = (const u16*)(p.ws + WS_Z) + (size_t)tok * NZ + ZC_KV;
  const float* gk = p.kv_norm_w + layer * 128;
  float ssq = 0.f;
  const u16* WT = (const u16*)(p.ws + (size_t)layer * WL_STRIDE + W_UKV);
  u16* KN = (u16*)(p.ws + WS_KN);
  u16* VT = (u16*)(p.ws + WS_VT);
  f32x16 acc[4];
#pragma unroll
  for (int m = 0; m < 4; ++m)
#pragma unroll
    for (int r = 0; r < 16; ++r) acc[m][r] = 0.f;
#pragma unroll 4
  for (int ks = 0; ks < 8; ++ks) {
    const bf16x8 bfr = normed_frag(zk + ks * 16 + h * 8, gk + ks * 16 + h * 8, ssq);
#pragma unroll
    for (int m = 0; m < 4; ++m) {
      const bf16x8 afr = *(const bf16x8*)(WT + (size_t)(hd * 128 + m * 32 + l31) * 128 + ks * 16 + h * 8);
      acc[m] = MFMA32(afr, bfr, acc[m]);
    }
  }
  {
    ssq += xor32(ssq);
    const float rinv = rsqrtf(ssq * (1.f / 128.f) + EPS);
#pragma unroll
    for (int m = 0; m < 4; ++m)
#pragma unroll
      for (int r = 0; r < 16; ++r) acc[m][r] *= rinv;
  }
  float ss = 0.f;
#pragma unroll
  for (int m = 0; m < 2; ++m)
#pragma unroll
    for (int r = 0; r < 16; ++r) ss += acc[m][r] * acc[m][r];
  ss += xor32(ss);
  const float rn = rsqrtf(ss * (1.f / 64.f) + EPS);
  u16* kd = KN + ((size_t)hd * NP + tok) * 64;
#pragma unroll
  for (int m = 0; m < 2; ++m)
#pragma unroll
    for (int q = 0; q < 4; ++q) {
      const int f0 = m * 32 + 8 * q + 4 * h;
      const float4 g = *(const float4*)(p.kn_nope + layer * 64 + f0);
      *(uint2*)(kd + f0) = make_uint2(pk2(acc[m][4 * q] * rn * g.x, acc[m][4 * q + 1] * rn * g.y), pk2(acc[m][4 * q + 2] * rn * g.z, acc[m][4 * q + 3] * rn * g.w));
    }
#pragma unroll
  for (int m = 0; m < 2; ++m)
#pragma unroll
    for (int r = 0; r < 16; ++r) {
      const int d = m * 32 + crow(r, h);
      VT[((size_t)hd * 64 + d) * NP + tok] = f2bf(acc[2 + m][r]);
    }
}

DI void phase_proj(const Params& p, int layer) {
  const int wave = tidx() >> 6, lane = tidx() & 63;
  const int nw = gridDim.x * 4, gw = blockIdx.x * 4 + wave;
  for (int it = gw; it < 544 * 8 + 512 * 8; it += nw) {
    if (it < 544 * 8) qproj_item(p, layer, it >> 3, it & 7, lane);
    else { const int j = it - 544 * 8; kvproj_item(p, layer, j >> 3, j & 7, lane); }
  }
}

DI float wave_max(float v) {
#pragma unroll
  for (int o = 32; o > 0; o >>= 1) v = fmaxf(v, __shfl_xor(v, o));
  return v;
}
DI float attn_bound(const Params& p, int layer, int lane) {
  const float gqn = wave_max(fabsf(p.qn_nope[layer * 64 + lane])), gkn = wave_max(fabsf(p.kn_nope[layer * 64 + lane]));
  const float gqr = wave_max(fabsf(p.qn_rope[layer * 32 + (lane & 31)])), gkr = wave_max(fabsf(p.kn_rope[layer * 32 + (lane & 31)]));
  const float qs = 0.10206207261596577f * 1.4426950408889634f;
  return 1.02f * qs * (64.f * gqn * gkn + 32.f * gqr * gkr) + 0.25f;
}
template <int NSUB>
DI void attn_tile(const bf16x8 (&qf)[6], const u16* sK, const u16* sVT, int ksub0, f32x16 (&o)[2], float& l, float negB, int l31, int h) {
  f32x16 s[NSUB];
  {
    bf16x8 kf[NSUB][6];
#pragma unroll
    for (int i = 0; i < NSUB; ++i)
#pragma unroll
      for (int ks = 0; ks < 6; ++ks) kf[i][ks] = *(const bf16x8*)(sK + ((ksub0 + i) * 32 + l31) * 104 + ks * 16 + h * 8);
#pragma unroll
    for (int i = 0; i < NSUB; ++i) {
#pragma unroll
      for (int r = 0; r < 16; ++r) s[i][r] = negB;
#pragma unroll
      for (int ks = 0; ks < 6; ++ks) s[i] = MFMA32(kf[i][ks], qf[ks], s[i]);
    }
    __builtin_amdgcn_sched_group_barrier(0x100, 6 * NSUB, 0);
    __builtin_amdgcn_sched_group_barrier(0x008, 6 * NSUB, 0);
  }
  bf16x8 vf[NSUB][2][2];
#pragma unroll
  for (int i = 0; i < NSUB; ++i)
#pragma unroll
    for (int st = 0; st < 2; ++st)
#pragma unroll
      for (int md = 0; md < 2; ++md) {
        const u16* vp = sVT + (md * 32 + l31) * 68 + (ksub0 + i) * 32 + 16 * st + 4 * h;
        const s16x4 lo = *(const s16x4*)vp;
        const s16x4 hi = *(const s16x4*)(vp + 8);
        vf[i][st][md] = __builtin_shufflevector(lo, hi, 0, 1, 2, 3, 4, 5, 6, 7);
      }
  float ps = 0.f;
#pragma unroll
  for (int i = 0; i < NSUB; ++i)
#pragma unroll
    for (int r = 0; r < 16; ++r) {
      const float pv = __builtin_amdgcn_exp2f(s[i][r]);
      ps += pv;
      s[i][r] = pv;
    }
  l += ps;
#pragma unroll
  for (int i = 0; i < NSUB; ++i)
#pragma unroll
    for (int st = 0; st < 2; ++st) {
      u32x4 pu;
      pu.x = pk2(s[i][8 * st + 0], s[i][8 * st + 1]);
      pu.y = pk2(s[i][8 * st + 2], s[i][8 * st + 3]);
      pu.z = pk2(s[i][8 * st + 4], s[i][8 * st + 5]);
      pu.w = pk2(s[i][8 * st + 6], s[i][8 * st + 7]);
      const bf16x8 pf = __builtin_bit_cast(bf16x8, pu);
#pragma unroll
      for (int md = 0; md < 2; ++md) o[md] = MFMA32(vf[i][st][md], pf, o[md]);
    }
}

DI void attn_store(const Params& p, int tok, int hd, const f32x16 (&o)[2], float linv, int h) {
  const u16* gz = (const u16*)(p.ws + WS_Z) + (size_t)tok * NZ + ZC_GA + hd * 64;
  u16* OA = (u16*)(p.ws + WS_OA) + (size_t)tok * 512 + hd * 64;
#pragma unroll
  for (int md = 0; md < 2; ++md)
#pragma unroll
    for (int q = 0; q < 4; ++q) {
      const int d0 = md * 32 + 8 * q + 4 * h;
      const uint2 g = *(const uint2*)(gz + d0);
      const float v0 = o[md][4 * q] * linv * siluf_(lo2f(g.x));
      const float v1 = o[md][4 * q + 1] * linv * siluf_(hi2f(g.x));
      const float v2 = o[md][4 * q + 2] * linv * siluf_(lo2f(g.y));
      const float v3 = o[md][4 * q + 3] * linv * siluf_(hi2f(g.y));
      *(uint2*)(OA + d0) = make_uint2(pk2(v0, v1), pk2(v2, v3));
    }
}

DI void attn_prompt_item(const Params& p, int layer, int qt, int hd, char* smem) {
  u16* sK = (u16*)smem;
  u16* sVT = (u16*)(smem + 13312);
  const int tid = tidx(), lane = tid & 63, w = tid >> 6, l31 = lane & 31, h = lane >> 5;
  const int tok = qt * 128 + w * 32 + l31;
  const u16* Q = (const u16*)(p.ws + WS_Q);
  const u16* KN = (const u16*)(p.ws + WS_KN) + (size_t)hd * NP * 64;
  const u16* KPEB = (const u16*)(p.ws + WS_KPEB);
  const u16* VT = (const u16*)(p.ws + WS_VT) + (size_t)hd * 64 * NP;
  bf16x8 qf[6];
#pragma unroll
  for (int ks = 0; ks < 6; ++ks) qf[ks] = *(const bf16x8*)(Q + (size_t)tok * 768 + hd * 96 + ks * 16 + h * 8);
  f32x16 o[2];
#pragma unroll
  for (int d = 0; d < 2; ++d)
#pragma unroll
    for (int r = 0; r < 16; ++r) o[d][r] = 0.f;
  float l = 0.f;
  const float negB = -attn_bound(p, layer, lane);
  const int nkt = 2 * qt + 2;
  const int my_nkt = (w < 2) ? nkt - 1 : nkt;
  u32x4 pk[2][2], pr[2], pv[2][2];
#define PA_GLOAD(SET, KT)                                                                        \
  {                                                                                              \
    const int key0_ = (KT) * 64;                                                                 \
    _Pragma("unroll") for (int i = 0; i < 2; ++i) {                                              \
      const int c = tid + 256 * i;                                                               \
      pk[SET][i] = *(const u32x4*)(KN + (size_t)(key0_ + (c >> 3)) * 64 + (c & 7) * 8);          \
      pv[SET][i] = *(const u32x4*)(VT + (size_t)(c >> 3) * NP + key0_ + (c & 7) * 8);            \
    }                                                                                            \
    pr[SET] = *(const u32x4*)(KPEB + (size_t)(key0_ + (tid >> 2)) * 32 + (tid & 3) * 8);         \
  }
  PA_GLOAD(0, 0)
  PA_GLOAD(1, 1)
  for (int kt0 = 0; kt0 < nkt; kt0 += 2) {
#pragma unroll
    for (int u = 0; u < 2; ++u) {
      const int kt = kt0 + u;
      __syncthreads();
#pragma unroll
      for (int i = 0; i < 2; ++i) {
        const int c = tid + 256 * i;
        *(u32x4*)(sK + (c >> 3) * 104 + (c & 7) * 8) = pk[u][i];
        u32x2* vd = (u32x2*)(sVT + (c >> 3) * 68 + (c & 7) * 8);
        vd[0] = u32x2{pv[u][i].x, pv[u][i].y};
        vd[1] = u32x2{pv[u][i].z, pv[u][i].w};
      }
      *(u32x4*)(sK + (tid >> 2) * 104 + 64 + (tid & 3) * 8) = pr[u];
      __syncthreads();
      if (kt + 2 < nkt) PA_GLOAD(u, kt + 2)
      if (kt < my_nkt) attn_tile<2>(qf, sK, sVT, 0, o, l, negB, l31, h);
    }
  }
#undef PA_GLOAD
  l += xor32(l);
  attn_store(p, tok, hd, o, 1.f / l, h);
}

DI void attn_sample_item(const Params& p, int layer, int b, int hd, char* smem) {
  u16* sC = (u16*)smem;
  u16* sK = (u16*)(smem + 17408);
  u16* sVT = (u16*)(smem + 17408 + 13312);
  u16* sW = (u16*)(smem + 39424);
  const int tid = tidx(), lane = tid & 63, w = tid >> 6, l31 = lane & 31, h = lane >> 5;
  const int khu = w & 1, part = w >> 1;
  const int qh = w >> 1, kh = w & 1;
  const int tok = NP + b * 64 + qh * 32 + l31;
  const u16* Q = (const u16*)(p.ws + WS_Q);
  const u16* WT = (const u16*)(p.ws + (size_t)layer * WL_STRIDE + W_UKV) + (size_t)hd * 128 * 128;
  __syncthreads();
#pragma unroll
  for (int i = 0; i < 8; ++i) {
    const int c = tid + 256 * i;
    *(u32x4*)(sW + (c >> 4) * 136 + (c & 15) * 8) = *(const u32x4*)(WT + (size_t)c * 8);
  }
  bf16x8 qf[6];
#pragma unroll
  for (int ks = 0; ks < 6; ++ks) qf[ks] = *(const bf16x8*)(Q + (size_t)tok * 768 + hd * 96 + ks * 16 + h * 8);
  f32x16 o[2];
#pragma unroll
  for (int d = 0; d < 2; ++d)
#pragma unroll
    for (int r = 0; r < 16; ++r) o[d][r] = 0.f;
  float l = 0.f;
  const float negB = -attn_bound(p, layer, lane);
  const u16* cck = (const u16*)(p.ws + WS_CKB) + (size_t)b * 4096 * 128;
  const u16* ckp = (const u16*)(p.ws + WS_KPB) + (size_t)b * 4096 * 32;
  const u16* nck = (const u16*)(p.ws + WS_CKVB) + (size_t)(NP + b * 64) * 128;
  const u16* nkp = (const u16*)(p.ws + WS_KPEB) + (size_t)(NP + b * 64) * 32;
  u32x4 pc[4], pp;
#define SA_GLOAD(KT)                                                                      \
  {                                                                                       \
    const u16* s1_ = ((KT) < 64) ? cck + (size_t)(KT) * 64 * 128 : nck;                   \
    const u16* s2_ = ((KT) < 64) ? ckp + (size_t)(KT) * 64 * 32 : nkp;                    \
    _Pragma("unroll") for (int i = 0; i < 4; ++i) pc[i] = *(const u32x4*)(s1_ + (size_t)(tid + 256 * i) * 8); \
    pp = *(const u32x4*)(s2_ + (size_t)tid * 8);                                          \
  }
  SA_GLOAD(0)
  for (int kt = 0; kt < 65; ++kt) {
    __syncthreads();
#pragma unroll
    for (int i = 0; i < 4; ++i) {
      const int c = tid + 256 * i;
      *(u32x4*)(sC + (c >> 4) * 136 + (c & 15) * 8) = pc[i];
    }
    *(u32x4*)(sK + (tid >> 2) * 104 + 64 + (tid & 3) * 8) = pp;
    __syncthreads();
    if (kt + 1 < 65) SA_GLOAD(kt + 1)
    {
      f32x16 acc[2];
#pragma unroll
      for (int mt = 0; mt < 2; ++mt)
#pragma unroll
        for (int r = 0; r < 16; ++r) acc[mt][r] = 0.f;
      bf16x8 cfa[8];
#pragma unroll
      for (int ks = 0; ks < 8; ++ks) cfa[ks] = *(const bf16x8*)(sC + (khu * 32 + l31) * 136 + ks * 16 + h * 8);
#pragma unroll
      for (int mt = 0; mt < 2; ++mt) {
        bf16x8 wfa[8];
#pragma unroll
        for (int ks = 0; ks < 8; ++ks) wfa[ks] = *(const bf16x8*)(sW + (part * 64 + mt * 32 + l31) * 136 + ks * 16 + h * 8);
#pragma unroll
        for (int ks = 0; ks < 8; ++ks) {
          if (part == 0) acc[mt] = MFMA32(wfa[ks], cfa[ks], acc[mt]);
          else acc[mt] = MFMA32(cfa[ks], wfa[ks], acc[mt]);
        }
      }
      if (part == 0) {
        float ss = 0.f;
#pragma unroll
        for (int mt = 0; mt < 2; ++mt)
#pragma unroll
          for (int r = 0; r < 16; ++r) ss += acc[mt][r] * acc[mt][r];
        ss += xor32(ss);
        const float rn = rsqrtf(ss * (1.f / 64.f) + EPS);
#pragma unroll
        for (int mt = 0; mt < 2; ++mt)
#pragma unroll
          for (int q = 0; q < 4; ++q) {
            const int f0 = mt * 32 + 8 * q + 4 * h;
            const float4 g = *(const float4*)(p.kn_nope + layer * 64 + f0);
            *(u32x2*)(sK + (khu * 32 + l31) * 104 + f0) = u32x2{pk2(acc[mt][4 * q] * rn * g.x, acc[mt][4 * q + 1] * rn * g.y), pk2(acc[mt][4 * q + 2] * rn * g.z, acc[mt][4 * q + 3] * rn * g.w)};
          }
      } else {
#pragma unroll
        for (int mt = 0; mt < 2; ++mt)
#pragma unroll
          for (int q = 0; q < 4; ++q)
            *(u32x2*)(sVT + (mt * 32 + l31) * 68 + khu * 32 + 8 * q + 4 * h) =
                u32x2{pk2(acc[mt][4 * q], acc[mt][4 * q + 1]), pk2(acc[mt][4 * q + 2], acc[mt][4 * q + 3])};
      }
    }
    __syncthreads();
    attn_tile<1>(qf, sK, sVT, kh, o, l, negB, l31, h);
  }
#undef SA_GLOAD
  __syncthreads();
  float* cb = (float*)smem;
  if (kh == 1) {
    float* d = cb + (qh * 64 + lane) * 34;
#pragma unroll
    for (int r = 0; r < 16; ++r) { d[r] = o[0][r]; d[16 + r] = o[1][r]; }
    d[32] = l;
  }
  __syncthreads();
  if (kh == 0) {
    const float* d = cb + (qh * 64 + lane) * 34;
#pragma unroll
    for (int r = 0; r < 16; ++r) { o[0][r] += d[r]; o[1][r] += d[16 + r]; }
    l += d[32];
    l += xor32(l);
    attn_store(p, tok, hd, o, 1.f / l, h);
  }
}

template <int N> DI void fmac_bc(float& acc, float srcvec, float other) {
  asm("v_fmac_f32_dpp %0, %1, %2 row_newbcast:%3 row_mask:0xf bank_mask:0xf" : "+v"(acc) : "v"(srcvec), "v"(other), "n"(N));
}
template <int N> DI float mul_bc(float srcvec, float other) {
  float r;
  asm("v_mul_f32_dpp %0, %1, %2 row_newbcast:%3 row_mask:0xf bank_mask:0xf" : "=v"(r) : "v"(srcvec), "v"(other), "n"(N));
  return r;
}
struct RplRaw { u32x2 r, e, k, a, b; unsigned v; };
template <int MODE> DI void rpl_load(RplRaw& q, const u16* s, int n, int lane) {
  q.e = *(const u32x2*)(s + 64 + 4 * n);
  q.a = *(const u32x2*)(s + 256 + 4 * n);
  q.b = *(const u32x2*)(s + 320 + 4 * n);
  if (MODE >= 1) { q.k = *(const u32x2*)(s + 128 + 4 * n); q.v = s[192 + lane]; }
  if (MODE == 2) q.r = *(const u32x2*)(s + 4 * n);
}
template <int MODE>
DI void rpl_item(const Params& p, int hd, int tok0, int nsteps, const float* Sinit, float* Sout, float* Yg, int lane) {
  const int n = lane & 15;
  float S[64];
  if (MODE == 0) {
#pragma unroll
    for (int k = 0; k < 64; ++k) S[k] = (k == lane) ? 1.f : 0.f;
  } else if (MODE == 1) {
#pragma unroll
    for (int k = 0; k < 64; ++k) S[k] = 0.f;
  } else {
#pragma unroll
    for (int k = 0; k < 64; k += 4) {
      const f32x4 t = *(const f32x4*)(Sinit + (size_t)lane * 64 + k);
      S[k] = t.x; S[k + 1] = t.y; S[k + 2] = t.z; S[k + 3] = t.w;
    }
  }
  const u16* src = (const u16*)(p.ws + WS_WKVIN) + ((size_t)hd * NT + tok0) * 384;
  float C0 = 1.f, C1 = 1.f, C2 = 1.f, C3 = 1.f;
  RplRaw c0, c1, c2;
  rpl_load<MODE>(c0, src, n, lane);
  rpl_load<MODE>(c1, src + 384, n, lane);
  for (int t = 0; t < nsteps; ++t) {
    if (t + 2 < nsteps) rpl_load<MODE>(c2, src + (size_t)(t + 2) * 384, n, lane);
    float A0 = -lo2f(c0.a.x), A1 = -hi2f(c0.a.x), A2 = -lo2f(c0.a.y), A3 = -hi2f(c0.a.y);
    float W0 = __expf(-lo2f(c0.e.x)), W1 = __expf(-hi2f(c0.e.x)), W2 = __expf(-lo2f(c0.e.y)), W3 = __expf(-hi2f(c0.e.y));
    float B0 = lo2f(c0.b.x), B1 = hi2f(c0.b.x), B2 = lo2f(c0.b.y), B3 = hi2f(c0.b.y);
    float K0 = 0.f, K1 = 0.f, K2 = 0.f, K3 = 0.f, R0 = 0.f, R1 = 0.f, R2 = 0.f, R3 = 0.f, vv = 0.f;
    if (MODE >= 1) { K0 = lo2f(c0.k.x); K1 = hi2f(c0.k.x); K2 = lo2f(c0.k.y); K3 = hi2f(c0.k.y); vv = lo2f(c0.v); }
    if (MODE == 2) { R0 = lo2f(c0.r.x); R1 = hi2f(c0.r.x); R2 = lo2f(c0.r.y); R3 = hi2f(c0.r.y); }
    A0 *= C0; A1 *= C1; A2 *= C2; A3 *= C3;
    C0 *= W0; C1 *= W1; C2 *= W2; C3 *= W3;
    {
      const float i0 = __builtin_amdgcn_rcpf(C0), i1 = __builtin_amdgcn_rcpf(C1), i2 = __builtin_amdgcn_rcpf(C2), i3 = __builtin_amdgcn_rcpf(C3);
      B0 *= i0; B1 *= i1; B2 *= i2; B3 *= i3;
      if (MODE >= 1) { K0 *= i0; K1 *= i1; K2 *= i2; K3 *= i3; }
      if (MODE == 2) { R0 *= C0; R1 *= C1; R2 *= C2; R3 *= C3; }
    }
    W0 = C0; W1 = C1; W2 = C2; W3 = C3;
    asm volatile("s_nop 1" : "+v"(A0), "+v"(A1), "+v"(A2), "+v"(A3), "+v"(W0), "+v"(W1), "+v"(W2), "+v"(W3), "+v"(B0), "+v"(B1), "+v"(B2), "+v"(B3));
    asm volatile("s_nop 1" : "+v"(K0), "+v"(K1), "+v"(K2), "+v"(K3), "+v"(R0), "+v"(R1), "+v"(R2), "+v"(R3));
    float sa0 = 0.f, sa1 = 0.f, sa2 = 0.f, sa3 = 0.f;
    fmac_bc<0>(sa0, A0, S[0]);
    fmac_bc<0>(sa1, A1, S[1]);
    fmac_bc<0>(sa2, A2, S[2]);
    fmac_bc<0>(sa3, A3, S[3]);
    fmac_bc<1>(sa0, A0, S[4]);
    fmac_bc<1>(sa1, A1, S[5]);
    fmac_bc<1>(sa2, A2, S[6]);
    fmac_bc<1>(sa3, A3, S[7]);
    fmac_bc<2>(sa0, A0, S[8]);
    fmac_bc<2>(sa1, A1, S[9]);
    fmac_bc<2>(sa2, A2, S[10]);
    fmac_bc<2>(sa3, A3, S[11]);
    fmac_bc<3>(sa0, A0, S[12]);
    fmac_bc<3>(sa1, A1, S[13]);
    fmac_bc<3>(sa2, A2, S[14]);
    fmac_bc<3>(sa3, A3, S[15]);
    fmac_bc<4>(sa0, A0, S[16]);
    fmac_bc<4>(sa1, A1, S[17]);
    fmac_bc<4>(sa2, A2, S[18]);
    fmac_bc<4>(sa3, A3, S[19]);
    fmac_bc<5>(sa0, A0, S[20]);
    fmac_bc<5>(sa1, A1, S[21]);
    fmac_bc<5>(sa2, A2, S[22]);
    fmac_bc<5>(sa3, A3, S[23]);
    fmac_bc<6>(sa0, A0, S[24]);
    fmac_bc<6>(sa1, A1, S[25]);
    fmac_bc<6>(sa2, A2, S[26]);
    fmac_bc<6>(sa3, A3, S[27]);
    fmac_bc<7>(sa0, A0, S[28]);
    fmac_bc<7>(sa1, A1, S[29]);
    fmac_bc<7>(sa2, A2, S[30]);
    fmac_bc<7>(sa3, A3, S[31]);
    fmac_bc<8>(sa0, A0, S[32]);
    fmac_bc<8>(sa1, A1, S[33]);
    fmac_bc<8>(sa2, A2, S[34]);
    fmac_bc<8>(sa3, A3, S[35]);
    fmac_bc<9>(sa0, A0, S[36]);
    fmac_bc<9>(sa1, A1, S[37]);
    fmac_bc<9>(sa2, A2, S[38]);
    fmac_bc<9>(sa3, A3, S[39]);
    fmac_bc<10>(sa0, A0, S[40]);
    fmac_bc<10>(sa1, A1, S[41]);
    fmac_bc<10>(sa2, A2, S[42]);
    fmac_bc<10>(sa3, A3, S[43]);
    fmac_bc<11>(sa0, A0, S[44]);
    fmac_bc<11>(sa1, A1, S[45]);
    fmac_bc<11>(sa2, A2, S[46]);
    fmac_bc<11>(sa3, A3, S[47]);
    fmac_bc<12>(sa0, A0, S[48]);
    fmac_bc<12>(sa1, A1, S[49]);
    fmac_bc<12>(sa2, A2, S[50]);
    fmac_bc<12>(sa3, A3, S[51]);
    fmac_bc<13>(sa0, A0, S[52]);
    fmac_bc<13>(sa1, A1, S[53]);
    fmac_bc<13>(sa2, A2, S[54]);
    fmac_bc<13>(sa3, A3, S[55]);
    fmac_bc<14>(sa0, A0, S[56]);
    fmac_bc<14>(sa1, A1, S[57]);
    fmac_bc<14>(sa2, A2, S[58]);
    fmac_bc<14>(sa3, A3, S[59]);
    fmac_bc<15>(sa0, A0, S[60]);
    fmac_bc<15>(sa1, A1, S[61]);
    fmac_bc<15>(sa2, A2, S[62]);
    fmac_bc<15>(sa3, A3, S[63]);
    const float sa = (sa0 + sa1) + (sa2 + sa3);
    float y0 = 0.f, y1 = 0.f, y2 = 0.f, y3 = 0.f;
    if (MODE >= 1) {
      fmac_bc<0>(S[0], K0, vv);
      fmac_bc<0>(S[1], K1, vv);
      fmac_bc<0>(S[2], K2, vv);
      fmac_bc<0>(S[3], K3, vv);
      fmac_bc<1>(S[4], K0, vv);
      fmac_bc<1>(S[5], K1, vv);
      fmac_bc<1>(S[6], K2, vv);
      fmac_bc<1>(S[7], K3, vv);
    }
    fmac_bc<0>(S[0], B0, sa);
    fmac_bc<0>(S[1], B1, sa);
    fmac_bc<0>(S[2], B2, sa);
    fmac_bc<0>(S[3], B3, sa);
    fmac_bc<1>(S[4], B0, sa);
    fmac_bc<1>(S[5], B1, sa);
    fmac_bc<1>(S[6], B2, sa);
    fmac_bc<1>(S[7], B3, sa);
    if (MODE == 2) {
      fmac_bc<0>(y0, R0, S[0]);
      fmac_bc<0>(y1, R1, S[1]);
      fmac_bc<0>(y2, R2, S[2]);
      fmac_bc<0>(y3, R3, S[3]);
      fmac_bc<1>(y0, R0, S[4]);
      fmac_bc<1>(y1, R1, S[5]);
      fmac_bc<1>(y2, R2, S[6]);
      fmac_bc<1>(y3, R3, S[7]);
    }
    if (MODE >= 1) {
      fmac_bc<2>(S[8], K0, vv);
      fmac_bc<2>(S[9], K1, vv);
      fmac_bc<2>(S[10], K2, vv);
      fmac_bc<2>(S[11], K3, vv);
      fmac_bc<3>(S[12], K0, vv);
      fmac_bc<3>(S[13], K1, vv);
      fmac_bc<3>(S[14], K2, vv);
      fmac_bc<3>(S[15], K3, vv);
    }
    fmac_bc<2>(S[8], B0, sa);
    fmac_bc<2>(S[9], B1, sa);
    fmac_bc<2>(S[10], B2, sa);
    fmac_bc<2>(S[11], B3, sa);
    fmac_bc<3>(S[12], B0, sa);
    fmac_bc<3>(S[13], B1, sa);
    fmac_bc<3>(S[14], B2, sa);
    fmac_bc<3>(S[15], B3, sa);
    if (MODE == 2) {
      fmac_bc<2>(y0, R0, S[8]);
      fmac_bc<2>(y1, R1, S[9]);
      fmac_bc<2>(y2, R2, S[10]);
      fmac_bc<2>(y3, R3, S[11]);
      fmac_bc<3>(y0, R0, S[12]);
      fmac_bc<3>(y1, R1, S[13]);
      fmac_bc<3>(y2, R2, S[14]);
      fmac_bc<3>(y3, R3, S[15]);
    }
    if (MODE >= 1) {
      fmac_bc<4>(S[16], K0, vv);
      fmac_bc<4>(S[17], K1, vv);
      fmac_bc<4>(S[18], K2, vv);
      fmac_bc<4>(S[19], K3, vv);
      fmac_bc<5>(S[20], K0, vv);
      fmac_bc<5>(S[21], K1, vv);
      fmac_bc<5>(S[22], K2, vv);
      fmac_bc<5>(S[23], K3, vv);
    }
    fmac_bc<4>(S[16], B0, sa);
    fmac_bc<4>(S[17], B1, sa);
    fmac_bc<4>(S[18], B2, sa);
    fmac_bc<4>(S[19], B3, sa);
    fmac_bc<5>(S[20], B0, sa);
    fmac_bc<5>(S[21], B1, sa);
    fmac_bc<5>(S[22], B2, sa);
    fmac_bc<5>(S[23], B3, sa);
    if (MODE == 2) {
      fmac_bc<4>(y0, R0, S[16]);
      fmac_bc<4>(y1, R1, S[17]);
      fmac_bc<4>(y2, R2, S[18]);
      fmac_bc<4>(y3, R3, S[19]);
      fmac_bc<5>(y0, R0, S[20]);
      fmac_bc<5>(y1, R1, S[21]);
      fmac_bc<5>(y2, R2, S[22]);
      fmac_bc<5>(y3, R3, S[23]);
    }
    if (MODE >= 1) {
      fmac_bc<6>(S[24], K0, vv);
      fmac_bc<6>(S[25], K1, vv);
      fmac_bc<6>(S[26], K2, vv);
      fmac_bc<6>(S[27], K3, vv);
      fmac_bc<7>(S[28], K0, vv);
      fmac_bc<7>(S[29], K1, vv);
      fmac_bc<7>(S[30], K2, vv);
      fmac_bc<7>(S[31], K3, vv);
    }
    fmac_bc<6>(S[24], B0, sa);
    fmac_bc<6>(S[25], B1, sa);
    fmac_bc<6>(S[26], B2, sa);
    fmac_bc<6>(S[27], B3, sa);
    fmac_bc<7>(S[28], B0, sa);
    fmac_bc<7>(S[29], B1, sa);
    fmac_bc<7>(S[30], B2, sa);
    fmac_bc<7>(S[31], B3, sa);
    if (MODE == 2) {
      fmac_bc<6>(y0, R0, S[24]);
      fmac_bc<6>(y1, R1, S[25]);
      fmac_bc<6>(y2, R2, S[26]);
      fmac_bc<6>(y3, R3, S[27]);
      fmac_bc<7>(y0, R0, S[28]);
      fmac_bc<7>(y1, R1, S[29]);
      fmac_bc<7>(y2, R2, S[30]);
      fmac_bc<7>(y3, R3, S[31]);
    }
    if (MODE >= 1) {
      fmac_bc<8>(S[32], K0, vv);
      fmac_bc<8>(S[33], K1, vv);
      fmac_bc<8>(S[34], K2, vv);
      fmac_bc<8>(S[35], K3, vv);
      fmac_bc<9>(S[36], K0, vv);
      fmac_bc<9>(S[37], K1, vv);
      fmac_bc<9>(S[38], K2, vv);
      fmac_bc<9>(S[39], K3, vv);
    }
    fmac_bc<8>(S[32], B0, sa);
    fmac_bc<8>(S[33], B1, sa);
    fmac_bc<8>(S[34], B2, sa);
    fmac_bc<8>(S[35], B3, sa);
    fmac_bc<9>(S[36], B0, sa);
    fmac_bc<9>(S[37], B1, sa);
    fmac_bc<9>(S[38], B2, sa);
    fmac_bc<9>(S[39], B3, sa);
    if (MODE == 2) {
      fmac_bc<8>(y0, R0, S[32]);
      fmac_bc<8>(y1, R1, S[33]);
      fmac_bc<8>(y2, R2, S[34]);
      fmac_bc<8>(y3, R3, S[35]);
      fmac_bc<9>(y0, R0, S[36]);
      fmac_bc<9>(y1, R1, S[37]);
      fmac_bc<9>(y2, R2, S[38]);
      fmac_bc<9>(y3, R3, S[39]);
    }
    if (MODE >= 1) {
      fmac_bc<10>(S[40], K0, vv);
      fmac_bc<10>(S[41], K1, vv);
      fmac_bc<10>(S[42], K2, vv);
      fmac_bc<10>(S[43], K3, vv);
      fmac_bc<11>(S[44], K0, vv);
      fmac_bc<11>(S[45], K1, vv);
      fmac_bc<11>(S[46], K2, vv);
      fmac_bc<11>(S[47], K3, vv);
    }
    fmac_bc<10>(S[40], B0, sa);
    fmac_bc<10>(S[41], B1, sa);
    fmac_bc<10>(S[42], B2, sa);
    fmac_bc<10>(S[43], B3, sa);
    fmac_bc<11>(S[44], B0, sa);
    fmac_bc<11>(S[45], B1, sa);
    fmac_bc<11>(S[46], B2, sa);
    fmac_bc<11>(S[47], B3, sa);
    if (MODE == 2) {
      fmac_bc<10>(y0, R0, S[40]);
      fmac_bc<10>(y1, R1, S[41]);
      fmac_bc<10>(y2, R2, S[42]);
      fmac_bc<10>(y3, R3, S[43]);
      fmac_bc<11>(y0, R0, S[44]);
      fmac_bc<11>(y1, R1, S[45]);
      fmac_bc<11>(y2, R2, S[46]);
      fmac_bc<11>(y3, R3, S[47]);
    }
    if (MODE >= 1) {
      fmac_bc<12>(S[48], K0, vv);
      fmac_bc<12>(S[49], K1, vv);
      fmac_bc<12>(S[50], K2, vv);
      fmac_bc<12>(S[51], K3, vv);
      fmac_bc<13>(S[52], K0, vv);
      fmac_bc<13>(S[53], K1, vv);
      fmac_bc<13>(S[54], K2, vv);
      fmac_bc<13>(S[55], K3, vv);
    }
    fmac_bc<12>(S[48], B0, sa);
    fmac_bc<12>(S[49], B1, sa);
    fmac_bc<12>(S[50], B2, sa);
    fmac_bc<12>(S[51], B3, sa);
    fmac_bc<13>(S[52], B0, sa);
    fmac_bc<13>(S[53], B1, sa);
    fmac_bc<13>(S[54], B2, sa);
    fmac_bc<13>(S[55], B3, sa);
    if (MODE == 2) {
      fmac_bc<12>(y0, R0, S[48]);
      fmac_bc<12>(y1, R1, S[49]);
      fmac_bc<12>(y2, R2, S[50]);
      fmac_bc<12>(y3, R3, S[51]);
      fmac_bc<13>(y0, R0, S[52]);
      fmac_bc<13>(y1, R1, S[53]);
      fmac_bc<13>(y2, R2, S[54]);
      fmac_bc<13>(y3, R3, S[55]);
    }
    if (MODE >= 1) {
      fmac_bc<14>(S[56], K0, vv);
      fmac_bc<14>(S[57], K1, vv);
      fmac_bc<14>(S[58], K2, vv);
      fmac_bc<14>(S[59], K3, vv);
      fmac_bc<15>(S[60], K0, vv);
      fmac_bc<15>(S[61], K1, vv);
      fmac_bc<15>(S[62], K2, vv);
      fmac_bc<15>(S[63], K3, vv);
    }
    fmac_bc<14>(S[56], B0, sa);
    fmac_bc<14>(S[57], B1, sa);
    fmac_bc<14>(S[58], B2, sa);
    fmac_bc<14>(S[59], B3, sa);
    fmac_bc<15>(S[60], B0, sa);
    fmac_bc<15>(S[61], B1, sa);
    fmac_bc<15>(S[62], B2, sa);
    fmac_bc<15>(S[63], B3, sa);
    if (MODE == 2) {
      fmac_bc<14>(y0, R0, S[56]);
      fmac_bc<14>(y1, R1, S[57]);
      fmac_bc<14>(y2, R2, S[58]);
      fmac_bc<14>(y3, R3, S[59]);
      fmac_bc<15>(y0, R0, S[60]);
      fmac_bc<15>(y1, R1, S[61]);
      fmac_bc<15>(y2, R2, S[62]);
      fmac_bc<15>(y3, R3, S[63]);
    }
    if ((t & 31) == 31) {
      S[0] = mul_bc<0>(W0, S[0]);
      S[1] = mul_bc<0>(W1, S[1]);
      S[2] = mul_bc<0>(W2, S[2]);
      S[3] = mul_bc<0>(W3, S[3]);
      S[4] = mul_bc<1>(W0, S[4]);
      S[5] = mul_bc<1>(W1, S[5]);
      S[6] = mul_bc<1>(W2, S[6]);
      S[7] = mul_bc<1>(W3, S[7]);
      S[8] = mul_bc<2>(W0, S[8]);
      S[9] = mul_bc<2>(W1, S[9]);
      S[10] = mul_bc<2>(W2, S[10]);
      S[11] = mul_bc<2>(W3, S[11]);
      S[12] = mul_bc<3>(W0, S[12]);
      S[13] = mul_bc<3>(W1, S[13]);
      S[14] = mul_bc<3>(W2, S[14]);
      S[15] = mul_bc<3>(W3, S[15]);
      S[16] = mul_bc<4>(W0, S[16]);
      S[17] = mul_bc<4>(W1, S[17]);
      S[18] = mul_bc<4>(W2, S[18]);
      S[19] = mul_bc<4>(W3, S[19]);
      S[20] = mul_bc<5>(W0, S[20]);
      S[21] = mul_bc<5>(W1, S[21]);
      S[22] = mul_bc<5>(W2, S[22]);
      S[23] = mul_bc<5>(W3, S[23]);
      S[24] = mul_bc<6>(W0, S[24]);
      S[25] = mul_bc<6>(W1, S[25]);
      S[26] = mul_bc<6>(W2, S[26]);
      S[27] = mul_bc<6>(W3, S[27]);
      S[28] = mul_bc<7>(W0, S[28]);
      S[29] = mul_bc<7>(W1, S[29]);
      S[30] = mul_bc<7>(W2, S[30]);
      S[31] = mul_bc<7>(W3, S[31]);
      S[32] = mul_bc<8>(W0, S[32]);
      S[33] = mul_bc<8>(W1, S[33]);
      S[34] = mul_bc<8>(W2, S[34]);
      S[35] = mul_bc<8>(W3, S[35]);
      S[36] = mul_bc<9>(W0, S[36]);
      S[37] = mul_bc<9>(W1, S[37]);
      S[38] = mul_bc<9>(W2, S[38]);
      S[39] = mul_bc<9>(W3, S[39]);
      S[40] = mul_bc<10>(W0, S[40]);
      S[41] = mul_bc<10>(W1, S[41]);
      S[42] = mul_bc<10>(W2, S[42]);
      S[43] = mul_bc<10>(W3, S[43]);
      S[44] = mul_bc<11>(W0, S[44]);
      S[45] = mul_bc<11>(W1, S[45]);
      S[46] = mul_bc<11>(W2, S[46]);
      S[47] = mul_bc<11>(W3, S[47]);
      S[48] = mul_bc<12>(W0, S[48]);
      S[49] = mul_bc<12>(W1, S[49]);
      S[50] = mul_bc<12>(W2, S[50]);
      S[51] = mul_bc<12>(W3, S[51]);
      S[52] = mul_bc<13>(W0, S[52]);
      S[53] = mul_bc<13>(W1, S[53]);
      S[54] = mul_bc<13>(W2, S[54]);
      S[55] = mul_bc<13>(W3, S[55]);
      S[56] = mul_bc<14>(W0, S[56]);
      S[57] = mul_bc<14>(W1, S[57]);
      S[58] = mul_bc<14>(W2, S[58]);
      S[59] = mul_bc<14>(W3, S[59]);
      S[60] = mul_bc<15>(W0, S[60]);
      S[61] = mul_bc<15>(W1, S[61]);
      S[62] = mul_bc<15>(W2, S[62]);
      S[63] = mul_bc<15>(W3, S[63]);
      C0 = 1.f; C1 = 1.f; C2 = 1.f; C3 = 1.f;
    }
    if (MODE == 2) Yg[(size_t)t * 512 + lane] = (y0 + y1) + (y2 + y3);
    c0 = c1; c1 = c2;
  }
  if (Sout) {
#pragma unroll
    for (int k = 0; k < 64; k += 4) *(f32x4*)(Sout + (size_t)lane * 64 + k) = f32x4{S[k], S[k + 1], S[k + 2], S[k + 3]};
  }
}

constexpr int RC = 128;
constexpr int NCH = NP / RC;
DI void seqs_item(const Params& p, int layer, int hd, char* smem) {
  float* sS = (float*)smem;
  const int tid = tidx(), lane = tid & 63, w = tid >> 6, l31 = lane & 31, h = lane >> 5, wr = w >> 1, wc = w & 1;
  const float* PQ = (const float*)(p.ws + WS_Y) + (size_t)hd * NCH * 8192;
  float* SS = (float*)(p.ws + WS_H) + (size_t)hd * NCH * 4096;
  const unsigned* pqflag = (const unsigned*)(p.ws + WS_CTR) + 1024 + (layer * 8 + hd) * 64;
  __syncthreads();
  for (int i = tid; i < 64 * 65; i += 256) sS[i] = 0.f;
  for (int i = tid; i < 4096; i += 256) SS[i] = 0.f;
  if (tid == 0) {
    for (int j = 0; j < 5; ++j)
      while (__hip_atomic_load((unsigned*)pqflag + j, __ATOMIC_RELAXED, __HIP_MEMORY_SCOPE_AGENT) == 0u) __builtin_amdgcn_s_sleep(4);
    __builtin_amdgcn_fence(__ATOMIC_ACQUIRE, "agent");
    asm volatile("s_waitcnt vmcnt(0)" ::: "memory");
  }
  __syncthreads();
  float bP[32], bQ[16], nP[32], nQ[16];
#pragma unroll
  for (int ks = 0; ks < 32; ++ks) bP[ks] = PQ[(2 * ks + h) * 64 + 32 * wc + l31];
#pragma unroll
  for (int r = 0; r < 16; ++r) bQ[r] = PQ[4096 + (32 * wr + crow(r, h)) * 64 + 32 * wc + l31];
  for (int c = 0; c < NCH; ++c) {
    if ((c & 7) == 0 && c > 0) {
      if (tid == 0) {
        const int j0 = c >> 1, j1 = (c + 8 < NCH) ? j0 + 5 : j0 + 4;
        for (int j = j0; j < j1; ++j)
          while (__hip_atomic_load((unsigned*)pqflag + j, __ATOMIC_RELAXED, __HIP_MEMORY_SCOPE_AGENT) == 0u) __builtin_amdgcn_s_sleep(4);
        __builtin_amdgcn_fence(__ATOMIC_ACQUIRE, "agent");
        asm volatile("s_waitcnt vmcnt(0)" ::: "memory");
      }
      __syncthreads();
    }
    if (c + 1 < NCH) {
      const float* Pn = PQ + (size_t)(c + 1) * 8192;
#pragma unroll
      for (int ks = 0; ks < 32; ++ks) nP[ks] = Pn[(2 * ks + h) * 64 + 32 * wc + l31];
#pragma unroll
      for (int r = 0; r < 16; ++r) nQ[r] = Pn[4096 + (32 * wr + crow(r, h)) * 64 + 32 * wc + l31];
    }
    f32x16 acc;
#pragma unroll
    for (int r = 0; r < 16; ++r) acc[r] = bQ[r];
    float a[32];
#pragma unroll
    for (int ks = 0; ks < 32; ++ks) a[ks] = sS[(32 * wr + l31) * 65 + 2 * ks + h];
#pragma unroll
    for (int ks = 0; ks < 32; ++ks) acc = __builtin_amdgcn_mfma_f32_32x32x2f32(a[ks], bP[ks], acc, 0, 0, 0);
    __syncthreads();
    float* dst = (c + 1 < NCH) ? SS + (size_t)(c + 1) * 4096 : p.out + OFF_WKV_P + ((size_t)layer * 8 + hd) * 4096;
#pragma unroll
    for (int r = 0; r < 16; ++r) {
      const int row = 32 * wr + crow(r, h), col = 32 * wc + l31;
      sS[row * 65 + col] = acc[r];
      dst[row * 64 + col] = acc[r];
    }
    __syncthreads();
#pragma unroll
    for (int ks = 0; ks < 32; ++ks) bP[ks] = nP[ks];
#pragma unroll
    for (int r = 0; r < 16; ++r) bQ[r] = nQ[r];
  }
}

DI void phase_mix(const Params& p, int layer, char* smem, int* s_item) {
  constexpr int NQ_PQ = NCH * 2 / 4, NQ_SY = 4, NQ_SATT = 16, NQ_PATT = 128;
  int* qctr = (int*)(p.ws + WS_CTR) + 64 + layer * 8;
  int* actr = (int*)(p.ws + WS_CTR) + 192 + layer * 8;
  if (blockIdx.x < 8) { seqs_item(p, layer, blockIdx.x, smem); return; }
  const int home = blockIdx.x & 7;
  const int first = (blockIdx.x >> 3) & 1;
  for (int pass = 0; pass < 2; ++pass) {
    const int kind = pass ^ first;
    for (int qi = 0; qi < 8; ++qi) {
      const int hd = (home + qi) & 7;
      for (;;) {
        __syncthreads();
        if (tidx() == 0) *s_item = atomicAdd((kind == 0 ? qctr : actr) + hd, 1);
        __syncthreads();
        const int it = *s_item;
        const int wave = __builtin_amdgcn_readfirstlane(tidx() >> 6), lane = tidx() & 63;
        if (kind == 0) {
          if (it >= NQ_PQ + NQ_SY) break;
          if (it < NQ_PQ) {
            const int q = it * 4 + wave, mode = q & 1, ch = q >> 1;
            float* dstm = (float*)(p.ws + WS_Y) + ((size_t)(hd * NCH + ch) * 2 + mode) * 4096;
            if (mode == 0) rpl_item<0>(p, hd, ch * RC, RC, nullptr, dstm, nullptr, lane);
            else rpl_item<1>(p, hd, ch * RC, RC, nullptr, dstm, nullptr, lane);
            asm volatile("s_waitcnt vmcnt(0)" ::: "memory");
            __syncthreads();
            if (tidx() == 0) {
              __builtin_amdgcn_fence(__ATOMIC_RELEASE, "agent");
              asm volatile("s_waitcnt vmcnt(0)" ::: "memory");
              __hip_atomic_store((unsigned*)(p.ws + WS_CTR) + 1024 + (layer * 8 + hd) * 64 + it, 1u, __ATOMIC_RELAXED, __HIP_MEMORY_SCOPE_AGENT);
            }
            continue;
          }
          const int b = (it - NQ_PQ) * 4 + wave;
          rpl_item<2>(p, hd, NP + b * 64, 64, p.state_wkv + (((size_t)layer * 16 + b) * 8 + hd) * 4096,
                      p.out + OFF_WKV_S + (((size_t)layer * 16 + b) * 8 + hd) * 4096, (float*)(p.ws + WS_Y) + (size_t)(NP + b * 64) * 512 + hd * 64, lane);
        } else {
          if (it >= NQ_SATT + NQ_PATT) break;
          if (it < NQ_SATT) { attn_sample_item(p, layer, it, hd, smem); continue; }
          attn_prompt_item(p, layer, 127 - (it - NQ_SATT), hd, smem);
        }
      }
    }
  }
}
DI void phase_ypass(const Params& p, int layer) {
  const int wave = __builtin_amdgcn_readfirstlane(tidx() >> 6), lane = tidx() & 63;
  const int hd = blockIdx.x & 7, nb = (gridDim.x + 7 - hd) >> 3;
  for (int j = blockIdx.x >> 3; j < NCH / 4; j += nb) {
    const int ch = j * 4 + wave;
    rpl_item<2>(p, hd, ch * RC, RC, (const float*)(p.ws + WS_H) + (size_t)(hd * NCH + ch) * 4096, nullptr,
                (float*)(p.ws + WS_Y) + (size_t)(ch * RC) * 512 + hd * 64, lane);
  }
}

DI void phase_ob(const Params& p, int layer) {
  const int wave = tidx() >> 6, lane = tidx() & 63;
  const float* Y = (const float*)(p.ws + WS_Y);
  const u16* WK = (const u16*)(p.ws + WS_WKVIN);
  const u16* Z = (const u16*)(p.ws + WS_Z);
  u16* OB = (u16*)(p.ws + WS_Q);
  const int f = lane * 8, hd = lane >> 3, fl = (lane & 7) * 8;
  for (int t = blockIdx.x * 4 + wave; t < NT; t += gridDim.x * 4) {
    const float4 ya = *(const float4*)(Y + (size_t)t * 512 + f);
    const float4 yb = *(const float4*)(Y + (size_t)t * 512 + f + 4);
    float y[8] = {ya.x, ya.y, ya.z, ya.w, yb.x, yb.y, yb.z, yb.w};
    float s = 0.f;
#pragma unroll
    for (int j = 0; j < 8; ++j) s += y[j];
    s += __shfl_xor(s, 1); s += __shfl_xor(s, 2); s += __shfl_xor(s, 4);
    const float mu = s * (1.f / 64.f);
    float vs = 0.f;
#pragma unroll
    for (int j = 0; j < 8; ++j) { y[j] -= mu; vs += y[j] * y[j]; }
    vs += __shfl_xor(vs, 1); vs += __shfl_xor(vs, 2); vs += __shfl_xor(vs, 4);
    const float rs = rsqrtf(vs * (1.f / 64.f) + GN_EPS);
    const u16* wk = WK + ((size_t)hd * NT + t) * 384 + fl;
    const uint4 r8 = *(const uint4*)(wk + 0 * 64);
    const uint4 k8 = *(const uint4*)(wk + 2 * 64);
    const uint4 v8 = *(const uint4*)(wk + 3 * 64);
    const float rr[8] = {lo2f(r8.x), hi2f(r8.x), lo2f(r8.y), hi2f(r8.y), lo2f(r8.z), hi2f(r8.z), lo2f(r8.w), hi2f(r8.w)};
    const float kk[8] = {lo2f(k8.x), hi2f(k8.x), lo2f(k8.y), hi2f(k8.y), lo2f(k8.z), hi2f(k8.z), lo2f(k8.w), hi2f(k8.w)};
    const float vv[8] = {lo2f(v8.x), hi2f(v8.x), lo2f(v8.y), hi2f(v8.y), lo2f(v8.z), hi2f(v8.z), lo2f(v8.w), hi2f(v8.w)};
    const float4 rka = *(const float4*)(p.r_k + layer * 512 + f);
    const float4 rkb = *(const float4*)(p.r_k + layer * 512 + f + 4);
    const float rk[8] = {rka.x, rka.y, rka.z, rka.w, rkb.x, rkb.y, rkb.z, rkb.w};
    float bs = 0.f;
#pragma unroll
    for (int j = 0; j < 8; ++j) bs += rr[j] * kk[j] * rk[j];
    bs += __shfl_xor(bs, 1); bs += __shfl_xor(bs, 2); bs += __shfl_xor(bs, 4);
    const float4 lwa = *(const float4*)(p.lnx_w + layer * 512 + f);
    const float4 lwb = *(const float4*)(p.lnx_w + layer * 512 + f + 4);
    const float4 lba = *(const float4*)(p.lnx_b + layer * 512 + f);
    const float4 lbb = *(const float4*)(p.lnx_b + layer * 512 + f + 4);
    const float lw[8] = {lwa.x, lwa.y, lwa.z, lwa.w, lwb.x, lwb.y, lwb.z, lwb.w};
    const float lb[8] = {lba.x, lba.y, lba.z, lba.w, lbb.x, lbb.y, lbb.z, lbb.w};
    const uint4 g8 = *(const uint4*)(Z + (size_t)t * NZ + ZC_GB + f);
    const float gg[8] = {lo2f(g8.x), hi2f(g8.x), lo2f(g8.y), hi2f(g8.y), lo2f(g8.z), hi2f(g8.z), lo2f(g8.w), hi2f(g8.w)};
    float ov[8];
#pragma unroll
    for (int j = 0; j < 8; ++j) ov[j] = (y[j] * rs * lw[j] + lb[j] + bs * vv[j]) * siluf_(gg[j]);
    *(uint4*)(OB + (size_t)t * 512 + f) = make_uint4(pk2(ov[0], ov[1]), pk2(ov[2], ov[3]), pk2(ov[4], ov[5]), pk2(ov[6], ov[7]));
  }
}

DI void phase_merge(const Params& p, int layer, char* smem) {
  const u16* OA = (const u16*)(p.ws + WS_OA);
  const u16* OB = (const u16*)(p.ws + WS_Q);
  const u16* WA = (const u16*)(p.ws + (size_t)layer * WL_STRIDE + W_OA);
  const u16* WB = (const u16*)(p.ws + (size_t)layer * WL_STRIDE + W_OB);
  const u16* Z = (const u16*)(p.ws + WS_Z);
  u16* M = (u16*)(p.ws + WS_H);
  const int xcd = blockIdx.x & 7, jb = blockIdx.x >> 3, nb = (gridDim.x + 7 - xcd) >> 3;
  for (int m = jb; m < 16 * 8; m += nb) {
    const int tt = xcd + 8 * (m >> 3), ft = m & 7;
    f32x16 acc[2][2];
    zero_acc(acc);
    gemm_mainloop(OA + (size_t)tt * 128 * 512, 512, WA + (size_t)ft * 128 * 512, 512, 512, smem, acc);
    acc_to_lds(acc, smem);
    EPI_ROWS({
      const u32x2 g = *(const u32x2*)(Z + (size_t)(tt * 128 + row) * NZ + ZC_MA + ft * 128 + col);
      *(u32x2*)(M + (size_t)(tt * 128 + row) * 1024 + ft * 128 + col) =
          u32x2{pk2(v.x * sigmoidf_(lo2f(g.x)), v.y * sigmoidf_(hi2f(g.x))), pk2(v.z * sigmoidf_(lo2f(g.y)), v.w * sigmoidf_(hi2f(g.y)))};
    })
    zero_acc(acc);
    gemm_mainloop(OB + (size_t)tt * 128 * 512, 512, WB + (size_t)ft * 128 * 512, 512, 512, smem, acc);
    acc_to_lds(acc, smem);
    EPI_ROWS({
      const u32x2 g = *(const u32x2*)(Z + (size_t)(tt * 128 + row) * NZ + ZC_MB + ft * 128 + col);
      u32x2* mp = (u32x2*)(M + (size_t)(tt * 128 + row) * 1024 + ft * 128 + col);
      const u32x2 pm = *mp;
      *mp = u32x2{pk2(lo2f(pm.x) + v.x * sigmoidf_(lo2f(g.x)), hi2f(pm.x) + v.y * sigmoidf_(hi2f(g.x))),
                  pk2(lo2f(pm.y) + v.z * sigmoidf_(lo2f(g.y)), hi2f(pm.y) + v.w * sigmoidf_(hi2f(g.y)))};
    })
  }
  for (int m = jb; m < 2 * 16; m += nb) {
    const int r0 = (128 + xcd) * 128 + (m >> 4) * 64, c0 = (m & 15) * 64;
    f32x16 acc;
#pragma unroll
    for (int r = 0; r < 16; ++r) acc[r] = 0.f;
    gemm64_mainloop(OA + (size_t)r0 * 512, 512, WA + (size_t)c0 * 512, 512, 512, smem, acc);
    acc64_to_lds(acc, smem);
    EPI64_ROWS({
      const u32x2 g = *(const u32x2*)(Z + (size_t)(r0 + row) * NZ + ZC_MA + c0 + col);
      *(u32x2*)(M + (size_t)(r0 + row) * 1024 + c0 + col) =
          u32x2{pk2(v.x * sigmoidf_(lo2f(g.x)), v.y * sigmoidf_(hi2f(g.x))), pk2(v.z * sigmoidf_(lo2f(g.y)), v.w * sigmoidf_(hi2f(g.y)))};
    })
#pragma unroll
    for (int r = 0; r < 16; ++r) acc[r] = 0.f;
    gemm64_mainloop(OB + (size_t)r0 * 512, 512, WB + (size_t)c0 * 512, 512, 512, smem, acc);
    acc64_to_lds(acc, smem);
    EPI64_ROWS({
      const u32x2 g = *(const u32x2*)(Z + (size_t)(r0 + row) * NZ + ZC_MB + c0 + col);
      u32x2* mp = (u32x2*)(M + (size_t)(r0 + row) * 1024 + c0 + col);
      const u32x2 pm = *mp;
      *mp = u32x2{pk2(lo2f(pm.x) + v.x * sigmoidf_(lo2f(g.x)), hi2f(pm.x) + v.y * sigmoidf_(hi2f(g.x))),
                  pk2(lo2f(pm.y) + v.z * sigmoidf_(lo2f(g.y)), hi2f(pm.y) + v.w * sigmoidf_(hi2f(g.y)))};
    })
  }
}

DI void phase_out(const Params& p, int layer, char* smem) {
  const u16* M = (const u16*)(p.ws + WS_H);
  const u16* W = (const u16*)(p.ws + (size_t)layer * WL_STRIDE + W_O);
  const int xcd = blockIdx.x & 7, jb = blockIdx.x >> 3, nb = (gridDim.x + 7 - xcd) >> 3;
  for (int m = jb; m < 16 * 8; m += nb) {
    const int tt = xcd + 8 * (m >> 3), ft = m & 7;
    f32x16 acc[2][2];
    zero_acc(acc);
    gemm_mainloop(M + (size_t)tt * 128 * 1024, 1024, W + (size_t)ft * 128 * 1024, 1024, 1024, smem, acc);
    acc_to_lds(acc, smem);
    EPI_ROWS({
      const int t = tt * 128 + row, n = ft * 128 + col;
      const f32x4 xo = *(const f32x4*)(xrow(p, layer, t) + n);
      *(f32x4*)(p.out + (size_t)t * 1024 + n) = xo + v;
    })
  }
  for (int m = jb; m < 2 * 16; m += nb) {
    const int r0 = (128 + xcd) * 128 + (m >> 4) * 64, c0 = (m & 15) * 64;
    f32x16 acc;
#pragma unroll
    for (int r = 0; r < 16; ++r) acc[r] = 0.f;
    gemm64_mainloop(M + (size_t)r0 * 1024, 1024, W + (size_t)c0 * 1024, 1024, 1024, smem, acc);
    acc64_to_lds(acc, smem);
    EPI64_ROWS({
      const int t = r0 + row, n = c0 + col;
      const f32x4 xo = *(const f32x4*)(xrow(p, layer, t) + n);
      *(f32x4*)(p.out + (size_t)t * 1024 + n) = xo + v;
    })
  }
}

#define XB_TMO      128
#define XB_XCNT(j)  (256  + 64 * (j))
#define XB_XSUB(j)  (1280 + 64 * (j))
#define XB_XGEN(j)  (2304 + 64 * (j))
#define XB_TOP      3328
#define XB_TOPGEN   3392
#define XCD_BAR_WORDS 3456
#define XB_SPIN_CAP (1u << 22)
#define LAS __attribute__((address_space(3)))
DI unsigned xb_ld(unsigned* p) { return __hip_atomic_load(p, __ATOMIC_RELAXED, __HIP_MEMORY_SCOPE_AGENT); }
DI unsigned xb_add(unsigned* p, unsigned v) { return __hip_atomic_fetch_add(p, v, __ATOMIC_RELAXED, __HIP_MEMORY_SCOPE_AGENT); }
DI unsigned xb_xcc_id() { return (unsigned)__builtin_amdgcn_s_getreg((3 << 11) | 20) & 0xFu; }
#define XB_SPIN(cond, bar) do { unsigned _sp = 0; while (cond) { __builtin_amdgcn_s_sleep(1); \
    if ((++_sp & 255u) == 0u) { if (xb_ld(&(bar)[XB_TMO])) break; if (_sp > XB_SPIN_CAP) { atomicAdd(&(bar)[XB_TMO], 1u); break; } } } } while (0)
struct XcdBarrier { unsigned* bar; unsigned x; volatile LAS unsigned* st; };
DI XcdBarrier xcd_barrier_post(unsigned* bar, volatile LAS unsigned* st) {
  XcdBarrier b; b.bar = bar; b.x = xb_xcc_id(); b.st = st;
  if (threadIdx.x == 0) (void)xb_add(&bar[XB_XCNT(b.x)], 1u);
  return b;
}
DI void xcd_barrier_complete(unsigned* bar, unsigned x, unsigned& nloc, unsigned& nx) {
  const unsigned G = gridDim.x * gridDim.y * gridDim.z;
  unsigned sum, cnt, mine, sp = 0u;
  for (;;) {
    sum = 0u; cnt = 0u; mine = 0u;
#pragma unroll
    for (unsigned j = 0; j < 16; ++j) { const unsigned c = xb_ld(&bar[XB_XCNT(j)]); sum += c; cnt += (c > 0u) ? 1u : 0u; mine = (j == x) ? c : mine; }
    if (sum == G) break;
    __builtin_amdgcn_s_sleep(1);
    if ((++sp & 255u) == 0u) { if (xb_ld(&bar[XB_TMO])) break; if (sp > XB_SPIN_CAP) { atomicAdd(&bar[XB_TMO], 1u); break; } }
  }
  nloc = mine > 0u ? mine : 1u; nx = cnt > 0u ? cnt : 1u;
}
DI void xcd_barrier(const XcdBarrier& b) {
  asm volatile("s_waitcnt vmcnt(0)" ::: "memory");
  __syncthreads();
  if (threadIdx.x == 0) {
    unsigned* bar = b.bar;
    __builtin_amdgcn_s_waitcnt(0);
    unsigned nloc = b.st[0], nx = b.st[1];
    if (nloc == 0u) { xcd_barrier_complete(bar, b.x, nloc, nx); b.st[0] = nloc; b.st[1] = nx; }
    const unsigned old = xb_add(&bar[XB_XSUB(b.x)], 1u);
    const unsigned gen = old / nloc;
    if (old + 1u == (gen + 1u) * nloc) {
      __builtin_amdgcn_fence(__ATOMIC_RELEASE, "agent");
      asm volatile("s_waitcnt vmcnt(0)" ::: "memory");
      const unsigned og = xb_add(&bar[XB_TOP], 1u);
      const unsigned tg = og / nx;
      if (og + 1u == (tg + 1u) * nx) xb_add(&bar[XB_TOPGEN], 1u);
      else XB_SPIN(xb_ld(&bar[XB_TOPGEN]) == tg, bar);
      __builtin_amdgcn_fence(__ATOMIC_ACQUIRE, "agent");
      xb_add(&bar[XB_XGEN(b.x)], 1u);
      asm volatile("s_waitcnt vmcnt(0)" ::: "memory");
    } else {
      XB_SPIN(xb_ld(&bar[XB_XGEN(b.x)]) == gen, bar);
      __builtin_amdgcn_fence(__ATOMIC_ACQUIRE, "agent");
      asm volatile("s_waitcnt vmcnt(0)" ::: "memory");
    }
  }
  __syncthreads();
}

constexpr int PH_PER_LAYER = 8;
constexpr int N_PHASES = 1 + 4 * PH_PER_LAYER;

DI void run_phase(const Params& p, int ph, char* smem, int* s_item) {
#ifndef PHMASK
#define PHMASK 0x3FF
#endif
  if (ph == 0) { if (PHMASK & 0x100) phase_convert(p, smem); return; }
  const int layer = (ph - 1) / PH_PER_LAYER, sub = (ph - 1) % PH_PER_LAYER;
  switch (sub) {
    case 0: if (PHMASK & 1) phase_rmsnorm(p, layer); break;
    case 1: if (PHMASK & 2) phase_g1(p, layer, smem); break;
    case 2: if (PHMASK & 4) phase_norms_prep(p, layer, smem, s_item); break;
    case 3: if (PHMASK & 16) phase_mix(p, layer, smem, s_item); break;
    case 4: if (PHMASK & 16) phase_ypass(p, layer); break;
    case 5: if (PHMASK & 32) phase_ob(p, layer); break;
    case 6: if (PHMASK & 64) phase_merge(p, layer, smem); break;
    default: if (PHMASK & 128) phase_out(p, layer, smem); break;
  }
}

__global__ void __launch_bounds__(256, 2) mk_kernel(Params p, int ph0, int ph1, int coop) {
  __shared__ __attribute__((aligned(16))) char smem[SMEM_BYTES];
  __shared__ int s_item[4];
  __shared__ uint4 xb_words;
  if (threadIdx.x == 0) xb_words = make_uint4(0u, 0u, 0u, 0u);
  __syncthreads();
  XcdBarrier xb = xcd_barrier_post((unsigned*)(p.ws + WS_BAR), (volatile LAS unsigned*)&xb_words);
  for (int ph = ph0; ph < ph1; ++ph) {
    run_phase(p, ph, smem, s_item);
    if (coop && ph + 1 < ph1) {
      xcd_barrier(xb);
      if (coop == 0x5a5a5a) cg::this_grid().sync();
    }
  }
}

extern "C" void kernel_launch(void* const* d_in, const int* in_sizes, int n_in, void* d_out, int out_size, void* d_ws, size_t ws_size,
                              hipStream_t stream) {
  static int grid_blocks = 0;
  if (!grid_blocks) {
    int dev = 0, cus = 0, per_cu = 0;
    hipGetDevice(&dev);
    hipDeviceGetAttribute(&cus, hipDeviceAttributeMultiprocessorCount, dev);
    hipOccupancyMaxActiveBlocksPerMultiprocessor(&per_cu, mk_kernel, 256, 0);
    if (per_cu < 1) per_cu = 1;
    if (per_cu > 2) per_cu = 2;
    grid_blocks = cus * per_cu;
  }
  Params p{};
  const float** pp = (const float**)&p;
  for (int i = 0; i < 29; ++i) pp[i] = (const float*)d_in[i];
  p.out = (float*)d_out;
  p.ws = (char*)d_ws;
  const int ONE_LAUNCH = 1;
  hipMemsetAsync((char*)d_ws + WS_CTR, 0, 16384 + XCD_BAR_WORDS * 4, stream);
  if (ONE_LAUNCH) {
    int ph0 = 0, ph1 = N_PHASES, coop = 1;
    void* args[] = {&p, &ph0, &ph1, &coop};
    hipError_t e = hipLaunchCooperativeKernel((void*)mk_kernel, dim3(grid_blocks), dim3(256), args, 0, stream);
    if (e != hipSuccess) fprintf(stderr, "cooperative launch failed: %s (grid %d)\n", hipGetErrorString(e), grid_blocks);
  } else {
    for (int ph = 0; ph < N_PHASES; ++ph) mk_kernel<<<dim3(grid_blocks), dim3(256), 0, stream>>>(p, ph, ph + 1, 0);
  }
}
```

```cpp
#include <hip/hip_runtime.h>
#include <hip/hip_cooperative_groups.h>
#include <cstdio>
namespace cg = cooperative_groups;

#define DI __device__ __forceinline__
typedef unsigned short u16;
typedef __attribute__((ext_vector_type(8))) short bf16x8;
typedef __attribute__((ext_vector_type(4))) short s16x4;
typedef __attribute__((ext_vector_type(2))) __bf16 bf2_t;
typedef __attribute__((ext_vector_type(2))) float f2_t;
typedef __attribute__((ext_vector_type(16))) float f32x16;
typedef __attribute__((ext_vector_type(4))) unsigned u32x4;
typedef __attribute__((ext_vector_type(2))) unsigned u32x2;
typedef __attribute__((ext_vector_type(4))) float f32x4;
#define MFMA32(a, b, c) __builtin_amdgcn_mfma_f32_32x32x16_bf16((a), (b), (c), 0, 0, 0)

constexpr int NP = 16384;
constexpr int NSM = 1024;
constexpr int NT = NP + NSM;
constexpr int NZ = 5248;
constexpr int ZC_KV = 256, ZC_KPE = 384, ZC_GA = 512, ZC_ZS = 1024, ZC_GB = 2688, ZC_MA = 3200, ZC_MB = 4224;
constexpr float EPS = 1e-6f;
constexpr float GN_EPS = 64e-5f;
constexpr int SHW = 1664;

constexpr size_t OFF_CKV_P = 17825792;
constexpr size_t OFF_KPE_P = 26214400;
constexpr size_t OFF_WKV_P = 28311552;
constexpr size_t OFF_SH_P = 28442624;
constexpr size_t OFF_CKV_S = 28449280;
constexpr size_t OFF_KPE_S = 28973568;
constexpr size_t OFF_WKV_S = 29104640;
constexpr size_t OFF_SH_S = 31201792;

constexpr size_t WL_STRIDE = 15728640;
constexpr size_t W_IN = 0, W_UQ = 10747904, W_UKV = 11141120, W_W2 = 11403264, W_A2 = 11468800, W_OA = 11534336, W_OB = 12582912, W_O = 13631488;
constexpr size_t WS_H = 62914560;
constexpr size_t WS_Z = WS_H + 35651584;
constexpr size_t WS_Q = WS_Z + 182714368;
constexpr size_t WS_CKVB = WS_Q + 26738688;
constexpr size_t WS_KPEB = WS_CKVB + 4456448;
constexpr size_t WS_KN = WS_KPEB + 1114112;
constexpr size_t WS_VT = WS_KN + 16777216;
constexpr size_t WS_WKVIN = WS_VT + 16777216;
constexpr size_t WS_OA = WS_WKVIN + 106954752;
constexpr size_t WS_Y = WS_OA + 17825792;
constexpr size_t WS_CTR = WS_Y + 35651584;
constexpr size_t WS_BAR = WS_CTR + 16384;
constexpr size_t WS_SH0 = WS_BAR + 16384;
constexpr size_t WS_CKB = WS_SH0 + 65536;
constexpr size_t WS_KPB = WS_CKB + 16777216;
constexpr size_t WS_TOTAL = WS_KPB + 4194304;
static_assert(WS_TOTAL < 536870912, "ws");

constexpr int SMEM_BYTES = 39424 + 128 * 136 * 2;

struct Params {
  const float *x_prompt, *x_sample, *cache_ckv, *cache_kpe, *state_wkv, *state_shift;
  const float *norm_w, *w_in, *q_norm_w, *kv_norm_w, *w_uq, *w_ukv, *qn_nope, *qn_rope, *kn_nope, *kn_rope;
  const float *mu_shift, *w0, *w2, *a0, *a2, *k_k, *k_a, *r_k, *lnx_w, *lnx_b, *w_out_a, *w_out_b, *w_o;
  float* out;
  char* ws;
};

__device__ const float ROPE_INV[16] = {1.0f, 0.5623413324356079f, 0.3162277638912201f, 0.17782793939113617f, 0.10000000149011612f, 0.05623413249850273f, 0.03162277489900589f, 0.017782794311642647f, 0.009999999776482582f, 0.005623413249850273f, 0.003162277629598975f, 0.0017782794311642647f, 0.0010000000474974513f, 0.000562341301701963f, 0.0003162277571391314f, 0.00017782794020604342f};

DI int tidx() { int t = threadIdx.x; asm volatile("" : "+v"(t)); return t; }
DI float bf2f(u16 h) { return __uint_as_float(((unsigned)h) << 16); }
DI unsigned pk2(float a, float b) { f2_t v = {a, b}; bf2_t r = __builtin_convertvector(v, bf2_t); return __builtin_bit_cast(unsigned, r); }
DI u16 f2bf(float a) { return (u16)(pk2(a, 0.f) & 0xffffu); }
DI float lo2f(unsigned u) { return __uint_as_float(u << 16); }
DI float hi2f(unsigned u) { return __uint_as_float(u & 0xffff0000u); }
DI float wave_sum(float v) {
  v += __builtin_bit_cast(float, __builtin_amdgcn_update_dpp(0, __builtin_bit_cast(int, v), 0x128, 0xF, 0xF, false));
  v += __builtin_bit_cast(float, __builtin_amdgcn_update_dpp(0, __builtin_bit_cast(int, v), 0x124, 0xF, 0xF, false));
  v += __builtin_bit_cast(float, __builtin_amdgcn_update_dpp(0, __builtin_bit_cast(int, v), 0x122, 0xF, 0xF, false));
  v += __builtin_bit_cast(float, __builtin_amdgcn_update_dpp(0, __builtin_bit_cast(int, v), 0x121, 0xF, 0xF, false));
  const int iv = __builtin_bit_cast(int, v);
  const float s0 = __builtin_bit_cast(float, __builtin_amdgcn_readlane(iv, 0)), s1 = __builtin_bit_cast(float, __builtin_amdgcn_readlane(iv, 16));
  const float s2 = __builtin_bit_cast(float, __builtin_amdgcn_readlane(iv, 32)), s3 = __builtin_bit_cast(float, __builtin_amdgcn_readlane(iv, 48));
  return (s0 + s1) + (s2 + s3);
}
DI float xor32(float v) { return __shfl_xor(v, 32); }
DI int crow(int reg, int h) { return (reg & 3) + 8 * (reg >> 2) + 4 * h; }
DI float sigmoidf_(float x) { return __builtin_amdgcn_rcpf(1.f + __expf(-x)); }
DI float siluf_(float x) { return x * __builtin_amdgcn_rcpf(1.f + __expf(-x)); }
DI void rope_sincos(int pos, int i, float& s, float& c) {
  float ang = (float)pos * ROPE_INV[i];
  double rev = (double)ang * 0.15915494309189533577;
  double fr = rev - rint(rev);
  float f = (float)fr;
  s = __builtin_amdgcn_sinf(f);
  c = __builtin_amdgcn_cosf(f);
}
DI const float* xrow(const Params& p, int layer, int t) {
  if (layer == 0) return (t < NP) ? p.x_prompt + (size_t)t * 1024 : p.x_sample + (size_t)(t - NP) * 1024;
  return p.out + (size_t)t * 1024;
}
DI int tok_pos(int t) { return (t < NP) ? t : 4096 + ((t - NP) & 63); }

DI void conv_tile(const float* __restrict__ src, int N, u16* __restrict__ dst, int K, int k0, int n0, int kind, float* sm) {
  const int tid = tidx();
  const int nl = tid & 63, kb = tid >> 6;
  const int np_ = n0 + nl;
  int sc = np_;
  if (kind == 1) sc = (np_ < 416) ? np_ : ((np_ < 512) ? -1 : np_ - 96);
#pragma unroll
  for (int i = 0; i < 16; ++i) {
    const int kl = kb + 4 * i;
    float v = 0.f;
    if (sc >= 0) v = src[(size_t)(k0 + kl) * N + sc];
    sm[kl * 65 + nl] = v;
  }
  __syncthreads();
  const int nr = tid >> 2, kc = (tid & 3) * 16;
  unsigned o[8];
#pragma unroll
  for (int j = 0; j < 8; ++j) o[j] = pk2(sm[(kc + 2 * j) * 65 + nr], sm[(kc + 2 * j + 1) * 65 + nr]);
  uint4* d = (uint4*)(dst + (size_t)(n0 + nr) * K + k0 + kc);
  d[0] = make_uint4(o[0], o[1], o[2], o[3]);
  d[1] = make_uint4(o[4], o[5], o[6], o[7]);
  __syncthreads();
}

DI void phase_convert(const Params& p, char* smem) {
  float* sm = (float*)smem;
  for (int it = blockIdx.x; it < 4 * 1920; it += gridDim.x) {
    const int layer = it / 1920;
    int r = it % 1920;
    const float* src; u16* dst; int K, N, kind = 0, nt;
    char* wl = p.ws + (size_t)layer * WL_STRIDE;
    if (r < 1312) { src = p.w_in + (size_t)layer * 1024 * 5152; dst = (u16*)(wl + W_IN); K = 1024; N = 5152; kind = 1; nt = 82; }
    else if (r < 1360) { r -= 1312; src = p.w_uq + (size_t)layer * 256 * 768; dst = (u16*)(wl + W_UQ); K = 256; N = 768; nt = 12; }
    else if (r < 1392) { r -= 1360; src = p.w_ukv + (size_t)layer * 128 * 1024; dst = (u16*)(wl + W_UKV); K = 128; N = 1024; nt = 16; }
    else if (r < 1400) { r -= 1392; src = p.w2 + (size_t)layer * 64 * 512; dst = (u16*)(wl + W_W2); K = 64; N = 512; nt = 8; }
    else if (r < 1408) { r -= 1400; src = p.a2 + (size_t)layer * 64 * 512; dst = (u16*)(wl + W_A2); K = 64; N = 512; nt = 8; }
    else if (r < 1536) { r -= 1408; src = p.w_out_a + (size_t)layer * 512 * 1024; dst = (u16*)(wl + W_OA); K = 512; N = 1024; nt = 16; }
    else if (r < 1664) { r -= 1536; src = p.w_out_b + (size_t)layer * 512 * 1024; dst = (u16*)(wl + W_OB); K = 512; N = 1024; nt = 16; }
    else { r -= 1664; src = p.w_o + (size_t)layer * 1024 * 1024; dst = (u16*)(wl + W_O); K = 1024; N = 1024; nt = 16; }
    const int kt = r / nt, ntile = r % nt;
    conv_tile(src, N, dst, K, kt * 64, ntile * 64, kind, sm);
  }
}

DI void phase_rmsnorm(const Params& p, int layer) {
  const int wave = tidx() >> 6, lane = tidx() & 63;
  u16* H = (u16*)(p.ws + WS_H);
  const float* g = p.norm_w + layer * 1024;
  if (blockIdx.x == gridDim.x - 1) {
    u16* sh0 = (u16*)(p.ws + WS_SH0);
    for (int i = tidx(); i < 17 * SHW; i += 256) {
      const int r = i / SHW, c = i - r * SHW;
      sh0[i] = (r == 0) ? (u16)0 : f2bf(p.state_shift[((size_t)layer * 16 + (r - 1)) * SHW + c]);
    }
  }
  {
    const float* c1 = p.cache_ckv + (size_t)layer * 16 * 4096 * 128;
    const float* c2 = p.cache_kpe + (size_t)layer * 16 * 4096 * 32;
    u16* d1 = (u16*)(p.ws + WS_CKB);
    u16* d2 = (u16*)(p.ws + WS_KPB);
    constexpr int N1 = 16 * 4096 * 128 / 8, N2 = 16 * 4096 * 32 / 8;
    for (int i = blockIdx.x * 256 + tidx(); i < N1 + N2; i += gridDim.x * 256) {
      const float* sp = (i < N1) ? c1 + (size_t)i * 8 : c2 + (size_t)(i - N1) * 8;
      u16* dp = (i < N1) ? d1 + (size_t)i * 8 : d2 + (size_t)(i - N1) * 8;
      const f32x4 a = *(const f32x4*)sp, b = *(const f32x4*)(sp + 4);
      *(u32x4*)dp = u32x4{pk2(a.x, a.y), pk2(a.z, a.w), pk2(b.x, b.y), pk2(b.z, b.w)};
    }
  }
  for (int t = blockIdx.x * 4 + wave; t < NT; t += gridDim.x * 4) {
    const float* xr = xrow(p, layer, t);
    float4 v[4];
    float ss = 0.f;
#pragma unroll
    for (int i = 0; i < 4; ++i) {
      v[i] = *(const float4*)(xr + i * 256 + lane * 4);
      ss += v[i].x * v[i].x + v[i].y * v[i].y + v[i].z * v[i].z + v[i].w * v[i].w;
    }
    ss = wave_sum(ss);
    const float rinv = rsqrtf(ss * (1.f / 1024.f) + EPS);
#pragma unroll
    for (int i = 0; i < 4; ++i) {
      const float4 g4 = *(const float4*)(g + i * 256 + lane * 4);
      uint2 o;
      o.x = pk2(v[i].x * rinv * g4.x, v[i].y * rinv * g4.y);
      o.y = pk2(v[i].z * rinv * g4.z, v[i].w * rinv * g4.w);
      *(uint2*)(H + (size_t)t * 1024 + i * 256 + lane * 4) = o;
    }
  }
}

DI void gemm_mainloop(const u16* __restrict__ R, int ldr, const u16* __restrict__ C, int ldc, int K, char* smem, f32x16 (&acc)[2][2]) {
  const int tid = tidx(), lane = tid & 63, w = tid >> 6, wr = w >> 1, wc = w & 1;
  const int l31 = lane & 31, h = lane >> 5;
  const int lrow = tid >> 3, lkc = (tid & 7) * 8;
  u32x4 rr[4], rc[4];
  const int nk = K >> 6;
#pragma unroll
  for (int i = 0; i < 4; ++i) {
    rr[i] = *(const u32x4*)(R + (size_t)(lrow + 32 * i) * ldr + lkc);
    rc[i] = *(const u32x4*)(C + (size_t)(lrow + 32 * i) * ldc + lkc);
  }
  __syncthreads();
  {
    u16* sR = (u16*)smem;
    u16* sC = sR + 128 * 72;
#pragma unroll
    for (int i = 0; i < 4; ++i) {
      *(u32x4*)(sR + (lrow + 32 * i) * 72 + lkc) = rr[i];
      *(u32x4*)(sC + (lrow + 32 * i) * 72 + lkc) = rc[i];
    }
  }
  if (nk > 1) {
#pragma unroll
    for (int i = 0; i < 4; ++i) {
      rr[i] = *(const u32x4*)(R + (size_t)(lrow + 32 * i) * ldr + 64 + lkc);
      rc[i] = *(const u32x4*)(C + (size_t)(lrow + 32 * i) * ldc + 64 + lkc);
    }
  }
  __syncthreads();
  for (int kt = 0; kt < nk; ++kt) {
    const u16* sR = (const u16*)smem + (kt & 1) * (2 * 128 * 72);
    const u16* sC = sR + 128 * 72;
    if (kt + 1 < nk) {
      u16* nR = (u16*)smem + ((kt + 1) & 1) * (2 * 128 * 72);
      u16* nC = nR + 128 * 72;
#pragma unroll
      for (int i = 0; i < 4; ++i) {
        *(u32x4*)(nR + (lrow + 32 * i) * 72 + lkc) = rr[i];
        *(u32x4*)(nC + (lrow + 32 * i) * 72 + lkc) = rc[i];
      }
    }
    if (kt + 2 < nk) {
      const int k0 = (kt + 2) * 64;
#pragma unroll
      for (int i = 0; i < 4; ++i) {
        rr[i] = *(const u32x4*)(R + (size_t)(lrow + 32 * i) * ldr + k0 + lkc);
        rc[i] = *(const u32x4*)(C + (size_t)(lrow + 32 * i) * ldc + k0 + lkc);
      }
    }
#pragma unroll
    for (int ks = 0; ks < 4; ++ks) {
      bf16x8 a[2], b[2];
#pragma unroll
      for (int mi = 0; mi < 2; ++mi) a[mi] = *(const bf16x8*)(sR + (wr * 64 + mi * 32 + l31) * 72 + ks * 16 + h * 8);
#pragma unroll
      for (int ni = 0; ni < 2; ++ni) b[ni] = *(const bf16x8*)(sC + (wc * 64 + ni * 32 + l31) * 72 + ks * 16 + h * 8);
#pragma unroll
      for (int mi = 0; mi < 2; ++mi)
#pragma unroll
        for (int ni = 0; ni < 2; ++ni) acc[mi][ni] = MFMA32(a[mi], b[ni], acc[mi][ni]);
    }
    __syncthreads();
  }
}
DI void zero_acc(f32x16 (&acc)[2][2]) {
#pragma unroll
  for (int mi = 0; mi < 2; ++mi)
#pragma unroll
    for (int ni = 0; ni < 2; ++ni)
#pragma unroll
      for (int r = 0; r < 16; ++r) acc[mi][ni][r] = 0.f;
}
DI void acc_to_lds(const f32x16 (&acc)[2][2], char* smem) {
  float* sT = (float*)smem;
  const int lane = tidx() & 63, w = tidx() >> 6;
  const int l31 = lane & 31, h = lane >> 5, wr = w >> 1, wc = w & 1;
  __syncthreads();
#pragma unroll
  for (int mi = 0; mi < 2; ++mi)
#pragma unroll
    for (int ni = 0; ni < 2; ++ni)
#pragma unroll
      for (int reg = 0; reg < 16; ++reg) sT[(wr * 64 + mi * 32 + crow(reg, h)) * 132 + wc * 64 + ni * 32 + l31] = acc[mi][ni][reg];
  __syncthreads();
}
#define EPI_ROWS(...)                                                          \
  {                                                                            \
    const float* sT_ = (const float*)smem;                                     \
    _Pragma("unroll 2") for (int it_ = 0; it_ < 16; ++it_) {                   \
      const int row = it_ * 8 + (tidx() >> 5), col = (tidx() & 31) * 4; \
      const f32x4 v = *(const f32x4*)(sT_ + row * 132 + col);                  \
      __VA_ARGS__                                                              \
    }                                                                          \
  }

DI void gemm64_mainloop(const u16* __restrict__ R, int ldr, const u16* __restrict__ C, int ldc, int K, char* smem, f32x16& acc) {
  const int tid = tidx(), lane = tid & 63, w = tid >> 6, wr = w >> 1, wc = w & 1;
  const int l31 = lane & 31, h = lane >> 5;
  const int lrow = tid >> 3, lkc = (tid & 7) * 8;
  u32x4 rr[2][2], rc[2][2];
  const int nk = K >> 6;
#define G64_GLOAD(SET, KT)                                                                    \
  {                                                                                           \
    const int k0_ = (KT) * 64;                                                                \
    _Pragma("unroll") for (int i = 0; i < 2; ++i) {                                           \
      rr[SET][i] = *(const u32x4*)(R + (size_t)(lrow + 32 * i) * ldr + k0_ + lkc);            \
      rc[SET][i] = *(const u32x4*)(C + (size_t)(lrow + 32 * i) * ldc + k0_ + lkc);            \
    }                                                                                         \
  }
#define G64_LSTORE(SET, BUF)                                                                  \
  {                                                                                           \
    u16* nR_ = (u16*)smem + (BUF) * (2 * 64 * 72);                                            \
    u16* nC_ = nR_ + 64 * 72;                                                                 \
    _Pragma("unroll") for (int i = 0; i < 2; ++i) {                                           \
      *(u32x4*)(nR_ + (lrow + 32 * i) * 72 + lkc) = rr[SET][i];                               \
      *(u32x4*)(nC_ + (lrow + 32 * i) * 72 + lkc) = rc[SET][i];                               \
    }                                                                                         \
  }
  G64_GLOAD(0, 0)
  G64_GLOAD(1, 1)
  __syncthreads();
  G64_LSTORE(0, 0)
  G64_GLOAD(0, 2)
  __syncthreads();
  for (int kt0 = 0; kt0 < nk; kt0 += 2) {
#pragma unroll
    for (int u = 0; u < 2; ++u) {
      const int kt = kt0 + u;
      const u16* sR = (const u16*)smem + u * (2 * 64 * 72);
      const u16* sC = sR + 64 * 72;
      if (kt + 1 < nk) G64_LSTORE(1 - u, 1 - u)
      if (kt + 3 < nk) G64_GLOAD(1 - u, kt + 3)
#pragma unroll
      for (int ks = 0; ks < 4; ++ks) {
        const bf16x8 a = *(const bf16x8*)(sR + (wr * 32 + l31) * 72 + ks * 16 + h * 8);
        const bf16x8 b = *(const bf16x8*)(sC + (wc * 32 + l31) * 72 + ks * 16 + h * 8);
        acc = MFMA32(a, b, acc);
      }
      __syncthreads();
    }
  }
#undef G64_GLOAD
#undef G64_LSTORE
}
DI void acc64_to_lds(const f32x16& acc, char* smem) {
  float* sT = (float*)smem;
  const int lane = tidx() & 63, w = tidx() >> 6;
  const int l31 = lane & 31, h = lane >> 5, wr = w >> 1, wc = w & 1;
  __syncthreads();
#pragma unroll
  for (int reg = 0; reg < 16; ++reg) sT[(wr * 32 + crow(reg, h)) * 68 + wc * 32 + l31] = acc[reg];
  __syncthreads();
}
#define EPI64_ROWS(...)                                                        \
  {                                                                            \
    const float* sT_ = (const float*)smem;                                     \
    _Pragma("unroll") for (int it_ = 0; it_ < 4; ++it_) {                      \
      const int row = it_ * 16 + (tidx() >> 4), col = (tidx() & 15) * 4;       \
      const f32x4 v = *(const f32x4*)(sT_ + row * 68 + col);                   \
      __VA_ARGS__                                                              \
    }                                                                          \
  }

DI void phase_g1(const Params& p, int layer, char* smem) {
  const u16* H = (const u16*)(p.ws + WS_H);
  const u16* W = (const u16*)(p.ws + (size_t)layer * WL_STRIDE + W_IN);
  u16* Z = (u16*)(p.ws + WS_Z);
  const int xcd = blockIdx.x & 7, jb = blockIdx.x >> 3, nb = (gridDim.x + 7 - xcd) >> 3;
  for (int m = jb; m < 17 * 41; m += nb) {
    const int ft = m / 17, tt = xcd + 8 * (m % 17);
    f32x16 acc[2][2];
    zero_acc(acc);
    gemm_mainloop(H + (size_t)tt * 128 * 1024, 1024, W + (size_t)ft * 128 * 1024, 1024, 1024, smem, acc);
    acc_to_lds(acc, smem);
    EPI_ROWS({ *(u32x2*)(Z + (size_t)(tt * 128 + row) * NZ + ft * 128 + col) = u32x2{pk2(v.x, v.y), pk2(v.z, v.w)}; })
  }
}

DI void norms_token(const Params& p, int layer, int t, int lane) {
  const u16* zr = (const u16*)(p.ws + WS_Z) + (size_t)t * NZ;
  u16* CQN = (u16*)(p.ws + WS_H);
  u16* CKVB = (u16*)(p.ws + WS_CKVB);
  u16* KPEB = (u16*)(p.ws + WS_KPEB);
  {
    const uint2 raw = *(const uint2*)(zr + lane * 4);
    const float c0 = lo2f(raw.x), c1 = hi2f(raw.x), c2 = lo2f(raw.y), c3 = hi2f(raw.y);
    float ss = wave_sum(c0 * c0 + c1 * c1 + c2 * c2 + c3 * c3);
    const float rinv = rsqrtf(ss * (1.f / 256.f) + EPS);
    const float4 g = *(const float4*)(p.q_norm_w + layer * 256 + lane * 4);
    uint2 o;
    o.x = pk2(c0 * rinv * g.x, c1 * rinv * g.y);
    o.y = pk2(c2 * rinv * g.z, c3 * rinv * g.w);
    *(uint2*)(CQN + (size_t)t * 256 + lane * 4) = o;
  }
  {
    const unsigned raw = *(const unsigned*)(zr + ZC_KV + lane * 2);
    const float c0 = lo2f(raw), c1 = hi2f(raw);
    float ss = wave_sum(c0 * c0 + c1 * c1);
    const float rinv = rsqrtf(ss * (1.f / 128.f) + EPS);
    const float2 g = *(const float2*)(p.kv_norm_w + layer * 128 + lane * 2);
    const float o0 = c0 * rinv * g.x, o1 = c1 * rinv * g.y;
    float* dst = (t < NP) ? p.out + OFF_CKV_P + ((size_t)layer * NP + t) * 128 : p.out + OFF_CKV_S + ((size_t)layer * NSM + (t - NP)) * 128;
    *(float2*)(dst + lane * 2) = make_float2(o0, o1);
    *(unsigned*)(CKVB + (size_t)t * 128 + lane * 2) = pk2(o0, o1);
  }
  {
    float v = (lane < 32) ? bf2f(zr[ZC_KPE + lane]) : 0.f;
    float ss = wave_sum(v * v);
    const float rinv = rsqrtf(ss * (1.f / 32.f) + EPS);
    v = v * rinv * p.kn_rope[layer * 32 + (lane & 31)];
    const float pr = __shfl_xor(v, 16);
    float s, c;
    rope_sincos(tok_pos(t), lane & 15, s, c);
    const float o = ((lane & 16) == 0) ? (v * c - pr * s) : (v * c + pr * s);
    if (lane < 32) {
      float* dst = (t < NP) ? p.out + OFF_KPE_P + ((size_t)layer * NP + t) * 32 : p.out + OFF_KPE_S + ((size_t)layer * NSM + (t - NP)) * 32;
      dst[lane] = o;
      KPEB[(size_t)t * 32 + lane] = f2bf(o);
    }
  }
  float* sh = nullptr;
  if (t == NP - 1) sh = p.out + OFF_SH_P + (size_t)layer * SHW;
  else if (t >= NP && ((t - NP) & 63) == 63) sh = p.out + OFF_SH_S + ((size_t)layer * 16 + ((t - NP) >> 6)) * SHW;
  if (sh) {
#pragma unroll 1
    for (int c = lane; c < SHW; c += 64) sh[c] = bf2f(zr[ZC_ZS + c]);
  }
}

DI void zm4(const Params& p, int layer, int t, int c, float (&o)[4]) {
  const u16* zr = (const u16*)(p.ws + WS_Z) + (size_t)t * NZ + ZC_ZS + c;
  const u32x2 a = *(const u32x2*)zr;
  const bool first = (t < NP) ? (t == 0) : (((t - NP) & 63) == 0);
  const int srow = (t < NP) ? 0 : 1 + ((t - NP) >> 6);
  const u16* pr = first ? (const u16*)(p.ws + WS_SH0) + srow * SHW + c : zr - NZ;
  const u32x2 b = *(const u32x2*)pr;
  const f32x4 mu = *(const f32x4*)(p.mu_shift + layer * SHW + c);
  const float c0 = lo2f(a.x), c1 = hi2f(a.x), c2 = lo2f(a.y), c3 = hi2f(a.y);
  o[0] = c0 + (lo2f(b.x) - c0) * mu.x;
  o[1] = c1 + (hi2f(b.x) - c1) * mu.y;
  o[2] = c2 + (lo2f(b.y) - c2) * mu.z;
  o[3] = c3 + (hi2f(b.y) - c3) * mu.w;
}
DI float tanhf_(float x) {
  const float t = __expf(-2.f * fabsf(x));
  const float r = (1.f - t) * __builtin_amdgcn_rcpf(1.f + t);
  return x < 0.f ? -r : r;
}

constexpr int WPS = 900;
DI void zml(const u16* sz, int row, int col, const float* mu, float (&o)[4]) {
  const u32x2 a = *(const u32x2*)(sz + (row + 1) * WPS + col);
  const u32x2 b = *(const u32x2*)(sz + row * WPS + col);
  const f32x4 m4 = *(const f32x4*)mu;
  const float c0 = lo2f(a.x), c1 = hi2f(a.x), c2 = lo2f(a.y), c3 = hi2f(a.y);
  o[0] = c0 + (lo2f(b.x) - c0) * m4.x;
  o[1] = c1 + (hi2f(b.x) - c1) * m4.y;
  o[2] = c2 + (lo2f(b.y) - c2) * m4.z;
  o[3] = c3 + (hi2f(b.y) - c3) * m4.w;
}
DI void wkvprep_block(const Params& p, int layer, int tt, int hg, char* smem) {
  u16* sz = (u16*)smem;
  const int tid = tidx(), lane = tid & 63, w = tid >> 6, l31 = lane & 31, h = lane >> 5;
  const int t0 = tt * 32;
  const int hd = hg * 4 + w;
  const u16* Z = (const u16*)(p.ws + WS_Z);
  const bool seq_start = (t0 < NP) ? (t0 == 0) : (((t0 - NP) & 63) == 0);
  const u16* prevrow = seq_start ? (const u16*)(p.ws + WS_SH0) + ((t0 < NP) ? 0 : 1 + ((t0 - NP) >> 6)) * SHW : Z + (size_t)(t0 - 1) * NZ + ZC_ZS;
  __syncthreads();
  for (int ci = tid; ci < 33 * 112; ci += 256) {
    const int row = ci / 112, cc = ci - row * 112;
    int scol, lcol;
    if (cc < 16) { scol = 1536 + cc * 8; lcol = cc * 8; }
    else {
      const int j = cc - 16, ww = j / 24, r2 = j - ww * 24, part = r2 >> 3, o = (r2 & 7) * 8;
      scol = part * 512 + (hg * 4 + ww) * 64 + o;
      lcol = 128 + ww * 192 + part * 64 + o;
    }
    const u16* src = (row == 0) ? prevrow + scol : Z + (size_t)(t0 + row - 1) * NZ + ZC_ZS + scol;
    const u32x4 v = *(const u32x4*)src;
    u32x2* d = (u32x2*)(sz + row * WPS + lcol);
    d[0] = u32x2{v.x, v.y};
    d[1] = u32x2{v.z, v.w};
  }
  __syncthreads();
  const int tok = t0 + l31;
  const u16* W2T = (const u16*)(p.ws + (size_t)layer * WL_STRIDE + W_W2);
  const u16* A2T = (const u16*)(p.ws + (size_t)layer * WL_STRIDE + W_A2);
  const float* mu = p.mu_shift + layer * SHW;
  u16* WK = (u16*)(p.ws + WS_WKVIN) + ((size_t)hd * NT + tok) * 384;
  f32x16 accW[2], accA[2];
#pragma unroll
  for (int m = 0; m < 2; ++m)
#pragma unroll
    for (int r = 0; r < 16; ++r) { accW[m][r] = 0.f; accA[m][r] = 0.f; }
#pragma unroll
  for (int ks = 0; ks < 4; ++ks) {
    const int c0 = ks * 16 + 8 * h;
    float t0a[4], t1a[4], u0[4], u1[4];
    zml(sz, l31, c0, mu + 1536 + c0, t0a);
    zml(sz, l31, c0 + 4, mu + 1536 + c0 + 4, t1a);
    zml(sz, l31, 64 + c0, mu + 1600 + c0, u0);
    zml(sz, l31, 64 + c0 + 4, mu + 1600 + c0 + 4, u1);
    u32x4 bw, ba;
    bw.x = pk2(tanhf_(t0a[0]), tanhf_(t0a[1])); bw.y = pk2(tanhf_(t0a[2]), tanhf_(t0a[3]));
    bw.z = pk2(tanhf_(t1a[0]), tanhf_(t1a[1])); bw.w = pk2(tanhf_(t1a[2]), tanhf_(t1a[3]));
    ba.x = pk2(u0[0], u0[1]); ba.y = pk2(u0[2], u0[3]); ba.z = pk2(u1[0], u1[1]); ba.w = pk2(u1[2], u1[3]);
    const bf16x8 bwf = __builtin_bit_cast(bf16x8, bw), baf = __builtin_bit_cast(bf16x8, ba);
#pragma unroll
    for (int m = 0; m < 2; ++m) {
      const bf16x8 aw = *(const bf16x8*)(W2T + (size_t)(hd * 64 + m * 32 + l31) * 64 + ks * 16 + h * 8);
      const bf16x8 aa = *(const bf16x8*)(A2T + (size_t)(hd * 64 + m * 32 + l31) * 64 + ks * 16 + h * 8);
      accW[m] = MFMA32(aw, bwf, accW[m]);
      accA[m] = MFMA32(aa, baf, accA[m]);
    }
  }
  const int hb = 128 + w * 192;
  float ss = 0.f;
#pragma unroll
  for (int m = 0; m < 2; ++m)
#pragma unroll
    for (int q = 0; q < 4; ++q) {
      const int f0 = m * 32 + 8 * q + 4 * h, F = hd * 64 + f0;
      float k4[4];
      zml(sz, l31, hb + 64 + f0, mu + 512 + F, k4);
      const float4 kk_ = *(const float4*)(p.k_k + layer * 512 + F);
      const float a = k4[0] * kk_.x, b = k4[1] * kk_.y, c = k4[2] * kk_.z, d = k4[3] * kk_.w;
      ss += a * a + b * b + c * c + d * d;
    }
  ss += xor32(ss);
  const float rn = 1.f / fmaxf(sqrtf(ss), 1e-12f);
#pragma unroll
  for (int m = 0; m < 2; ++m)
#pragma unroll
    for (int q = 0; q < 4; ++q) {
      const int f0 = m * 32 + 8 * q + 4 * h, F = hd * 64 + f0;
      float r4[4], k4[4], v4[4];
      zml(sz, l31, hb + f0, mu + F, r4);
      zml(sz, l31, hb + 64 + f0, mu + 512 + F, k4);
      zml(sz, l31, hb + 128 + f0, mu + 1024 + F, v4);
      const float4 w0 = *(const float4*)(p.w0 + layer * 512 + F);
      const float4 a0 = *(const float4*)(p.a0 + layer * 512 + F);
      const float4 kk_ = *(const float4*)(p.k_k + layer * 512 + F);
      const float4 ka_ = *(const float4*)(p.k_a + layer * 512 + F);
      const float w0a[4] = {w0.x, w0.y, w0.z, w0.w}, a0a[4] = {a0.x, a0.y, a0.z, a0.w};
      const float kka[4] = {kk_.x, kk_.y, kk_.z, kk_.w}, kaa[4] = {ka_.x, ka_.y, ka_.z, ka_.w};
      float e4[4], kp4[4], kn4[4], b4[4];
#pragma unroll
      for (int j = 0; j < 4; ++j) {
        const float lw = w0a[j] + accW[m][4 * q + j];
        const float nx = -lw;
        const float sp = fmaxf(nx, 0.f) + __logf(1.f + __expf(-fabsf(nx)));
        e4[j] = __expf(-sp - 0.5f);
        const float a = sigmoidf_(a0a[j] + accA[m][4 * q + j]);
        kn4[j] = k4[j] * kka[j] * rn;
        b4[j] = kn4[j] * a;
        kp4[j] = k4[j] * (1.f + (a - 1.f) * kaa[j]);
      }
      *(u32x2*)(WK + 0 * 64 + f0) = u32x2{pk2(r4[0], r4[1]), pk2(r4[2], r4[3])};
      *(u32x2*)(WK + 1 * 64 + f0) = u32x2{pk2(e4[0] * -1.4426950408889634f, e4[1] * -1.4426950408889634f), pk2(e4[2] * -1.4426950408889634f, e4[3] * -1.4426950408889634f)};
      *(u32x2*)(WK + 2 * 64 + f0) = u32x2{pk2(kp4[0], kp4[1]), pk2(kp4[2], kp4[3])};
      *(u32x2*)(WK + 3 * 64 + f0) = u32x2{pk2(v4[0], v4[1]), pk2(v4[2], v4[3])};
      *(u32x2*)(WK + 4 * 64 + f0) = u32x2{pk2(-kn4[0], -kn4[1]), pk2(-kn4[2], -kn4[3])};
      *(u32x2*)(WK + 5 * 64 + f0) = u32x2{pk2(b4[0], b4[1]), pk2(b4[2], b4[3])};
    }
}

DI void qproj_item(const Params& p, int layer, int tt, int hd, int lane);
DI void kvproj_item(const Params& p, int layer, int tt, int hd, int lane);
DI void phase_norms_prep(const Params& p, int layer, char* smem, int* s_item) {
  int* ctr = (int*)(p.ws + WS_CTR) + 4 + layer;
  const int wave = tidx() >> 6, lane = tidx() & 63;
  for (;;) {
    __syncthreads();
    if (tidx() == 0) *s_item = atomicAdd(ctr, 1);
    __syncthreads();
    const int it = *s_item;
    if (it >= 1088 + 2112 + 272) break;
    if (it < 1088) { wkvprep_block(p, layer, it >> 1, it & 1, smem); continue; }
    if (it < 1088 + 2112) {
      const int wi = (it - 1088) * 4 + wave;
      if (wi < 544 * 8) qproj_item(p, layer, wi >> 3, wi & 7, lane);
      else { const int j = wi - 544 * 8; kvproj_item(p, layer, j >> 3, j & 7, lane); }
      continue;
    }
    const int tb = (it - 1088 - 2112) * 64 + wave * 16;
    for (int j = 0; j < 16; ++j) norms_token(p, layer, tb + j, lane);
  }
}

DI bf16x8 normed_frag(const u16* zsrc, const float* g, float& ssq) {
  const u32x4 raw = *(const u32x4*)zsrc;
  const f32x4 g0 = *(const f32x4*)g, g1 = *(const f32x4*)(g + 4);
  const float f0 = lo2f(raw.x), f1 = hi2f(raw.x), f2 = lo2f(raw.y), f3 = hi2f(raw.y);
  const float f4 = lo2f(raw.z), f5 = hi2f(raw.z), f6 = lo2f(raw.w), f7 = hi2f(raw.w);
  ssq += (f0 * f0 + f1 * f1) + (f2 * f2 + f3 * f3) + (f4 * f4 + f5 * f5) + (f6 * f6 + f7 * f7);
  const u32x4 o = {pk2(f0 * g0.x, f1 * g0.y), pk2(f2 * g0.z, f3 * g0.w), pk2(f4 * g1.x, f5 * g1.y), pk2(f6 * g1.z, f7 * g1.w)};
  return __builtin_bit_cast(bf16x8, o);
}
DI void qproj_item(const Params& p, int layer, int tt, int hd, int lane) {
  const int l31 = lane & 31, h = lane >> 5;
  const int tok = tt * 32 + l31;
  const u16* zq = (const u16*)(p.ws + WS_Z) + (size_t)tok * NZ;
  const float* gq = p.q_norm_w + layer * 256;
  float ssq = 0.f;
  const u16* WT = (const u16*)(p.ws + (size_t)layer * WL_STRIDE + W_UQ);
  u16* Q = (u16*)(p.ws + WS_Q);
  f32x16 acc[3];
#pragma unroll
  for (int m = 0; m < 3; ++m)
#pragma unroll
    for (int r = 0; r < 16; ++r) acc[m][r] = 0.f;
#pragma unroll 4
  for (int ks = 0; ks < 16; ++ks) {
    const bf16x8 bfr = normed_frag(zq + ks * 16 + h * 8, gq + ks * 16 + h * 8, ssq);
#pragma unroll
    for (int m = 0; m < 3; ++m) {
      const bf16x8 afr = *(const bf16x8*)(WT + (size_t)(hd * 96 + m * 32 + l31) * 256 + ks * 16 + h * 8);
      acc[m] = MFMA32(afr, bfr, acc[m]);
    }
  }
  {
    ssq += xor32(ssq);
    const float rinv = rsqrtf(ssq * (1.f / 256.f) + EPS);
#pragma unroll
    for (int m = 0; m < 3; ++m)
#pragma unroll
      for (int r = 0; r < 16; ++r) acc[m][r] *= rinv;
  }
  const float qs = 0.10206207261596577f * 1.4426950408889634f;
  float ss = 0.f;
#pragma unroll
  for (int m = 0; m < 2; ++m)
#pragma unroll
    for (int r = 0; r < 16; ++r) ss += acc[m][r] * acc[m][r];
  ss += xor32(ss);
  const float rn = rsqrtf(ss * (1.f / 64.f) + EPS) * qs;
  u16* qd = Q + (size_t)tok * 768 + hd * 96;
#pragma unroll
  for (int m = 0; m < 2; ++m)
#pragma unroll
    for (int q = 0; q < 4; ++q) {
      const int f0 = m * 32 + 8 * q + 4 * h;
      const float4 g = *(const float4*)(p.qn_nope + layer * 64 + f0);
      *(uint2*)(qd + f0) = make_uint2(pk2(acc[m][4 * q] * rn * g.x, acc[m][4 * q + 1] * rn * g.y), pk2(acc[m][4 * q + 2] * rn * g.z, acc[m][4 * q + 3] * rn * g.w));
    }
  float sr = 0.f;
#pragma unroll
  for (int r = 0; r < 16; ++r) sr += acc[2][r] * acc[2][r];
  sr += xor32(sr);
  const float rr = rsqrtf(sr * (1.f / 32.f) + EPS);
  const int pos = tok_pos(tok);
  float o1[8], o2[8];
#pragma unroll
  for (int r = 0; r < 8; ++r) {
    const int i = crow(r, h);
    const float x1 = acc[2][r] * rr * p.qn_rope[layer * 32 + i];
    const float x2 = acc[2][r + 8] * rr * p.qn_rope[layer * 32 + i + 16];
    float s, c;
    rope_sincos(pos, i, s, c);
    o1[r] = (x1 * c - x2 * s) * qs;
    o2[r] = (x2 * c + x1 * s) * qs;
  }
#pragma unroll
  for (int q = 0; q < 2; ++q) {
    const int i0 = 8 * q + 4 * h;
    *(uint2*)(qd + 64 + i0) = make_uint2(pk2(o1[4 * q], o1[4 * q + 1]), pk2(o1[4 * q + 2], o1[4 * q + 3]));
    *(uint2*)(qd + 64 + 16 + i0) = make_uint2(pk2(o2[4 * q], o2[4 * q + 1]), pk2(o2[4 * q + 2], o2[4 * q + 3]));
  }
}

DI void kvproj_item(const Params& p, int layer, int tt, int hd, int lane) {
  const int l31 = lane & 31, h = lane >> 5;
  const int tok = tt * 32 + l31;
  const u16* zk = (const u16*)(p.ws + WS_Z) + (size_t)tok * NZ + ZC_KV;
  const float* gk = p.kv_norm_w + layer * 128;
  float ssq = 0.f;
  const u16* WT = (const u16*)(p.ws + (size_t)layer * WL_STRIDE + W_UKV);
  u16* KN = (u16*)(p.ws + WS_KN);
  u16* VT = (u16*)(p.ws + WS_VT);
  f32x16 acc[4];
#pragma unroll
  for (int m = 0; m < 4; ++m)
#pragma unroll
    for (int r = 0; r < 16; ++r) acc[m][r] = 0.f;
#pragma unroll 4
  for (int ks = 0; ks < 8; ++ks) {
    const bf16x8 bfr = normed_frag(zk + ks * 16 + h * 8, gk + ks * 16 + h * 8, ssq);
#pragma unroll
    for (int m = 0; m < 4; ++m) {
      const bf16x8 afr = *(const bf16x8*)(WT + (size_t)(hd * 128 + m * 32 + l31) * 128 + ks * 16 + h * 8);
      acc[m] = MFMA32(afr, bfr, acc[m]);
    }
  }
  {
    ssq += xor32(ssq);
    const float rinv = rsqrtf(ssq * (1.f / 128.f) + EPS);
#pragma unroll
    for (int m = 0; m < 4; ++m)
#pragma unroll
      for (int r = 0; r < 16; ++r) acc[m][r] *= rinv;
  }
  float ss = 0.f;
#pragma unroll
  for (int m = 0; m < 2; ++m)
#pragma unroll
    for (int r = 0; r < 16; ++r) ss += acc[m][r] * acc[m][r];
  ss += xor32(ss);
  const float rn = rsqrtf(ss * (1.f / 64.f) + EPS);
  u16* kd = KN + ((size_t)hd * NP + tok) * 64;
#pragma unroll
  for (int m = 0; m < 2; ++m)
#pragma unroll
    for (int q = 0; q < 4; ++q) {
      const int f0 = m * 32 + 8 * q + 4 * h;
      const float4 g = *(const float4*)(p.kn_nope + layer * 64 + f0);
      *(uint2*)(kd + f0) = make_uint2(pk2(acc[m][4 * q] * rn * g.x, acc[m][4 * q + 1] * rn * g.y), pk2(acc[m][4 * q + 2] * rn * g.z, acc[m][4 * q + 3] * rn * g.w));
    }
#pragma unroll
  for (int m = 0; m < 2; ++m)
#pragma unroll
    for (int r = 0; r < 16; ++r) {
      const int d = m * 32 + crow(r, h);
      VT[((size_t)hd * 64 + d) * NP + tok] = f2bf(acc[2 + m][r]);
    }
}

DI void phase_proj(const Params& p, int layer) {
  const int wave = tidx() >> 6, lane = tidx() & 63;
  const int nw = gridDim.x * 4, gw = blockIdx.x * 4 + wave;
  for (int it = gw; it < 544 * 8 + 512 * 8; it += nw) {
    if (it < 544 * 8) qproj_item(p, layer, it >> 3, it & 7, lane);
    else { const int j = it - 544 * 8; kvproj_item(p, layer, j >> 3, j & 7, lane); }
  }
}

DI float wave_max(float v) {
#pragma unroll
  for (int o = 32; o > 0; o >>= 1) v = fmaxf(v, __shfl_xor(v, o));
  return v;
}
DI float attn_bound(const Params& p, int layer, int lane) {
  const float gqn = wave_max(fabsf(p.qn_nope[layer * 64 + lane])), gkn = wave_max(fabsf(p.kn_nope[layer * 64 + lane]));
  const float gqr = wave_max(fabsf(p.qn_rope[layer * 32 + (lane & 31)])), gkr = wave_max(fabsf(p.kn_rope[layer * 32 + (lane & 31)]));
  const float qs = 0.10206207261596577f * 1.4426950408889634f;
  return 1.02f * qs * (64.f * gqn * gkn + 32.f * gqr * gkr) + 0.25f;
}
template <int NSUB>
DI void attn_tile(const bf16x8 (&qf)[6], const u16* sK, const u16* sVT, int ksub0, f32x16 (&o)[2], float& l, float negB, int l31, int h) {
  f32x16 s[NSUB];
  {
    bf16x8 kf[NSUB][6];
#pragma unroll
    for (int i = 0; i < NSUB; ++i)
#pragma unroll
      for (int ks = 0; ks < 6; ++ks) kf[i][ks] = *(const bf16x8*)(sK + ((ksub0 + i) * 32 + l31) * 104 + ks * 16 + h * 8);
#pragma unroll
    for (int i = 0; i < NSUB; ++i) {
#pragma unroll
      for (int r = 0; r < 16; ++r) s[i][r] = negB;
#pragma unroll
      for (int ks = 0; ks < 6; ++ks) s[i] = MFMA32(kf[i][ks], qf[ks], s[i]);
    }
    __builtin_amdgcn_sched_group_barrier(0x100, 6 * NSUB, 0);
    __builtin_amdgcn_sched_group_barrier(0x008, 6 * NSUB, 0);
  }
  bf16x8 vf[NSUB][2][2];
#pragma unroll
  for (int i = 0; i < NSUB; ++i)
#pragma unroll
    for (int st = 0; st < 2; ++st)
#pragma unroll
      for (int md = 0; md < 2; ++md) {
        const u16* vp = sVT + (md * 32 + l31) * 68 + (ksub0 + i) * 32 + 16 * st + 4 * h;
        const s16x4 lo = *(const s16x4*)vp;
        const s16x4 hi = *(const s16x4*)(vp + 8);
        vf[i][st][md] = __builtin_shufflevector(lo, hi, 0, 1, 2, 3, 4, 5, 6, 7);
      }
  float ps = 0.f;
#pragma unroll
  for (int i = 0; i < NSUB; ++i)
#pragma unroll
    for (int r = 0; r < 16; ++r) {
      const float pv = __builtin_amdgcn_exp2f(s[i][r]);
      ps += pv;
      s[i][r] = pv;
    }
  l += ps;
#pragma unroll
  for (int i = 0; i < NSUB; ++i)
#pragma unroll
    for (int st = 0; st < 2; ++st) {
      u32x4 pu;
      pu.x = pk2(s[i][8 * st + 0], s[i][8 * st + 1]);
      pu.y = pk2(s[i][8 * st + 2], s[i][8 * st + 3]);
      pu.z = pk2(s[i][8 * st + 4], s[i][8 * st + 5]);
      pu.w = pk2(s[i][8 * st + 6], s[i][8 * st + 7]);
      const bf16x8 pf = __builtin_bit_cast(bf16x8, pu);
#pragma unroll
      for (int md = 0; md < 2; ++md) o[md] = MFMA32(vf[i][st][md], pf, o[md]);
    }
}

DI void attn_store(const Params& p, int tok, int hd, const f32x16 (&o)[2], float linv, int h) {
  const u16* gz = (const u16*)(p.ws + WS_Z) + (size_t)tok * NZ + ZC_GA + hd * 64;
  u16* OA = (u16*)(p.ws + WS_OA) + (size_t)tok * 512 + hd * 64;
#pragma unroll
  for (int md = 0; md < 2; ++md)
#pragma unroll
    for (int q = 0; q < 4; ++q) {
      const int d0 = md * 32 + 8 * q + 4 * h;
      const uint2 g = *(const uint2*)(gz + d0);
      const float v0 = o[md][4 * q] * linv * siluf_(lo2f(g.x));
      const float v1 = o[md][4 * q + 1] * linv * siluf_(hi2f(g.x));
      const float v2 = o[md][4 * q + 2] * linv * siluf_(lo2f(g.y));
      const float v3 = o[md][4 * q + 3] * linv * siluf_(hi2f(g.y));
      *(uint2*)(OA + d0) = make_uint2(pk2(v0, v1), pk2(v2, v3));
    }
}

DI void attn_prompt_item(const Params& p, int layer, int qt, int hd, char* smem) {
  u16* sK = (u16*)smem;
  u16* sVT = (u16*)(smem + 13312);
  const int tid = tidx(), lane = tid & 63, w = tid >> 6, l31 = lane & 31, h = lane >> 5;
  const int tok = qt * 128 + w * 32 + l31;
  const u16* Q = (const u16*)(p.ws + WS_Q);
  const u16* KN = (const u16*)(p.ws + WS_KN) + (size_t)hd * NP * 64;
  const u16* KPEB = (const u16*)(p.ws + WS_KPEB);
  const u16* VT = (const u16*)(p.ws + WS_VT) + (size_t)hd * 64 * NP;
  bf16x8 qf[6];
#pragma unroll
  for (int ks = 0; ks < 6; ++ks) qf[ks] = *(const bf16x8*)(Q + (size_t)tok * 768 + hd * 96 + ks * 16 + h * 8);
  f32x16 o[2];
#pragma unroll
  for (int d = 0; d < 2; ++d)
#pragma unroll
    for (int r = 0; r < 16; ++r) o[d][r] = 0.f;
  float l = 0.f;
  const float negB = -attn_bound(p, layer, lane);
  const int nkt = 2 * qt + 2;
  const int my_nkt = (w < 2) ? nkt - 1 : nkt;
  u32x4 pk[2][2], pr[2], pv[2][2];
#define PA_GLOAD(SET, KT)                                                                        \
  {                                                                                              \
    const int key0_ = (KT) * 64;                                                                 \
    _Pragma("unroll") for (int i = 0; i < 2; ++i) {                                              \
      const int c = tid + 256 * i;                                                               \
      pk[SET][i] = *(const u32x4*)(KN + (size_t)(key0_ + (c >> 3)) * 64 + (c & 7) * 8);          \
      pv[SET][i] = *(const u32x4*)(VT + (size_t)(c >> 3) * NP + key0_ + (c & 7) * 8);            \
    }                                                                                            \
    pr[SET] = *(const u32x4*)(KPEB + (size_t)(key0_ + (tid >> 2)) * 32 + (tid & 3) * 8);         \
  }
  PA_GLOAD(0, 0)
  PA_GLOAD(1, 1)
  for (int kt0 = 0; kt0 < nkt; kt0 += 2) {
#pragma unroll
    for (int u = 0; u < 2; ++u) {
      const int kt = kt0 + u;
      __syncthreads();
#pragma unroll
      for (int i = 0; i < 2; ++i) {
        const int c = tid + 256 * i;
        *(u32x4*)(sK + (c >> 3) * 104 + (c & 7) * 8) = pk[u][i];
        u32x2* vd = (u32x2*)(sVT + (c >> 3) * 68 + (c & 7) * 8);
        vd[0] = u32x2{pv[u][i].x, pv[u][i].y};
        vd[1] = u32x2{pv[u][i].z, pv[u][i].w};
      }
      *(u32x4*)(sK + (tid >> 2) * 104 + 64 + (tid & 3) * 8) = pr[u];
      __syncthreads();
      if (kt + 2 < nkt) PA_GLOAD(u, kt + 2)
      if (kt < my_nkt) attn_tile<2>(qf, sK, sVT, 0, o, l, negB, l31, h);
    }
  }
#undef PA_GLOAD
  l += xor32(l);
  attn_store(p, tok, hd, o, 1.f / l, h);
}

DI void attn_sample_item(const Params& p, int layer, int b, int hd, char* smem) {
  u16* sC = (u16*)smem;
  u16* sK = (u16*)(smem + 17408);
  u16* sVT = (u16*)(smem + 17408 + 13312);
  u16* sW = (u16*)(smem + 39424);
  const int tid = tidx(), lane = tid & 63, w = tid >> 6, l31 = lane & 31, h = lane >> 5;
  const int khu = w & 1, part = w >> 1;
  const int qh = w >> 1, kh = w & 1;
  const int tok = NP + b * 64 + qh * 32 + l31;
  const u16* Q = (const u16*)(p.ws + WS_Q);
  const u16* WT = (const u16*)(p.ws + (size_t)layer * WL_STRIDE + W_UKV) + (size_t)hd * 128 * 128;
  __syncthreads();
#pragma unroll
  for (int i = 0; i < 8; ++i) {
    const int c = tid + 256 * i;
    *(u32x4*)(sW + (c >> 4) * 136 + (c & 15) * 8) = *(const u32x4*)(WT + (size_t)c * 8);
  }
  bf16x8 qf[6];
#pragma unroll
  for (int ks = 0; ks < 6; ++ks) qf[ks] = *(const bf16x8*)(Q + (size_t)tok * 768 + hd * 96 + ks * 16 + h * 8);
  f32x16 o[2];
#pragma unroll
  for (int d = 0; d < 2; ++d)
#pragma unroll
    for (int r = 0; r < 16; ++r) o[d][r] = 0.f;
  float l = 0.f;
  const float negB = -attn_bound(p, layer, lane);
  const u16* cck = (const u16*)(p.ws + WS_CKB) + (size_t)b * 4096 * 128;
  const u16* ckp = (const u16*)(p.ws + WS_KPB) + (size_t)b * 4096 * 32;
  const u16* nck = (const u16*)(p.ws + WS_CKVB) + (size_t)(NP + b * 64) * 128;
  const u16* nkp = (const u16*)(p.ws + WS_KPEB) + (size_t)(NP + b * 64) * 32;
  u32x4 pc[4], pp;
#define SA_GLOAD(KT)                                                                      \
  {                                                                                       \
    const u16* s1_ = ((KT) < 64) ? cck + (size_t)(KT) * 64 * 128 : nck;                   \
    const u16* s2_ = ((KT) < 64) ? ckp + (size_t)(KT) * 64 * 32 : nkp;                    \
    _Pragma("unroll") for (int i = 0; i < 4; ++i) pc[i] = *(const u32x4*)(s1_ + (size_t)(tid + 256 * i) * 8); \
    pp = *(const u32x4*)(s2_ + (size_t)tid * 8);                                          \
  }
  SA_GLOAD(0)
  for (int kt = 0; kt < 65; ++kt) {
    __syncthreads();
#pragma unroll
    for (int i = 0; i < 4; ++i) {
      const int c = tid + 256 * i;
      *(u32x4*)(sC + (c >> 4) * 136 + (c & 15) * 8) = pc[i];
    }
    *(u32x4*)(sK + (tid >> 2) * 104 + 64 + (tid & 3) * 8) = pp;
    __syncthreads();
    if (kt + 1 < 65) SA_GLOAD(kt + 1)
    {
      f32x16 acc[2];
#pragma unroll
      for (int mt = 0; mt < 2; ++mt)
#pragma unroll
        for (int r = 0; r < 16; ++r) acc[mt][r] = 0.f;
      bf16x8 cfa[8];
#pragma unroll
      for (int ks = 0; ks < 8; ++ks) cfa[ks] = *(const bf16x8*)(sC + (khu * 32 + l31) * 136 + ks * 16 + h * 8);
#pragma unroll
      for (int mt = 0; mt < 2; ++mt) {
        bf16x8 wfa[8];
#pragma unroll
        for (int ks = 0; ks < 8; ++ks) wfa[ks] = *(const bf16x8*)(sW + (part * 64 + mt * 32 + l31) * 136 + ks * 16 + h * 8);
#pragma unroll
        for (int ks = 0; ks < 8; ++ks) {
          if (part == 0) acc[mt] = MFMA32(wfa[ks], cfa[ks], acc[mt]);
          else acc[mt] = MFMA32(cfa[ks], wfa[ks], acc[mt]);
        }
      }
      if (part == 0) {
        float ss = 0.f;
#pragma unroll
        for (int mt = 0; mt < 2; ++mt)
#pragma unroll
          for (int r = 0; r < 16; ++r) ss += acc[mt][r] * acc[mt][r];
        ss += xor32(ss);
        const float rn = rsqrtf(ss * (1.f / 64.f) + EPS);
#pragma unroll
        for (int mt = 0; mt < 2; ++mt)
#pragma unroll
          for (int q = 0; q < 4; ++q) {
            const int f0 = mt * 32 + 8 * q + 4 * h;
            const float4 g = *(const float4*)(p.kn_nope + layer * 64 + f0);
            *(u32x2*)(sK + (khu * 32 + l31) * 104 + f0) = u32x2{pk2(acc[mt][4 * q] * rn * g.x, acc[mt][4 * q + 1] * rn * g.y), pk2(acc[mt][4 * q + 2] * rn * g.z, acc[mt][4 * q + 3] * rn * g.w)};
          }
      } else {
#pragma unroll
        for (int mt = 0; mt < 2; ++mt)
#pragma unroll
          for (int q = 0; q < 4; ++q)
            *(u32x2*)(sVT + (mt * 32 + l31) * 68 + khu * 32 + 8 * q + 4 * h) =
                u32x2{pk2(acc[mt][4 * q], acc[mt][4 * q + 1]), pk2(acc[mt][4 * q + 2], acc[mt][4 * q + 3])};
      }
    }
    __syncthreads();
    attn_tile<1>(qf, sK, sVT, kh, o, l, negB, l31, h);
  }
#undef SA_GLOAD
  __syncthreads();
  float* cb = (float*)smem;
  if (kh == 1) {
    float* d = cb + (qh * 64 + lane) * 34;
#pragma unroll
    for (int r = 0; r < 16; ++r) { d[r] = o[0][r]; d[16 + r] = o[1][r]; }
    d[32] = l;
  }
  __syncthreads();
  if (kh == 0) {
    const float* d = cb + (qh * 64 + lane) * 34;
#pragma unroll
    for (int r = 0; r < 16; ++r) { o[0][r] += d[r]; o[1][r] += d[16 + r]; }
    l += d[32];
    l += xor32(l);
    attn_store(p, tok, hd, o, 1.f / l, h);
  }
}

template <int N> DI void fmac_bc(float& acc, float srcvec, float other) {
  asm("v_fmac_f32_dpp %0, %1, %2 row_newbcast:%3 row_mask:0xf bank_mask:0xf" : "+v"(acc) : "v"(srcvec), "v"(other), "n"(N));
}
template <int N> DI float mul_bc(float srcvec, float other) {
  float r;
  asm("v_mul_f32_dpp %0, %1, %2 row_newbcast:%3 row_mask:0xf bank_mask:0xf" : "=v"(r) : "v"(srcvec), "v"(other), "n"(N));
  return r;
}
struct RplRaw { u32x2 r, e, k, a, b; unsigned v; };
template <int MODE> DI void rpl_load(RplRaw& q, const u16* s, int n, int lane) {
  q.e = *(const u32x2*)(s + 64 + 4 * n);
  q.a = *(const u32x2*)(s + 256 + 4 * n);
  q.b = *(const u32x2*)(s + 320 + 4 * n);
  if (MODE >= 1) { q.k = *(const u32x2*)(s + 128 + 4 * n); q.v = s[192 + lane]; }
  if (MODE == 2) q.r = *(const u32x2*)(s + 4 * n);
}
template <int MODE>
DI void rpl_item(const Params& p, int hd, int tok0, int nsteps, const float* Sinit, float* Sout, float* Yg, int lane) {
  const int n = lane & 15;
  float S[64];
  if (MODE == 0) {
#pragma unroll
    for (int k = 0; k < 64; ++k) S[k] = (k == lane) ? 1.f : 0.f;
  } else if (MODE == 1) {
#pragma unroll
    for (int k = 0; k < 64; ++k) S[k] = 0.f;
  } else {
#pragma unroll
    for (int k = 0; k < 64; k += 4) {
      const f32x4 t = *(const f32x4*)(Sinit + (size_t)lane * 64 + k);
      S[k] = t.x; S[k + 1] = t.y; S[k + 2] = t.z; S[k + 3] = t.w;
    }
  }
  const u16* src = (const u16*)(p.ws + WS_WKVIN) + ((size_t)hd * NT + tok0) * 384;
  float C0 = 1.f, C1 = 1.f, C2 = 1.f, C3 = 1.f;
  RplRaw c0, c1, c2;
  rpl_load<MODE>(c0, src, n, lane);
  rpl_load<MODE>(c1, src + 384, n, lane);
  for (int t = 0; t < nsteps; ++t) {
    if (t + 2 < nsteps) rpl_load<MODE>(c2, src + (size_t)(t + 2) * 384, n, lane);
    float A0 = lo2f(c0.a.x), A1 = hi2f(c0.a.x), A2 = lo2f(c0.a.y), A3 = hi2f(c0.a.y);
    float W0 = __builtin_amdgcn_exp2f(lo2f(c0.e.x)), W1 = __builtin_amdgcn_exp2f(hi2f(c0.e.x)), W2 = __builtin_amdgcn_exp2f(lo2f(c0.e.y)), W3 = __builtin_amdgcn_exp2f(hi2f(c0.e.y));
    float B0 = lo2f(c0.b.x), B1 = hi2f(c0.b.x), B2 = lo2f(c0.b.y), B3 = hi2f(c0.b.y);
    float K0 = 0.f, K1 = 0.f, K2 = 0.f, K3 = 0.f, R0 = 0.f, R1 = 0.f, R2 = 0.f, R3 = 0.f, vv = 0.f;
    if (MODE >= 1) { K0 = lo2f(c0.k.x); K1 = hi2f(c0.k.x); K2 = lo2f(c0.k.y); K3 = hi2f(c0.k.y); vv = lo2f(c0.v); }
    if (MODE == 2) { R0 = lo2f(c0.r.x); R1 = hi2f(c0.r.x); R2 = lo2f(c0.r.y); R3 = hi2f(c0.r.y); }
    A0 *= C0; A1 *= C1; A2 *= C2; A3 *= C3;
    C0 *= W0; C1 *= W1; C2 *= W2; C3 *= W3;
    {
      const float i0 = __builtin_amdgcn_rcpf(C0), i1 = __builtin_amdgcn_rcpf(C1), i2 = __builtin_amdgcn_rcpf(C2), i3 = __builtin_amdgcn_rcpf(C3);
      B0 *= i0; B1 *= i1; B2 *= i2; B3 *= i3;
      if (MODE >= 1) { K0 *= i0; K1 *= i1; K2 *= i2; K3 *= i3; }
      if (MODE == 2) { R0 *= C0; R1 *= C1; R2 *= C2; R3 *= C3; }
    }
    W0 = C0; W1 = C1; W2 = C2; W3 = C3;
    asm volatile("s_nop 1" : "+v"(A0), "+v"(A1), "+v"(A2), "+v"(A3), "+v"(W0), "+v"(W1), "+v"(W2), "+v"(W3), "+v"(B0), "+v"(B1), "+v"(B2), "+v"(B3));
    asm volatile("s_nop 1" : "+v"(K0), "+v"(K1), "+v"(K2), "+v"(K3), "+v"(R0), "+v"(R1), "+v"(R2), "+v"(R3));
    float sa0 = 0.f, sa1 = 0.f, sa2 = 0.f, sa3 = 0.f;
    fmac_bc<0>(sa0, A0, S[0]);
    fmac_bc<0>(sa1, A1, S[1]);
    fmac_bc<0>(sa2, A2, S[2]);
    fmac_bc<0>(sa3, A3, S[3]);
    fmac_bc<1>(sa0, A0, S[4]);
    fmac_bc<1>(sa1, A1, S[5]);
    fmac_bc<1>(sa2, A2, S[6]);
    fmac_bc<1>(sa3, A3, S[7]);
    fmac_bc<2>(sa0, A0, S[8]);
    fmac_bc<2>(sa1, A1, S[9]);
    fmac_bc<2>(sa2, A2, S[10]);
    fmac_bc<2>(sa3, A3, S[11]);
    fmac_bc<3>(sa0, A0, S[12]);
    fmac_bc<3>(sa1, A1, S[13]);
    fmac_bc<3>(sa2, A2, S[14]);
    fmac_bc<3>(sa3, A3, S[15]);
    fmac_bc<4>(sa0, A0, S[16]);
    fmac_bc<4>(sa1, A1, S[17]);
    fmac_bc<4>(sa2, A2, S[18]);
    fmac_bc<4>(sa3, A3, S[19]);
    fmac_bc<5>(sa0, A0, S[20]);
    fmac_bc<5>(sa1, A1, S[21]);
    fmac_bc<5>(sa2, A2, S[22]);
    fmac_bc<5>(sa3, A3, S[23]);
    fmac_bc<6>(sa0, A0, S[24]);
    fmac_bc<6>(sa1, A1, S[25]);
    fmac_bc<6>(sa2, A2, S[26]);
    fmac_bc<6>(sa3, A3, S[27]);
    fmac_bc<7>(sa0, A0, S[28]);
    fmac_bc<7>(sa1, A1, S[29]);
    fmac_bc<7>(sa2, A2, S[30]);
    fmac_bc<7>(sa3, A3, S[31]);
    fmac_bc<8>(sa0, A0, S[32]);
    fmac_bc<8>(sa1, A1, S[33]);
    fmac_bc<8>(sa2, A2, S[34]);
    fmac_bc<8>(sa3, A3, S[35]);
    fmac_bc<9>(sa0, A0, S[36]);
    fmac_bc<9>(sa1, A1, S[37]);
    fmac_bc<9>(sa2, A2, S[38]);
    fmac_bc<9>(sa3, A3, S[39]);
    fmac_bc<10>(sa0, A0, S[40]);
    fmac_bc<10>(sa1, A1, S[41]);
    fmac_bc<10>(sa2, A2, S[42]);
    fmac_bc<10>(sa3, A3, S[43]);
    fmac_bc<11>(sa0, A0, S[44]);
    fmac_bc<11>(sa1, A1, S[45]);
    fmac_bc<11>(sa2, A2, S[46]);
    fmac_bc<11>(sa3, A3, S[47]);
    fmac_bc<12>(sa0, A0, S[48]);
    fmac_bc<12>(sa1, A1, S[49]);
    fmac_bc<12>(sa2, A2, S[50]);
    fmac_bc<12>(sa3, A3, S[51]);
    fmac_bc<13>(sa0, A0, S[52]);
    fmac_bc<13>(sa1, A1, S[53]);
    fmac_bc<13>(sa2, A2, S[54]);
    fmac_bc<13>(sa3, A3, S[55]);
    fmac_bc<14>(sa0, A0, S[56]);
    fmac_bc<14>(sa1, A1, S[57]);
    fmac_bc<14>(sa2, A2, S[58]);
    fmac_bc<14>(sa3, A3, S[59]);
    fmac_bc<15>(sa0, A0, S[60]);
    fmac_bc<15>(sa1, A1, S[61]);
    fmac_bc<15>(sa2, A2, S[62]);
    fmac_bc<15>(sa3, A3, S[63]);
    const float sa = (sa0 + sa1) + (sa2 + sa3);
    float y0 = 0.f, y1 = 0.f, y2 = 0.f, y3 = 0.f;
    if (MODE >= 1) {
      fmac_bc<0>(S[0], K0, vv);
      fmac_bc<0>(S[1], K1, vv);
      fmac_bc<0>(S[2], K2, vv);
      fmac_bc<0>(S[3], K3, vv);
      fmac_bc<1>(S[4], K0, vv);
      fmac_bc<1>(S[5], K1, vv);
      fmac_bc<1>(S[6], K2, vv);
      fmac_bc<1>(S[7], K3, vv);
    }
    fmac_bc<0>(S[0], B0, sa);
    fmac_bc<0>(S[1], B1, sa);
    fmac_bc<0>(S[2], B2, sa);
    fmac_bc<0>(S[3], B3, sa);
    fmac_bc<1>(S[4], B0, sa);
    fmac_bc<1>(S[5], B1, sa);
    fmac_bc<1>(S[6], B2, sa);
    fmac_bc<1>(S[7], B3, sa);
    if (MODE == 2) {
      fmac_bc<0>(y0, R0, S[0]);
      fmac_bc<0>(y1, R1, S[1]);
      fmac_bc<0>(y2, R2, S[2]);
      fmac_bc<0>(y3, R3, S[3]);
      fmac_bc<1>(y0, R0, S[4]);
      fmac_bc<1>(y1, R1, S[5]);
      fmac_bc<1>(y2, R2, S[6]);
      fmac_bc<1>(y3, R3, S[7]);
    }
    if (MODE >= 1) {
      fmac_bc<2>(S[8], K0, vv);
      fmac_bc<2>(S[9], K1, vv);
      fmac_bc<2>(S[10], K2, vv);
      fmac_bc<2>(S[11], K3, vv);
      fmac_bc<3>(S[12], K0, vv);
      fmac_bc<3>(S[13], K1, vv);
      fmac_bc<3>(S[14], K2, vv);
      fmac_bc<3>(S[15], K3, vv);
    }
    fmac_bc<2>(S[8], B0, sa);
    fmac_bc<2>(S[9], B1, sa);
    fmac_bc<2>(S[10], B2, sa);
    fmac_bc<2>(S[11], B3, sa);
    fmac_bc<3>(S[12], B0, sa);
    fmac_bc<3>(S[13], B1, sa);
    fmac_bc<3>(S[14], B2, sa);
    fmac_bc<3>(S[15], B3, sa);
    if (MODE == 2) {
      fmac_bc<2>(y0, R0, S[8]);
      fmac_bc<2>(y1, R1, S[9]);
      fmac_bc<2>(y2, R2, S[10]);
      fmac_bc<2>(y3, R3, S[11]);
      fmac_bc<3>(y0, R0, S[12]);
      fmac_bc<3>(y1, R1, S[13]);
      fmac_bc<3>(y2, R2, S[14]);
      fmac_bc<3>(y3, R3, S[15]);
    }
    if (MODE >= 1) {
      fmac_bc<4>(S[16], K0, vv);
      fmac_bc<4>(S[17], K1, vv);
      fmac_bc<4>(S[18], K2, vv);
      fmac_bc<4>(S[19], K3, vv);
      fmac_bc<5>(S[20], K0, vv);
      fmac_bc<5>(S[21], K1, vv);
      fmac_bc<5>(S[22], K2, vv);
      fmac_bc<5>(S[23], K3, vv);
    }
    fmac_bc<4>(S[16], B0, sa);
    fmac_bc<4>(S[17], B1, sa);
    fmac_bc<4>(S[18], B2, sa);
    fmac_bc<4>(S[19], B3, sa);
    fmac_bc<5>(S[20], B0, sa);
    fmac_bc<5>(S[21], B1, sa);
    fmac_bc<5>(S[22], B2, sa);
    fmac_bc<5>(S[23], B3, sa);
    if (MODE == 2) {
      fmac_bc<4>(y0, R0, S[16]);
      fmac_bc<4>(y1, R1, S[17]);
      fmac_bc<4>(y2, R2, S[18]);
      fmac_bc<4>(y3, R3, S[19]);
      fmac_bc<5>(y0, R0, S[20]);
      fmac_bc<5>(y1, R1, S[21]);
      fmac_bc<5>(y2, R2, S[22]);
      fmac_bc<5>(y3, R3, S[23]);
    }
    if (MODE >= 1) {
      fmac_bc<6>(S[24], K0, vv);
      fmac_bc<6>(S[25], K1, vv);
      fmac_bc<6>(S[26], K2, vv);
      fmac_bc<6>(S[27], K3, vv);
      fmac_bc<7>(S[28], K0, vv);
      fmac_bc<7>(S[29], K1, vv);
      fmac_bc<7>(S[30], K2, vv);
      fmac_bc<7>(S[31], K3, vv);
    }
    fmac_bc<6>(S[24], B0, sa);
    fmac_bc<6>(S[25], B1, sa);
    fmac_bc<6>(S[26], B2, sa);
    fmac_bc<6>(S[27], B3, sa);
    fmac_bc<7>(S[28], B0, sa);
    fmac_bc<7>(S[29], B1, sa);
    fmac_bc<7>(S[30], B2, sa);
    fmac_bc<7>(S[31], B3, sa);
    if (MODE == 2) {
      fmac_bc<6>(y0, R0, S[24]);
      fmac_bc<6>(y1, R1, S[25]);
      fmac_bc<6>(y2, R2, S[26]);
      fmac_bc<6>(y3, R3, S[27]);
      fmac_bc<7>(y0, R0, S[28]);
      fmac_bc<7>(y1, R1, S[29]);
      fmac_bc<7>(y2, R2, S[30]);
      fmac_bc<7>(y3, R3, S[31]);
    }
    if (MODE >= 1) {
      fmac_bc<8>(S[32], K0, vv);
      fmac_bc<8>(S[33], K1, vv);
      fmac_bc<8>(S[34], K2, vv);
      fmac_bc<8>(S[35], K3, vv);
      fmac_bc<9>(S[36], K0, vv);
      fmac_bc<9>(S[37], K1, vv);
      fmac_bc<9>(S[38], K2, vv);
      fmac_bc<9>(S[39], K3, vv);
    }
    fmac_bc<8>(S[32], B0, sa);
    fmac_bc<8>(S[33], B1, sa);
    fmac_bc<8>(S[34], B2, sa);
    fmac_bc<8>(S[35], B3, sa);
    fmac_bc<9>(S[36], B0, sa);
    fmac_bc<9>(S[37], B1, sa);
    fmac_bc<9>(S[38], B2, sa);
    fmac_bc<9>(S[39], B3, sa);
    if (MODE == 2) {
      fmac_bc<8>(y0, R0, S[32]);
      fmac_bc<8>(y1, R1, S[33]);
      fmac_bc<8>(y2, R2, S[34]);
      fmac_bc<8>(y3, R3, S[35]);
      fmac_bc<9>(y0, R0, S[36]);
      fmac_bc<9>(y1, R1, S[37]);
      fmac_bc<9>(y2, R2, S[38]);
      fmac_bc<9>(y3, R3, S[39]);
    }
    if (MODE >= 1) {
      fmac_bc<10>(S[40], K0, vv);
      fmac_bc<10>(S[41], K1, vv);
      fmac_bc<10>(S[42], K2, vv);
      fmac_bc<10>(S[43], K3, vv);
      fmac_bc<11>(S[44], K0, vv);
      fmac_bc<11>(S[45], K1, vv);
      fmac_bc<11>(S[46], K2, vv);
      fmac_bc<11>(S[47], K3, vv);
    }
    fmac_bc<10>(S[40], B0, sa);
    fmac_bc<10>(S[41], B1, sa);
    fmac_bc<10>(S[42], B2, sa);
    fmac_bc<10>(S[43], B3, sa);
    fmac_bc<11>(S[44], B0, sa);
    fmac_bc<11>(S[45], B1, sa);
    fmac_bc<11>(S[46], B2, sa);
    fmac_bc<11>(S[47], B3, sa);
    if (MODE == 2) {
      fmac_bc<10>(y0, R0, S[40]);
      fmac_bc<10>(y1, R1, S[41]);
      fmac_bc<10>(y2, R2, S[42]);
      fmac_bc<10>(y3, R3, S[43]);
      fmac_bc<11>(y0, R0, S[44]);
      fmac_bc<11>(y1, R1, S[45]);
      fmac_bc<11>(y2, R2, S[46]);
      fmac_bc<11>(y3, R3, S[47]);
    }
    if (MODE >= 1) {
      fmac_bc<12>(S[48], K0, vv);
      fmac_bc<12>(S[49], K1, vv);
      fmac_bc<12>(S[50], K2, vv);
      fmac_bc<12>(S[51], K3, vv);
      fmac_bc<13>(S[52], K0, vv);
      fmac_bc<13>(S[53], K1, vv);
      fmac_bc<13>(S[54], K2, vv);
      fmac_bc<13>(S[55], K3, vv);
    }
    fmac_bc<12>(S[48], B0, sa);
    fmac_bc<12>(S[49], B1, sa);
    fmac_bc<12>(S[50], B2, sa);
    fmac_bc<12>(S[51], B3, sa);
    fmac_bc<13>(S[52], B0, sa);
    fmac_bc<13>(S[53], B1, sa);
    fmac_bc<13>(S[54], B2, sa);
    fmac_bc<13>(S[55], B3, sa);
    if (MODE == 2) {
      fmac_bc<12>(y0, R0, S[48]);
      fmac_bc<12>(y1, R1, S[49]);
      fmac_bc<12>(y2, R2, S[50]);
      fmac_bc<12>(y3, R3, S[51]);
      fmac_bc<13>(y0, R0, S[52]);
      fmac_bc<13>(y1, R1, S[53]);
      fmac_bc<13>(y2, R2, S[54]);
      fmac_bc<13>(y3, R3, S[55]);
    }
    if (MODE >= 1) {
      fmac_bc<14>(S[56], K0, vv);
      fmac_bc<14>(S[57], K1, vv);
      fmac_bc<14>(S[58], K2, vv);
      fmac_bc<14>(S[59], K3, vv);
      fmac_bc<15>(S[60], K0, vv);
      fmac_bc<15>(S[61], K1, vv);
      fmac_bc<15>(S[62], K2, vv);
      fmac_bc<15>(S[63], K3, vv);
    }
    fmac_bc<14>(S[56], B0, sa);
    fmac_bc<14>(S[57], B1, sa);
    fmac_bc<14>(S[58], B2, sa);
    fmac_bc<14>(S[59], B3, sa);
    fmac_bc<15>(S[60], B0, sa);
    fmac_bc<15>(S[61], B1, sa);
    fmac_bc<15>(S[62], B2, sa);
    fmac_bc<15>(S[63], B3, sa);
    if (MODE == 2) {
      fmac_bc<14>(y0, R0, S[56]);
      fmac_bc<14>(y1, R1, S[57]);
      fmac_bc<14>(y2, R2, S[58]);
      fmac_bc<14>(y3, R3, S[59]);
      fmac_bc<15>(y0, R0, S[60]);
      fmac_bc<15>(y1, R1, S[61]);
      fmac_bc<15>(y2, R2, S[62]);
      fmac_bc<15>(y3, R3, S[63]);
    }
    if ((t & 31) == 31) {
      S[0] = mul_bc<0>(W0, S[0]);
      S[1] = mul_bc<0>(W1, S[1]);
      S[2] = mul_bc<0>(W2, S[2]);
      S[3] = mul_bc<0>(W3, S[3]);
      S[4] = mul_bc<1>(W0, S[4]);
      S[5] = mul_bc<1>(W1, S[5]);
      S[6] = mul_bc<1>(W2, S[6]);
      S[7] = mul_bc<1>(W3, S[7]);
      S[8] = mul_bc<2>(W0, S[8]);
      S[9] = mul_bc<2>(W1, S[9]);
      S[10] = mul_bc<2>(W2, S[10]);
      S[11] = mul_bc<2>(W3, S[11]);
      S[12] = mul_bc<3>(W0, S[12]);
      S[13] = mul_bc<3>(W1, S[13]);
      S[14] = mul_bc<3>(W2, S[14]);
      S[15] = mul_bc<3>(W3, S[15]);
      S[16] = mul_bc<4>(W0, S[16]);
      S[17] = mul_bc<4>(W1, S[17]);
      S[18] = mul_bc<4>(W2, S[18]);
      S[19] = mul_bc<4>(W3, S[19]);
      S[20] = mul_bc<5>(W0, S[20]);
      S[21] = mul_bc<5>(W1, S[21]);
      S[22] = mul_bc<5>(W2, S[22]);
      S[23] = mul_bc<5>(W3, S[23]);
      S[24] = mul_bc<6>(W0, S[24]);
      S[25] = mul_bc<6>(W1, S[25]);
      S[26] = mul_bc<6>(W2, S[26]);
      S[27] = mul_bc<6>(W3, S[27]);
      S[28] = mul_bc<7>(W0, S[28]);
      S[29] = mul_bc<7>(W1, S[29]);
      S[30] = mul_bc<7>(W2, S[30]);
      S[31] = mul_bc<7>(W3, S[31]);
      S[32] = mul_bc<8>(W0, S[32]);
      S[33] = mul_bc<8>(W1, S[33]);
      S[34] = mul_bc<8>(W2, S[34]);
      S[35] = mul_bc<8>(W3, S[35]);
      S[36] = mul_bc<9>(W0, S[36]);
      S[37] = mul_bc<9>(W1, S[37]);
      S[38] = mul_bc<9>(W2, S[38]);
      S[39] = mul_bc<9>(W3, S[39]);
      S[40] = mul_bc<10>(W0, S[40]);
      S[41] = mul_bc<10>(W1, S[41]);
      S[42] = mul_bc<10>(W2, S[42]);
      S[43] = mul_bc<10>(W3, S[43]);
      S[44] = mul_bc<11>(W0, S[44]);
      S[45] = mul_bc<11>(W1, S[45]);
      S[46] = mul_bc<11>(W2, S[46]);
      S[47] = mul_bc<11>(W3, S[47]);
      S[48] = mul_bc<12>(W0, S[48]);
      S[49] = mul_bc<12>(W1, S[49]);
      S[50] = mul_bc<12>(W2, S[50]);
      S[51] = mul_bc<12>(W3, S[51]);
      S[52] = mul_bc<13>(W0, S[52]);
      S[53] = mul_bc<13>(W1, S[53]);
      S[54] = mul_bc<13>(W2, S[54]);
      S[55] = mul_bc<13>(W3, S[55]);
      S[56] = mul_bc<14>(W0, S[56]);
      S[57] = mul_bc<14>(W1, S[57]);
      S[58] = mul_bc<14>(W2, S[58]);
      S[59] = mul_bc<14>(W3, S[59]);
      S[60] = mul_bc<15>(W0, S[60]);
      S[61] = mul_bc<15>(W1, S[61]);
      S[62] = mul_bc<15>(W2, S[62]);
      S[63] = mul_bc<15>(W3, S[63]);
      C0 = 1.f; C1 = 1.f; C2 = 1.f; C3 = 1.f;
    }
    if (MODE == 2) Yg[(size_t)t * 512 + lane] = (y0 + y1) + (y2 + y3);
    c0 = c1; c1 = c2;
  }
  if (Sout) {
#pragma unroll
    for (int k = 0; k < 64; k += 4) *(f32x4*)(Sout + (size_t)lane * 64 + k) = f32x4{S[k], S[k + 1], S[k + 2], S[k + 3]};
  }
}

constexpr int RC = 128;
constexpr int NCH = NP / RC;
DI void seqs_item(const Params& p, int layer, int hd, char* smem) {
  float* sS = (float*)smem;
  const int tid = tidx(), lane = tid & 63, w = tid >> 6, l31 = lane & 31, h = lane >> 5, wr = w >> 1, wc = w & 1;
  const float* PQ = (const float*)(p.ws + WS_Y) + (size_t)hd * NCH * 8192;
  float* SS = (float*)(p.ws + WS_H) + (size_t)hd * NCH * 4096;
  const unsigned* pqflag = (const unsigned*)(p.ws + WS_CTR) + 1024 + (layer * 8 + hd) * 64;
  __syncthreads();
  for (int i = tid; i < 64 * 65; i += 256) sS[i] = 0.f;
  for (int i = tid; i < 4096; i += 256) SS[i] = 0.f;
  if (tid == 0) {
    for (int j = 0; j < 5; ++j)
      while (__hip_atomic_load((unsigned*)pqflag + j, __ATOMIC_RELAXED, __HIP_MEMORY_SCOPE_AGENT) == 0u) __builtin_amdgcn_s_sleep(4);
    __builtin_amdgcn_fence(__ATOMIC_ACQUIRE, "agent");
    asm volatile("s_waitcnt vmcnt(0)" ::: "memory");
  }
  __syncthreads();
  float bP[32], bQ[16], nP[32], nQ[16];
#pragma unroll
  for (int ks = 0; ks < 32; ++ks) bP[ks] = PQ[(2 * ks + h) * 64 + 32 * wc + l31];
#pragma unroll
  for (int r = 0; r < 16; ++r) bQ[r] = PQ[4096 + (32 * wr + crow(r, h)) * 64 + 32 * wc + l31];
  for (int c = 0; c < NCH; ++c) {
    if ((c & 7) == 0 && c > 0) {
      if (tid == 0) {
        const int j0 = c >> 1, j1 = (c + 8 < NCH) ? j0 + 5 : j0 + 4;
        for (int j = j0; j < j1; ++j)
          while (__hip_atomic_load((unsigned*)pqflag + j, __ATOMIC_RELAXED, __HIP_MEMORY_SCOPE_AGENT) == 0u) __builtin_amdgcn_s_sleep(4);
        __builtin_amdgcn_fence(__ATOMIC_ACQUIRE, "agent");
        asm volatile("s_waitcnt vmcnt(0)" ::: "memory");
      }
      __syncthreads();
    }
    if (c + 1 < NCH) {
      const float* Pn = PQ + (size_t)(c + 1) * 8192;
#pragma unroll
      for (int ks = 0; ks < 32; ++ks) nP[ks] = Pn[(2 * ks + h) * 64 + 32 * wc + l31];
#pragma unroll
      for (int r = 0; r < 16; ++r) nQ[r] = Pn[4096 + (32 * wr + crow(r, h)) * 64 + 32 * wc + l31];
    }
    f32x16 acc;
#pragma unroll
    for (int r = 0; r < 16; ++r) acc[r] = bQ[r];
    float a[32];
#pragma unroll
    for (int ks = 0; ks < 32; ++ks) a[ks] = sS[(32 * wr + l31) * 65 + 2 * ks + h];
#pragma unroll
    for (int ks = 0; ks < 32; ++ks) acc = __builtin_amdgcn_mfma_f32_32x32x2f32(a[ks], bP[ks], acc, 0, 0, 0);
    __syncthreads();
    float* dst = (c + 1 < NCH) ? SS + (size_t)(c + 1) * 4096 : p.out + OFF_WKV_P + ((size_t)layer * 8 + hd) * 4096;
#pragma unroll
    for (int r = 0; r < 16; ++r) {
      const int row = 32 * wr + crow(r, h), col = 32 * wc + l31;
      sS[row * 65 + col] = acc[r];
      dst[row * 64 + col] = acc[r];
    }
    __syncthreads();
#pragma unroll
    for (int ks = 0; ks < 32; ++ks) bP[ks] = nP[ks];
#pragma unroll
    for (int r = 0; r < 16; ++r) bQ[r] = nQ[r];
  }
}

DI void phase_mix(const Params& p, int layer, char* smem, int* s_item) {
  constexpr int NQ_PQ = NCH * 2 / 4, NQ_SY = 4, NQ_SATT = 16, NQ_PATT = 128;
  int* qctr = (int*)(p.ws + WS_CTR) + 64 + layer * 8;
  int* actr = (int*)(p.ws + WS_CTR) + 192 + layer * 8;
  if (blockIdx.x < 8) { seqs_item(p, layer, blockIdx.x, smem); return; }
  const int home = blockIdx.x & 7;
  const int first = (blockIdx.x >> 3) & 1;
  for (int pass = 0; pass < 2; ++pass) {
    const int kind = pass ^ first;
    for (int qi = 0; qi < 8; ++qi) {
      const int hd = (home + qi) & 7;
      for (;;) {
        __syncthreads();
        if (tidx() == 0) *s_item = atomicAdd((kind == 0 ? qctr : actr) + hd, 1);
        __syncthreads();
        const int it = *s_item;
        const int wave = __builtin_amdgcn_readfirstlane(tidx() >> 6), lane = tidx() & 63;
        if (kind == 0) {
          if (it >= NQ_PQ + NQ_SY) break;
          if (it < NQ_PQ) {
            const int q = it * 4 + wave, mode = q & 1, ch = q >> 1;
            float* dstm = (float*)(p.ws + WS_Y) + ((size_t)(hd * NCH + ch) * 2 + mode) * 4096;
            if (mode == 0) rpl_item<0>(p, hd, ch * RC, RC, nullptr, dstm, nullptr, lane);
            else rpl_item<1>(p, hd, ch * RC, RC, nullptr, dstm, nullptr, lane);
            asm volatile("s_waitcnt vmcnt(0)" ::: "memory");
            __syncthreads();
            if (tidx() == 0) {
              __builtin_amdgcn_fence(__ATOMIC_RELEASE, "agent");
              asm volatile("s_waitcnt vmcnt(0)" ::: "memory");
              __hip_atomic_store((unsigned*)(p.ws + WS_CTR) + 1024 + (layer * 8 + hd) * 64 + it, 1u, __ATOMIC_RELAXED, __HIP_MEMORY_SCOPE_AGENT);
            }
            continue;
          }
          const int b = (it - NQ_PQ) * 4 + wave;
          rpl_item<2>(p, hd, NP + b * 64, 64, p.state_wkv + (((size_t)layer * 16 + b) * 8 + hd) * 4096,
                      p.out + OFF_WKV_S + (((size_t)layer * 16 + b) * 8 + hd) * 4096, (float*)(p.ws + WS_Y) + (size_t)(NP + b * 64) * 512 + hd * 64, lane);
        } else {
          if (it >= NQ_SATT + NQ_PATT) break;
          if (it < NQ_SATT) { attn_sample_item(p, layer, it, hd, smem); continue; }
          attn_prompt_item(p, layer, 127 - (it - NQ_SATT), hd, smem);
        }
      }
    }
  }
}
DI void phase_ypass(const Params& p, int layer) {
  const int wave = __builtin_amdgcn_readfirstlane(tidx() >> 6), lane = tidx() & 63;
  const int hd = blockIdx.x & 7, nb = (gridDim.x + 7 - hd) >> 3;
  for (int j = blockIdx.x >> 3; j < NCH / 4; j += nb) {
    const int ch = j * 4 + wave;
    rpl_item<2>(p, hd, ch * RC, RC, (const float*)(p.ws + WS_H) + (size_t)(hd * NCH + ch) * 4096, nullptr,
                (float*)(p.ws + WS_Y) + (size_t)(ch * RC) * 512 + hd * 64, lane);
  }
}

DI void phase_ob(const Params& p, int layer) {
  const int wave = tidx() >> 6, lane = tidx() & 63;
  const float* Y = (const float*)(p.ws + WS_Y);
  const u16* WK = (const u16*)(p.ws + WS_WKVIN);
  const u16* Z = (const u16*)(p.ws + WS_Z);
  u16* OB = (u16*)(p.ws + WS_Q);
  const int f = lane * 8, hd = lane >> 3, fl = (lane & 7) * 8;
  for (int t = blockIdx.x * 4 + wave; t < NT; t += gridDim.x * 4) {
    const float4 ya = *(const float4*)(Y + (size_t)t * 512 + f);
    const float4 yb = *(const float4*)(Y + (size_t)t * 512 + f + 4);
    float y[8] = {ya.x, ya.y, ya.z, ya.w, yb.x, yb.y, yb.z, yb.w};
    float s = 0.f;
#pragma unroll
    for (int j = 0; j < 8; ++j) s += y[j];
    s += __shfl_xor(s, 1); s += __shfl_xor(s, 2); s += __shfl_xor(s, 4);
    const float mu = s * (1.f / 64.f);
    float vs = 0.f;
#pragma unroll
    for (int j = 0; j < 8; ++j) { y[j] -= mu; vs += y[j] * y[j]; }
    vs += __shfl_xor(vs, 1); vs += __shfl_xor(vs, 2); vs += __shfl_xor(vs, 4);
    const float rs = rsqrtf(vs * (1.f / 64.f) + GN_EPS);
    const u16* wk = WK + ((size_t)hd * NT + t) * 384 + fl;
    const uint4 r8 = *(const uint4*)(wk + 0 * 64);
    const uint4 k8 = *(const uint4*)(wk + 2 * 64);
    const uint4 v8 = *(const uint4*)(wk + 3 * 64);
    const float rr[8] = {lo2f(r8.x), hi2f(r8.x), lo2f(r8.y), hi2f(r8.y), lo2f(r8.z), hi2f(r8.z), lo2f(r8.w), hi2f(r8.w)};
    const float kk[8] = {lo2f(k8.x), hi2f(k8.x), lo2f(k8.y), hi2f(k8.y), lo2f(k8.z), hi2f(k8.z), lo2f(k8.w), hi2f(k8.w)};
    const float vv[8] = {lo2f(v8.x), hi2f(v8.x), lo2f(v8.y), hi2f(v8.y), lo2f(v8.z), hi2f(v8.z), lo2f(v8.w), hi2f(v8.w)};
    const float4 rka = *(const float4*)(p.r_k + layer * 512 + f);
    const float4 rkb = *(const float4*)(p.r_k + layer * 512 + f + 4);
    const float rk[8] = {rka.x, rka.y, rka.z, rka.w, rkb.x, rkb.y, rkb.z, rkb.w};
    float bs = 0.f;
#pragma unroll
    for (int j = 0; j < 8; ++j) bs += rr[j] * kk[j] * rk[j];
    bs += __shfl_xor(bs, 1); bs += __shfl_xor(bs, 2); bs += __shfl_xor(bs, 4);
    const float4 lwa = *(const float4*)(p.lnx_w + layer * 512 + f);
    const float4 lwb = *(const float4*)(p.lnx_w + layer * 512 + f + 4);
    const float4 lba = *(const float4*)(p.lnx_b + layer * 512 + f);
    const float4 lbb = *(const float4*)(p.lnx_b + layer * 512 + f + 4);
    const float lw[8] = {lwa.x, lwa.y, lwa.z, lwa.w, lwb.x, lwb.y, lwb.z, lwb.w};
    const float lb[8] = {lba.x, lba.y, lba.z, lba.w, lbb.x, lbb.y, lbb.z, lbb.w};
    const uint4 g8 = *(const uint4*)(Z + (size_t)t * NZ + ZC_GB + f);
    const float gg[8] = {lo2f(g8.x), hi2f(g8.x), lo2f(g8.y), hi2f(g8.y), lo2f(g8.z), hi2f(g8.z), lo2f(g8.w), hi2f(g8.w)};
    float ov[8];
#pragma unroll
    for (int j = 0; j < 8; ++j) ov[j] = (y[j] * rs * lw[j] + lb[j] + bs * vv[j]) * siluf_(gg[j]);
    *(uint4*)(OB + (size_t)t * 512 + f) = make_uint4(pk2(ov[0], ov[1]), pk2(ov[2], ov[3]), pk2(ov[4], ov[5]), pk2(ov[6], ov[7]));
  }
}

DI void phase_merge(const Params& p, int layer, char* smem) {
  const u16* OA = (const u16*)(p.ws + WS_OA);
  const u16* OB = (const u16*)(p.ws + WS_Q);
  const u16* WA = (const u16*)(p.ws + (size_t)layer * WL_STRIDE + W_OA);
  const u16* WB = (const u16*)(p.ws + (size_t)layer * WL_STRIDE + W_OB);
  const u16* Z = (const u16*)(p.ws + WS_Z);
  u16* M = (u16*)(p.ws + WS_H);
  const int xcd = blockIdx.x & 7, jb = blockIdx.x >> 3, nb = (gridDim.x + 7 - xcd) >> 3;
  for (int m = jb; m < 16 * 8; m += nb) {
    const int tt = xcd + 8 * (m >> 3), ft = m & 7;
    f32x16 acc[2][2];
    zero_acc(acc);
    gemm_mainloop(OA + (size_t)tt * 128 * 512, 512, WA + (size_t)ft * 128 * 512, 512, 512, smem, acc);
    acc_to_lds(acc, smem);
    EPI_ROWS({
      const u32x2 g = *(const u32x2*)(Z + (size_t)(tt * 128 + row) * NZ + ZC_MA + ft * 128 + col);
      *(u32x2*)(M + (size_t)(tt * 128 + row) * 1024 + ft * 128 + col) =
          u32x2{pk2(v.x * sigmoidf_(lo2f(g.x)), v.y * sigmoidf_(hi2f(g.x))), pk2(v.z * sigmoidf_(lo2f(g.y)), v.w * sigmoidf_(hi2f(g.y)))};
    })
    zero_acc(acc);
    gemm_mainloop(OB + (size_t)tt * 128 * 512, 512, WB + (size_t)ft * 128 * 512, 512, 512, smem, acc);
    acc_to_lds(acc, smem);
    EPI_ROWS({
      const u32x2 g = *(const u32x2*)(Z + (size_t)(tt * 128 + row) * NZ + ZC_MB + ft * 128 + col);
      u32x2* mp = (u32x2*)(M + (size_t)(tt * 128 + row) * 1024 + ft * 128 + col);
      const u32x2 pm = *mp;
      *mp = u32x2{pk2(lo2f(pm.x) + v.x * sigmoidf_(lo2f(g.x)), hi2f(pm.x) + v.y * sigmoidf_(hi2f(g.x))),
                  pk2(lo2f(pm.y) + v.z * sigmoidf_(lo2f(g.y)), hi2f(pm.y) + v.w * sigmoidf_(hi2f(g.y)))};
    })
  }
  for (int m = jb; m < 2 * 16; m += nb) {
    const int r0 = (128 + xcd) * 128 + (m >> 4) * 64, c0 = (m & 15) * 64;
    f32x16 acc;
#pragma unroll
    for (int r = 0; r < 16; ++r) acc[r] = 0.f;
    gemm64_mainloop(OA + (size_t)r0 * 512, 512, WA + (size_t)c0 * 512, 512, 512, smem, acc);
    acc64_to_lds(acc, smem);
    EPI64_ROWS({
      const u32x2 g = *(const u32x2*)(Z + (size_t)(r0 + row) * NZ + ZC_MA + c0 + col);
      *(u32x2*)(M + (size_t)(r0 + row) * 1024 + c0 + col) =
          u32x2{pk2(v.x * sigmoidf_(lo2f(g.x)), v.y * sigmoidf_(hi2f(g.x))), pk2(v.z * sigmoidf_(lo2f(g.y)), v.w * sigmoidf_(hi2f(g.y)))};
    })
#pragma unroll
    for (int r = 0; r < 16; ++r) acc[r] = 0.f;
    gemm64_mainloop(OB + (size_t)r0 * 512, 512, WB + (size_t)c0 * 512, 512, 512, smem, acc);
    acc64_to_lds(acc, smem);
    EPI64_ROWS({
      const u32x2 g = *(const u32x2*)(Z + (size_t)(r0 + row) * NZ + ZC_MB + c0 + col);
      u32x2* mp = (u32x2*)(M + (size_t)(r0 + row) * 1024 + c0 + col);
      const u32x2 pm = *mp;
      *mp = u32x2{pk2(lo2f(pm.x) + v.x * sigmoidf_(lo2f(g.x)), hi2f(pm.x) + v.y * sigmoidf_(hi2f(g.x))),
                  pk2(lo2f(pm.y) + v.z * sigmoidf_(lo2f(g.y)), hi2f(pm.y) + v.w * sigmoidf_(hi2f(g.y)))};
    })
  }
}

DI void phase_out(const Params& p, int layer, char* smem) {
  const u16* M = (const u16*)(p.ws + WS_H);
  const u16* W = (const u16*)(p.ws + (size_t)layer * WL_STRIDE + W_O);
  const int xcd = blockIdx.x & 7, jb = blockIdx.x >> 3, nb = (gridDim.x + 7 - xcd) >> 3;
  for (int m = jb; m < 16 * 8; m += nb) {
    const int tt = xcd + 8 * (m >> 3), ft = m & 7;
    f32x16 acc[2][2];
    zero_acc(acc);
    gemm_mainloop(M + (size_t)tt * 128 * 1024, 1024, W + (size_t)ft * 128 * 1024, 1024, 1024, smem, acc);
    acc_to_lds(acc, smem);
    EPI_ROWS({
      const int t = tt * 128 + row, n = ft * 128 + col;
      const f32x4 xo = *(const f32x4*)(xrow(p, layer, t) + n);
      *(f32x4*)(p.out + (size_t)t * 1024 + n) = xo + v;
    })
  }
  for (int m = jb; m < 2 * 16; m += nb) {
    const int r0 = (128 + xcd) * 128 + (m >> 4) * 64, c0 = (m & 15) * 64;
    f32x16 acc;
#pragma unroll
    for (int r = 0; r < 16; ++r) acc[r] = 0.f;
    gemm64_mainloop(M + (size_t)r0 * 1024, 1024, W + (size_t)c0 * 1024, 1024, 1024, smem, acc);
    acc64_to_lds(acc, smem);
    EPI64_ROWS({
      const int t = r0 + row, n = c0 + col;
      const f32x4 xo = *(const f32x4*)(xrow(p, layer, t) + n);
      *(f32x4*)(p.out + (size_t)t * 1024 + n) = xo + v;
    })
  }
}

#define XB_TMO      128
#define XB_XCNT(j)  (256  + 64 * (j))
#define XB_XSUB(j)  (1280 + 64 * (j))
#define XB_XGEN(j)  (2304 + 64 * (j))
#define XB_TOP      3328
#define XB_TOPGEN   3392
#define XCD_BAR_WORDS 3456
#define XB_SPIN_CAP (1u << 22)
#define LAS __attribute__((address_space(3)))
DI unsigned xb_ld(unsigned* p) { return __hip_atomic_load(p, __ATOMIC_RELAXED, __HIP_MEMORY_SCOPE_AGENT); }
DI unsigned xb_add(unsigned* p, unsigned v) { return __hip_atomic_fetch_add(p, v, __ATOMIC_RELAXED, __HIP_MEMORY_SCOPE_AGENT); }
DI unsigned xb_xcc_id() { return (unsigned)__builtin_amdgcn_s_getreg((3 << 11) | 20) & 0xFu; }
#define XB_SPIN(cond, bar) do { unsigned _sp = 0; while (cond) { __builtin_amdgcn_s_sleep(1); \
    if ((++_sp & 255u) == 0u) { if (xb_ld(&(bar)[XB_TMO])) break; if (_sp > XB_SPIN_CAP) { atomicAdd(&(bar)[XB_TMO], 1u); break; } } } } while (0)
struct XcdBarrier { unsigned* bar; unsigned x; volatile LAS unsigned* st; };
DI XcdBarrier xcd_barrier_post(unsigned* bar, volatile LAS unsigned* st) {
  XcdBarrier b; b.bar = bar; b.x = xb_xcc_id(); b.st = st;
  if (threadIdx.x == 0) (void)xb_add(&bar[XB_XCNT(b.x)], 1u);
  return b;
}
DI void xcd_barrier_complete(unsigned* bar, unsigned x, unsigned& nloc, unsigned& nx) {
  const unsigned G = gridDim.x * gridDim.y * gridDim.z;
  unsigned sum, cnt, mine, sp = 0u;
  for (;;) {
    sum = 0u; cnt = 0u; mine = 0u;
#pragma unroll
    for (unsigned j = 0; j < 16; ++j) { const unsigned c = xb_ld(&bar[XB_XCNT(j)]); sum += c; cnt += (c > 0u) ? 1u : 0u; mine = (j == x) ? c : mine; }
    if (sum == G) break;
    __builtin_amdgcn_s_sleep(1);
    if ((++sp & 255u) == 0u) { if (xb_ld(&bar[XB_TMO])) break; if (sp > XB_SPIN_CAP) { atomicAdd(&bar[XB_TMO], 1u); break; } }
  }
  nloc = mine > 0u ? mine : 1u; nx = cnt > 0u ? cnt : 1u;
}
DI void xcd_barrier(const XcdBarrier& b) {
  asm volatile("s_waitcnt vmcnt(0)" ::: "memory");
  __syncthreads();
  if (threadIdx.x == 0) {
    unsigned* bar = b.bar;
    __builtin_amdgcn_s_waitcnt(0);
    unsigned nloc = b.st[0], nx = b.st[1];
    if (nloc == 0u) { xcd_barrier_complete(bar, b.x, nloc, nx); b.st[0] = nloc; b.st[1] = nx; }
    const unsigned old = xb_add(&bar[XB_XSUB(b.x)], 1u);
    const unsigned gen = old / nloc;
    if (old + 1u == (gen + 1u) * nloc) {
      __builtin_amdgcn_fence(__ATOMIC_RELEASE, "agent");
      asm volatile("s_waitcnt vmcnt(0)" ::: "memory");
      const unsigned og = xb_add(&bar[XB_TOP], 1u);
      const unsigned tg = og / nx;
      if (og + 1u == (tg + 1u) * nx) xb_add(&bar[XB_TOPGEN], 1u);
      else XB_SPIN(xb_ld(&bar[XB_TOPGEN]) == tg, bar);
      __builtin_amdgcn_fence(__ATOMIC_ACQUIRE, "agent");
      xb_add(&bar[XB_XGEN(b.x)], 1u);
      asm volatile("s_waitcnt vmcnt(0)" ::: "memory");
    } else {
      XB_SPIN(xb_ld(&bar[XB_XGEN(b.x)]) == gen, bar);
      __builtin_amdgcn_fence(__ATOMIC_ACQUIRE, "agent");
      asm volatile("s_waitcnt vmcnt(0)" ::: "memory");
    }
  }
  __syncthreads();
}

constexpr int PH_PER_LAYER = 8;
constexpr int N_PHASES = 1 + 4 * PH_PER_LAYER;

DI void run_phase(const Params& p, int ph, char* smem, int* s_item) {
#ifndef PHMASK
#define PHMASK 0x3FF
#endif
  if (ph == 0) { if (PHMASK & 0x100) phase_convert(p, smem); return; }
  const int layer = (ph - 1) / PH_PER_LAYER, sub = (ph - 1) % PH_PER_LAYER;
  switch (sub) {
    case 0: if (PHMASK & 1) phase_rmsnorm(p, layer); break;
    case 1: if (PHMASK & 2) phase_g1(p, layer, smem); break;
    case 2: if (PHMASK & 4) phase_norms_prep(p, layer, smem, s_item); break;
    case 3: if (PHMASK & 16) phase_mix(p, layer, smem, s_item); break;
    case 4: if (PHMASK & 16) phase_ypass(p, layer); break;
    case 5: if (PHMASK & 32) phase_ob(p, layer); break;
    case 6: if (PHMASK & 64) phase_merge(p, layer, smem); break;
    default: if (PHMASK & 128) phase_out(p, layer, smem); break;
  }
}

__global__ void __launch_bounds__(256, 2) mk_kernel(Params p, int ph0, int ph1, int coop) {
  __shared__ __attribute__((aligned(16))) char smem[SMEM_BYTES];
  __shared__ int s_item[4];
  __shared__ uint4 xb_words;
  if (threadIdx.x == 0) xb_words = make_uint4(0u, 0u, 0u, 0u);
  __syncthreads();
  XcdBarrier xb = xcd_barrier_post((unsigned*)(p.ws + WS_BAR), (volatile LAS unsigned*)&xb_words);
  for (int ph = ph0; ph < ph1; ++ph) {
    run_phase(p, ph, smem, s_item);
    if (coop && ph + 1 < ph1) {
      xcd_barrier(xb);
      if (coop == 0x5a5a5a) cg::this_grid().sync();
    }
  }
}

extern "C" void kernel_launch(void* const* d_in, const int* in_sizes, int n_in, void* d_out, int out_size, void* d_ws, size_t ws_size,
                              hipStream_t stream) {
  static int grid_blocks = 0;
  if (!grid_blocks) {
    int dev = 0, cus = 0, per_cu = 0;
    hipGetDevice(&dev);
    hipDeviceGetAttribute(&cus, hipDeviceAttributeMultiprocessorCount, dev);
    hipOccupancyMaxActiveBlocksPerMultiprocessor(&per_cu, mk_kernel, 256, 0);
    if (per_cu < 1) per_cu = 1;
    if (per_cu > 2) per_cu = 2;
    grid_blocks = cus * per_cu;
  }
  Params p{};
  const float** pp = (const float**)&p;
  for (int i = 0; i < 29; ++i) pp[i] = (const float*)d_in[i];
  p.out = (float*)d_out;
  p.ws = (char*)d_ws;
  const int ONE_LAUNCH = 1;
  hipMemsetAsync((char*)d_ws + WS_CTR, 0, 16384 + XCD_BAR_WORDS * 4, stream);
  if (ONE_LAUNCH) {
    int ph0 = 0, ph1 = N_PHASES, coop = 1;
    void* args[] = {&p, &ph0, &ph1, &coop};
    hipError_t e = hipLaunchCooperativeKernel((void*)mk_kernel, dim3(grid_blocks), dim3(256), args, 0, stream);
    if (e != hipSuccess) fprintf(stderr, "cooperative launch failed: %s (grid %d)\n", hipGetErrorString(e), grid_blocks);
  } else {
    for (int ph = 0; ph < N_PHASES; ++ph) mk_kernel<<<dim3(grid_blocks), dim3(256), 0, stream>>>(p, ph, ph + 1, 0);
  }
}
```

```cpp
#include <hip/hip_runtime.h>
#include <hip/hip_cooperative_groups.h>
#include <cstdio>
namespace cg = cooperative_groups;

#define DI __device__ __forceinline__
typedef unsigned short u16;
typedef __attribute__((ext_vector_type(8))) short bf16x8;
typedef __attribute__((ext_vector_type(4))) short s16x4;
typedef __attribute__((ext_vector_type(2))) __bf16 bf2_t;
typedef __attribute__((ext_vector_type(2))) float f2_t;
typedef __attribute__((ext_vector_type(16))) float f32x16;
typedef __attribute__((ext_vector_type(4))) unsigned u32x4;
typedef __attribute__((ext_vector_type(2))) unsigned u32x2;
typedef __attribute__((ext_vector_type(4))) float f32x4;
#define MFMA32(a, b, c) __builtin_amdgcn_mfma_f32_32x32x16_bf16((a), (b), (c), 0, 0, 0)

constexpr int NP = 16384;
constexpr int NSM = 1024;
constexpr int NT = NP + NSM;
constexpr int NZ = 5248;
constexpr int ZC_KV = 256, ZC_KPE = 384, ZC_GA = 512, ZC_ZS = 1024, ZC_GB = 2688, ZC_MA = 3200, ZC_MB = 4224;
constexpr float EPS = 1e-6f;
constexpr float GN_EPS = 64e-5f;
constexpr int SHW = 1664;

constexpr size_t OFF_CKV_P = 17825792;
constexpr size_t OFF_KPE_P = 26214400;
constexpr size_t OFF_WKV_P = 28311552;
constexpr size_t OFF_SH_P = 28442624;
constexpr size_t OFF_CKV_S = 28449280;
constexpr size_t OFF_KPE_S = 28973568;
constexpr size_t OFF_WKV_S = 29104640;
constexpr size_t OFF_SH_S = 31201792;

constexpr size_t WL_STRIDE = 15728640;
constexpr size_t W_IN = 0, W_UQ = 10747904, W_UKV = 11141120, W_W2 = 11403264, W_A2 = 11468800, W_OA = 11534336, W_OB = 12582912, W_O = 13631488;
constexpr size_t WS_H = 62914560;
constexpr size_t WS_Z = WS_H + 35651584;
constexpr size_t WS_Q = WS_Z + 182714368;
constexpr size_t WS_CKVB = WS_Q + 26738688;
constexpr size_t WS_KPEB = WS_CKVB + 4456448;
constexpr size_t WS_KN = WS_KPEB + 1114112;
constexpr size_t WS_VT = WS_KN + 16777216;
constexpr size_t WS_WKVIN = WS_VT + 16777216;
constexpr size_t WS_OA = WS_WKVIN + 106954752;
constexpr size_t WS_Y = WS_OA + 17825792;
constexpr size_t WS_CTR = WS_Y + 35651584;
constexpr size_t WS_BAR = WS_CTR + 16384;
constexpr size_t WS_SH0 = WS_BAR + 16384;
constexpr size_t WS_CKB = WS_SH0 + 65536;
constexpr size_t WS_KPB = WS_CKB + 16777216;
constexpr size_t WS_TOTAL = WS_KPB + 4194304;
static_assert(WS_TOTAL < 536870912, "ws");

constexpr int SMEM_BYTES = 39424 + 128 * 136 * 2;

struct Params {
  const float *x_prompt, *x_sample, *cache_ckv, *cache_kpe, *state_wkv, *state_shift;
  const float *norm_w, *w_in, *q_norm_w, *kv_norm_w, *w_uq, *w_ukv, *qn_nope, *qn_rope, *kn_nope, *kn_rope;
  const float *mu_shift, *w0, *w2, *a0, *a2, *k_k, *k_a, *r_k, *lnx_w, *lnx_b, *w_out_a, *w_out_b, *w_o;
  float* out;
  char* ws;
};

__device__ const float ROPE_INV[16] = {1.0f, 0.5623413324356079f, 0.3162277638912201f, 0.17782793939113617f, 0.10000000149011612f, 0.05623413249850273f, 0.03162277489900589f, 0.017782794311642647f, 0.009999999776482582f, 0.005623413249850273f, 0.003162277629598975f, 0.0017782794311642647f, 0.0010000000474974513f, 0.000562341301701963f, 0.0003162277571391314f, 0.00017782794020604342f};

DI int tidx() { int t = threadIdx.x; asm volatile("" : "+v"(t)); return t; }
DI float bf2f(u16 h) { return __uint_as_float(((unsigned)h) << 16); }
DI unsigned pk2(float a, float b) { f2_t v = {a, b}; bf2_t r = __builtin_convertvector(v, bf2_t); return __builtin_bit_cast(unsigned, r); }
DI u16 f2bf(float a) { return (u16)(pk2(a, 0.f) & 0xffffu); }
DI float lo2f(unsigned u) { return __uint_as_float(u << 16); }
DI float hi2f(unsigned u) { return __uint_as_float(u & 0xffff0000u); }
DI float wave_sum(float v) {
  v += __builtin_bit_cast(float, __builtin_amdgcn_update_dpp(0, __builtin_bit_cast(int, v), 0x128, 0xF, 0xF, false));
  v += __builtin_bit_cast(float, __builtin_amdgcn_update_dpp(0, __builtin_bit_cast(int, v), 0x124, 0xF, 0xF, false));
  v += __builtin_bit_cast(float, __builtin_amdgcn_update_dpp(0, __builtin_bit_cast(int, v), 0x122, 0xF, 0xF, false));
  v += __builtin_bit_cast(float, __builtin_amdgcn_update_dpp(0, __builtin_bit_cast(int, v), 0x121, 0xF, 0xF, false));
  const int iv = __builtin_bit_cast(int, v);
  const float s0 = __builtin_bit_cast(float, __builtin_amdgcn_readlane(iv, 0)), s1 = __builtin_bit_cast(float, __builtin_amdgcn_readlane(iv, 16));
  const float s2 = __builtin_bit_cast(float, __builtin_amdgcn_readlane(iv, 32)), s3 = __builtin_bit_cast(float, __builtin_amdgcn_readlane(iv, 48));
  return (s0 + s1) + (s2 + s3);
}
DI float xor32(float v) { return __shfl_xor(v, 32); }
DI int crow(int reg, int h) { return (reg & 3) + 8 * (reg >> 2) + 4 * h; }
DI float sigmoidf_(float x) { return __builtin_amdgcn_rcpf(1.f + __expf(-x)); }
DI float siluf_(float x) { return x * __builtin_amdgcn_rcpf(1.f + __expf(-x)); }
DI void rope_sincos(int pos, int i, float& s, float& c) {
  float ang = (float)pos * ROPE_INV[i];
  double rev = (double)ang * 0.15915494309189533577;
  double fr = rev - rint(rev);
  float f = (float)fr;
  s = __builtin_amdgcn_sinf(f);
  c = __builtin_amdgcn_cosf(f);
}
DI const float* xrow(const Params& p, int layer, int t) {
  if (layer == 0) return (t < NP) ? p.x_prompt + (size_t)t * 1024 : p.x_sample + (size_t)(t - NP) * 1024;
  return p.out + (size_t)t * 1024;
}
DI int tok_pos(int t) { return (t < NP) ? t : 4096 + ((t - NP) & 63); }

DI void conv_tile(const float* __restrict__ src, int N, u16* __restrict__ dst, int K, int k0, int n0, int kind, float* sm) {
  const int tid = tidx();
  const int n4 = (tid & 15) * 4, kb = tid >> 4;
  const int np_ = n0 + n4;
  int sc = np_;
  if (kind == 1) sc = (np_ < 416) ? np_ : ((np_ < 512) ? -1 : np_ - 96);
#pragma unroll
  for (int i = 0; i < 4; ++i) {
    const int kl = kb + 16 * i;
    f32x4 v = {0.f, 0.f, 0.f, 0.f};
    if (sc >= 0) v = *(const f32x4*)(src + (size_t)(k0 + kl) * N + sc);
    sm[kl * 65 + n4] = v.x; sm[kl * 65 + n4 + 1] = v.y; sm[kl * 65 + n4 + 2] = v.z; sm[kl * 65 + n4 + 3] = v.w;
  }
  __syncthreads();
  const int nr = tid >> 2, kc = (tid & 3) * 16;
  unsigned o[8];
#pragma unroll
  for (int j = 0; j < 8; ++j) o[j] = pk2(sm[(kc + 2 * j) * 65 + nr], sm[(kc + 2 * j + 1) * 65 + nr]);
  uint4* d = (uint4*)(dst + (size_t)(n0 + nr) * K + k0 + kc);
  d[0] = make_uint4(o[0], o[1], o[2], o[3]);
  d[1] = make_uint4(o[4], o[5], o[6], o[7]);
  __syncthreads();
}

DI void phase_convert(const Params& p, char* smem) {
  float* sm = (float*)smem;
  for (int it = blockIdx.x; it < 4 * 1920; it += gridDim.x) {
    const int layer = it / 1920;
    int r = it % 1920;
    const float* src; u16* dst; int K, N, kind = 0, nt;
    char* wl = p.ws + (size_t)layer * WL_STRIDE;
    if (r < 1312) { src = p.w_in + (size_t)layer * 1024 * 5152; dst = (u16*)(wl + W_IN); K = 1024; N = 5152; kind = 1; nt = 82; }
    else if (r < 1360) { r -= 1312; src = p.w_uq + (size_t)layer * 256 * 768; dst = (u16*)(wl + W_UQ); K = 256; N = 768; nt = 12; }
    else if (r < 1392) { r -= 1360; src = p.w_ukv + (size_t)layer * 128 * 1024; dst = (u16*)(wl + W_UKV); K = 128; N = 1024; nt = 16; }
    else if (r < 1400) { r -= 1392; src = p.w2 + (size_t)layer * 64 * 512; dst = (u16*)(wl + W_W2); K = 64; N = 512; nt = 8; }
    else if (r < 1408) { r -= 1400; src = p.a2 + (size_t)layer * 64 * 512; dst = (u16*)(wl + W_A2); K = 64; N = 512; nt = 8; }
    else if (r < 1536) { r -= 1408; src = p.w_out_a + (size_t)layer * 512 * 1024; dst = (u16*)(wl + W_OA); K = 512; N = 1024; nt = 16; }
    else if (r < 1664) { r -= 1536; src = p.w_out_b + (size_t)layer * 512 * 1024; dst = (u16*)(wl + W_OB); K = 512; N = 1024; nt = 16; }
    else { r -= 1664; src = p.w_o + (size_t)layer * 1024 * 1024; dst = (u16*)(wl + W_O); K = 1024; N = 1024; nt = 16; }
    const int kt = r / nt, ntile = r % nt;
    conv_tile(src, N, dst, K, kt * 64, ntile * 64, kind, sm);
  }
}

DI void phase_rmsnorm(const Params& p, int layer) {
  const int wave = tidx() >> 6, lane = tidx() & 63;
  u16* H = (u16*)(p.ws + WS_H);
  const float* g = p.norm_w + layer * 1024;
  if (blockIdx.x == gridDim.x - 1) {
    u16* sh0 = (u16*)(p.ws + WS_SH0);
    for (int i = tidx(); i < 17 * SHW; i += 256) {
      const int r = i / SHW, c = i - r * SHW;
      sh0[i] = (r == 0) ? (u16)0 : f2bf(p.state_shift[((size_t)layer * 16 + (r - 1)) * SHW + c]);
    }
  }
  {
    const float* c1 = p.cache_ckv + (size_t)layer * 16 * 4096 * 128;
    const float* c2 = p.cache_kpe + (size_t)layer * 16 * 4096 * 32;
    u16* d1 = (u16*)(p.ws + WS_CKB);
    u16* d2 = (u16*)(p.ws + WS_KPB);
    constexpr int N1 = 16 * 4096 * 128 / 8, N2 = 16 * 4096 * 32 / 8;
    for (int i = blockIdx.x * 256 + tidx(); i < N1 + N2; i += gridDim.x * 256) {
      const float* sp = (i < N1) ? c1 + (size_t)i * 8 : c2 + (size_t)(i - N1) * 8;
      u16* dp = (i < N1) ? d1 + (size_t)i * 8 : d2 + (size_t)(i - N1) * 8;
      const f32x4 a = *(const f32x4*)sp, b = *(const f32x4*)(sp + 4);
      *(u32x4*)dp = u32x4{pk2(a.x, a.y), pk2(a.z, a.w), pk2(b.x, b.y), pk2(b.z, b.w)};
    }
  }
  for (int t = blockIdx.x * 4 + wave; t < NT; t += gridDim.x * 4) {
    const float* xr = xrow(p, layer, t);
    float4 v[4];
    float ss = 0.f;
#pragma unroll
    for (int i = 0; i < 4; ++i) {
      v[i] = *(const float4*)(xr + i * 256 + lane * 4);
      ss += v[i].x * v[i].x + v[i].y * v[i].y + v[i].z * v[i].z + v[i].w * v[i].w;
    }
    ss = wave_sum(ss);
    const float rinv = rsqrtf(ss * (1.f / 1024.f) + EPS);
#pragma unroll
    for (int i = 0; i < 4; ++i) {
      const float4 g4 = *(const float4*)(g + i * 256 + lane * 4);
      uint2 o;
      o.x = pk2(v[i].x * rinv * g4.x, v[i].y * rinv * g4.y);
      o.y = pk2(v[i].z * rinv * g4.z, v[i].w * rinv * g4.w);
      *(uint2*)(H + (size_t)t * 1024 + i * 256 + lane * 4) = o;
    }
  }
}

DI void gemm_mainloop(const u16* __restrict__ R, int ldr, const u16* __restrict__ C, int ldc, int K, char* smem, f32x16 (&acc)[2][2]) {
  const int tid = tidx(), lane = tid & 63, w = tid >> 6, wr = w >> 1, wc = w & 1;
  const int l31 = lane & 31, h = lane >> 5;
  const int lrow = tid >> 3, lkc = (tid & 7) * 8;
  u32x4 rr[4], rc[4];
  const int nk = K >> 6;
#pragma unroll
  for (int i = 0; i < 4; ++i) {
    rr[i] = *(const u32x4*)(R + (size_t)(lrow + 32 * i) * ldr + lkc);
    rc[i] = *(const u32x4*)(C + (size_t)(lrow + 32 * i) * ldc + lkc);
  }
  __syncthreads();
  {
    u16* sR = (u16*)smem;
    u16* sC = sR + 128 * 72;
#pragma unroll
    for (int i = 0; i < 4; ++i) {
      *(u32x4*)(sR + (lrow + 32 * i) * 72 + lkc) = rr[i];
      *(u32x4*)(sC + (lrow + 32 * i) * 72 + lkc) = rc[i];
    }
  }
  if (nk > 1) {
#pragma unroll
    for (int i = 0; i < 4; ++i) {
      rr[i] = *(const u32x4*)(R + (size_t)(lrow + 32 * i) * ldr + 64 + lkc);
      rc[i] = *(const u32x4*)(C + (size_t)(lrow + 32 * i) * ldc + 64 + lkc);
    }
  }
  __syncthreads();
  for (int kt = 0; kt < nk; ++kt) {
    const u16* sR = (const u16*)smem + (kt & 1) * (2 * 128 * 72);
    const u16* sC = sR + 128 * 72;
    if (kt + 1 < nk) {
      u16* nR = (u16*)smem + ((kt + 1) & 1) * (2 * 128 * 72);
      u16* nC = nR + 128 * 72;
#pragma unroll
      for (int i = 0; i < 4; ++i) {
        *(u32x4*)(nR + (lrow + 32 * i) * 72 + lkc) = rr[i];
        *(u32x4*)(nC + (lrow + 32 * i) * 72 + lkc) = rc[i];
      }
    }
    if (kt + 2 < nk) {
      const int k0 = (kt + 2) * 64;
#pragma unroll
      for (int i = 0; i < 4; ++i) {
        rr[i] = *(const u32x4*)(R + (size_t)(lrow + 32 * i) * ldr + k0 + lkc);
        rc[i] = *(const u32x4*)(C + (size_t)(lrow + 32 * i) * ldc + k0 + lkc);
      }
    }
#pragma unroll
    for (int ks = 0; ks < 4; ++ks) {
      bf16x8 a[2], b[2];
#pragma unroll
      for (int mi = 0; mi < 2; ++mi) a[mi] = *(const bf16x8*)(sR + (wr * 64 + mi * 32 + l31) * 72 + ks * 16 + h * 8);
#pragma unroll
      for (int ni = 0; ni < 2; ++ni) b[ni] = *(const bf16x8*)(sC + (wc * 64 + ni * 32 + l31) * 72 + ks * 16 + h * 8);
#pragma unroll
      for (int mi = 0; mi < 2; ++mi)
#pragma unroll
        for (int ni = 0; ni < 2; ++ni) acc[mi][ni] = MFMA32(a[mi], b[ni], acc[mi][ni]);
    }
    __syncthreads();
  }
}
DI void zero_acc(f32x16 (&acc)[2][2]) {
#pragma unroll
  for (int mi = 0; mi < 2; ++mi)
#pragma unroll
    for (int ni = 0; ni < 2; ++ni)
#pragma unroll
      for (int r = 0; r < 16; ++r) acc[mi][ni][r] = 0.f;
}
DI void acc_to_lds(const f32x16 (&acc)[2][2], char* smem) {
  float* sT = (float*)smem;
  const int lane = tidx() & 63, w = tidx() >> 6;
  const int l31 = lane & 31, h = lane >> 5, wr = w >> 1, wc = w & 1;
  __syncthreads();
#pragma unroll
  for (int mi = 0; mi < 2; ++mi)
#pragma unroll
    for (int ni = 0; ni < 2; ++ni)
#pragma unroll
      for (int reg = 0; reg < 16; ++reg) sT[(wr * 64 + mi * 32 + crow(reg, h)) * 132 + wc * 64 + ni * 32 + l31] = acc[mi][ni][reg];
  __syncthreads();
}
#define EPI_ROWS(...)                                                          \
  {                                                                            \
    const float* sT_ = (const float*)smem;                                     \
    _Pragma("unroll 2") for (int it_ = 0; it_ < 16; ++it_) {                   \
      const int row = it_ * 8 + (tidx() >> 5), col = (tidx() & 31) * 4; \
      const f32x4 v = *(const f32x4*)(sT_ + row * 132 + col);                  \
      __VA_ARGS__                                                              \
    }                                                                          \
  }

DI void gemm64_mainloop(const u16* __restrict__ R, int ldr, const u16* __restrict__ C, int ldc, int K, char* smem, f32x16& acc) {
  const int tid = tidx(), lane = tid & 63, w = tid >> 6, wr = w >> 1, wc = w & 1;
  const int l31 = lane & 31, h = lane >> 5;
  const int lrow = tid >> 3, lkc = (tid & 7) * 8;
  u32x4 rr[2][2], rc[2][2];
  const int nk = K >> 6;
#define G64_GLOAD(SET, KT)                                                                    \
  {                                                                                           \
    const int k0_ = (KT) * 64;                                                                \
    _Pragma("unroll") for (int i = 0; i < 2; ++i) {                                           \
      rr[SET][i] = *(const u32x4*)(R + (size_t)(lrow + 32 * i) * ldr + k0_ + lkc);            \
      rc[SET][i] = *(const u32x4*)(C + (size_t)(lrow + 32 * i) * ldc + k0_ + lkc);            \
    }                                                                                         \
  }
#define G64_LSTORE(SET, BUF)                                                                  \
  {                                                                                           \
    u16* nR_ = (u16*)smem + (BUF) * (2 * 64 * 72);                                            \
    u16* nC_ = nR_ + 64 * 72;                                                                 \
    _Pragma("unroll") for (int i = 0; i < 2; ++i) {                                           \
      *(u32x4*)(nR_ + (lrow + 32 * i) * 72 + lkc) = rr[SET][i];                               \
      *(u32x4*)(nC_ + (lrow + 32 * i) * 72 + lkc) = rc[SET][i];                               \
    }                                                                                         \
  }
  G64_GLOAD(0, 0)
  G64_GLOAD(1, 1)
  __syncthreads();
  G64_LSTORE(0, 0)
  G64_GLOAD(0, 2)
  __syncthreads();
  for (int kt0 = 0; kt0 < nk; kt0 += 2) {
#pragma unroll
    for (int u = 0; u < 2; ++u) {
      const int kt = kt0 + u;
      const u16* sR = (const u16*)smem + u * (2 * 64 * 72);
      const u16* sC = sR + 64 * 72;
      if (kt + 1 < nk) G64_LSTORE(1 - u, 1 - u)
      if (kt + 3 < nk) G64_GLOAD(1 - u, kt + 3)
#pragma unroll
      for (int ks = 0; ks < 4; ++ks) {
        const bf16x8 a = *(const bf16x8*)(sR + (wr * 32 + l31) * 72 + ks * 16 + h * 8);
        const bf16x8 b = *(const bf16x8*)(sC + (wc * 32 + l31) * 72 + ks * 16 + h * 8);
        acc = MFMA32(a, b, acc);
      }
      __syncthreads();
    }
  }
#undef G64_GLOAD
#undef G64_LSTORE
}
DI void acc64_to_lds(const f32x16& acc, char* smem) {
  float* sT = (float*)smem;
  const int lane = tidx() & 63, w = tidx() >> 6;
  const int l31 = lane & 31, h = lane >> 5, wr = w >> 1, wc = w & 1;
  __syncthreads();
#pragma unroll
  for (int reg = 0; reg < 16; ++reg) sT[(wr * 32 + crow(reg, h)) * 68 + wc * 32 + l31] = acc[reg];
  __syncthreads();
}
#define EPI64_ROWS(...)                                                        \
  {                                                                            \
    const float* sT_ = (const float*)smem;                                     \
    _Pragma("unroll") for (int it_ = 0; it_ < 4; ++it_) {                      \
      const int row = it_ * 16 + (tidx() >> 4), col = (tidx() & 15) * 4;       \
      const f32x4 v = *(const f32x4*)(sT_ + row * 68 + col);                   \
      __VA_ARGS__                                                              \
    }                                                                          \
  }

DI void phase_g1(const Params& p, int layer, char* smem) {
  const u16* H = (const u16*)(p.ws + WS_H);
  const u16* W = (const u16*)(p.ws + (size_t)layer * WL_STRIDE + W_IN);
  u16* Z = (u16*)(p.ws + WS_Z);
  const int xcd = blockIdx.x & 7, jb = blockIdx.x >> 3, nb = (gridDim.x + 7 - xcd) >> 3;
  for (int m = jb; m < 17 * 41; m += nb) {
    const int ft = m / 17, tt = xcd + 8 * (m % 17);
    f32x16 acc[2][2];
    zero_acc(acc);
    gemm_mainloop(H + (size_t)tt * 128 * 1024, 1024, W + (size_t)ft * 128 * 1024, 1024, 1024, smem, acc);
    acc_to_lds(acc, smem);
    EPI_ROWS({ *(u32x2*)(Z + (size_t)(tt * 128 + row) * NZ + ft * 128 + col) = u32x2{pk2(v.x, v.y), pk2(v.z, v.w)}; })
  }
}

DI void norms_token(const Params& p, int layer, int t, int lane) {
  const u16* zr = (const u16*)(p.ws + WS_Z) + (size_t)t * NZ;
  u16* CQN = (u16*)(p.ws + WS_H);
  u16* CKVB = (u16*)(p.ws + WS_CKVB);
  u16* KPEB = (u16*)(p.ws + WS_KPEB);
  {
    const uint2 raw = *(const uint2*)(zr + lane * 4);
    const float c0 = lo2f(raw.x), c1 = hi2f(raw.x), c2 = lo2f(raw.y), c3 = hi2f(raw.y);
    float ss = wave_sum(c0 * c0 + c1 * c1 + c2 * c2 + c3 * c3);
    const float rinv = rsqrtf(ss * (1.f / 256.f) + EPS);
    const float4 g = *(const float4*)(p.q_norm_w + layer * 256 + lane * 4);
    uint2 o;
    o.x = pk2(c0 * rinv * g.x, c1 * rinv * g.y);
    o.y = pk2(c2 * rinv * g.z, c3 * rinv * g.w);
    *(uint2*)(CQN + (size_t)t * 256 + lane * 4) = o;
  }
  {
    const unsigned raw = *(const unsigned*)(zr + ZC_KV + lane * 2);
    const float c0 = lo2f(raw), c1 = hi2f(raw);
    float ss = wave_sum(c0 * c0 + c1 * c1);
    const float rinv = rsqrtf(ss * (1.f / 128.f) + EPS);
    const float2 g = *(const float2*)(p.kv_norm_w + layer * 128 + lane * 2);
    const float o0 = c0 * rinv * g.x, o1 = c1 * rinv * g.y;
    float* dst = (t < NP) ? p.out + OFF_CKV_P + ((size_t)layer * NP + t) * 128 : p.out + OFF_CKV_S + ((size_t)layer * NSM + (t - NP)) * 128;
    *(float2*)(dst + lane * 2) = make_float2(o0, o1);
    *(unsigned*)(CKVB + (size_t)t * 128 + lane * 2) = pk2(o0, o1);
  }
  {
    float v = (lane < 32) ? bf2f(zr[ZC_KPE + lane]) : 0.f;
    float ss = wave_sum(v * v);
    const float rinv = rsqrtf(ss * (1.f / 32.f) + EPS);
    v = v * rinv * p.kn_rope[layer * 32 + (lane & 31)];
    const float pr = __shfl_xor(v, 16);
    float s, c;
    rope_sincos(tok_pos(t), lane & 15, s, c);
    const float o = ((lane & 16) == 0) ? (v * c - pr * s) : (v * c + pr * s);
    if (lane < 32) {
      float* dst = (t < NP) ? p.out + OFF_KPE_P + ((size_t)layer * NP + t) * 32 : p.out + OFF_KPE_S + ((size_t)layer * NSM + (t - NP)) * 32;
      dst[lane] = o;
      KPEB[(size_t)t * 32 + lane] = f2bf(o);
    }
  }
  float* sh = nullptr;
  if (t == NP - 1) sh = p.out + OFF_SH_P + (size_t)layer * SHW;
  else if (t >= NP && ((t - NP) & 63) == 63) sh = p.out + OFF_SH_S + ((size_t)layer * 16 + ((t - NP) >> 6)) * SHW;
  if (sh) {
#pragma unroll 1
    for (int c = lane; c < SHW; c += 64) sh[c] = bf2f(zr[ZC_ZS + c]);
  }
}

DI void zm4(const Params& p, int layer, int t, int c, float (&o)[4]) {
  const u16* zr = (const u16*)(p.ws + WS_Z) + (size_t)t * NZ + ZC_ZS + c;
  const u32x2 a = *(const u32x2*)zr;
  const bool first = (t < NP) ? (t == 0) : (((t - NP) & 63) == 0);
  const int srow = (t < NP) ? 0 : 1 + ((t - NP) >> 6);
  const u16* pr = first ? (const u16*)(p.ws + WS_SH0) + srow * SHW + c : zr - NZ;
  const u32x2 b = *(const u32x2*)pr;
  const f32x4 mu = *(const f32x4*)(p.mu_shift + layer * SHW + c);
  const float c0 = lo2f(a.x), c1 = hi2f(a.x), c2 = lo2f(a.y), c3 = hi2f(a.y);
  o[0] = c0 + (lo2f(b.x) - c0) * mu.x;
  o[1] = c1 + (hi2f(b.x) - c1) * mu.y;
  o[2] = c2 + (lo2f(b.y) - c2) * mu.z;
  o[3] = c3 + (hi2f(b.y) - c3) * mu.w;
}
DI float tanhf_(float x) {
  const float t = __expf(-2.f * fabsf(x));
  const float r = (1.f - t) * __builtin_amdgcn_rcpf(1.f + t);
  return x < 0.f ? -r : r;
}

constexpr int WPS = 900;
DI void zml(const u16* sz, int row, int col, const float* mu, float (&o)[4]) {
  const u32x2 a = *(const u32x2*)(sz + (row + 1) * WPS + col);
  const u32x2 b = *(const u32x2*)(sz + row * WPS + col);
  const f32x4 m4 = *(const f32x4*)mu;
  const float c0 = lo2f(a.x), c1 = hi2f(a.x), c2 = lo2f(a.y), c3 = hi2f(a.y);
  o[0] = c0 + (lo2f(b.x) - c0) * m4.x;
  o[1] = c1 + (hi2f(b.x) - c1) * m4.y;
  o[2] = c2 + (lo2f(b.y) - c2) * m4.z;
  o[3] = c3 + (hi2f(b.y) - c3) * m4.w;
}
DI void wkvprep_block(const Params& p, int layer, int tt, int hg, char* smem) {
  u16* sz = (u16*)smem;
  const int tid = tidx(), lane = tid & 63, w = tid >> 6, l31 = lane & 31, h = lane >> 5;
  const int t0 = tt * 32;
  const int hd = hg * 4 + w;
  const u16* Z = (const u16*)(p.ws + WS_Z);
  const bool seq_start = (t0 < NP) ? (t0 == 0) : (((t0 - NP) & 63) == 0);
  const u16* prevrow = seq_start ? (const u16*)(p.ws + WS_SH0) + ((t0 < NP) ? 0 : 1 + ((t0 - NP) >> 6)) * SHW : Z + (size_t)(t0 - 1) * NZ + ZC_ZS;
  __syncthreads();
  for (int ci = tid; ci < 33 * 112; ci += 256) {
    const int row = ci / 112, cc = ci - row * 112;
    int scol, lcol;
    if (cc < 16) { scol = 1536 + cc * 8; lcol = cc * 8; }
    else {
      const int j = cc - 16, ww = j / 24, r2 = j - ww * 24, part = r2 >> 3, o = (r2 & 7) * 8;
      scol = part * 512 + (hg * 4 + ww) * 64 + o;
      lcol = 128 + ww * 192 + part * 64 + o;
    }
    const u16* src = (row == 0) ? prevrow + scol : Z + (size_t)(t0 + row - 1) * NZ + ZC_ZS + scol;
    const u32x4 v = *(const u32x4*)src;
    u32x2* d = (u32x2*)(sz + row * WPS + lcol);
    d[0] = u32x2{v.x, v.y};
    d[1] = u32x2{v.z, v.w};
  }
  __syncthreads();
  const int tok = t0 + l31;
  const u16* W2T = (const u16*)(p.ws + (size_t)layer * WL_STRIDE + W_W2);
  const u16* A2T = (const u16*)(p.ws + (size_t)layer * WL_STRIDE + W_A2);
  const float* mu = p.mu_shift + layer * SHW;
  u16* WK = (u16*)(p.ws + WS_WKVIN) + ((size_t)hd * NT + tok) * 384;
  f32x16 accW[2], accA[2];
#pragma unroll
  for (int m = 0; m < 2; ++m)
#pragma unroll
    for (int r = 0; r < 16; ++r) { accW[m][r] = 0.f; accA[m][r] = 0.f; }
#pragma unroll
  for (int ks = 0; ks < 4; ++ks) {
    const int c0 = ks * 16 + 8 * h;
    float t0a[4], t1a[4], u0[4], u1[4];
    zml(sz, l31, c0, mu + 1536 + c0, t0a);
    zml(sz, l31, c0 + 4, mu + 1536 + c0 + 4, t1a);
    zml(sz, l31, 64 + c0, mu + 1600 + c0, u0);
    zml(sz, l31, 64 + c0 + 4, mu + 1600 + c0 + 4, u1);
    u32x4 bw, ba;
    bw.x = pk2(tanhf_(t0a[0]), tanhf_(t0a[1])); bw.y = pk2(tanhf_(t0a[2]), tanhf_(t0a[3]));
    bw.z = pk2(tanhf_(t1a[0]), tanhf_(t1a[1])); bw.w = pk2(tanhf_(t1a[2]), tanhf_(t1a[3]));
    ba.x = pk2(u0[0], u0[1]); ba.y = pk2(u0[2], u0[3]); ba.z = pk2(u1[0], u1[1]); ba.w = pk2(u1[2], u1[3]);
    const bf16x8 bwf = __builtin_bit_cast(bf16x8, bw), baf = __builtin_bit_cast(bf16x8, ba);
#pragma unroll
    for (int m = 0; m < 2; ++m) {
      const bf16x8 aw = *(const bf16x8*)(W2T + (size_t)(hd * 64 + m * 32 + l31) * 64 + ks * 16 + h * 8);
      const bf16x8 aa = *(const bf16x8*)(A2T + (size_t)(hd * 64 + m * 32 + l31) * 64 + ks * 16 + h * 8);
      accW[m] = MFMA32(aw, bwf, accW[m]);
      accA[m] = MFMA32(aa, baf, accA[m]);
    }
  }
  const int hb = 128 + w * 192;
  float ss = 0.f;
#pragma unroll
  for (int m = 0; m < 2; ++m)
#pragma unroll
    for (int q = 0; q < 4; ++q) {
      const int f0 = m * 32 + 8 * q + 4 * h, F = hd * 64 + f0;
      float k4[4];
      zml(sz, l31, hb + 64 + f0, mu + 512 + F, k4);
      const float4 kk_ = *(const float4*)(p.k_k + layer * 512 + F);
      const float a = k4[0] * kk_.x, b = k4[1] * kk_.y, c = k4[2] * kk_.z, d = k4[3] * kk_.w;
      ss += a * a + b * b + c * c + d * d;
    }
  ss += xor32(ss);
  const float rn = 1.f / fmaxf(sqrtf(ss), 1e-12f);
#pragma unroll
  for (int m = 0; m < 2; ++m)
#pragma unroll
    for (int q = 0; q < 4; ++q) {
      const int f0 = m * 32 + 8 * q + 4 * h, F = hd * 64 + f0;
      float r4[4], k4[4], v4[4];
      zml(sz, l31, hb + f0, mu + F, r4);
      zml(sz, l31, hb + 64 + f0, mu + 512 + F, k4);
      zml(sz, l31, hb + 128 + f0, mu + 1024 + F, v4);
      const float4 w0 = *(const float4*)(p.w0 + layer * 512 + F);
      const float4 a0 = *(const float4*)(p.a0 + layer * 512 + F);
      const float4 kk_ = *(const float4*)(p.k_k + layer * 512 + F);
      const float4 ka_ = *(const float4*)(p.k_a + layer * 512 + F);
      const float w0a[4] = {w0.x, w0.y, w0.z, w0.w}, a0a[4] = {a0.x, a0.y, a0.z, a0.w};
      const float kka[4] = {kk_.x, kk_.y, kk_.z, kk_.w}, kaa[4] = {ka_.x, ka_.y, ka_.z, ka_.w};
      float e4[4], kp4[4], kn4[4], b4[4];
#pragma unroll
      for (int j = 0; j < 4; ++j) {
        const float lw = w0a[j] + accW[m][4 * q + j];
        const float nx = -lw;
        const float sp = fmaxf(nx, 0.f) + __logf(1.f + __expf(-fabsf(nx)));
        e4[j] = __expf(-sp - 0.5f);
        const float a = sigmoidf_(a0a[j] + accA[m][4 * q + j]);
        kn4[j] = k4[j] * kka[j] * rn;
        b4[j] = kn4[j] * a;
        kp4[j] = k4[j] * (1.f + (a - 1.f) * kaa[j]);
      }
      *(u32x2*)(WK + 0 * 64 + f0) = u32x2{pk2(r4[0], r4[1]), pk2(r4[2], r4[3])};
      *(u32x2*)(WK + 1 * 64 + f0) = u32x2{pk2(e4[0] * -1.4426950408889634f, e4[1] * -1.4426950408889634f), pk2(e4[2] * -1.4426950408889634f, e4[3] * -1.4426950408889634f)};
      *(u32x2*)(WK + 2 * 64 + f0) = u32x2{pk2(kp4[0], kp4[1]), pk2(kp4[2], kp4[3])};
      *(u32x2*)(WK + 3 * 64 + f0) = u32x2{pk2(v4[0], v4[1]), pk2(v4[2], v4[3])};
      *(u32x2*)(WK + 4 * 64 + f0) = u32x2{pk2(-kn4[0], -kn4[1]), pk2(-kn4[2], -kn4[3])};
      *(u32x2*)(WK + 5 * 64 + f0) = u32x2{pk2(b4[0], b4[1]), pk2(b4[2], b4[3])};
    }
}

DI void qproj_item(const Params& p, int layer, int tt, int hd, int lane);
DI void kvproj_item(const Params& p, int layer, int tt, int hd, int lane);
DI void phase_norms_prep(const Params& p, int layer, char* smem, int* s_item) {
  int* ctr = (int*)(p.ws + WS_CTR) + 4 + layer;
  const int wave = tidx() >> 6, lane = tidx() & 63;
  for (;;) {
    __syncthreads();
    if (tidx() == 0) *s_item = atomicAdd(ctr, 1);
    __syncthreads();
    const int it = *s_item;
    if (it >= 1088 + 2112 + 272) break;
    if (it < 1088) { wkvprep_block(p, layer, it >> 1, it & 1, smem); continue; }
    if (it < 1088 + 2112) {
      const int wi = (it - 1088) * 4 + wave;
      if (wi < 544 * 8) qproj_item(p, layer, wi >> 3, wi & 7, lane);
      else { const int j = wi - 544 * 8; kvproj_item(p, layer, j >> 3, j & 7, lane); }
      continue;
    }
    const int tb = (it - 1088 - 2112) * 64 + wave * 16;
    for (int j = 0; j < 16; ++j) norms_token(p, layer, tb + j, lane);
  }
}

DI bf16x8 normed_frag(const u16* zsrc, const float* g, float& ssq) {
  const u32x4 raw = *(const u32x4*)zsrc;
  const f32x4 g0 = *(const f32x4*)g, g1 = *(const f32x4*)(g + 4);
  const float f0 = lo2f(raw.x), f1 = hi2f(raw.x), f2 = lo2f(raw.y), f3 = hi2f(raw.y);
  const float f4 = lo2f(raw.z), f5 = hi2f(raw.z), f6 = lo2f(raw.w), f7 = hi2f(raw.w);
  ssq += (f0 * f0 + f1 * f1) + (f2 * f2 + f3 * f3) + (f4 * f4 + f5 * f5) + (f6 * f6 + f7 * f7);
  const u32x4 o = {pk2(f0 * g0.x, f1 * g0.y), pk2(f2 * g0.z, f3 * g0.w), pk2(f4 * g1.x, f5 * g1.y), pk2(f6 * g1.z, f7 * g1.w)};
  return __builtin_bit_cast(bf16x8, o);
}
DI void qproj_item(const Params& p, int layer, int tt, int hd, int lane) {
  const int l31 = lane & 31, h = lane >> 5;
  const int tok = tt * 32 + l31;
  const u16* zq = (const u16*)(p.ws + WS_Z) + (size_t)tok * NZ;
  const float* gq = p.q_norm_w + layer * 256;
  float ssq = 0.f;
  const u16* WT = (const u16*)(p.ws + (size_t)layer * WL_STRIDE + W_UQ);
  u16* Q = (u16*)(p.ws + WS_Q);
  f32x16 acc[3];
#pragma unroll
  for (int m = 0; m < 3; ++m)
#pragma unroll
    for (int r = 0; r < 16; ++r) acc[m][r] = 0.f;
#pragma unroll 4
  for (int ks = 0; ks < 16; ++ks) {
    const bf16x8 bfr = normed_frag(zq + ks * 16 + h * 8, gq + ks * 16 + h * 8, ssq);
#pragma unroll
    for (int m = 0; m < 3; ++m) {
      const bf16x8 afr = *(const bf16x8*)(WT + (size_t)(hd * 96 + m * 32 + l31) * 256 + ks * 16 + h * 8);
      acc[m] = MFMA32(afr, bfr, acc[m]);
    }
  }
  {
    ssq += xor32(ssq);
    const float rinv = rsqrtf(ssq * (1.f / 256.f) + EPS);
#pragma unroll
    for (int m = 0; m < 3; ++m)
#pragma unroll
      for (int r = 0; r < 16; ++r) acc[m][r] *= rinv;
  }
  const float qs = 0.10206207261596577f * 1.4426950408889634f;
  float ss = 0.f;
#pragma unroll
  for (int m = 0; m < 2; ++m)
#pragma unroll
    for (int r = 0; r < 16; ++r) ss += acc[m][r] * acc[m][r];
  ss += xor32(ss);
  const float rn = rsqrtf(ss * (1.f / 64.f) + EPS) * qs;
  u16* qd = Q + (size_t)tok * 768 + hd * 96;
#pragma unroll
  for (int m = 0; m < 2; ++m)
#pragma unroll
    for (int q = 0; q < 4; ++q) {
      const int f0 = m * 32 + 8 * q + 4 * h;
      const float4 g = *(const float4*)(p.qn_nope + layer * 64 + f0);
      *(uint2*)(qd + f0) = make_uint2(pk2(acc[m][4 * q] * rn * g.x, acc[m][4 * q + 1] * rn * g.y), pk2(acc[m][4 * q + 2] * rn * g.z, acc[m][4 * q + 3] * rn * g.w));
    }
  float sr = 0.f;
#pragma unroll
  for (int r = 0; r < 16; ++r) sr += acc[2][r] * acc[2][r];
  sr += xor32(sr);
  const float rr = rsqrtf(sr * (1.f / 32.f) + EPS);
  const int pos = tok_pos(tok);
  float o1[8], o2[8];
#pragma unroll
  for (int r = 0; r < 8; ++r) {
    const int i = crow(r, h);
    const float x1 = acc[2][r] * rr * p.qn_rope[layer * 32 + i];
    const float x2 = acc[2][r + 8] * rr * p.qn_rope[layer * 32 + i + 16];
    float s, c;
    rope_sincos(pos, i, s, c);
    o1[r] = (x1 * c - x2 * s) * qs;
    o2[r] = (x2 * c + x1 * s) * qs;
  }
#pragma unroll
  for (int q = 0; q < 2; ++q) {
    const int i0 = 8 * q + 4 * h;
    *(uint2*)(qd + 64 + i0) = make_uint2(pk2(o1[4 * q], o1[4 * q + 1]), pk2(o1[4 * q + 2], o1[4 * q + 3]));
    *(uint2*)(qd + 64 + 16 + i0) = make_uint2(pk2(o2[4 * q], o2[4 * q + 1]), pk2(o2[4 * q + 2], o2[4 * q + 3]));
  }
}

DI void kvproj_item(const Params& p, int layer, int tt, int hd, int lane) {
  const int l31 = lane & 31, h = lane >> 5;
  const int tok = tt * 32 + l31;
  const u16* zk = (const u16*)(p.ws + WS_Z) + (size_t)tok * NZ + ZC_KV;
  const float* gk = p.kv_norm_w + layer * 128;
  float ssq = 0.f;
  const u16* WT = (const u16*)(p.ws + (size_t)layer * WL_STRIDE + W_UKV);
  u16* KN = (u16*)(p.ws + WS_KN);
  u16* VT = (u16*)(p.ws + WS_VT);
  f32x16 acc[4];
#pragma unroll
  for (int m = 0; m < 4; ++m)
#pragma unroll
    for (int r = 0; r < 16; ++r) acc[m][r] = 0.f;
#pragma unroll 4
  for (int ks = 0; ks < 8; ++ks) {
    const bf16x8 bfr = normed_frag(zk + ks * 16 + h * 8, gk + ks * 16 + h * 8, ssq);
#pragma unroll
    for (int m = 0; m < 4; ++m) {
      const bf16x8 afr = *(const bf16x8*)(WT + (size_t)(hd * 128 + m * 32 + l31) * 128 + ks * 16 + h * 8);
      acc[m] = MFMA32(afr, bfr, acc[m]);
    }
  }
  {
    ssq += xor32(ssq);
    const float rinv = rsqrtf(ssq * (1.f / 128.f) + EPS);
#pragma unroll
    for (int m = 0; m < 4; ++m)
#pragma unroll
      for (int r = 0; r < 16; ++r) acc[m][r] *= rinv;
  }
  float ss = 0.f;
#pragma unroll
  for (int m = 0; m < 2; ++m)
#pragma unroll
    for (int r = 0; r < 16; ++r) ss += acc[m][r] * acc[m][r];
  ss += xor32(ss);
  const float rn = rsqrtf(ss * (1.f / 64.f) + EPS);
  u16* kd = KN + ((size_t)hd * NP + tok) * 64;
#pragma unroll
  for (int m = 0; m < 2; ++m)
#pragma unroll
    for (int q = 0; q < 4; ++q) {
      const int f0 = m * 32 + 8 * q + 4 * h;
      const float4 g = *(const float4*)(p.kn_nope + layer * 64 + f0);
      *(uint2*)(kd + f0) = make_uint2(pk2(acc[m][4 * q] * rn * g.x, acc[m][4 * q + 1] * rn * g.y), pk2(acc[m][4 * q + 2] * rn * g.z, acc[m][4 * q + 3] * rn * g.w));
    }
#pragma unroll
  for (int m = 0; m < 2; ++m)
#pragma unroll
    for (int r = 0; r < 16; ++r) {
      const int d = m * 32 + crow(r, h);
      VT[((size_t)hd * 64 + d) * NP + tok] = f2bf(acc[2 + m][r]);
    }
}

DI void phase_proj(const Params& p, int layer) {
  const int wave = tidx() >> 6, lane = tidx() & 63;
  const int nw = gridDim.x * 4, gw = blockIdx.x * 4 + wave;
  for (int it = gw; it < 544 * 8 + 512 * 8; it += nw) {
    if (it < 544 * 8) qproj_item(p, layer, it >> 3, it & 7, lane);
    else { const int j = it - 544 * 8; kvproj_item(p, layer, j >> 3, j & 7, lane); }
  }
}

DI float wave_max(float v) {
#pragma unroll
  for (int o = 32; o > 0; o >>= 1) v = fmaxf(v, __shfl_xor(v, o));
  return v;
}
DI float attn_bound(const Params& p, int layer, int lane) {
  const float gqn = wave_max(fabsf(p.qn_nope[layer * 64 + lane])), gkn = wave_max(fabsf(p.kn_nope[layer * 64 + lane]));
  const float gqr = wave_max(fabsf(p.qn_rope[layer * 32 + (lane & 31)])), gkr = wave_max(fabsf(p.kn_rope[layer * 32 + (lane & 31)]));
  const float qs = 0.10206207261596577f * 1.4426950408889634f;
  return 1.02f * qs * (64.f * gqn * gkn + 32.f * gqr * gkr) + 0.25f;
}
template <int NSUB>
DI void attn_tile(const bf16x8 (&qf)[6], const u16* sK, const u16* sVT, int ksub0, f32x16 (&o)[2], float& l, float negB, int l31, int h) {
  f32x16 s[NSUB];
  {
    bf16x8 kf[NSUB][6];
#pragma unroll
    for (int i = 0; i < NSUB; ++i)
#pragma unroll
      for (int ks = 0; ks < 6; ++ks) kf[i][ks] = *(const bf16x8*)(sK + ((ksub0 + i) * 32 + l31) * 104 + ks * 16 + h * 8);
#pragma unroll
    for (int i = 0; i < NSUB; ++i) {
#pragma unroll
      for (int r = 0; r < 16; ++r) s[i][r] = negB;
#pragma unroll
      for (int ks = 0; ks < 6; ++ks) s[i] = MFMA32(kf[i][ks], qf[ks], s[i]);
    }
    __builtin_amdgcn_sched_group_barrier(0x100, 6 * NSUB, 0);
    __builtin_amdgcn_sched_group_barrier(0x008, 6 * NSUB, 0);
  }
  bf16x8 vf[NSUB][2][2];
#pragma unroll
  for (int i = 0; i < NSUB; ++i)
#pragma unroll
    for (int st = 0; st < 2; ++st)
#pragma unroll
      for (int md = 0; md < 2; ++md) {
        const u16* vp = sVT + (md * 32 + l31) * 68 + (ksub0 + i) * 32 + 16 * st + 4 * h;
        const s16x4 lo = *(const s16x4*)vp;
        const s16x4 hi = *(const s16x4*)(vp + 8);
        vf[i][st][md] = __builtin_shufflevector(lo, hi, 0, 1, 2, 3, 4, 5, 6, 7);
      }
  float ps = 0.f;
#pragma unroll
  for (int i = 0; i < NSUB; ++i)
#pragma unroll
    for (int r = 0; r < 16; ++r) {
      const float pv = __builtin_amdgcn_exp2f(s[i][r]);
      ps += pv;
      s[i][r] = pv;
    }
  l += ps;
#pragma unroll
  for (int i = 0; i < NSUB; ++i)
#pragma unroll
    for (int st = 0; st < 2; ++st) {
      u32x4 pu;
      pu.x = pk2(s[i][8 * st + 0], s[i][8 * st + 1]);
      pu.y = pk2(s[i][8 * st + 2], s[i][8 * st + 3]);
      pu.z = pk2(s[i][8 * st + 4], s[i][8 * st + 5]);
      pu.w = pk2(s[i][8 * st + 6], s[i][8 * st + 7]);
      const bf16x8 pf = __builtin_bit_cast(bf16x8, pu);
#pragma unroll
      for (int md = 0; md < 2; ++md) o[md] = MFMA32(vf[i][st][md], pf, o[md]);
    }
}

DI void attn_store(const Params& p, int tok, int hd, const f32x16 (&o)[2], float linv, int h) {
  const u16* gz = (const u16*)(p.ws + WS_Z) + (size_t)tok * NZ + ZC_GA + hd * 64;
  u16* OA = (u16*)(p.ws + WS_OA) + (size_t)tok * 512 + hd * 64;
#pragma unroll
  for (int md = 0; md < 2; ++md)
#pragma unroll
    for (int q = 0; q < 4; ++q) {
      const int d0 = md * 32 + 8 * q + 4 * h;
      const uint2 g = *(const uint2*)(gz + d0);
      const float v0 = o[md][4 * q] * linv * siluf_(lo2f(g.x));
      const float v1 = o[md][4 * q + 1] * linv * siluf_(hi2f(g.x));
      const float v2 = o[md][4 * q + 2] * linv * siluf_(lo2f(g.y));
      const float v3 = o[md][4 * q + 3] * linv * siluf_(hi2f(g.y));
      *(uint2*)(OA + d0) = make_uint2(pk2(v0, v1), pk2(v2, v3));
    }
}

DI void attn_prompt_item(const Params& p, int layer, int qt, int hd, char* smem) {
  u16* sK = (u16*)smem;
  u16* sVT = (u16*)(smem + 13312);
  const int tid = tidx(), lane = tid & 63, w = tid >> 6, l31 = lane & 31, h = lane >> 5;
  const int tok = qt * 128 + w * 32 + l31;
  const u16* Q = (const u16*)(p.ws + WS_Q);
  const u16* KN = (const u16*)(p.ws + WS_KN) + (size_t)hd * NP * 64;
  const u16* KPEB = (const u16*)(p.ws + WS_KPEB);
  const u16* VT = (const u16*)(p.ws + WS_VT) + (size_t)hd * 64 * NP;
  bf16x8 qf[6];
#pragma unroll
  for (int ks = 0; ks < 6; ++ks) qf[ks] = *(const bf16x8*)(Q + (size_t)tok * 768 + hd * 96 + ks * 16 + h * 8);
  f32x16 o[2];
#pragma unroll
  for (int d = 0; d < 2; ++d)
#pragma unroll
    for (int r = 0; r < 16; ++r) o[d][r] = 0.f;
  float l = 0.f;
  const float negB = -attn_bound(p, layer, lane);
  const int nkt = 2 * qt + 2;
  const int my_nkt = (w < 2) ? nkt - 1 : nkt;
  u32x4 pk[2][2], pr[2], pv[2][2];
#define PA_GLOAD(SET, KT)                                                                        \
  {                                                                                              \
    const int key0_ = (KT) * 64;                                                                 \
    _Pragma("unroll") for (int i = 0; i < 2; ++i) {                                              \
      const int c = tid + 256 * i;                                                               \
      pk[SET][i] = *(const u32x4*)(KN + (size_t)(key0_ + (c >> 3)) * 64 + (c & 7) * 8);          \
      pv[SET][i] = *(const u32x4*)(VT + (size_t)(c >> 3) * NP + key0_ + (c & 7) * 8);            \
    }                                                                                            \
    pr[SET] = *(const u32x4*)(KPEB + (size_t)(key0_ + (tid >> 2)) * 32 + (tid & 3) * 8);         \
  }
  PA_GLOAD(0, 0)
  PA_GLOAD(1, 1)
  for (int kt0 = 0; kt0 < nkt; kt0 += 2) {
#pragma unroll
    for (int u = 0; u < 2; ++u) {
      const int kt = kt0 + u;
      __syncthreads();
#pragma unroll
      for (int i = 0; i < 2; ++i) {
        const int c = tid + 256 * i;
        *(u32x4*)(sK + (c >> 3) * 104 + (c & 7) * 8) = pk[u][i];
        u32x2* vd = (u32x2*)(sVT + (c >> 3) * 68 + (c & 7) * 8);
        vd[0] = u32x2{pv[u][i].x, pv[u][i].y};
        vd[1] = u32x2{pv[u][i].z, pv[u][i].w};
      }
      *(u32x4*)(sK + (tid >> 2) * 104 + 64 + (tid & 3) * 8) = pr[u];
      __syncthreads();
      if (kt + 2 < nkt) PA_GLOAD(u, kt + 2)
      if (kt < my_nkt) attn_tile<2>(qf, sK, sVT, 0, o, l, negB, l31, h);
    }
  }
#undef PA_GLOAD
  l += xor32(l);
  attn_store(p, tok, hd, o, 1.f / l, h);
}

DI void attn_sample_item(const Params& p, int layer, int b, int hd, char* smem) {
  u16* sC = (u16*)smem;
  u16* sK = (u16*)(smem + 17408);
  u16* sVT = (u16*)(smem + 17408 + 13312);
  u16* sW = (u16*)(smem + 39424);
  const int tid = tidx(), lane = tid & 63, w = tid >> 6, l31 = lane & 31, h = lane >> 5;
  const int khu = w & 1, part = w >> 1;
  const int qh = w >> 1, kh = w & 1;
  const int tok = NP + b * 64 + qh * 32 + l31;
  const u16* Q = (const u16*)(p.ws + WS_Q);
  const u16* WT = (const u16*)(p.ws + (size_t)layer * WL_STRIDE + W_UKV) + (size_t)hd * 128 * 128;
  __syncthreads();
#pragma unroll
  for (int i = 0; i < 8; ++i) {
    const int c = tid + 256 * i;
    *(u32x4*)(sW + (c >> 4) * 136 + (c & 15) * 8) = *(const u32x4*)(WT + (size_t)c * 8);
  }
  bf16x8 qf[6];
#pragma unroll
  for (int ks = 0; ks < 6; ++ks) qf[ks] = *(const bf16x8*)(Q + (size_t)tok * 768 + hd * 96 + ks * 16 + h * 8);
  f32x16 o[2];
#pragma unroll
  for (int d = 0; d < 2; ++d)
#pragma unroll
    for (int r = 0; r < 16; ++r) o[d][r] = 0.f;
  float l = 0.f;
  const float negB = -attn_bound(p, layer, lane);
  const u16* cck = (const u16*)(p.ws + WS_CKB) + (size_t)b * 4096 * 128;
  const u16* ckp = (const u16*)(p.ws + WS_KPB) + (size_t)b * 4096 * 32;
  const u16* nck = (const u16*)(p.ws + WS_CKVB) + (size_t)(NP + b * 64) * 128;
  const u16* nkp = (const u16*)(p.ws + WS_KPEB) + (size_t)(NP + b * 64) * 32;
  u32x4 pc[4], pp;
#define SA_GLOAD(KT)                                                                      \
  {                                                                                       \
    const u16* s1_ = ((KT) < 64) ? cck + (size_t)(KT) * 64 * 128 : nck;                   \
    const u16* s2_ = ((KT) < 64) ? ckp + (size_t)(KT) * 64 * 32 : nkp;                    \
    _Pragma("unroll") for (int i = 0; i < 4; ++i) pc[i] = *(const u32x4*)(s1_ + (size_t)(tid + 256 * i) * 8); \
    pp = *(const u32x4*)(s2_ + (size_t)tid * 8);                                          \
  }
  SA_GLOAD(0)
  for (int kt = 0; kt < 65; ++kt) {
    __syncthreads();
#pragma unroll
    for (int i = 0; i < 4; ++i) {
      const int c = tid + 256 * i;
      *(u32x4*)(sC + (c >> 4) * 136 + (c & 15) * 8) = pc[i];
    }
    *(u32x4*)(sK + (tid >> 2) * 104 + 64 + (tid & 3) * 8) = pp;
    __syncthreads();
    if (kt + 1 < 65) SA_GLOAD(kt + 1)
    {
      f32x16 acc[2];
#pragma unroll
      for (int mt = 0; mt < 2; ++mt)
#pragma unroll
        for (int r = 0; r < 16; ++r) acc[mt][r] = 0.f;
      bf16x8 cfa[8];
#pragma unroll
      for (int ks = 0; ks < 8; ++ks) cfa[ks] = *(const bf16x8*)(sC + (khu * 32 + l31) * 136 + ks * 16 + h * 8);
#pragma unroll
      for (int mt = 0; mt < 2; ++mt) {
        bf16x8 wfa[8];
#pragma unroll
        for (int ks = 0; ks < 8; ++ks) wfa[ks] = *(const bf16x8*)(sW + (part * 64 + mt * 32 + l31) * 136 + ks * 16 + h * 8);
#pragma unroll
        for (int ks = 0; ks < 8; ++ks) {
          if (part == 0) acc[mt] = MFMA32(wfa[ks], cfa[ks], acc[mt]);
          else acc[mt] = MFMA32(cfa[ks], wfa[ks], acc[mt]);
        }
      }
      if (part == 0) {
        float ss = 0.f;
#pragma unroll
        for (int mt = 0; mt < 2; ++mt)
#pragma unroll
          for (int r = 0; r < 16; ++r) ss += acc[mt][r] * acc[mt][r];
        ss += xor32(ss);
        const float rn = rsqrtf(ss * (1.f / 64.f) + EPS);
#pragma unroll
        for (int mt = 0; mt < 2; ++mt)
#pragma unroll
          for (int q = 0; q < 4; ++q) {
            const int f0 = mt * 32 + 8 * q + 4 * h;
            const float4 g = *(const float4*)(p.kn_nope + layer * 64 + f0);
            *(u32x2*)(sK + (khu * 32 + l31) * 104 + f0) = u32x2{pk2(acc[mt][4 * q] * rn * g.x, acc[mt][4 * q + 1] * rn * g.y), pk2(acc[mt][4 * q + 2] * rn * g.z, acc[mt][4 * q + 3] * rn * g.w)};
          }
      } else {
#pragma unroll
        for (int mt = 0; mt < 2; ++mt)
#pragma unroll
          for (int q = 0; q < 4; ++q)
            *(u32x2*)(sVT + (mt * 32 + l31) * 68 + khu * 32 + 8 * q + 4 * h) =
                u32x2{pk2(acc[mt][4 * q], acc[mt][4 * q + 1]), pk2(acc[mt][4 * q + 2], acc[mt][4 * q + 3])};
      }
    }
    __syncthreads();
    attn_tile<1>(qf, sK, sVT, kh, o, l, negB, l31, h);
  }
#undef SA_GLOAD
  __syncthreads();
  float* cb = (float*)smem;
  if (kh == 1) {
    float* d = cb + (qh * 64 + lane) * 34;
#pragma unroll
    for (int r = 0; r < 16; ++r) { d[r] = o[0][r]; d[16 + r] = o[1][r]; }
    d[32] = l;
  }
  __syncthreads();
  if (kh == 0) {
    const float* d = cb + (qh * 64 + lane) * 34;
#pragma unroll
    for (int r = 0; r < 16; ++r) { o[0][r] += d[r]; o[1][r] += d[16 + r]; }
    l += d[32];
    l += xor32(l);
    attn_store(p, tok, hd, o, 1.f / l, h);
  }
}

template <int N> DI void fmac_bc(float& acc, float srcvec, float other) {
  asm("v_fmac_f32_dpp %0, %1, %2 row_newbcast:%3 row_mask:0xf bank_mask:0xf" : "+v"(acc) : "v"(srcvec), "v"(other), "n"(N));
}
template <int N> DI float mul_bc(float srcvec, float other) {
  float r;
  asm("v_mul_f32_dpp %0, %1, %2 row_newbcast:%3 row_mask:0xf bank_mask:0xf" : "=v"(r) : "v"(srcvec), "v"(other), "n"(N));
  return r;
}
struct RplRaw { u32x2 r, e, k, a, b; unsigned v; };
template <int MODE> DI void rpl_load(RplRaw& q, const u16* s, int n, int lane) {
  q.e = *(const u32x2*)(s + 64 + 4 * n);
  q.a = *(const u32x2*)(s + 256 + 4 * n);
  q.b = *(const u32x2*)(s + 320 + 4 * n);
  if (MODE >= 1) { q.k = *(const u32x2*)(s + 128 + 4 * n); q.v = s[192 + lane]; }
  if (MODE == 2) q.r = *(const u32x2*)(s + 4 * n);
}
template <int MODE>
DI void rpl_item(const Params& p, int hd, int tok0, int nsteps, const float* Sinit, float* Sout, float* Yg, int lane) {
  const int n = lane & 15;
  float S[64];
  if (MODE == 0) {
#pragma unroll
    for (int k = 0; k < 64; ++k) S[k] = (k == lane) ? 1.f : 0.f;
  } else if (MODE == 1) {
#pragma unroll
    for (int k = 0; k < 64; ++k) S[k] = 0.f;
  } else {
#pragma unroll
    for (int k = 0; k < 64; k += 4) {
      const f32x4 t = *(const f32x4*)(Sinit + (size_t)lane * 64 + k);
      S[k] = t.x; S[k + 1] = t.y; S[k + 2] = t.z; S[k + 3] = t.w;
    }
  }
  const u16* src = (const u16*)(p.ws + WS_WKVIN) + ((size_t)hd * NT + tok0) * 384;
  float C0 = 1.f, C1 = 1.f, C2 = 1.f, C3 = 1.f;
  RplRaw c0, c1, c2;
  rpl_load<MODE>(c0, src, n, lane);
  rpl_load<MODE>(c1, src + 384, n, lane);
  for (int t = 0; t < nsteps; ++t) {
    if (t + 2 < nsteps) rpl_load<MODE>(c2, src + (size_t)(t + 2) * 384, n, lane);
    float A0 = lo2f(c0.a.x), A1 = hi2f(c0.a.x), A2 = lo2f(c0.a.y), A3 = hi2f(c0.a.y);
    float W0 = __builtin_amdgcn_exp2f(lo2f(c0.e.x)), W1 = __builtin_amdgcn_exp2f(hi2f(c0.e.x)), W2 = __builtin_amdgcn_exp2f(lo2f(c0.e.y)), W3 = __builtin_amdgcn_exp2f(hi2f(c0.e.y));
    float B0 = lo2f(c0.b.x), B1 = hi2f(c0.b.x), B2 = lo2f(c0.b.y), B3 = hi2f(c0.b.y);
    float K0 = 0.f, K1 = 0.f, K2 = 0.f, K3 = 0.f, R0 = 0.f, R1 = 0.f, R2 = 0.f, R3 = 0.f, vv = 0.f;
    if (MODE >= 1) { K0 = lo2f(c0.k.x); K1 = hi2f(c0.k.x); K2 = lo2f(c0.k.y); K3 = hi2f(c0.k.y); vv = lo2f(c0.v); }
    if (MODE == 2) { R0 = lo2f(c0.r.x); R1 = hi2f(c0.r.x); R2 = lo2f(c0.r.y); R3 = hi2f(c0.r.y); }
    A0 *= C0; A1 *= C1; A2 *= C2; A3 *= C3;
    C0 *= W0; C1 *= W1; C2 *= W2; C3 *= W3;
    {
      const float i0 = __builtin_amdgcn_rcpf(C0), i1 = __builtin_amdgcn_rcpf(C1), i2 = __builtin_amdgcn_rcpf(C2), i3 = __builtin_amdgcn_rcpf(C3);
      B0 *= i0; B1 *= i1; B2 *= i2; B3 *= i3;
      if (MODE >= 1) { K0 *= i0; K1 *= i1; K2 *= i2; K3 *= i3; }
      if (MODE == 2) { R0 *= C0; R1 *= C1; R2 *= C2; R3 *= C3; }
    }
    W0 = C0; W1 = C1; W2 = C2; W3 = C3;
    asm volatile("s_nop 1" : "+v"(A0), "+v"(A1), "+v"(A2), "+v"(A3), "+v"(W0), "+v"(W1), "+v"(W2), "+v"(W3), "+v"(B0), "+v"(B1), "+v"(B2), "+v"(B3));
    asm volatile("s_nop 1" : "+v"(K0), "+v"(K1), "+v"(K2), "+v"(K3), "+v"(R0), "+v"(R1), "+v"(R2), "+v"(R3));
    float sa0 = 0.f, sa1 = 0.f, sa2 = 0.f, sa3 = 0.f;
    fmac_bc<0>(sa0, A0, S[0]);
    fmac_bc<0>(sa1, A1, S[1]);
    fmac_bc<0>(sa2, A2, S[2]);
    fmac_bc<0>(sa3, A3, S[3]);
    fmac_bc<1>(sa0, A0, S[4]);
    fmac_bc<1>(sa1, A1, S[5]);
    fmac_bc<1>(sa2, A2, S[6]);
    fmac_bc<1>(sa3, A3, S[7]);
    fmac_bc<2>(sa0, A0, S[8]);
    fmac_bc<2>(sa1, A1, S[9]);
    fmac_bc<2>(sa2, A2, S[10]);
    fmac_bc<2>(sa3, A3, S[11]);
    fmac_bc<3>(sa0, A0, S[12]);
    fmac_bc<3>(sa1, A1, S[13]);
    fmac_bc<3>(sa2, A2, S[14]);
    fmac_bc<3>(sa3, A3, S[15]);
    fmac_bc<4>(sa0, A0, S[16]);
    fmac_bc<4>(sa1, A1, S[17]);
    fmac_bc<4>(sa2, A2, S[18]);
    fmac_bc<4>(sa3, A3, S[19]);
    fmac_bc<5>(sa0, A0, S[20]);
    fmac_bc<5>(sa1, A1, S[21]);
    fmac_bc<5>(sa2, A2, S[22]);
    fmac_bc<5>(sa3, A3, S[23]);
    fmac_bc<6>(sa0, A0, S[24]);
    fmac_bc<6>(sa1, A1, S[25]);
    fmac_bc<6>(sa2, A2, S[26]);
    fmac_bc<6>(sa3, A3, S[27]);
    fmac_bc<7>(sa0, A0, S[28]);
    fmac_bc<7>(sa1, A1, S[29]);
    fmac_bc<7>(sa2, A2, S[30]);
    fmac_bc<7>(sa3, A3, S[31]);
    fmac_bc<8>(sa0, A0, S[32]);
    fmac_bc<8>(sa1, A1, S[33]);
    fmac_bc<8>(sa2, A2, S[34]);
    fmac_bc<8>(sa3, A3, S[35]);
    fmac_bc<9>(sa0, A0, S[36]);
    fmac_bc<9>(sa1, A1, S[37]);
    fmac_bc<9>(sa2, A2, S[38]);
    fmac_bc<9>(sa3, A3, S[39]);
    fmac_bc<10>(sa0, A0, S[40]);
    fmac_bc<10>(sa1, A1, S[41]);
    fmac_bc<10>(sa2, A2, S[42]);
    fmac_bc<10>(sa3, A3, S[43]);
    fmac_bc<11>(sa0, A0, S[44]);
    fmac_bc<11>(sa1, A1, S[45]);
    fmac_bc<11>(sa2, A2, S[46]);
    fmac_bc<11>(sa3, A3, S[47]);
    fmac_bc<12>(sa0, A0, S[48]);
    fmac_bc<12>(sa1, A1, S[49]);
    fmac_bc<12>(sa2, A2, S[50]);
    fmac_bc<12>(sa3, A3, S[51]);
    fmac_bc<13>(sa0, A0, S[52]);
    fmac_bc<13>(sa1, A1, S[53]);
    fmac_bc<13>(sa2, A2, S[54]);
    fmac_bc<13>(sa3, A3, S[55]);
    fmac_bc<14>(sa0, A0, S[56]);
    fmac_bc<14>(sa1, A1, S[57]);
    fmac_bc<14>(sa2, A2, S[58]);
    fmac_bc<14>(sa3, A3, S[59]);
    fmac_bc<15>(sa0, A0, S[60]);
    fmac_bc<15>(sa1, A1, S[61]);
    fmac_bc<15>(sa2, A2, S[62]);
    fmac_bc<15>(sa3, A3, S[63]);
    const float sa = (sa0 + sa1) + (sa2 + sa3);
    float y0 = 0.f, y1 = 0.f, y2 = 0.f, y3 = 0.f;
    if (MODE >= 1) {
      fmac_bc<0>(S[0], K0, vv);
      fmac_bc<0>(S[1], K1, vv);
      fmac_bc<0>(S[2], K2, vv);
      fmac_bc<0>(S[3], K3, vv);
      fmac_bc<1>(S[4], K0, vv);
      fmac_bc<1>(S[5], K1, vv);
      fmac_bc<1>(S[6], K2, vv);
      fmac_bc<1>(S[7], K3, vv);
    }
    fmac_bc<0>(S[0], B0, sa);
    fmac_bc<0>(S[1], B1, sa);
    fmac_bc<0>(S[2], B2, sa);
    fmac_bc<0>(S[3], B3, sa);
    fmac_bc<1>(S[4], B0, sa);
    fmac_bc<1>(S[5], B1, sa);
    fmac_bc<1>(S[6], B2, sa);
    fmac_bc<1>(S[7], B3, sa);
    if (MODE == 2) {
      fmac_bc<0>(y0, R0, S[0]);
      fmac_bc<0>(y1, R1, S[1]);
      fmac_bc<0>(y2, R2, S[2]);
      fmac_bc<0>(y3, R3, S[3]);
      fmac_bc<1>(y0, R0, S[4]);
      fmac_bc<1>(y1, R1, S[5]);
      fmac_bc<1>(y2, R2, S[6]);
      fmac_bc<1>(y3, R3, S[7]);
    }
    if (MODE >= 1) {
      fmac_bc<2>(S[8], K0, vv);
      fmac_bc<2>(S[9], K1, vv);
      fmac_bc<2>(S[10], K2, vv);
      fmac_bc<2>(S[11], K3, vv);
      fmac_bc<3>(S[12], K0, vv);
      fmac_bc<3>(S[13], K1, vv);
      fmac_bc<3>(S[14], K2, vv);
      fmac_bc<3>(S[15], K3, vv);
    }
    fmac_bc<2>(S[8], B0, sa);
    fmac_bc<2>(S[9], B1, sa);
    fmac_bc<2>(S[10], B2, sa);
    fmac_bc<2>(S[11], B3, sa);
    fmac_bc<3>(S[12], B0, sa);
    fmac_bc<3>(S[13], B1, sa);
    fmac_bc<3>(S[14], B2, sa);
    fmac_bc<3>(S[15], B3, sa);
    if (MODE == 2) {
      fmac_bc<2>(y0, R0, S[8]);
      fmac_bc<2>(y1, R1, S[9]);
      fmac_bc<2>(y2, R2, S[10]);
      fmac_bc<2>(y3, R3, S[11]);
      fmac_bc<3>(y0, R0, S[12]);
      fmac_bc<3>(y1, R1, S[13]);
      fmac_bc<3>(y2, R2, S[14]);
      fmac_bc<3>(y3, R3, S[15]);
    }
    if (MODE >= 1) {
      fmac_bc<4>(S[16], K0, vv);
      fmac_bc<4>(S[17], K1, vv);
      fmac_bc<4>(S[18], K2, vv);
      fmac_bc<4>(S[19], K3, vv);
      fmac_bc<5>(S[20], K0, vv);
      fmac_bc<5>(S[21], K1, vv);
      fmac_bc<5>(S[22], K2, vv);
      fmac_bc<5>(S[23], K3, vv);
    }
    fmac_bc<4>(S[16], B0, sa);
    fmac_bc<4>(S[17], B1, sa);
    fmac_bc<4>(S[18], B2, sa);
    fmac_bc<4>(S[19], B3, sa);
    fmac_bc<5>(S[20], B0, sa);
    fmac_bc<5>(S[21], B1, sa);
    fmac_bc<5>(S[22], B2, sa);
    fmac_bc<5>(S[23], B3, sa);
    if (MODE == 2) {
      fmac_bc<4>(y0, R0, S[16]);
      fmac_bc<4>(y1, R1, S[17]);
      fmac_bc<4>(y2, R2, S[18]);
      fmac_bc<4>(y3, R3, S[19]);
      fmac_bc<5>(y0, R0, S[20]);
      fmac_bc<5>(y1, R1, S[21]);
      fmac_bc<5>(y2, R2, S[22]);
      fmac_bc<5>(y3, R3, S[23]);
    }
    if (MODE >= 1) {
      fmac_bc<6>(S[24], K0, vv);
      fmac_bc<6>(S[25], K1, vv);
      fmac_bc<6>(S[26], K2, vv);
      fmac_bc<6>(S[27], K3, vv);
      fmac_bc<7>(S[28], K0, vv);
      fmac_bc<7>(S[29], K1, vv);
      fmac_bc<7>(S[30], K2, vv);
      fmac_bc<7>(S[31], K3, vv);
    }
    fmac_bc<6>(S[24], B0, sa);
    fmac_bc<6>(S[25], B1, sa);
    fmac_bc<6>(S[26], B2, sa);
    fmac_bc<6>(S[27], B3, sa);
    fmac_bc<7>(S[28], B0, sa);
    fmac_bc<7>(S[29], B1, sa);
    fmac_bc<7>(S[30], B2, sa);
    fmac_bc<7>(S[31], B3, sa);
    if (MODE == 2) {
      fmac_bc<6>(y0, R0, S[24]);
      fmac_bc<6>(y1, R1, S[25]);
      fmac_bc<6>(y2, R2, S[26]);
      fmac_bc<6>(y3, R3, S[27]);
      fmac_bc<7>(y0, R0, S[28]);
      fmac_bc<7>(y1, R1, S[29]);
      fmac_bc<7>(y2, R2, S[30]);
      fmac_bc<7>(y3, R3, S[31]);
    }
    if (MODE >= 1) {
      fmac_bc<8>(S[32], K0, vv);
      fmac_bc<8>(S[33], K1, vv);
      fmac_bc<8>(S[34], K2, vv);
      fmac_bc<8>(S[35], K3, vv);
      fmac_bc<9>(S[36], K0, vv);
      fmac_bc<9>(S[37], K1, vv);
      fmac_bc<9>(S[38], K2, vv);
      fmac_bc<9>(S[39], K3, vv);
    }
    fmac_bc<8>(S[32], B0, sa);
    fmac_bc<8>(S[33], B1, sa);
    fmac_bc<8>(S[34], B2, sa);
    fmac_bc<8>(S[35], B3, sa);
    fmac_bc<9>(S[36], B0, sa);
    fmac_bc<9>(S[37], B1, sa);
    fmac_bc<9>(S[38], B2, sa);
    fmac_bc<9>(S[39], B3, sa);
    if (MODE == 2) {
      fmac_bc<8>(y0, R0, S[32]);
      fmac_bc<8>(y1, R1, S[33]);
      fmac_bc<8>(y2, R2, S[34]);
      fmac_bc<8>(y3, R3, S[35]);
      fmac_bc<9>(y0, R0, S[36]);
      fmac_bc<9>(y1, R1, S[37]);
      fmac_bc<9>(y2, R2, S[38]);
      fmac_bc<9>(y3, R3, S[39]);
    }
    if (MODE >= 1) {
      fmac_bc<10>(S[40], K0, vv);
      fmac_bc<10>(S[41], K1, vv);
      fmac_bc<10>(S[42], K2, vv);
      fmac_bc<10>(S[43], K3, vv);
      fmac_bc<11>(S[44], K0, vv);
      fmac_bc<11>(S[45], K1, vv);
      fmac_bc<11>(S[46], K2, vv);
      fmac_bc<11>(S[47], K3, vv);
    }
    fmac_bc<10>(S[40], B0, sa);
    fmac_bc<10>(S[41], B1, sa);
    fmac_bc<10>(S[42], B2, sa);
    fmac_bc<10>(S[43], B3, sa);
    fmac_bc<11>(S[44], B0, sa);
    fmac_bc<11>(S[45], B1, sa);
    fmac_bc<11>(S[46], B2, sa);
    fmac_bc<11>(S[47], B3, sa);
    if (MODE == 2) {
      fmac_bc<10>(y0, R0, S[40]);
      fmac_bc<10>(y1, R1, S[41]);
      fmac_bc<10>(y2, R2, S[42]);
      fmac_bc<10>(y3, R3, S[43]);
      fmac_bc<11>(y0, R0, S[44]);
      fmac_bc<11>(y1, R1, S[45]);
      fmac_bc<11>(y2, R2, S[46]);
      fmac_bc<11>(y3, R3, S[47]);
    }
    if (MODE >= 1) {
      fmac_bc<12>(S[48], K0, vv);
      fmac_bc<12>(S[49], K1, vv);
      fmac_bc<12>(S[50], K2, vv);
      fmac_bc<12>(S[51], K3, vv);
      fmac_bc<13>(S[52], K0, vv);
      fmac_bc<13>(S[53], K1, vv);
      fmac_bc<13>(S[54], K2, vv);
      fmac_bc<13>(S[55], K3, vv);
    }
    fmac_bc<12>(S[48], B0, sa);
    fmac_bc<12>(S[49], B1, sa);
    fmac_bc<12>(S[50], B2, sa);
    fmac_bc<12>(S[51], B3, sa);
    fmac_bc<13>(S[52], B0, sa);
    fmac_bc<13>(S[53], B1, sa);
    fmac_bc<13>(S[54], B2, sa);
    fmac_bc<13>(S[55], B3, sa);
    if (MODE == 2) {
      fmac_bc<12>(y0, R0, S[48]);
      fmac_bc<12>(y1, R1, S[49]);
      fmac_bc<12>(y2, R2, S[50]);
      fmac_bc<12>(y3, R3, S[51]);
      fmac_bc<13>(y0, R0, S[52]);
      fmac_bc<13>(y1, R1, S[53]);
      fmac_bc<13>(y2, R2, S[54]);
      fmac_bc<13>(y3, R3, S[55]);
    }
    if (MODE >= 1) {
      fmac_bc<14>(S[56], K0, vv);
      fmac_bc<14>(S[57], K1, vv);
      fmac_bc<14>(S[58], K2, vv);
      fmac_bc<14>(S[59], K3, vv);
      fmac_bc<15>(S[60], K0, vv);
      fmac_bc<15>(S[61], K1, vv);
      fmac_bc<15>(S[62], K2, vv);
      fmac_bc<15>(S[63], K3, vv);
    }
    fmac_bc<14>(S[56], B0, sa);
    fmac_bc<14>(S[57], B1, sa);
    fmac_bc<14>(S[58], B2, sa);
    fmac_bc<14>(S[59], B3, sa);
    fmac_bc<15>(S[60], B0, sa);
    fmac_bc<15>(S[61], B1, sa);
    fmac_bc<15>(S[62], B2, sa);
    fmac_bc<15>(S[63], B3, sa);
    if (MODE == 2) {
      fmac_bc<14>(y0, R0, S[56]);
      fmac_bc<14>(y1, R1, S[57]);
      fmac_bc<14>(y2, R2, S[58]);
      fmac_bc<14>(y3, R3, S[59]);
      fmac_bc<15>(y0, R0, S[60]);
      fmac_bc<15>(y1, R1, S[61]);
      fmac_bc<15>(y2, R2, S[62]);
      fmac_bc<15>(y3, R3, S[63]);
    }
    if ((t & 31) == 31) {
      S[0] = mul_bc<0>(W0, S[0]);
      S[1] = mul_bc<0>(W1, S[1]);
      S[2] = mul_bc<0>(W2, S[2]);
      S[3] = mul_bc<0>(W3, S[3]);
      S[4] = mul_bc<1>(W0, S[4]);
      S[5] = mul_bc<1>(W1, S[5]);
      S[6] = mul_bc<1>(W2, S[6]);
      S[7] = mul_bc<1>(W3, S[7]);
      S[8] = mul_bc<2>(W0, S[8]);
      S[9] = mul_bc<2>(W1, S[9]);
      S[10] = mul_bc<2>(W2, S[10]);
      S[11] = mul_bc<2>(W3, S[11]);
      S[12] = mul_bc<3>(W0, S[12]);
      S[13] = mul_bc<3>(W1, S[13]);
      S[14] = mul_bc<3>(W2, S[14]);
      S[15] = mul_bc<3>(W3, S[15]);
      S[16] = mul_bc<4>(W0, S[16]);
      S[17] = mul_bc<4>(W1, S[17]);
      S[18] = mul_bc<4>(W2, S[18]);
      S[19] = mul_bc<4>(W3, S[19]);
      S[20] = mul_bc<5>(W0, S[20]);
      S[21] = mul_bc<5>(W1, S[21]);
      S[22] = mul_bc<5>(W2, S[22]);
      S[23] = mul_bc<5>(W3, S[23]);
      S[24] = mul_bc<6>(W0, S[24]);
      S[25] = mul_bc<6>(W1, S[25]);
      S[26] = mul_bc<6>(W2, S[26]);
      S[27] = mul_bc<6>(W3, S[27]);
      S[28] = mul_bc<7>(W0, S[28]);
      S[29] = mul_bc<7>(W1, S[29]);
      S[30] = mul_bc<7>(W2, S[30]);
      S[31] = mul_bc<7>(W3, S[31]);
      S[32] = mul_bc<8>(W0, S[32]);
      S[33] = mul_bc<8>(W1, S[33]);
      S[34] = mul_bc<8>(W2, S[34]);
      S[35] = mul_bc<8>(W3, S[35]);
      S[36] = mul_bc<9>(W0, S[36]);
      S[37] = mul_bc<9>(W1, S[37]);
      S[38] = mul_bc<9>(W2, S[38]);
      S[39] = mul_bc<9>(W3, S[39]);
      S[40] = mul_bc<10>(W0, S[40]);
      S[41] = mul_bc<10>(W1, S[41]);
      S[42] = mul_bc<10>(W2, S[42]);
      S[43] = mul_bc<10>(W3, S[43]);
      S[44] = mul_bc<11>(W0, S[44]);
      S[45] = mul_bc<11>(W1, S[45]);
      S[46] = mul_bc<11>(W2, S[46]);
      S[47] = mul_bc<11>(W3, S[47]);
      S[48] = mul_bc<12>(W0, S[48]);
      S[49] = mul_bc<12>(W1, S[49]);
      S[50] = mul_bc<12>(W2, S[50]);
      S[51] = mul_bc<12>(W3, S[51]);
      S[52] = mul_bc<13>(W0, S[52]);
      S[53] = mul_bc<13>(W1, S[53]);
      S[54] = mul_bc<13>(W2, S[54]);
      S[55] = mul_bc<13>(W3, S[55]);
      S[56] = mul_bc<14>(W0, S[56]);
      S[57] = mul_bc<14>(W1, S[57]);
      S[58] = mul_bc<14>(W2, S[58]);
      S[59] = mul_bc<14>(W3, S[59]);
      S[60] = mul_bc<15>(W0, S[60]);
      S[61] = mul_bc<15>(W1, S[61]);
      S[62] = mul_bc<15>(W2, S[62]);
      S[63] = mul_bc<15>(W3, S[63]);
      C0 = 1.f; C1 = 1.f; C2 = 1.f; C3 = 1.f;
    }
    if (MODE == 2) Yg[(size_t)t * 512 + lane] = (y0 + y1) + (y2 + y3);
    c0 = c1; c1 = c2;
  }
  if (Sout) {
#pragma unroll
    for (int k = 0; k < 64; k += 4) *(f32x4*)(Sout + (size_t)lane * 64 + k) = f32x4{S[k], S[k + 1], S[k + 2], S[k + 3]};
  }
}

constexpr int RC = 128;
constexpr int NCH = NP / RC;
DI void seqs_item(const Params& p, int layer, int hd, char* smem) {
  float* sS = (float*)smem;
  const int tid = tidx(), lane = tid & 63, w = tid >> 6, l31 = lane & 31, h = lane >> 5, wr = w >> 1, wc = w & 1;
  const float* PQ = (const float*)(p.ws + WS_Y) + (size_t)hd * NCH * 8192;
  float* SS = (float*)(p.ws + WS_H) + (size_t)hd * NCH * 4096;
  const unsigned* pqflag = (const unsigned*)(p.ws + WS_CTR) + 1024 + (layer * 8 + hd) * 64;
  __syncthreads();
  for (int i = tid; i < 64 * 65; i += 256) sS[i] = 0.f;
  for (int i = tid; i < 4096; i += 256) SS[i] = 0.f;
  if (tid == 0) {
    for (int j = 0; j < 5; ++j)
      while (__hip_atomic_load((unsigned*)pqflag + j, __ATOMIC_RELAXED, __HIP_MEMORY_SCOPE_AGENT) == 0u) __builtin_amdgcn_s_sleep(4);
    __builtin_amdgcn_fence(__ATOMIC_ACQUIRE, "agent");
    asm volatile("s_waitcnt vmcnt(0)" ::: "memory");
  }
  __syncthreads();
  float bP[32], bQ[16], nP[32], nQ[16];
#pragma unroll
  for (int ks = 0; ks < 32; ++ks) bP[ks] = PQ[(2 * ks + h) * 64 + 32 * wc + l31];
#pragma unroll
  for (int r = 0; r < 16; ++r) bQ[r] = PQ[4096 + (32 * wr + crow(r, h)) * 64 + 32 * wc + l31];
  for (int c = 0; c < NCH; ++c) {
    if ((c & 7) == 0 && c > 0) {
      if (tid == 0) {
        const int j0 = c >> 1, j1 = (c + 8 < NCH) ? j0 + 5 : j0 + 4;
        for (int j = j0; j < j1; ++j)
          while (__hip_atomic_load((unsigned*)pqflag + j, __ATOMIC_RELAXED, __HIP_MEMORY_SCOPE_AGENT) == 0u) __builtin_amdgcn_s_sleep(4);
        __builtin_amdgcn_fence(__ATOMIC_ACQUIRE, "agent");
        asm volatile("s_waitcnt vmcnt(0)" ::: "memory");
      }
      __syncthreads();
    }
    if (c + 1 < NCH) {
      const float* Pn = PQ + (size_t)(c + 1) * 8192;
#pragma unroll
      for (int ks = 0; ks < 32; ++ks) nP[ks] = Pn[(2 * ks + h) * 64 + 32 * wc + l31];
#pragma unroll
      for (int r = 0; r < 16; ++r) nQ[r] = Pn[4096 + (32 * wr + crow(r, h)) * 64 + 32 * wc + l31];
    }
    f32x16 acc;
#pragma unroll
    for (int r = 0; r < 16; ++r) acc[r] = bQ[r];
    float a[32];
#pragma unroll
    for (int ks = 0; ks < 32; ++ks) a[ks] = sS[(32 * wr + l31) * 65 + 2 * ks + h];
#pragma unroll
    for (int ks = 0; ks < 32; ++ks) acc = __builtin_amdgcn_mfma_f32_32x32x2f32(a[ks], bP[ks], acc, 0, 0, 0);
    __syncthreads();
    float* dst = (c + 1 < NCH) ? SS + (size_t)(c + 1) * 4096 : p.out + OFF_WKV_P + ((size_t)layer * 8 + hd) * 4096;
#pragma unroll
    for (int r = 0; r < 16; ++r) {
      const int row = 32 * wr + crow(r, h), col = 32 * wc + l31;
      sS[row * 65 + col] = acc[r];
      dst[row * 64 + col] = acc[r];
    }
    __syncthreads();
#pragma unroll
    for (int ks = 0; ks < 32; ++ks) bP[ks] = nP[ks];
#pragma unroll
    for (int r = 0; r < 16; ++r) bQ[r] = nQ[r];
  }
}

DI void phase_mix(const Params& p, int layer, char* smem, int* s_item) {
  constexpr int NQ_PQ = NCH * 2 / 4, NQ_SY = 4, NQ_SATT = 16, NQ_PATT = 128;
  int* qctr = (int*)(p.ws + WS_CTR) + 64 + layer * 8;
  int* actr = (int*)(p.ws + WS_CTR) + 192 + layer * 8;
  if (blockIdx.x < 8) { seqs_item(p, layer, blockIdx.x, smem); return; }
  const int home = blockIdx.x & 7;
  const int first = (blockIdx.x >> 3) & 1;
  for (int pass = 0; pass < 2; ++pass) {
    const int kind = pass ^ first;
    for (int qi = 0; qi < 8; ++qi) {
      const int hd = (home + qi) & 7;
      for (;;) {
        __syncthreads();
        if (tidx() == 0) *s_item = atomicAdd((kind == 0 ? qctr : actr) + hd, 1);
        __syncthreads();
        const int it = *s_item;
        const int wave = __builtin_amdgcn_readfirstlane(tidx() >> 6), lane = tidx() & 63;
        if (kind == 0) {
          if (it >= NQ_PQ + NQ_SY) break;
          if (it < NQ_PQ) {
            const int q = it * 4 + wave, mode = q & 1, ch = q >> 1;
            float* dstm = (float*)(p.ws + WS_Y) + ((size_t)(hd * NCH + ch) * 2 + mode) * 4096;
            if (mode == 0) rpl_item<0>(p, hd, ch * RC, RC, nullptr, dstm, nullptr, lane);
            else rpl_item<1>(p, hd, ch * RC, RC, nullptr, dstm, nullptr, lane);
            asm volatile("s_waitcnt vmcnt(0)" ::: "memory");
            __syncthreads();
            if (tidx() == 0) {
              __builtin_amdgcn_fence(__ATOMIC_RELEASE, "agent");
              asm volatile("s_waitcnt vmcnt(0)" ::: "memory");
              __hip_atomic_store((unsigned*)(p.ws + WS_CTR) + 1024 + (layer * 8 + hd) * 64 + it, 1u, __ATOMIC_RELAXED, __HIP_MEMORY_SCOPE_AGENT);
            }
            continue;
          }
          const int b = (it - NQ_PQ) * 4 + wave;
          rpl_item<2>(p, hd, NP + b * 64, 64, p.state_wkv + (((size_t)layer * 16 + b) * 8 + hd) * 4096,
                      p.out + OFF_WKV_S + (((size_t)layer * 16 + b) * 8 + hd) * 4096, (float*)(p.ws + WS_Y) + (size_t)(NP + b * 64) * 512 + hd * 64, lane);
        } else {
          if (it >= NQ_SATT + NQ_PATT) break;
          if (it < NQ_SATT) { attn_sample_item(p, layer, it, hd, smem); continue; }
          attn_prompt_item(p, layer, 127 - (it - NQ_SATT), hd, smem);
        }
      }
    }
  }
}
DI void phase_ypass(const Params& p, int layer) {
  const int wave = __builtin_amdgcn_readfirstlane(tidx() >> 6), lane = tidx() & 63;
  const int hd = blockIdx.x & 7, nb = (gridDim.x + 7 - hd) >> 3;
  for (int j = blockIdx.x >> 3; j < NCH / 4; j += nb) {
    const int ch = j * 4 + wave;
    rpl_item<2>(p, hd, ch * RC, RC, (const float*)(p.ws + WS_H) + (size_t)(hd * NCH + ch) * 4096, nullptr,
                (float*)(p.ws + WS_Y) + (size_t)(ch * RC) * 512 + hd * 64, lane);
  }
}

DI void phase_ob(const Params& p, int layer) {
  const int wave = tidx() >> 6, lane = tidx() & 63;
  const float* Y = (const float*)(p.ws + WS_Y);
  const u16* WK = (const u16*)(p.ws + WS_WKVIN);
  const u16* Z = (const u16*)(p.ws + WS_Z);
  u16* OB = (u16*)(p.ws + WS_Q);
  const int f = lane * 8, hd = lane >> 3, fl = (lane & 7) * 8;
  for (int t = blockIdx.x * 4 + wave; t < NT; t += gridDim.x * 4) {
    const float4 ya = *(const float4*)(Y + (size_t)t * 512 + f);
    const float4 yb = *(const float4*)(Y + (size_t)t * 512 + f + 4);
    float y[8] = {ya.x, ya.y, ya.z, ya.w, yb.x, yb.y, yb.z, yb.w};
    float s = 0.f;
#pragma unroll
    for (int j = 0; j < 8; ++j) s += y[j];
    s += __shfl_xor(s, 1); s += __shfl_xor(s, 2); s += __shfl_xor(s, 4);
    const float mu = s * (1.f / 64.f);
    float vs = 0.f;
#pragma unroll
    for (int j = 0; j < 8; ++j) { y[j] -= mu; vs += y[j] * y[j]; }
    vs += __shfl_xor(vs, 1); vs += __shfl_xor(vs, 2); vs += __shfl_xor(vs, 4);
    const float rs = rsqrtf(vs * (1.f / 64.f) + GN_EPS);
    const u16* wk = WK + ((size_t)hd * NT + t) * 384 + fl;
    const uint4 r8 = *(const uint4*)(wk + 0 * 64);
    const uint4 k8 = *(const uint4*)(wk + 2 * 64);
    const uint4 v8 = *(const uint4*)(wk + 3 * 64);
    const float rr[8] = {lo2f(r8.x), hi2f(r8.x), lo2f(r8.y), hi2f(r8.y), lo2f(r8.z), hi2f(r8.z), lo2f(r8.w), hi2f(r8.w)};
    const float kk[8] = {lo2f(k8.x), hi2f(k8.x), lo2f(k8.y), hi2f(k8.y), lo2f(k8.z), hi2f(k8.z), lo2f(k8.w), hi2f(k8.w)};
    const float vv[8] = {lo2f(v8.x), hi2f(v8.x), lo2f(v8.y), hi2f(v8.y), lo2f(v8.z), hi2f(v8.z), lo2f(v8.w), hi2f(v8.w)};
    const float4 rka = *(const float4*)(p.r_k + layer * 512 + f);
    const float4 rkb = *(const float4*)(p.r_k + layer * 512 + f + 4);
    const float rk[8] = {rka.x, rka.y, rka.z, rka.w, rkb.x, rkb.y, rkb.z, rkb.w};
    float bs = 0.f;
#pragma unroll
    for (int j = 0; j < 8; ++j) bs += rr[j] * kk[j] * rk[j];
    bs += __shfl_xor(bs, 1); bs += __shfl_xor(bs, 2); bs += __shfl_xor(bs, 4);
    const float4 lwa = *(const float4*)(p.lnx_w + layer * 512 + f);
    const float4 lwb = *(const float4*)(p.lnx_w + layer * 512 + f + 4);
    const float4 lba = *(const float4*)(p.lnx_b + layer * 512 + f);
    const float4 lbb = *(const float4*)(p.lnx_b + layer * 512 + f + 4);
    const float lw[8] = {lwa.x, lwa.y, lwa.z, lwa.w, lwb.x, lwb.y, lwb.z, lwb.w};
    const float lb[8] = {lba.x, lba.y, lba.z, lba.w, lbb.x, lbb.y, lbb.z, lbb.w};
    const uint4 g8 = *(const uint4*)(Z + (size_t)t * NZ + ZC_GB + f);
    const float gg[8] = {lo2f(g8.x), hi2f(g8.x), lo2f(g8.y), hi2f(g8.y), lo2f(g8.z), hi2f(g8.z), lo2f(g8.w), hi2f(g8.w)};
    float ov[8];
#pragma unroll
    for (int j = 0; j < 8; ++j) ov[j] = (y[j] * rs * lw[j] + lb[j] + bs * vv[j]) * siluf_(gg[j]);
    *(uint4*)(OB + (size_t)t * 512 + f) = make_uint4(pk2(ov[0], ov[1]), pk2(ov[2], ov[3]), pk2(ov[4], ov[5]), pk2(ov[6], ov[7]));
  }
}

DI void phase_merge(const Params& p, int layer, char* smem) {
  const u16* OA = (const u16*)(p.ws + WS_OA);
  const u16* OB = (const u16*)(p.ws + WS_Q);
  const u16* WA = (const u16*)(p.ws + (size_t)layer * WL_STRIDE + W_OA);
  const u16* WB = (const u16*)(p.ws + (size_t)layer * WL_STRIDE + W_OB);
  const u16* Z = (const u16*)(p.ws + WS_Z);
  u16* M = (u16*)(p.ws + WS_H);
  const int xcd = blockIdx.x & 7, jb = blockIdx.x >> 3, nb = (gridDim.x + 7 - xcd) >> 3;
  for (int m = jb; m < 16 * 8; m += nb) {
    const int tt = xcd + 8 * (m >> 3), ft = m & 7;
    f32x16 acc[2][2];
    zero_acc(acc);
    gemm_mainloop(OA + (size_t)tt * 128 * 512, 512, WA + (size_t)ft * 128 * 512, 512, 512, smem, acc);
    acc_to_lds(acc, smem);
    EPI_ROWS({
      const u32x2 g = *(const u32x2*)(Z + (size_t)(tt * 128 + row) * NZ + ZC_MA + ft * 128 + col);
      *(u32x2*)(M + (size_t)(tt * 128 + row) * 1024 + ft * 128 + col) =
          u32x2{pk2(v.x * sigmoidf_(lo2f(g.x)), v.y * sigmoidf_(hi2f(g.x))), pk2(v.z * sigmoidf_(lo2f(g.y)), v.w * sigmoidf_(hi2f(g.y)))};
    })
    zero_acc(acc);
    gemm_mainloop(OB + (size_t)tt * 128 * 512, 512, WB + (size_t)ft * 128 * 512, 512, 512, smem, acc);
    acc_to_lds(acc, smem);
    EPI_ROWS({
      const u32x2 g = *(const u32x2*)(Z + (size_t)(tt * 128 + row) * NZ + ZC_MB + ft * 128 + col);
      u32x2* mp = (u32x2*)(M + (size_t)(tt * 128 + row) * 1024 + ft * 128 + col);
      const u32x2 pm = *mp;
      *mp = u32x2{pk2(lo2f(pm.x) + v.x * sigmoidf_(lo2f(g.x)), hi2f(pm.x) + v.y * sigmoidf_(hi2f(g.x))),
                  pk2(lo2f(pm.y) + v.z * sigmoidf_(lo2f(g.y)), hi2f(pm.y) + v.w * sigmoidf_(hi2f(g.y)))};
    })
  }
  for (int m = jb; m < 2 * 16; m += nb) {
    const int r0 = (128 + xcd) * 128 + (m >> 4) * 64, c0 = (m & 15) * 64;
    f32x16 acc;
#pragma unroll
    for (int r = 0; r < 16; ++r) acc[r] = 0.f;
    gemm64_mainloop(OA + (size_t)r0 * 512, 512, WA + (size_t)c0 * 512, 512, 512, smem, acc);
    acc64_to_lds(acc, smem);
    EPI64_ROWS({
      const u32x2 g = *(const u32x2*)(Z + (size_t)(r0 + row) * NZ + ZC_MA + c0 + col);
      *(u32x2*)(M + (size_t)(r0 + row) * 1024 + c0 + col) =
          u32x2{pk2(v.x * sigmoidf_(lo2f(g.x)), v.y * sigmoidf_(hi2f(g.x))), pk2(v.z * sigmoidf_(lo2f(g.y)), v.w * sigmoidf_(hi2f(g.y)))};
    })
#pragma unroll
    for (int r = 0; r < 16; ++r) acc[r] = 0.f;
    gemm64_mainloop(OB + (size_t)r0 * 512, 512, WB + (size_t)c0 * 512, 512, 512, smem, acc);
    acc64_to_lds(acc, smem);
    EPI64_ROWS({
      const u32x2 g = *(const u32x2*)(Z + (size_t)(r0 + row) * NZ + ZC_MB + c0 + col);
      u32x2* mp = (u32x2*)(M + (size_t)(r0 + row) * 1024 + c0 + col);
      const u32x2 pm = *mp;
      *mp = u32x2{pk2(lo2f(pm.x) + v.x * sigmoidf_(lo2f(g.x)), hi2f(pm.x) + v.y * sigmoidf_(hi2f(g.x))),
                  pk2(lo2f(pm.y) + v.z * sigmoidf_(lo2f(g.y)), hi2f(pm.y) + v.w * sigmoidf_(hi2f(g.y)))};
    })
  }
}

DI void phase_out(const Params& p, int layer, char* smem) {
  const u16* M = (const u16*)(p.ws + WS_H);
  const u16* W = (const u16*)(p.ws + (size_t)layer * WL_STRIDE + W_O);
  const int xcd = blockIdx.x & 7, jb = blockIdx.x >> 3, nb = (gridDim.x + 7 - xcd) >> 3;
  for (int m = jb; m < 16 * 8; m += nb) {
    const int tt = xcd + 8 * (m >> 3), ft = m & 7;
    f32x16 acc[2][2];
    zero_acc(acc);
    gemm_mainloop(M + (size_t)tt * 128 * 1024, 1024, W + (size_t)ft * 128 * 1024, 1024, 1024, smem, acc);
    acc_to_lds(acc, smem);
    EPI_ROWS({
      const int t = tt * 128 + row, n = ft * 128 + col;
      const f32x4 xo = *(const f32x4*)(xrow(p, layer, t) + n);
      *(f32x4*)(p.out + (size_t)t * 1024 + n) = xo + v;
    })
  }
  for (int m = jb; m < 2 * 16; m += nb) {
    const int r0 = (128 + xcd) * 128 + (m >> 4) * 64, c0 = (m & 15) * 64;
    f32x16 acc;
#pragma unroll
    for (int r = 0; r < 16; ++r) acc[r] = 0.f;
    gemm64_mainloop(M + (size_t)r0 * 1024, 1024, W + (size_t)c0 * 1024, 1024, 1024, smem, acc);
    acc64_to_lds(acc, smem);
    EPI64_ROWS({
      const int t = r0 + row, n = c0 + col;
      const f32x4 xo = *(const f32x4*)(xrow(p, layer, t) + n);
      *(f32x4*)(p.out + (size_t)t * 1024 + n) = xo + v;
    })
  }
}

#define XB_TMO      128
#define XB_XCNT(j)  (256  + 64 * (j))
#define XB_XSUB(j)  (1280 + 64 * (j))
#define XB_XGEN(j)  (2304 + 64 * (j))
#define XB_TOP      3328
#define XB_TOPGEN   3392
#define XCD_BAR_WORDS 3456
#define XB_SPIN_CAP (1u << 22)
#define LAS __attribute__((address_space(3)))
DI unsigned xb_ld(unsigned* p) { return __hip_atomic_load(p, __ATOMIC_RELAXED, __HIP_MEMORY_SCOPE_AGENT); }
DI unsigned xb_add(unsigned* p, unsigned v) { return __hip_atomic_fetch_add(p, v, __ATOMIC_RELAXED, __HIP_MEMORY_SCOPE_AGENT); }
DI unsigned xb_xcc_id() { return (unsigned)__builtin_amdgcn_s_getreg((3 << 11) | 20) & 0xFu; }
#define XB_SPIN(cond, bar) do { unsigned _sp = 0; while (cond) { __builtin_amdgcn_s_sleep(1); \
    if ((++_sp & 255u) == 0u) { if (xb_ld(&(bar)[XB_TMO])) break; if (_sp > XB_SPIN_CAP) { atomicAdd(&(bar)[XB_TMO], 1u); break; } } } } while (0)
struct XcdBarrier { unsigned* bar; unsigned x; volatile LAS unsigned* st; };
DI XcdBarrier xcd_barrier_post(unsigned* bar, volatile LAS unsigned* st) {
  XcdBarrier b; b.bar = bar; b.x = xb_xcc_id(); b.st = st;
  if (threadIdx.x == 0) (void)xb_add(&bar[XB_XCNT(b.x)], 1u);
  return b;
}
DI void xcd_barrier_complete(unsigned* bar, unsigned x, unsigned& nloc, unsigned& nx) {
  const unsigned G = gridDim.x * gridDim.y * gridDim.z;
  unsigned sum, cnt, mine, sp = 0u;
  for (;;) {
    sum = 0u; cnt = 0u; mine = 0u;
#pragma unroll
    for (unsigned j = 0; j < 16; ++j) { const unsigned c = xb_ld(&bar[XB_XCNT(j)]); sum += c; cnt += (c > 0u) ? 1u : 0u; mine = (j == x) ? c : mine; }
    if (sum == G) break;
    __builtin_amdgcn_s_sleep(1);
    if ((++sp & 255u) == 0u) { if (xb_ld(&bar[XB_TMO])) break; if (sp > XB_SPIN_CAP) { atomicAdd(&bar[XB_TMO], 1u); break; } }
  }
  nloc = mine > 0u ? mine : 1u; nx = cnt > 0u ? cnt : 1u;
}
DI void xcd_barrier(const XcdBarrier& b) {
  asm volatile("s_waitcnt vmcnt(0)" ::: "memory");
  __syncthreads();
  if (threadIdx.x == 0) {
    unsigned* bar = b.bar;
    __builtin_amdgcn_s_waitcnt(0);
    unsigned nloc = b.st[0], nx = b.st[1];
    if (nloc == 0u) { xcd_barrier_complete(bar, b.x, nloc, nx); b.st[0] = nloc; b.st[1] = nx; }
    const unsigned old = xb_add(&bar[XB_XSUB(b.x)], 1u);
    const unsigned gen = old / nloc;
    if (old + 1u == (gen + 1u) * nloc) {
      __builtin_amdgcn_fence(__ATOMIC_RELEASE, "agent");
      asm volatile("s_waitcnt vmcnt(0)" ::: "memory");
      const unsigned og = xb_add(&bar[XB_TOP], 1u);
      const unsigned tg = og / nx;
      if (og + 1u == (tg + 1u) * nx) xb_add(&bar[XB_TOPGEN], 1u);
      else XB_SPIN(xb_ld(&bar[XB_TOPGEN]) == tg, bar);
      __builtin_amdgcn_fence(__ATOMIC_ACQUIRE, "agent");
      xb_add(&bar[XB_XGEN(b.x)], 1u);
      asm volatile("s_waitcnt vmcnt(0)" ::: "memory");
    } else {
      XB_SPIN(xb_ld(&bar[XB_XGEN(b.x)]) == gen, bar);
      __builtin_amdgcn_fence(__ATOMIC_ACQUIRE, "agent");
      asm volatile("s_waitcnt vmcnt(0)" ::: "memory");
    }
  }
  __syncthreads();
}

constexpr int PH_PER_LAYER = 8;
constexpr int N_PHASES = 1 + 4 * PH_PER_LAYER;

DI void run_phase(const Params& p, int ph, char* smem, int* s_item) {
#ifndef PHMASK
#define PHMASK 0x3FF
#endif
  if (ph == 0) { if (PHMASK & 0x100) phase_convert(p, smem); return; }
  const int layer = (ph - 1) / PH_PER_LAYER, sub = (ph - 1) % PH_PER_LAYER;
  switch (sub) {
    case 0: if (PHMASK & 1) phase_rmsnorm(p, layer); break;
    case 1: if (PHMASK & 2) phase_g1(p, layer, smem); break;
    case 2: if (PHMASK & 4) phase_norms_prep(p, layer, smem, s_item); break;
    case 3: if (PHMASK & 16) phase_mix(p, layer, smem, s_item); break;
    case 4: if (PHMASK & 16) phase_ypass(p, layer); break;
    case 5: if (PHMASK & 32) phase_ob(p, layer); break;
    case 6: if (PHMASK & 64) phase_merge(p, layer, smem); break;
    default: if (PHMASK & 128) phase_out(p, layer, smem); break;
  }
}

__global__ void __launch_bounds__(256, 2) mk_kernel(Params p, int ph0, int ph1, int coop) {
  __shared__ __attribute__((aligned(16))) char smem[SMEM_BYTES];
  __shared__ int s_item[4];
  __shared__ uint4 xb_words;
  if (threadIdx.x == 0) xb_words = make_uint4(0u, 0u, 0u, 0u);
  __syncthreads();
  XcdBarrier xb = xcd_barrier_post((unsigned*)(p.ws + WS_BAR), (volatile LAS unsigned*)&xb_words);
  for (int ph = ph0; ph < ph1; ++ph) {
    run_phase(p, ph, smem, s_item);
    if (coop && ph + 1 < ph1) {
      xcd_barrier(xb);
      if (coop == 0x5a5a5a) cg::this_grid().sync();
    }
  }
}

extern "C" void kernel_launch(void* const* d_in, const int* in_sizes, int n_in, void* d_out, int out_size, void* d_ws, size_t ws_size,
                              hipStream_t stream) {
  static int grid_blocks = 0;
  if (!grid_blocks) {
    int dev = 0, cus = 0, per_cu = 0;
    hipGetDevice(&dev);
    hipDeviceGetAttribute(&cus, hipDeviceAttributeMultiprocessorCount, dev);
    hipOccupancyMaxActiveBlocksPerMultiprocessor(&per_cu, mk_kernel, 256, 0);
    if (per_cu < 1) per_cu = 1;
    if (per_cu > 2) per_cu = 2;
    grid_blocks = cus * per_cu;
  }
  Params p{};
  const float** pp = (const float**)&p;
  for (int i = 0; i < 29; ++i) pp[i] = (const float*)d_in[i];
  p.out = (float*)d_out;
  p.ws = (char*)d_ws;
  const int ONE_LAUNCH = 1;
  hipMemsetAsync((char*)d_ws + WS_CTR, 0, 16384 + XCD_BAR_WORDS * 4, stream);
  if (ONE_LAUNCH) {
    int ph0 = 0, ph1 = N_PHASES, coop = 1;
    void* args[] = {&p, &ph0, &ph1, &coop};
    hipError_t e = hipLaunchCooperativeKernel((void*)mk_kernel, dim3(grid_blocks), dim3(256), args, 0, stream);
    if (e != hipSuccess) fprintf(stderr, "cooperative launch failed: %s (grid %d)\n", hipGetErrorString(e), grid_blocks);
  } else {
    for (int ph = 0; ph < N_PHASES; ++ph) mk_kernel<<<dim3(grid_blocks), dim3(256), 0, stream>>>(p, ph, ph + 1, 0);
  }
}
```

```cpp
#include <hip/hip_runtime.h>
#include <hip/hip_cooperative_groups.h>
#include <cstdio>
namespace cg = cooperative_groups;

#define DI __device__ __forceinline__
typedef unsigned short u16;
typedef __attribute__((ext_vector_type(8))) short bf16x8;
typedef __attribute__((ext_vector_type(4))) short s16x4;
typedef __attribute__((ext_vector_type(2))) __bf16 bf2_t;
typedef __attribute__((ext_vector_type(2))) float f2_t;
typedef __attribute__((ext_vector_type(16))) float f32x16;
typedef __attribute__((ext_vector_type(4))) unsigned u32x4;
typedef __attribute__((ext_vector_type(2))) unsigned u32x2;
typedef __attribute__((ext_vector_type(4))) float f32x4;
#define MFMA32(a, b, c) __builtin_amdgcn_mfma_f32_32x32x16_bf16((a), (b), (c), 0, 0, 0)

constexpr int NP = 16384;
constexpr int NSM = 1024;
constexpr int NT = NP + NSM;
constexpr int NZ = 5248;
constexpr int ZC_KV = 256, ZC_KPE = 384, ZC_GA = 512, ZC_ZS = 1024, ZC_GB = 2688, ZC_MA = 3200, ZC_MB = 4224;
constexpr float EPS = 1e-6f;
constexpr float GN_EPS = 64e-5f;
constexpr int SHW = 1664;

constexpr size_t OFF_CKV_P = 17825792;
constexpr size_t OFF_KPE_P = 26214400;
constexpr size_t OFF_WKV_P = 28311552;
constexpr size_t OFF_SH_P = 28442624;
constexpr size_t OFF_CKV_S = 28449280;
constexpr size_t OFF_KPE_S = 28973568;
constexpr size_t OFF_WKV_S = 29104640;
constexpr size_t OFF_SH_S = 31201792;

constexpr size_t WL_STRIDE = 15728640;
constexpr size_t W_IN = 0, W_UQ = 10747904, W_UKV = 11141120, W_W2 = 11403264, W_A2 = 11468800, W_OA = 11534336, W_OB = 12582912, W_O = 13631488;
constexpr size_t WS_H = 62914560;
constexpr size_t WS_Z = WS_H + 35651584;
constexpr size_t WS_Q = WS_Z + 182714368;
constexpr size_t WS_CKVB = WS_Q + 26738688;
constexpr size_t WS_KPEB = WS_CKVB + 4456448;
constexpr size_t WS_KN = WS_KPEB + 1114112;
constexpr size_t WS_VT = WS_KN + 16777216;
constexpr size_t WS_WKVIN = WS_VT + 16777216;
constexpr size_t WS_OA = WS_WKVIN + 106954752;
constexpr size_t WS_Y = WS_OA + 17825792;
constexpr size_t WS_CTR = WS_Y + 35651584;
constexpr size_t WS_BAR = WS_CTR + 16384;
constexpr size_t WS_SH0 = WS_BAR + 16384;
constexpr size_t WS_CKB = WS_SH0 + 65536;
constexpr size_t WS_KPB = WS_CKB + 16777216;
constexpr size_t WS_TOTAL = WS_KPB + 4194304;
static_assert(WS_TOTAL < 536870912, "ws");

constexpr int SMEM_BYTES = 39424 + 128 * 136 * 2;

struct Params {
  const float *x_prompt, *x_sample, *cache_ckv, *cache_kpe, *state_wkv, *state_shift;
  const float *norm_w, *w_in, *q_norm_w, *kv_norm_w, *w_uq, *w_ukv, *qn_nope, *qn_rope, *kn_nope, *kn_rope;
  const float *mu_shift, *w0, *w2, *a0, *a2, *k_k, *k_a, *r_k, *lnx_w, *lnx_b, *w_out_a, *w_out_b, *w_o;
  float* out;
  char* ws;
};

__device__ const float ROPE_INV[16] = {1.0f, 0.5623413324356079f, 0.3162277638912201f, 0.17782793939113617f, 0.10000000149011612f, 0.05623413249850273f, 0.03162277489900589f, 0.017782794311642647f, 0.009999999776482582f, 0.005623413249850273f, 0.003162277629598975f, 0.0017782794311642647f, 0.0010000000474974513f, 0.000562341301701963f, 0.0003162277571391314f, 0.00017782794020604342f};

DI int tidx() { int t = threadIdx.x; asm volatile("" : "+v"(t)); return t; }
DI float bf2f(u16 h) { return __uint_as_float(((unsigned)h) << 16); }
DI unsigned pk2(float a, float b) { f2_t v = {a, b}; bf2_t r = __builtin_convertvector(v, bf2_t); return __builtin_bit_cast(unsigned, r); }
DI u16 f2bf(float a) { return (u16)(pk2(a, 0.f) & 0xffffu); }
DI float lo2f(unsigned u) { return __uint_as_float(u << 16); }
DI float hi2f(unsigned u) { return __uint_as_float(u & 0xffff0000u); }
DI float wave_sum(float v) {
  v += __builtin_bit_cast(float, __builtin_amdgcn_update_dpp(0, __builtin_bit_cast(int, v), 0x128, 0xF, 0xF, false));
  v += __builtin_bit_cast(float, __builtin_amdgcn_update_dpp(0, __builtin_bit_cast(int, v), 0x124, 0xF, 0xF, false));
  v += __builtin_bit_cast(float, __builtin_amdgcn_update_dpp(0, __builtin_bit_cast(int, v), 0x122, 0xF, 0xF, false));
  v += __builtin_bit_cast(float, __builtin_amdgcn_update_dpp(0, __builtin_bit_cast(int, v), 0x121, 0xF, 0xF, false));
  const int iv = __builtin_bit_cast(int, v);
  const float s0 = __builtin_bit_cast(float, __builtin_amdgcn_readlane(iv, 0)), s1 = __builtin_bit_cast(float, __builtin_amdgcn_readlane(iv, 16));
  const float s2 = __builtin_bit_cast(float, __builtin_amdgcn_readlane(iv, 32)), s3 = __builtin_bit_cast(float, __builtin_amdgcn_readlane(iv, 48));
  return (s0 + s1) + (s2 + s3);
}
DI float xor32(float v) { return __shfl_xor(v, 32); }
DI int crow(int reg, int h) { return (reg & 3) + 8 * (reg >> 2) + 4 * h; }
DI float sigmoidf_(float x) { return __builtin_amdgcn_rcpf(1.f + __expf(-x)); }
DI float siluf_(float x) { return x * __builtin_amdgcn_rcpf(1.f + __expf(-x)); }
DI void rope_sincos(int pos, int i, float& s, float& c) {
  float ang = (float)pos * ROPE_INV[i];
  double rev = (double)ang * 0.15915494309189533577;
  double fr = rev - rint(rev);
  float f = (float)fr;
  s = __builtin_amdgcn_sinf(f);
  c = __builtin_amdgcn_cosf(f);
}
DI const float* xrow(const Params& p, int layer, int t) {
  if (layer == 0) return (t < NP) ? p.x_prompt + (size_t)t * 1024 : p.x_sample + (size_t)(t - NP) * 1024;
  return p.out + (size_t)t * 1024;
}
DI int tok_pos(int t) { return (t < NP) ? t : 4096 + ((t - NP) & 63); }

DI void conv_tile(const float* __restrict__ src, int N, u16* __restrict__ dst, int K, int k0, int n0, int kind, float* sm) {
  const int tid = tidx();
  const int n4 = (tid & 15) * 4, kb = tid >> 4;
  const int np_ = n0 + n4;
  int sc = np_;
  if (kind == 1) sc = (np_ < 416) ? np_ : ((np_ < 512) ? -1 : np_ - 96);
#pragma unroll
  for (int i = 0; i < 4; ++i) {
    const int kl = kb + 16 * i;
    f32x4 v = {0.f, 0.f, 0.f, 0.f};
    if (sc >= 0) v = *(const f32x4*)(src + (size_t)(k0 + kl) * N + sc);
    sm[kl * 65 + n4] = v.x; sm[kl * 65 + n4 + 1] = v.y; sm[kl * 65 + n4 + 2] = v.z; sm[kl * 65 + n4 + 3] = v.w;
  }
  __syncthreads();
  const int nr = tid >> 2, kc = (tid & 3) * 16;
  unsigned o[8];
#pragma unroll
  for (int j = 0; j < 8; ++j) o[j] = pk2(sm[(kc + 2 * j) * 65 + nr], sm[(kc + 2 * j + 1) * 65 + nr]);
  uint4* d = (uint4*)(dst + (size_t)(n0 + nr) * K + k0 + kc);
  d[0] = make_uint4(o[0], o[1], o[2], o[3]);
  d[1] = make_uint4(o[4], o[5], o[6], o[7]);
  __syncthreads();
}

DI void phase_convert(const Params& p, char* smem) {
  float* sm = (float*)smem;
  for (int it = blockIdx.x; it < 4 * 1920; it += gridDim.x) {
    const int layer = it / 1920;
    int r = it % 1920;
    const float* src; u16* dst; int K, N, kind = 0, nt;
    char* wl = p.ws + (size_t)layer * WL_STRIDE;
    if (r < 1312) { src = p.w_in + (size_t)layer * 1024 * 5152; dst = (u16*)(wl + W_IN); K = 1024; N = 5152; kind = 1; nt = 82; }
    else if (r < 1360) { r -= 1312; src = p.w_uq + (size_t)layer * 256 * 768; dst = (u16*)(wl + W_UQ); K = 256; N = 768; nt = 12; }
    else if (r < 1392) { r -= 1360; src = p.w_ukv + (size_t)layer * 128 * 1024; dst = (u16*)(wl + W_UKV); K = 128; N = 1024; nt = 16; }
    else if (r < 1400) { r -= 1392; src = p.w2 + (size_t)layer * 64 * 512; dst = (u16*)(wl + W_W2); K = 64; N = 512; nt = 8; }
    else if (r < 1408) { r -= 1400; src = p.a2 + (size_t)layer * 64 * 512; dst = (u16*)(wl + W_A2); K = 64; N = 512; nt = 8; }
    else if (r < 1536) { r -= 1408; src = p.w_out_a + (size_t)layer * 512 * 1024; dst = (u16*)(wl + W_OA); K = 512; N = 1024; nt = 16; }
    else if (r < 1664) { r -= 1536; src = p.w_out_b + (size_t)layer * 512 * 1024; dst = (u16*)(wl + W_OB); K = 512; N = 1024; nt = 16; }
    else { r -= 1664; src = p.w_o + (size_t)layer * 1024 * 1024; dst = (u16*)(wl + W_O); K = 1024; N = 1024; nt = 16; }
    const int kt = r / nt, ntile = r % nt;
    conv_tile(src, N, dst, K, kt * 64, ntile * 64, kind, sm);
  }
}

DI void phase_rmsnorm(const Params& p, int layer) {
  const int wave = tidx() >> 6, lane = tidx() & 63;
  u16* H = (u16*)(p.ws + WS_H);
  const float* g = p.norm_w + layer * 1024;
  {
    u16* sh0 = (u16*)(p.ws + WS_SH0);
    for (int i = blockIdx.x * 256 + tidx(); i < 17 * SHW / 4; i += gridDim.x * 256) {
      const int e = i * 4, r = e / SHW, c = e - r * SHW;
      f32x4 v = {0.f, 0.f, 0.f, 0.f};
      if (r > 0) v = *(const f32x4*)(p.state_shift + ((size_t)layer * 16 + (r - 1)) * SHW + c);
      *(u32x2*)(sh0 + e) = u32x2{pk2(v.x, v.y), pk2(v.z, v.w)};
    }
  }
  {
    const float* c1 = p.cache_ckv + (size_t)layer * 16 * 4096 * 128;
    const float* c2 = p.cache_kpe + (size_t)layer * 16 * 4096 * 32;
    u16* d1 = (u16*)(p.ws + WS_CKB);
    u16* d2 = (u16*)(p.ws + WS_KPB);
    constexpr int N1 = 16 * 4096 * 128 / 8, N2 = 16 * 4096 * 32 / 8;
    for (int i = blockIdx.x * 256 + tidx(); i < N1 + N2; i += gridDim.x * 256) {
      const float* sp = (i < N1) ? c1 + (size_t)i * 8 : c2 + (size_t)(i - N1) * 8;
      u16* dp = (i < N1) ? d1 + (size_t)i * 8 : d2 + (size_t)(i - N1) * 8;
      const f32x4 a = *(const f32x4*)sp, b = *(const f32x4*)(sp + 4);
      *(u32x4*)dp = u32x4{pk2(a.x, a.y), pk2(a.z, a.w), pk2(b.x, b.y), pk2(b.z, b.w)};
    }
  }
  for (int t = blockIdx.x * 4 + wave; t < NT; t += gridDim.x * 4) {
    const float* xr = xrow(p, layer, t);
    float4 v[4];
    float ss = 0.f;
#pragma unroll
    for (int i = 0; i < 4; ++i) {
      v[i] = *(const float4*)(xr + i * 256 + lane * 4);
      ss += v[i].x * v[i].x + v[i].y * v[i].y + v[i].z * v[i].z + v[i].w * v[i].w;
    }
    ss = wave_sum(ss);
    const float rinv = rsqrtf(ss * (1.f / 1024.f) + EPS);
#pragma unroll
    for (int i = 0; i < 4; ++i) {
      const float4 g4 = *(const float4*)(g + i * 256 + lane * 4);
      uint2 o;
      o.x = pk2(v[i].x * rinv * g4.x, v[i].y * rinv * g4.y);
      o.y = pk2(v[i].z * rinv * g4.z, v[i].w * rinv * g4.w);
      *(uint2*)(H + (size_t)t * 1024 + i * 256 + lane * 4) = o;
    }
  }
}

DI void gemm_mainloop(const u16* __restrict__ R, int ldr, const u16* __restrict__ C, int ldc, int K, char* smem, f32x16 (&acc)[2][2]) {
  const int tid = tidx(), lane = tid & 63, w = tid >> 6, wr = w >> 1, wc = w & 1;
  const int l31 = lane & 31, h = lane >> 5;
  const int lrow = tid >> 3, lkc = (tid & 7) * 8;
  u32x4 rr[4], rc[4];
  const int nk = K >> 6;
#pragma unroll
  for (int i = 0; i < 4; ++i) {
    rr[i] = *(const u32x4*)(R + (size_t)(lrow + 32 * i) * ldr + lkc);
    rc[i] = *(const u32x4*)(C + (size_t)(lrow + 32 * i) * ldc + lkc);
  }
  __syncthreads();
  {
    u16* sR = (u16*)smem;
    u16* sC = sR + 128 * 72;
#pragma unroll
    for (int i = 0; i < 4; ++i) {
      *(u32x4*)(sR + (lrow + 32 * i) * 72 + lkc) = rr[i];
      *(u32x4*)(sC + (lrow + 32 * i) * 72 + lkc) = rc[i];
    }
  }
  if (nk > 1) {
#pragma unroll
    for (int i = 0; i < 4; ++i) {
      rr[i] = *(const u32x4*)(R + (size_t)(lrow + 32 * i) * ldr + 64 + lkc);
      rc[i] = *(const u32x4*)(C + (size_t)(lrow + 32 * i) * ldc + 64 + lkc);
    }
  }
  __syncthreads();
  for (int kt = 0; kt < nk; ++kt) {
    const u16* sR = (const u16*)smem + (kt & 1) * (2 * 128 * 72);
    const u16* sC = sR + 128 * 72;
    if (kt + 1 < nk) {
      u16* nR = (u16*)smem + ((kt + 1) & 1) * (2 * 128 * 72);
      u16* nC = nR + 128 * 72;
#pragma unroll
      for (int i = 0; i < 4; ++i) {
        *(u32x4*)(nR + (lrow + 32 * i) * 72 + lkc) = rr[i];
        *(u32x4*)(nC + (lrow + 32 * i) * 72 + lkc) = rc[i];
      }
    }
    if (kt + 2 < nk) {
      const int k0 = (kt + 2) * 64;
#pragma unroll
      for (int i = 0; i < 4; ++i) {
        rr[i] = *(const u32x4*)(R + (size_t)(lrow + 32 * i) * ldr + k0 + lkc);
        rc[i] = *(const u32x4*)(C + (size_t)(lrow + 32 * i) * ldc + k0 + lkc);
      }
    }
#pragma unroll
    for (int ks = 0; ks < 4; ++ks) {
      bf16x8 a[2], b[2];
#pragma unroll
      for (int mi = 0; mi < 2; ++mi) a[mi] = *(const bf16x8*)(sR + (wr * 64 + mi * 32 + l31) * 72 + ks * 16 + h * 8);
#pragma unroll
      for (int ni = 0; ni < 2; ++ni) b[ni] = *(const bf16x8*)(sC + (wc * 64 + ni * 32 + l31) * 72 + ks * 16 + h * 8);
#pragma unroll
      for (int mi = 0; mi < 2; ++mi)
#pragma unroll
        for (int ni = 0; ni < 2; ++ni) acc[mi][ni] = MFMA32(a[mi], b[ni], acc[mi][ni]);
    }
    __syncthreads();
  }
}
DI void zero_acc(f32x16 (&acc)[2][2]) {
#pragma unroll
  for (int mi = 0; mi < 2; ++mi)
#pragma unroll
    for (int ni = 0; ni < 2; ++ni)
#pragma unroll
      for (int r = 0; r < 16; ++r) acc[mi][ni][r] = 0.f;
}
DI void acc_to_lds(const f32x16 (&acc)[2][2], char* smem) {
  float* sT = (float*)smem;
  const int lane = tidx() & 63, w = tidx() >> 6;
  const int l31 = lane & 31, h = lane >> 5, wr = w >> 1, wc = w & 1;
  __syncthreads();
#pragma unroll
  for (int mi = 0; mi < 2; ++mi)
#pragma unroll
    for (int ni = 0; ni < 2; ++ni)
#pragma unroll
      for (int reg = 0; reg < 16; ++reg) sT[(wr * 64 + mi * 32 + crow(reg, h)) * 132 + wc * 64 + ni * 32 + l31] = acc[mi][ni][reg];
  __syncthreads();
}
#define EPI_ROWS(...)                                                          \
  {                                                                            \
    const float* sT_ = (const float*)smem;                                     \
    _Pragma("unroll 2") for (int it_ = 0; it_ < 16; ++it_) {                   \
      const int row = it_ * 8 + (tidx() >> 5), col = (tidx() & 31) * 4; \
      const f32x4 v = *(const f32x4*)(sT_ + row * 132 + col);                  \
      __VA_ARGS__                                                              \
    }                                                                          \
  }

DI void gemm64_mainloop(const u16* __restrict__ R, int ldr, const u16* __restrict__ C, int ldc, int K, char* smem, f32x16& acc) {
  const int tid = tidx(), lane = tid & 63, w = tid >> 6, wr = w >> 1, wc = w & 1;
  const int l31 = lane & 31, h = lane >> 5;
  const int lrow = tid >> 3, lkc = (tid & 7) * 8;
  u32x4 rr[2][2], rc[2][2];
  const int nk = K >> 6;
#define G64_GLOAD(SET, KT)                                                                    \
  {                                                                                           \
    const int k0_ = (KT) * 64;                                                                \
    _Pragma("unroll") for (int i = 0; i < 2; ++i) {                                           \
      rr[SET][i] = *(const u32x4*)(R + (size_t)(lrow + 32 * i) * ldr + k0_ + lkc);            \
      rc[SET][i] = *(const u32x4*)(C + (size_t)(lrow + 32 * i) * ldc + k0_ + lkc);            \
    }                                                                                         \
  }
#define G64_LSTORE(SET, BUF)                                                                  \
  {                                                                                           \
    u16* nR_ = (u16*)smem + (BUF) * (2 * 64 * 72);                                            \
    u16* nC_ = nR_ + 64 * 72;                                                                 \
    _Pragma("unroll") for (int i = 0; i < 2; ++i) {                                           \
      *(u32x4*)(nR_ + (lrow + 32 * i) * 72 + lkc) = rr[SET][i];                               \
      *(u32x4*)(nC_ + (lrow + 32 * i) * 72 + lkc) = rc[SET][i];                               \
    }                                                                                         \
  }
  G64_GLOAD(0, 0)
  G64_GLOAD(1, 1)
  __syncthreads();
  G64_LSTORE(0, 0)
  G64_GLOAD(0, 2)
  __syncthreads();
  for (int kt0 = 0; kt0 < nk; kt0 += 2) {
#pragma unroll
    for (int u = 0; u < 2; ++u) {
      const int kt = kt0 + u;
      const u16* sR = (const u16*)smem + u * (2 * 64 * 72);
      const u16* sC = sR + 64 * 72;
      if (kt + 1 < nk) G64_LSTORE(1 - u, 1 - u)
      if (kt + 3 < nk) G64_GLOAD(1 - u, kt + 3)
#pragma unroll
      for (int ks = 0; ks < 4; ++ks) {
        const bf16x8 a = *(const bf16x8*)(sR + (wr * 32 + l31) * 72 + ks * 16 + h * 8);
        const bf16x8 b = *(const bf16x8*)(sC + (wc * 32 + l31) * 72 + ks * 16 + h * 8);
        acc = MFMA32(a, b, acc);
      }
      __syncthreads();
    }
  }
#undef G64_GLOAD
#undef G64_LSTORE
}
DI void acc64_to_lds(const f32x16& acc, char* smem) {
  float* sT = (float*)smem;
  const int lane = tidx() & 63, w = tidx() >> 6;
  const int l31 = lane & 31, h = lane >> 5, wr = w >> 1, wc = w & 1;
  __syncthreads();
#pragma unroll
  for (int reg = 0; reg < 16; ++reg) sT[(wr * 32 + crow(reg, h)) * 68 + wc * 32 + l31] = acc[reg];
  __syncthreads();
}
#define EPI64_ROWS(...)                                                        \
  {                                                                            \
    const float* sT_ = (const float*)smem;                                     \
    _Pragma("unroll") for (int it_ = 0; it_ < 4; ++it_) {                      \
      const int row = it_ * 16 + (tidx() >> 4), col = (tidx() & 15) * 4;       \
      const f32x4 v = *(const f32x4*)(sT_ + row * 68 + col);                   \
      __VA_ARGS__                                                              \
    }                                                                          \
  }

DI void phase_g1(const Params& p, int layer, char* smem) {
  const u16* H = (const u16*)(p.ws + WS_H);
  const u16* W = (const u16*)(p.ws + (size_t)layer * WL_STRIDE + W_IN);
  u16* Z = (u16*)(p.ws + WS_Z);
  const int xcd = blockIdx.x & 7, jb = blockIdx.x >> 3, nb = (gridDim.x + 7 - xcd) >> 3;
  for (int m = jb; m < 17 * 41; m += nb) {
    const int ft = m / 17, tt = xcd + 8 * (m % 17);
    f32x16 acc[2][2];
    zero_acc(acc);
    gemm_mainloop(H + (size_t)tt * 128 * 1024, 1024, W + (size_t)ft * 128 * 1024, 1024, 1024, smem, acc);
    acc_to_lds(acc, smem);
    EPI_ROWS({ *(u32x2*)(Z + (size_t)(tt * 128 + row) * NZ + ft * 128 + col) = u32x2{pk2(v.x, v.y), pk2(v.z, v.w)}; })
  }
}

DI void norms_token(const Params& p, int layer, int t, int lane) {
  const u16* zr = (const u16*)(p.ws + WS_Z) + (size_t)t * NZ;
  u16* CQN = (u16*)(p.ws + WS_H);
  u16* CKVB = (u16*)(p.ws + WS_CKVB);
  u16* KPEB = (u16*)(p.ws + WS_KPEB);
  {
    const uint2 raw = *(const uint2*)(zr + lane * 4);
    const float c0 = lo2f(raw.x), c1 = hi2f(raw.x), c2 = lo2f(raw.y), c3 = hi2f(raw.y);
    float ss = wave_sum(c0 * c0 + c1 * c1 + c2 * c2 + c3 * c3);
    const float rinv = rsqrtf(ss * (1.f / 256.f) + EPS);
    const float4 g = *(const float4*)(p.q_norm_w + layer * 256 + lane * 4);
    uint2 o;
    o.x = pk2(c0 * rinv * g.x, c1 * rinv * g.y);
    o.y = pk2(c2 * rinv * g.z, c3 * rinv * g.w);
    *(uint2*)(CQN + (size_t)t * 256 + lane * 4) = o;
  }
  {
    const unsigned raw = *(const unsigned*)(zr + ZC_KV + lane * 2);
    const float c0 = lo2f(raw), c1 = hi2f(raw);
    float ss = wave_sum(c0 * c0 + c1 * c1);
    const float rinv = rsqrtf(ss * (1.f / 128.f) + EPS);
    const float2 g = *(const float2*)(p.kv_norm_w + layer * 128 + lane * 2);
    const float o0 = c0 * rinv * g.x, o1 = c1 * rinv * g.y;
    float* dst = (t < NP) ? p.out + OFF_CKV_P + ((size_t)layer * NP + t) * 128 : p.out + OFF_CKV_S + ((size_t)layer * NSM + (t - NP)) * 128;
    *(float2*)(dst + lane * 2) = make_float2(o0, o1);
    *(unsigned*)(CKVB + (size_t)t * 128 + lane * 2) = pk2(o0, o1);
  }
  {
    float v = (lane < 32) ? bf2f(zr[ZC_KPE + lane]) : 0.f;
    float ss = wave_sum(v * v);
    const float rinv = rsqrtf(ss * (1.f / 32.f) + EPS);
    v = v * rinv * p.kn_rope[layer * 32 + (lane & 31)];
    const float pr = __shfl_xor(v, 16);
    float s, c;
    rope_sincos(tok_pos(t), lane & 15, s, c);
    const float o = ((lane & 16) == 0) ? (v * c - pr * s) : (v * c + pr * s);
    if (lane < 32) {
      float* dst = (t < NP) ? p.out + OFF_KPE_P + ((size_t)layer * NP + t) * 32 : p.out + OFF_KPE_S + ((size_t)layer * NSM + (t - NP)) * 32;
      dst[lane] = o;
      KPEB[(size_t)t * 32 + lane] = f2bf(o);
    }
  }
  float* sh = nullptr;
  if (t == NP - 1) sh = p.out + OFF_SH_P + (size_t)layer * SHW;
  else if (t >= NP && ((t - NP) & 63) == 63) sh = p.out + OFF_SH_S + ((size_t)layer * 16 + ((t - NP) >> 6)) * SHW;
  if (sh) {
#pragma unroll 1
    for (int c = lane; c < SHW; c += 64) sh[c] = bf2f(zr[ZC_ZS + c]);
  }
}

DI void zm4(const Params& p, int layer, int t, int c, float (&o)[4]) {
  const u16* zr = (const u16*)(p.ws + WS_Z) + (size_t)t * NZ + ZC_ZS + c;
  const u32x2 a = *(const u32x2*)zr;
  const bool first = (t < NP) ? (t == 0) : (((t - NP) & 63) == 0);
  const int srow = (t < NP) ? 0 : 1 + ((t - NP) >> 6);
  const u16* pr = first ? (const u16*)(p.ws + WS_SH0) + srow * SHW + c : zr - NZ;
  const u32x2 b = *(const u32x2*)pr;
  const f32x4 mu = *(const f32x4*)(p.mu_shift + layer * SHW + c);
  const float c0 = lo2f(a.x), c1 = hi2f(a.x), c2 = lo2f(a.y), c3 = hi2f(a.y);
  o[0] = c0 + (lo2f(b.x) - c0) * mu.x;
  o[1] = c1 + (hi2f(b.x) - c1) * mu.y;
  o[2] = c2 + (lo2f(b.y) - c2) * mu.z;
  o[3] = c3 + (hi2f(b.y) - c3) * mu.w;
}
DI float tanhf_(float x) {
  const float t = __expf(-2.f * fabsf(x));
  const float r = (1.f - t) * __builtin_amdgcn_rcpf(1.f + t);
  return x < 0.f ? -r : r;
}

constexpr int WPS = 900;
DI void zml(const u16* sz, int row, int col, const float* mu, float (&o)[4]) {
  const u32x2 a = *(const u32x2*)(sz + (row + 1) * WPS + col);
  const u32x2 b = *(const u32x2*)(sz + row * WPS + col);
  const f32x4 m4 = *(const f32x4*)mu;
  const float c0 = lo2f(a.x), c1 = hi2f(a.x), c2 = lo2f(a.y), c3 = hi2f(a.y);
  o[0] = c0 + (lo2f(b.x) - c0) * m4.x;
  o[1] = c1 + (hi2f(b.x) - c1) * m4.y;
  o[2] = c2 + (lo2f(b.y) - c2) * m4.z;
  o[3] = c3 + (hi2f(b.y) - c3) * m4.w;
}
DI void wkvprep_block(const Params& p, int layer, int tt, int hg, char* smem) {
  u16* sz = (u16*)smem;
  const int tid = tidx(), lane = tid & 63, w = tid >> 6, l31 = lane & 31, h = lane >> 5;
  const int t0 = tt * 32;
  const int hd = hg * 4 + w;
  const u16* Z = (const u16*)(p.ws + WS_Z);
  const bool seq_start = (t0 < NP) ? (t0 == 0) : (((t0 - NP) & 63) == 0);
  const u16* prevrow = seq_start ? (const u16*)(p.ws + WS_SH0) + ((t0 < NP) ? 0 : 1 + ((t0 - NP) >> 6)) * SHW : Z + (size_t)(t0 - 1) * NZ + ZC_ZS;
  __syncthreads();
  for (int ci = tid; ci < 33 * 112; ci += 256) {
    const int row = ci / 112, cc = ci - row * 112;
    int scol, lcol;
    if (cc < 16) { scol = 1536 + cc * 8; lcol = cc * 8; }
    else {
      const int j = cc - 16, ww = j / 24, r2 = j - ww * 24, part = r2 >> 3, o = (r2 & 7) * 8;
      scol = part * 512 + (hg * 4 + ww) * 64 + o;
      lcol = 128 + ww * 192 + part * 64 + o;
    }
    const u16* src = (row == 0) ? prevrow + scol : Z + (size_t)(t0 + row - 1) * NZ + ZC_ZS + scol;
    const u32x4 v = *(const u32x4*)src;
    u32x2* d = (u32x2*)(sz + row * WPS + lcol);
    d[0] = u32x2{v.x, v.y};
    d[1] = u32x2{v.z, v.w};
  }
  __syncthreads();
  const int tok = t0 + l31;
  const u16* W2T = (const u16*)(p.ws + (size_t)layer * WL_STRIDE + W_W2);
  const u16* A2T = (const u16*)(p.ws + (size_t)layer * WL_STRIDE + W_A2);
  const float* mu = p.mu_shift + layer * SHW;
  u16* WK = (u16*)(p.ws + WS_WKVIN) + ((size_t)hd * NT + tok) * 384;
  f32x16 accW[2], accA[2];
#pragma unroll
  for (int m = 0; m < 2; ++m)
#pragma unroll
    for (int r = 0; r < 16; ++r) { accW[m][r] = 0.f; accA[m][r] = 0.f; }
#pragma unroll
  for (int ks = 0; ks < 4; ++ks) {
    const int c0 = ks * 16 + 8 * h;
    float t0a[4], t1a[4], u0[4], u1[4];
    zml(sz, l31, c0, mu + 1536 + c0, t0a);
    zml(sz, l31, c0 + 4, mu + 1536 + c0 + 4, t1a);
    zml(sz, l31, 64 + c0, mu + 1600 + c0, u0);
    zml(sz, l31, 64 + c0 + 4, mu + 1600 + c0 + 4, u1);
    u32x4 bw, ba;
    bw.x = pk2(tanhf_(t0a[0]), tanhf_(t0a[1])); bw.y = pk2(tanhf_(t0a[2]), tanhf_(t0a[3]));
    bw.z = pk2(tanhf_(t1a[0]), tanhf_(t1a[1])); bw.w = pk2(tanhf_(t1a[2]), tanhf_(t1a[3]));
    ba.x = pk2(u0[0], u0[1]); ba.y = pk2(u0[2], u0[3]); ba.z = pk2(u1[0], u1[1]); ba.w = pk2(u1[2], u1[3]);
    const bf16x8 bwf = __builtin_bit_cast(bf16x8, bw), baf = __builtin_bit_cast(bf16x8, ba);
#pragma unroll
    for (int m = 0; m < 2; ++m) {
      const bf16x8 aw = *(const bf16x8*)(W2T + (size_t)(hd * 64 + m * 32 + l31) * 64 + ks * 16 + h * 8);
      const bf16x8 aa = *(const bf16x8*)(A2T + (size_t)(hd * 64 + m * 32 + l31) * 64 + ks * 16 + h * 8);
      accW[m] = MFMA32(aw, bwf, accW[m]);
      accA[m] = MFMA32(aa, baf, accA[m]);
    }
  }
  const int hb = 128 + w * 192;
  float ss = 0.f;
#pragma unroll
  for (int m = 0; m < 2; ++m)
#pragma unroll
    for (int q = 0; q < 4; ++q) {
      const int f0 = m * 32 + 8 * q + 4 * h, F = hd * 64 + f0;
      float k4[4];
      zml(sz, l31, hb + 64 + f0, mu + 512 + F, k4);
      const float4 kk_ = *(const float4*)(p.k_k + layer * 512 + F);
      const float a = k4[0] * kk_.x, b = k4[1] * kk_.y, c = k4[2] * kk_.z, d = k4[3] * kk_.w;
      ss += a * a + b * b + c * c + d * d;
    }
  ss += xor32(ss);
  const float rn = 1.f / fmaxf(sqrtf(ss), 1e-12f);
#pragma unroll
  for (int m = 0; m < 2; ++m)
#pragma unroll
    for (int q = 0; q < 4; ++q) {
      const int f0 = m * 32 + 8 * q + 4 * h, F = hd * 64 + f0;
      float r4[4], k4[4], v4[4];
      zml(sz, l31, hb + f0, mu + F, r4);
      zml(sz, l31, hb + 64 + f0, mu + 512 + F, k4);
      zml(sz, l31, hb + 128 + f0, mu + 1024 + F, v4);
      const float4 w0 = *(const float4*)(p.w0 + layer * 512 + F);
      const float4 a0 = *(const float4*)(p.a0 + layer * 512 + F);
      const float4 kk_ = *(const float4*)(p.k_k + layer * 512 + F);
      const float4 ka_ = *(const float4*)(p.k_a + layer * 512 + F);
      const float w0a[4] = {w0.x, w0.y, w0.z, w0.w}, a0a[4] = {a0.x, a0.y, a0.z, a0.w};
      const float kka[4] = {kk_.x, kk_.y, kk_.z, kk_.w}, kaa[4] = {ka_.x, ka_.y, ka_.z, ka_.w};
      float e4[4], kp4[4], kn4[4], b4[4];
#pragma unroll
      for (int j = 0; j < 4; ++j) {
        const float lw = w0a[j] + accW[m][4 * q + j];
        const float nx = -lw;
        const float sp = fmaxf(nx, 0.f) + __logf(1.f + __expf(-fabsf(nx)));
        e4[j] = __expf(-sp - 0.5f);
        const float a = sigmoidf_(a0a[j] + accA[m][4 * q + j]);
        kn4[j] = k4[j] * kka[j] * rn;
        b4[j] = kn4[j] * a;
        kp4[j] = k4[j] * (1.f + (a - 1.f) * kaa[j]);
      }
      *(u32x2*)(WK + 0 * 64 + f0) = u32x2{pk2(r4[0], r4[1]), pk2(r4[2], r4[3])};
      *(u32x2*)(WK + 1 * 64 + f0) = u32x2{pk2(e4[0] * -1.4426950408889634f, e4[1] * -1.4426950408889634f), pk2(e4[2] * -1.4426950408889634f, e4[3] * -1.4426950408889634f)};
      *(u32x2*)(WK + 2 * 64 + f0) = u32x2{pk2(kp4[0], kp4[1]), pk2(kp4[2], kp4[3])};
      *(u32x2*)(WK + 3 * 64 + f0) = u32x2{pk2(v4[0], v4[1]), pk2(v4[2], v4[3])};
      *(u32x2*)(WK + 4 * 64 + f0) = u32x2{pk2(-kn4[0], -kn4[1]), pk2(-kn4[2], -kn4[3])};
      *(u32x2*)(WK + 5 * 64 + f0) = u32x2{pk2(b4[0], b4[1]), pk2(b4[2], b4[3])};
    }
}

DI void qproj_item(const Params& p, int layer, int tt, int hd, int lane);
DI void kvproj_item(const Params& p, int layer, int tt, int hd, int lane);
DI void phase_norms_prep(const Params& p, int layer, char* smem, int* s_item) {
  int* ctr = (int*)(p.ws + WS_CTR) + 4 + layer;
  const int wave = tidx() >> 6, lane = tidx() & 63;
  for (;;) {
    __syncthreads();
    if (tidx() == 0) *s_item = atomicAdd(ctr, 1);
    __syncthreads();
    const int it = *s_item;
    if (it >= 1088 + 2112 + 272) break;
    if (it < 1088) { wkvprep_block(p, layer, it >> 1, it & 1, smem); continue; }
    if (it < 1088 + 2112) {
      const int wi = (it - 1088) * 4 + wave;
      if (wi < 544 * 8) qproj_item(p, layer, wi >> 3, wi & 7, lane);
      else { const int j = wi - 544 * 8; kvproj_item(p, layer, j >> 3, j & 7, lane); }
      continue;
    }
    const int tb = (it - 1088 - 2112) * 64 + wave * 16;
    for (int j = 0; j < 16; ++j) norms_token(p, layer, tb + j, lane);
  }
}

DI bf16x8 normed_frag(const u16* zsrc, const float* g, float& ssq) {
  const u32x4 raw = *(const u32x4*)zsrc;
  const f32x4 g0 = *(const f32x4*)g, g1 = *(const f32x4*)(g + 4);
  const float f0 = lo2f(raw.x), f1 = hi2f(raw.x), f2 = lo2f(raw.y), f3 = hi2f(raw.y);
  const float f4 = lo2f(raw.z), f5 = hi2f(raw.z), f6 = lo2f(raw.w), f7 = hi2f(raw.w);
  ssq += (f0 * f0 + f1 * f1) + (f2 * f2 + f3 * f3) + (f4 * f4 + f5 * f5) + (f6 * f6 + f7 * f7);
  const u32x4 o = {pk2(f0 * g0.x, f1 * g0.y), pk2(f2 * g0.z, f3 * g0.w), pk2(f4 * g1.x, f5 * g1.y), pk2(f6 * g1.z, f7 * g1.w)};
  return __builtin_bit_cast(bf16x8, o);
}
DI void qproj_item(const Params& p, int layer, int tt, int hd, int lane) {
  const int l31 = lane & 31, h = lane >> 5;
  const int tok = tt * 32 + l31;
  const u16* zq = (const u16*)(p.ws + WS_Z) + (size_t)tok * NZ;
  const float* gq = p.q_norm_w + layer * 256;
  float ssq = 0.f;
  const u16* WT = (const u16*)(p.ws + (size_t)layer * WL_STRIDE + W_UQ);
  u16* Q = (u16*)(p.ws + WS_Q);
  f32x16 acc[3];
#pragma unroll
  for (int m = 0; m < 3; ++m)
#pragma unroll
    for (int r = 0; r < 16; ++r) acc[m][r] = 0.f;
#pragma unroll 4
  for (int ks = 0; ks < 16; ++ks) {
    const bf16x8 bfr = normed_frag(zq + ks * 16 + h * 8, gq + ks * 16 + h * 8, ssq);
#pragma unroll
    for (int m = 0; m < 3; ++m) {
      const bf16x8 afr = *(const bf16x8*)(WT + (size_t)(hd * 96 + m * 32 + l31) * 256 + ks * 16 + h * 8);
      acc[m] = MFMA32(afr, bfr, acc[m]);
    }
  }
  {
    ssq += xor32(ssq);
    const float rinv = rsqrtf(ssq * (1.f / 256.f) + EPS);
#pragma unroll
    for (int m = 0; m < 3; ++m)
#pragma unroll
      for (int r = 0; r < 16; ++r) acc[m][r] *= rinv;
  }
  const float qs = 0.10206207261596577f * 1.4426950408889634f;
  float ss = 0.f;
#pragma unroll
  for (int m = 0; m < 2; ++m)
#pragma unroll
    for (int r = 0; r < 16; ++r) ss += acc[m][r] * acc[m][r];
  ss += xor32(ss);
  const float rn = rsqrtf(ss * (1.f / 64.f) + EPS) * qs;
  u16* qd = Q + (size_t)tok * 768 + hd * 96;
#pragma unroll
  for (int m = 0; m < 2; ++m)
#pragma unroll
    for (int q = 0; q < 4; ++q) {
      const int f0 = m * 32 + 8 * q + 4 * h;
      const float4 g = *(const float4*)(p.qn_nope + layer * 64 + f0);
      *(uint2*)(qd + f0) = make_uint2(pk2(acc[m][4 * q] * rn * g.x, acc[m][4 * q + 1] * rn * g.y), pk2(acc[m][4 * q + 2] * rn * g.z, acc[m][4 * q + 3] * rn * g.w));
    }
  float sr = 0.f;
#pragma unroll
  for (int r = 0; r < 16; ++r) sr += acc[2][r] * acc[2][r];
  sr += xor32(sr);
  const float rr = rsqrtf(sr * (1.f / 32.f) + EPS);
  const int pos = tok_pos(tok);
  float o1[8], o2[8];
#pragma unroll
  for (int r = 0; r < 8; ++r) {
    const int i = crow(r, h);
    const float x1 = acc[2][r] * rr * p.qn_rope[layer * 32 + i];
    const float x2 = acc[2][r + 8] * rr * p.qn_rope[layer * 32 + i + 16];
    float s, c;
    rope_sincos(pos, i, s, c);
    o1[r] = (x1 * c - x2 * s) * qs;
    o2[r] = (x2 * c + x1 * s) * qs;
  }
#pragma unroll
  for (int q = 0; q < 2; ++q) {
    const int i0 = 8 * q + 4 * h;
    *(uint2*)(qd + 64 + i0) = make_uint2(pk2(o1[4 * q], o1[4 * q + 1]), pk2(o1[4 * q + 2], o1[4 * q + 3]));
    *(uint2*)(qd + 64 + 16 + i0) = make_uint2(pk2(o2[4 * q], o2[4 * q + 1]), pk2(o2[4 * q + 2], o2[4 * q + 3]));
  }
}

DI void kvproj_item(const Params& p, int layer, int tt, int hd, int lane) {
  const int l31 = lane & 31, h = lane >> 5;
  const int tok = tt * 32 + l31;
  const u16* zk = (const u16*)(p.ws + WS_Z) + (size_t)tok * NZ + ZC_KV;
  const float* gk = p.kv_norm_w + layer * 128;
  float ssq = 0.f;
  const u16* WT = (const u16*)(p.ws + (size_t)layer * WL_STRIDE + W_UKV);
  u16* KN = (u16*)(p.ws + WS_KN);
  u16* VT = (u16*)(p.ws + WS_VT);
  f32x16 acc[4];
#pragma unroll
  for (int m = 0; m < 4; ++m)
#pragma unroll
    for (int r = 0; r < 16; ++r) acc[m][r] = 0.f;
#pragma unroll 4
  for (int ks = 0; ks < 8; ++ks) {
    const bf16x8 bfr = normed_frag(zk + ks * 16 + h * 8, gk + ks * 16 + h * 8, ssq);
#pragma unroll
    for (int m = 0; m < 4; ++m) {
      const bf16x8 afr = *(const bf16x8*)(WT + (size_t)(hd * 128 + m * 32 + l31) * 128 + ks * 16 + h * 8);
      acc[m] = MFMA32(afr, bfr, acc[m]);
    }
  }
  {
    ssq += xor32(ssq);
    const float rinv = rsqrtf(ssq * (1.f / 128.f) + EPS);
#pragma unroll
    for (int m = 0; m < 4; ++m)
#pragma unroll
      for (int r = 0; r < 16; ++r) acc[m][r] *= rinv;
  }
  float ss = 0.f;
#pragma unroll
  for (int m = 0; m < 2; ++m)
#pragma unroll
    for (int r = 0; r < 16; ++r) ss += acc[m][r] * acc[m][r];
  ss += xor32(ss);
  const float rn = rsqrtf(ss * (1.f / 64.f) + EPS);
  u16* kd = KN + ((size_t)hd * NP + tok) * 64;
#pragma unroll
  for (int m = 0; m < 2; ++m)
#pragma unroll
    for (int q = 0; q < 4; ++q) {
      const int f0 = m * 32 + 8 * q + 4 * h;
      const float4 g = *(const float4*)(p.kn_nope + layer * 64 + f0);
      *(uint2*)(kd + f0) = make_uint2(pk2(acc[m][4 * q] * rn * g.x, acc[m][4 * q + 1] * rn * g.y), pk2(acc[m][4 * q + 2] * rn * g.z, acc[m][4 * q + 3] * rn * g.w));
    }
#pragma unroll
  for (int m = 0; m < 2; ++m)
#pragma unroll
    for (int r = 0; r < 16; ++r) {
      const int d = m * 32 + crow(r, h);
      VT[((size_t)hd * 64 + d) * NP + tok] = f2bf(acc[2 + m][r]);
    }
}

DI void phase_proj(const Params& p, int layer) {
  const int wave = tidx() >> 6, lane = tidx() & 63;
  const int nw = gridDim.x * 4, gw = blockIdx.x * 4 + wave;
  for (int it = gw; it < 544 * 8 + 512 * 8; it += nw) {
    if (it < 544 * 8) qproj_item(p, layer, it >> 3, it & 7, lane);
    else { const int j = it - 544 * 8; kvproj_item(p, layer, j >> 3, j & 7, lane); }
  }
}

DI float wave_max(float v) {
#pragma unroll
  for (int o = 32; o > 0; o >>= 1) v = fmaxf(v, __shfl_xor(v, o));
  return v;
}
DI float attn_bound(const Params& p, int layer, int lane) {
  const float gqn = wave_max(fabsf(p.qn_nope[layer * 64 + lane])), gkn = wave_max(fabsf(p.kn_nope[layer * 64 + lane]));
  const float gqr = wave_max(fabsf(p.qn_rope[layer * 32 + (lane & 31)])), gkr = wave_max(fabsf(p.kn_rope[layer * 32 + (lane & 31)]));
  const float qs = 0.10206207261596577f * 1.4426950408889634f;
  return 1.02f * qs * (64.f * gqn * gkn + 32.f * gqr * gkr) + 0.25f;
}
template <int NSUB>
DI void attn_tile(const bf16x8 (&qf)[6], const u16* sK, const u16* sVT, int ksub0, f32x16 (&o)[2], float& l, float negB, int l31, int h) {
  f32x16 s[NSUB];
  {
    bf16x8 kf[NSUB][6];
#pragma unroll
    for (int i = 0; i < NSUB; ++i)
#pragma unroll
      for (int ks = 0; ks < 6; ++ks) kf[i][ks] = *(const bf16x8*)(sK + ((ksub0 + i) * 32 + l31) * 104 + ks * 16 + h * 8);
#pragma unroll
    for (int i = 0; i < NSUB; ++i) {
#pragma unroll
      for (int r = 0; r < 16; ++r) s[i][r] = negB;
#pragma unroll
      for (int ks = 0; ks < 6; ++ks) s[i] = MFMA32(kf[i][ks], qf[ks], s[i]);
    }
    __builtin_amdgcn_sched_group_barrier(0x100, 6 * NSUB, 0);
    __builtin_amdgcn_sched_group_barrier(0x008, 6 * NSUB, 0);
  }
  bf16x8 vf[NSUB][2][2];
#pragma unroll
  for (int i = 0; i < NSUB; ++i)
#pragma unroll
    for (int st = 0; st < 2; ++st)
#pragma unroll
      for (int md = 0; md < 2; ++md) {
        const u16* vp = sVT + (md * 32 + l31) * 68 + (ksub0 + i) * 32 + 16 * st + 4 * h;
        const s16x4 lo = *(const s16x4*)vp;
        const s16x4 hi = *(const s16x4*)(vp + 8);
        vf[i][st][md] = __builtin_shufflevector(lo, hi, 0, 1, 2, 3, 4, 5, 6, 7);
      }
  float ps = 0.f;
#pragma unroll
  for (int i = 0; i < NSUB; ++i)
#pragma unroll
    for (int r = 0; r < 16; ++r) {
      const float pv = __builtin_amdgcn_exp2f(s[i][r]);
      ps += pv;
      s[i][r] = pv;
    }
  l += ps;
#pragma unroll
  for (int i = 0; i < NSUB; ++i)
#pragma unroll
    for (int st = 0; st < 2; ++st) {
      u32x4 pu;
      pu.x = pk2(s[i][8 * st + 0], s[i][8 * st + 1]);
      pu.y = pk2(s[i][8 * st + 2], s[i][8 * st + 3]);
      pu.z = pk2(s[i][8 * st + 4], s[i][8 * st + 5]);
      pu.w = pk2(s[i][8 * st + 6], s[i][8 * st + 7]);
      const bf16x8 pf = __builtin_bit_cast(bf16x8, pu);
#pragma unroll
      for (int md = 0; md < 2; ++md) o[md] = MFMA32(vf[i][st][md], pf, o[md]);
    }
}

DI void attn_store(const Params& p, int tok, int hd, const f32x16 (&o)[2], float linv, int h) {
  const u16* gz = (const u16*)(p.ws + WS_Z) + (size_t)tok * NZ + ZC_GA + hd * 64;
  u16* OA = (u16*)(p.ws + WS_OA) + (size_t)tok * 512 + hd * 64;
#pragma unroll
  for (int md = 0; md < 2; ++md)
#pragma unroll
    for (int q = 0; q < 4; ++q) {
      const int d0 = md * 32 + 8 * q + 4 * h;
      const uint2 g = *(const uint2*)(gz + d0);
      const float v0 = o[md][4 * q] * linv * siluf_(lo2f(g.x));
      const float v1 = o[md][4 * q + 1] * linv * siluf_(hi2f(g.x));
      const float v2 = o[md][4 * q + 2] * linv * siluf_(lo2f(g.y));
      const float v3 = o[md][4 * q + 3] * linv * siluf_(hi2f(g.y));
      *(uint2*)(OA + d0) = make_uint2(pk2(v0, v1), pk2(v2, v3));
    }
}

DI void attn_prompt_item(const Params& p, int layer, int qt, int hd, char* smem) {
  u16* sK = (u16*)smem;
  u16* sVT = (u16*)(smem + 13312);
  const int tid = tidx(), lane = tid & 63, w = tid >> 6, l31 = lane & 31, h = lane >> 5;
  const int tok = qt * 128 + w * 32 + l31;
  const u16* Q = (const u16*)(p.ws + WS_Q);
  const u16* KN = (const u16*)(p.ws + WS_KN) + (size_t)hd * NP * 64;
  const u16* KPEB = (const u16*)(p.ws + WS_KPEB);
  const u16* VT = (const u16*)(p.ws + WS_VT) + (size_t)hd * 64 * NP;
  bf16x8 qf[6];
#pragma unroll
  for (int ks = 0; ks < 6; ++ks) qf[ks] = *(const bf16x8*)(Q + (size_t)tok * 768 + hd * 96 + ks * 16 + h * 8);
  f32x16 o[2];
#pragma unroll
  for (int d = 0; d < 2; ++d)
#pragma unroll
    for (int r = 0; r < 16; ++r) o[d][r] = 0.f;
  float l = 0.f;
  const float negB = -attn_bound(p, layer, lane);
  const int nkt = 2 * qt + 2;
  const int my_nkt = (w < 2) ? nkt - 1 : nkt;
  u32x4 pk[2][2], pr[2], pv[2][2];
#define PA_GLOAD(SET, KT)                                                                        \
  {                                                                                              \
    const int key0_ = (KT) * 64;                                                                 \
    _Pragma("unroll") for (int i = 0; i < 2; ++i) {                                              \
      const int c = tid + 256 * i;                                                               \
      pk[SET][i] = *(const u32x4*)(KN + (size_t)(key0_ + (c >> 3)) * 64 + (c & 7) * 8);          \
      pv[SET][i] = *(const u32x4*)(VT + (size_t)(c >> 3) * NP + key0_ + (c & 7) * 8);            \
    }                                                                                            \
    pr[SET] = *(const u32x4*)(KPEB + (size_t)(key0_ + (tid >> 2)) * 32 + (tid & 3) * 8);         \
  }
  PA_GLOAD(0, 0)
  PA_GLOAD(1, 1)
  for (int kt0 = 0; kt0 < nkt; kt0 += 2) {
#pragma unroll
    for (int u = 0; u < 2; ++u) {
      const int kt = kt0 + u;
      __syncthreads();
#pragma unroll
      for (int i = 0; i < 2; ++i) {
        const int c = tid + 256 * i;
        *(u32x4*)(sK + (c >> 3) * 104 + (c & 7) * 8) = pk[u][i];
        u32x2* vd = (u32x2*)(sVT + (c >> 3) * 68 + (c & 7) * 8);
        vd[0] = u32x2{pv[u][i].x, pv[u][i].y};
        vd[1] = u32x2{pv[u][i].z, pv[u][i].w};
      }
      *(u32x4*)(sK + (tid >> 2) * 104 + 64 + (tid & 3) * 8) = pr[u];
      __syncthreads();
      if (kt + 2 < nkt) PA_GLOAD(u, kt + 2)
      if (kt < my_nkt) attn_tile<2>(qf, sK, sVT, 0, o, l, negB, l31, h);
    }
  }
#undef PA_GLOAD
  l += xor32(l);
  attn_store(p, tok, hd, o, 1.f / l, h);
}

DI void attn_sample_item(const Params& p, int layer, int b, int hd, char* smem) {
  u16* sC = (u16*)smem;
  u16* sK = (u16*)(smem + 17408);
  u16* sVT = (u16*)(smem + 17408 + 13312);
  u16* sW = (u16*)(smem + 39424);
  const int tid = tidx(), lane = tid & 63, w = tid >> 6, l31 = lane & 31, h = lane >> 5;
  const int khu = w & 1, part = w >> 1;
  const int qh = w >> 1, kh = w & 1;
  const int tok = NP + b * 64 + qh * 32 + l31;
  const u16* Q = (const u16*)(p.ws + WS_Q);
  const u16* WT = (const u16*)(p.ws + (size_t)layer * WL_STRIDE + W_UKV) + (size_t)hd * 128 * 128;
  __syncthreads();
#pragma unroll
  for (int i = 0; i < 8; ++i) {
    const int c = tid + 256 * i;
    *(u32x4*)(sW + (c >> 4) * 136 + (c & 15) * 8) = *(const u32x4*)(WT + (size_t)c * 8);
  }
  bf16x8 qf[6];
#pragma unroll
  for (int ks = 0; ks < 6; ++ks) qf[ks] = *(const bf16x8*)(Q + (size_t)tok * 768 + hd * 96 + ks * 16 + h * 8);
  f32x16 o[2];
#pragma unroll
  for (int d = 0; d < 2; ++d)
#pragma unroll
    for (int r = 0; r < 16; ++r) o[d][r] = 0.f;
  float l = 0.f;
  const float negB = -attn_bound(p, layer, lane);
  const u16* cck = (const u16*)(p.ws + WS_CKB) + (size_t)b * 4096 * 128;
  const u16* ckp = (const u16*)(p.ws + WS_KPB) + (size_t)b * 4096 * 32;
  const u16* nck = (const u16*)(p.ws + WS_CKVB) + (size_t)(NP + b * 64) * 128;
  const u16* nkp = (const u16*)(p.ws + WS_KPEB) + (size_t)(NP + b * 64) * 32;
  u32x4 pc[4], pp;
#define SA_GLOAD(KT)                                                                      \
  {                                                                                       \
    const u16* s1_ = ((KT) < 64) ? cck + (size_t)(KT) * 64 * 128 : nck;                   \
    const u16* s2_ = ((KT) < 64) ? ckp + (size_t)(KT) * 64 * 32 : nkp;                    \
    _Pragma("unroll") for (int i = 0; i < 4; ++i) pc[i] = *(const u32x4*)(s1_ + (size_t)(tid + 256 * i) * 8); \
    pp = *(const u32x4*)(s2_ + (size_t)tid * 8);                                          \
  }
  SA_GLOAD(0)
  for (int kt = 0; kt < 65; ++kt) {
    __syncthreads();
#pragma unroll
    for (int i = 0; i < 4; ++i) {
      const int c = tid + 256 * i;
      *(u32x4*)(sC + (c >> 4) * 136 + (c & 15) * 8) = pc[i];
    }
    *(u32x4*)(sK + (tid >> 2) * 104 + 64 + (tid & 3) * 8) = pp;
    __syncthreads();
    if (kt + 1 < 65) SA_GLOAD(kt + 1)
    {
      f32x16 acc[2];
#pragma unroll
      for (int mt = 0; mt < 2; ++mt)
#pragma unroll
        for (int r = 0; r < 16; ++r) acc[mt][r] = 0.f;
      bf16x8 cfa[8];
#pragma unroll
      for (int ks = 0; ks < 8; ++ks) cfa[ks] = *(const bf16x8*)(sC + (khu * 32 + l31) * 136 + ks * 16 + h * 8);
#pragma unroll
      for (int mt = 0; mt < 2; ++mt) {
        bf16x8 wfa[8];
#pragma unroll
        for (int ks = 0; ks < 8; ++ks) wfa[ks] = *(const bf16x8*)(sW + (part * 64 + mt * 32 + l31) * 136 + ks * 16 + h * 8);
#pragma unroll
        for (int ks = 0; ks < 8; ++ks) {
          if (part == 0) acc[mt] = MFMA32(wfa[ks], cfa[ks], acc[mt]);
          else acc[mt] = MFMA32(cfa[ks], wfa[ks], acc[mt]);
        }
      }
      if (part == 0) {
        float ss = 0.f;
#pragma unroll
        for (int mt = 0; mt < 2; ++mt)
#pragma unroll
          for (int r = 0; r < 16; ++r) ss += acc[mt][r] * acc[mt][r];
        ss += xor32(ss);
        const float rn = rsqrtf(ss * (1.f / 64.f) + EPS);
#pragma unroll
        for (int mt = 0; mt < 2; ++mt)
#pragma unroll
          for (int q = 0; q < 4; ++q) {
            const int f0 = mt * 32 + 8 * q + 4 * h;
            const float4 g = *(const float4*)(p.kn_nope + layer * 64 + f0);
            *(u32x2*)(sK + (khu * 32 + l31) * 104 + f0) = u32x2{pk2(acc[mt][4 * q] * rn * g.x, acc[mt][4 * q + 1] * rn * g.y), pk2(acc[mt][4 * q + 2] * rn * g.z, acc[mt][4 * q + 3] * rn * g.w)};
          }
      } else {
#pragma unroll
        for (int mt = 0; mt < 2; ++mt)
#pragma unroll
          for (int q = 0; q < 4; ++q)
            *(u32x2*)(sVT + (mt * 32 + l31) * 68 + khu * 32 + 8 * q + 4 * h) =
                u32x2{pk2(acc[mt][4 * q], acc[mt][4 * q + 1]), pk2(acc[mt][4 * q + 2], acc[mt][4 * q + 3])};
      }
    }
    __syncthreads();
    attn_tile<1>(qf, sK, sVT, kh, o, l, negB, l31, h);
  }
#undef SA_GLOAD
  __syncthreads();
  float* cb = (float*)smem;
  if (kh == 1) {
    float* d = cb + (qh * 64 + lane) * 34;
#pragma unroll
    for (int r = 0; r < 16; ++r) { d[r] = o[0][r]; d[16 + r] = o[1][r]; }
    d[32] = l;
  }
  __syncthreads();
  if (kh == 0) {
    const float* d = cb + (qh * 64 + lane) * 34;
#pragma unroll
    for (int r = 0; r < 16; ++r) { o[0][r] += d[r]; o[1][r] += d[16 + r]; }
    l += d[32];
    l += xor32(l);
    attn_store(p, tok, hd, o, 1.f / l, h);
  }
}

template <int N> DI void fmac_bc(float& acc, float srcvec, float other) {
  asm("v_fmac_f32_dpp %0, %1, %2 row_newbcast:%3 row_mask:0xf bank_mask:0xf" : "+v"(acc) : "v"(srcvec), "v"(other), "n"(N));
}
template <int N> DI float mul_bc(float srcvec, float other) {
  float r;
  asm("v_mul_f32_dpp %0, %1, %2 row_newbcast:%3 row_mask:0xf bank_mask:0xf" : "=v"(r) : "v"(srcvec), "v"(other), "n"(N));
  return r;
}
struct RplRaw { u32x2 r, e, k, a, b; unsigned v; };
template <int MODE> DI void rpl_load(RplRaw& q, const u16* s, int n, int lane) {
  q.e = *(const u32x2*)(s + 64 + 4 * n);
  q.a = *(const u32x2*)(s + 256 + 4 * n);
  q.b = *(const u32x2*)(s + 320 + 4 * n);
  if (MODE >= 1) { q.k = *(const u32x2*)(s + 128 + 4 * n); q.v = s[192 + lane]; }
  if (MODE == 2) q.r = *(const u32x2*)(s + 4 * n);
}
template <int MODE>
DI void rpl_item(const Params& p, int hd, int tok0, int nsteps, const float* Sinit, float* Sout, float* Yg, int lane) {
  const int n = lane & 15;
  float S[64];
  if (MODE == 0) {
#pragma unroll
    for (int k = 0; k < 64; ++k) S[k] = (k == lane) ? 1.f : 0.f;
  } else if (MODE == 1) {
#pragma unroll
    for (int k = 0; k < 64; ++k) S[k] = 0.f;
  } else {
#pragma unroll
    for (int k = 0; k < 64; k += 4) {
      const f32x4 t = *(const f32x4*)(Sinit + (size_t)lane * 64 + k);
      S[k] = t.x; S[k + 1] = t.y; S[k + 2] = t.z; S[k + 3] = t.w;
    }
  }
  const u16* src = (const u16*)(p.ws + WS_WKVIN) + ((size_t)hd * NT + tok0) * 384;
  float C0 = 1.f, C1 = 1.f, C2 = 1.f, C3 = 1.f;
  RplRaw c0, c1, c2;
  rpl_load<MODE>(c0, src, n, lane);
  rpl_load<MODE>(c1, src + 384, n, lane);
  for (int t = 0; t < nsteps; ++t) {
    if (t + 2 < nsteps) rpl_load<MODE>(c2, src + (size_t)(t + 2) * 384, n, lane);
    float A0 = lo2f(c0.a.x), A1 = hi2f(c0.a.x), A2 = lo2f(c0.a.y), A3 = hi2f(c0.a.y);
    float W0 = __builtin_amdgcn_exp2f(lo2f(c0.e.x)), W1 = __builtin_amdgcn_exp2f(hi2f(c0.e.x)), W2 = __builtin_amdgcn_exp2f(lo2f(c0.e.y)), W3 = __builtin_amdgcn_exp2f(hi2f(c0.e.y));
    float B0 = lo2f(c0.b.x), B1 = hi2f(c0.b.x), B2 = lo2f(c0.b.y), B3 = hi2f(c0.b.y);
    float K0 = 0.f, K1 = 0.f, K2 = 0.f, K3 = 0.f, R0 = 0.f, R1 = 0.f, R2 = 0.f, R3 = 0.f, vv = 0.f;
    if (MODE >= 1) { K0 = lo2f(c0.k.x); K1 = hi2f(c0.k.x); K2 = lo2f(c0.k.y); K3 = hi2f(c0.k.y); vv = lo2f(c0.v); }
    if (MODE == 2) { R0 = lo2f(c0.r.x); R1 = hi2f(c0.r.x); R2 = lo2f(c0.r.y); R3 = hi2f(c0.r.y); }
    A0 *= C0; A1 *= C1; A2 *= C2; A3 *= C3;
    C0 *= W0; C1 *= W1; C2 *= W2; C3 *= W3;
    {
      const float i0 = __builtin_amdgcn_rcpf(C0), i1 = __builtin_amdgcn_rcpf(C1), i2 = __builtin_amdgcn_rcpf(C2), i3 = __builtin_amdgcn_rcpf(C3);
      B0 *= i0; B1 *= i1; B2 *= i2; B3 *= i3;
      if (MODE >= 1) { K0 *= i0; K1 *= i1; K2 *= i2; K3 *= i3; }
      if (MODE == 2) { R0 *= C0; R1 *= C1; R2 *= C2; R3 *= C3; }
    }
    W0 = C0; W1 = C1; W2 = C2; W3 = C3;
    asm volatile("s_nop 1" : "+v"(A0), "+v"(A1), "+v"(A2), "+v"(A3), "+v"(W0), "+v"(W1), "+v"(W2), "+v"(W3), "+v"(B0), "+v"(B1), "+v"(B2), "+v"(B3));
    asm volatile("s_nop 1" : "+v"(K0), "+v"(K1), "+v"(K2), "+v"(K3), "+v"(R0), "+v"(R1), "+v"(R2), "+v"(R3));
    float sa0 = 0.f, sa1 = 0.f, sa2 = 0.f, sa3 = 0.f;
    fmac_bc<0>(sa0, A0, S[0]);
    fmac_bc<0>(sa1, A1, S[1]);
    fmac_bc<0>(sa2, A2, S[2]);
    fmac_bc<0>(sa3, A3, S[3]);
    fmac_bc<1>(sa0, A0, S[4]);
    fmac_bc<1>(sa1, A1, S[5]);
    fmac_bc<1>(sa2, A2, S[6]);
    fmac_bc<1>(sa3, A3, S[7]);
    fmac_bc<2>(sa0, A0, S[8]);
    fmac_bc<2>(sa1, A1, S[9]);
    fmac_bc<2>(sa2, A2, S[10]);
    fmac_bc<2>(sa3, A3, S[11]);
    fmac_bc<3>(sa0, A0, S[12]);
    fmac_bc<3>(sa1, A1, S[13]);
    fmac_bc<3>(sa2, A2, S[14]);
    fmac_bc<3>(sa3, A3, S[15]);
    fmac_bc<4>(sa0, A0, S[16]);
    fmac_bc<4>(sa1, A1, S[17]);
    fmac_bc<4>(sa2, A2, S[18]);
    fmac_bc<4>(sa3, A3, S[19]);
    fmac_bc<5>(sa0, A0, S[20]);
    fmac_bc<5>(sa1, A1, S[21]);
    fmac_bc<5>(sa2, A2, S[22]);
    fmac_bc<5>(sa3, A3, S[23]);
    fmac_bc<6>(sa0, A0, S[24]);
    fmac_bc<6>(sa1, A1, S[25]);
    fmac_bc<6>(sa2, A2, S[26]);
    fmac_bc<6>(sa3, A3, S[27]);
    fmac_bc<7>(sa0, A0, S[28]);
    fmac_bc<7>(sa1, A1, S[29]);
    fmac_bc<7>(sa2, A2, S[30]);
    fmac_bc<7>(sa3, A3, S[31]);
    fmac_bc<8>(sa0, A0, S[32]);
    fmac_bc<8>(sa1, A1, S[33]);
    fmac_bc<8>(sa2, A2, S[34]);
    fmac_bc<8>(sa3, A3, S[35]);
    fmac_bc<9>(sa0, A0, S[36]);
    fmac_bc<9>(sa1, A1, S[37]);
    fmac_bc<9>(sa2, A2, S[38]);
    fmac_bc<9>(sa3, A3, S[39]);
    fmac_bc<10>(sa0, A0, S[40]);
    fmac_bc<10>(sa1, A1, S[41]);
    fmac_bc<10>(sa2, A2, S[42]);
    fmac_bc<10>(sa3, A3, S[43]);
    fmac_bc<11>(sa0, A0, S[44]);
    fmac_bc<11>(sa1, A1, S[45]);
    fmac_bc<11>(sa2, A2, S[46]);
    fmac_bc<11>(sa3, A3, S[47]);
    fmac_bc<12>(sa0, A0, S[48]);
    fmac_bc<12>(sa1, A1, S[49]);
    fmac_bc<12>(sa2, A2, S[50]);
    fmac_bc<12>(sa3, A3, S[51]);
    fmac_bc<13>(sa0, A0, S[52]);
    fmac_bc<13>(sa1, A1, S[53]);
    fmac_bc<13>(sa2, A2, S[54]);
    fmac_bc<13>(sa3, A3, S[55]);
    fmac_bc<14>(sa0, A0, S[56]);
    fmac_bc<14>(sa1, A1, S[57]);
    fmac_bc<14>(sa2, A2, S[58]);
    fmac_bc<14>(sa3, A3, S[59]);
    fmac_bc<15>(sa0, A0, S[60]);
    fmac_bc<15>(sa1, A1, S[61]);
    fmac_bc<15>(sa2, A2, S[62]);
    fmac_bc<15>(sa3, A3, S[63]);
    const float sa = (sa0 + sa1) + (sa2 + sa3);
    float y0 = 0.f, y1 = 0.f, y2 = 0.f, y3 = 0.f;
    if (MODE >= 1) {
      fmac_bc<0>(S[0], K0, vv);
      fmac_bc<0>(S[1], K1, vv);
      fmac_bc<0>(S[2], K2, vv);
      fmac_bc<0>(S[3], K3, vv);
      fmac_bc<1>(S[4], K0, vv);
      fmac_bc<1>(S[5], K1, vv);
      fmac_bc<1>(S[6], K2, vv);
      fmac_bc<1>(S[7], K3, vv);
    }
    fmac_bc<0>(S[0], B0, sa);
    fmac_bc<0>(S[1], B1, sa);
    fmac_bc<0>(S[2], B2, sa);
    fmac_bc<0>(S[3], B3, sa);
    fmac_bc<1>(S[4], B0, sa);
    fmac_bc<1>(S[5], B1, sa);
    fmac_bc<1>(S[6], B2, sa);
    fmac_bc<1>(S[7], B3, sa);
    if (MODE == 2) {
      fmac_bc<0>(y0, R0, S[0]);
      fmac_bc<0>(y1, R1, S[1]);
      fmac_bc<0>(y2, R2, S[2]);
      fmac_bc<0>(y3, R3, S[3]);
      fmac_bc<1>(y0, R0, S[4]);
      fmac_bc<1>(y1, R1, S[5]);
      fmac_bc<1>(y2, R2, S[6]);
      fmac_bc<1>(y3, R3, S[7]);
    }
    if (MODE >= 1) {
      fmac_bc<2>(S[8], K0, vv);
      fmac_bc<2>(S[9], K1, vv);
      fmac_bc<2>(S[10], K2, vv);
      fmac_bc<2>(S[11], K3, vv);
      fmac_bc<3>(S[12], K0, vv);
      fmac_bc<3>(S[13], K1, vv);
      fmac_bc<3>(S[14], K2, vv);
      fmac_bc<3>(S[15], K3, vv);
    }
    fmac_bc<2>(S[8], B0, sa);
    fmac_bc<2>(S[9], B1, sa);
    fmac_bc<2>(S[10], B2, sa);
    fmac_bc<2>(S[11], B3, sa);
    fmac_bc<3>(S[12], B0, sa);
    fmac_bc<3>(S[13], B1, sa);
    fmac_bc<3>(S[14], B2, sa);
    fmac_bc<3>(S[15], B3, sa);
    if (MODE == 2) {
      fmac_bc<2>(y0, R0, S[8]);
      fmac_bc<2>(y1, R1, S[9]);
      fmac_bc<2>(y2, R2, S[10]);
      fmac_bc<2>(y3, R3, S[11]);
      fmac_bc<3>(y0, R0, S[12]);
      fmac_bc<3>(y1, R1, S[13]);
      fmac_bc<3>(y2, R2, S[14]);
      fmac_bc<3>(y3, R3, S[15]);
    }
    if (MODE >= 1) {
      fmac_bc<4>(S[16], K0, vv);
      fmac_bc<4>(S[17], K1, vv);
      fmac_bc<4>(S[18], K2, vv);
      fmac_bc<4>(S[19], K3, vv);
      fmac_bc<5>(S[20], K0, vv);
      fmac_bc<5>(S[21], K1, vv);
      fmac_bc<5>(S[22], K2, vv);
      fmac_bc<5>(S[23], K3, vv);
    }
    fmac_bc<4>(S[16], B0, sa);
    fmac_bc<4>(S[17], B1, sa);
    fmac_bc<4>(S[18], B2, sa);
    fmac_bc<4>(S[19], B3, sa);
    fmac_bc<5>(S[20], B0, sa);
    fmac_bc<5>(S[21], B1, sa);
    fmac_bc<5>(S[22], B2, sa);
    fmac_bc<5>(S[23], B3, sa);
    if (MODE == 2) {
      fmac_bc<4>(y0, R0, S[16]);
      fmac_bc<4>(y1, R1, S[17]);
      fmac_bc<4>(y2, R2, S[18]);
      fmac_bc<4>(y3, R3, S[19]);
      fmac_bc<5>(y0, R0, S[20]);
      fmac_bc<5>(y1, R1, S[21]);
      fmac_bc<5>(y2, R2, S[22]);
      fmac_bc<5>(y3, R3, S[23]);
    }
    if (MODE >= 1) {
      fmac_bc<6>(S[24], K0, vv);
      fmac_bc<6>(S[25], K1, vv);
      fmac_bc<6>(S[26], K2, vv);
      fmac_bc<6>(S[27], K3, vv);
      fmac_bc<7>(S[28], K0, vv);
      fmac_bc<7>(S[29], K1, vv);
      fmac_bc<7>(S[30], K2, vv);
      fmac_bc<7>(S[31], K3, vv);
    }
    fmac_bc<6>(S[24], B0, sa);
    fmac_bc<6>(S[25], B1, sa);
    fmac_bc<6>(S[26], B2, sa);
    fmac_bc<6>(S[27], B3, sa);
    fmac_bc<7>(S[28], B0, sa);
    fmac_bc<7>(S[29], B1, sa);
    fmac_bc<7>(S[30], B2, sa);
    fmac_bc<7>(S[31], B3, sa);
    if (MODE == 2) {
      fmac_bc<6>(y0, R0, S[24]);
      fmac_bc<6>(y1, R1, S[25]);
      fmac_bc<6>(y2, R2, S[26]);
      fmac_bc<6>(y3, R3, S[27]);
      fmac_bc<7>(y0, R0, S[28]);
      fmac_bc<7>(y1, R1, S[29]);
      fmac_bc<7>(y2, R2, S[30]);
      fmac_bc<7>(y3, R3, S[31]);
    }
    if (MODE >= 1) {
      fmac_bc<8>(S[32], K0, vv);
      fmac_bc<8>(S[33], K1, vv);
      fmac_bc<8>(S[34], K2, vv);
      fmac_bc<8>(S[35], K3, vv);
      fmac_bc<9>(S[36], K0, vv);
      fmac_bc<9>(S[37], K1, vv);
      fmac_bc<9>(S[38], K2, vv);
      fmac_bc<9>(S[39], K3, vv);
    }
    fmac_bc<8>(S[32], B0, sa);
    fmac_bc<8>(S[33], B1, sa);
    fmac_bc<8>(S[34], B2, sa);
    fmac_bc<8>(S[35], B3, sa);
    fmac_bc<9>(S[36], B0, sa);
    fmac_bc<9>(S[37], B1, sa);
    fmac_bc<9>(S[38], B2, sa);
    fmac_bc<9>(S[39], B3, sa);
    if (MODE == 2) {
      fmac_bc<8>(y0, R0, S[32]);
      fmac_bc<8>(y1, R1, S[33]);
      fmac_bc<8>(y2, R2, S[34]);
      fmac_bc<8>(y3, R3, S[35]);
      fmac_bc<9>(y0, R0, S[36]);
      fmac_bc<9>(y1, R1, S[37]);
      fmac_bc<9>(y2, R2, S[38]);
      fmac_bc<9>(y3, R3, S[39]);
    }
    if (MODE >= 1) {
      fmac_bc<10>(S[40], K0, vv);
      fmac_bc<10>(S[41], K1, vv);
      fmac_bc<10>(S[42], K2, vv);
      fmac_bc<10>(S[43], K3, vv);
      fmac_bc<11>(S[44], K0, vv);
      fmac_bc<11>(S[45], K1, vv);
      fmac_bc<11>(S[46], K2, vv);
      fmac_bc<11>(S[47], K3, vv);
    }
    fmac_bc<10>(S[40], B0, sa);
    fmac_bc<10>(S[41], B1, sa);
    fmac_bc<10>(S[42], B2, sa);
    fmac_bc<10>(S[43], B3, sa);
    fmac_bc<11>(S[44], B0, sa);
    fmac_bc<11>(S[45], B1, sa);
    fmac_bc<11>(S[46], B2, sa);
    fmac_bc<11>(S[47], B3, sa);
    if (MODE == 2) {
      fmac_bc<10>(y0, R0, S[40]);
      fmac_bc<10>(y1, R1, S[41]);
      fmac_bc<10>(y2, R2, S[42]);
      fmac_bc<10>(y3, R3, S[43]);
      fmac_bc<11>(y0, R0, S[44]);
      fmac_bc<11>(y1, R1, S[45]);
      fmac_bc<11>(y2, R2, S[46]);
      fmac_bc<11>(y3, R3, S[47]);
    }
    if (MODE >= 1) {
      fmac_bc<12>(S[48], K0, vv);
      fmac_bc<12>(S[49], K1, vv);
      fmac_bc<12>(S[50], K2, vv);
      fmac_bc<12>(S[51], K3, vv);
      fmac_bc<13>(S[52], K0, vv);
      fmac_bc<13>(S[53], K1, vv);
      fmac_bc<13>(S[54], K2, vv);
      fmac_bc<13>(S[55], K3, vv);
    }
    fmac_bc<12>(S[48], B0, sa);
    fmac_bc<12>(S[49], B1, sa);
    fmac_bc<12>(S[50], B2, sa);
    fmac_bc<12>(S[51], B3, sa);
    fmac_bc<13>(S[52], B0, sa);
    fmac_bc<13>(S[53], B1, sa);
    fmac_bc<13>(S[54], B2, sa);
    fmac_bc<13>(S[55], B3, sa);
    if (MODE == 2) {
      fmac_bc<12>(y0, R0, S[48]);
      fmac_bc<12>(y1, R1, S[49]);
      fmac_bc<12>(y2, R2, S[50]);
      fmac_bc<12>(y3, R3, S[51]);
      fmac_bc<13>(y0, R0, S[52]);
      fmac_bc<13>(y1, R1, S[53]);
      fmac_bc<13>(y2, R2, S[54]);
      fmac_bc<13>(y3, R3, S[55]);
    }
    if (MODE >= 1) {
      fmac_bc<14>(S[56], K0, vv);
      fmac_bc<14>(S[57], K1, vv);
      fmac_bc<14>(S[58], K2, vv);
      fmac_bc<14>(S[59], K3, vv);
      fmac_bc<15>(S[60], K0, vv);
      fmac_bc<15>(S[61], K1, vv);
      fmac_bc<15>(S[62], K2, vv);
      fmac_bc<15>(S[63], K3, vv);
    }
    fmac_bc<14>(S[56], B0, sa);
    fmac_bc<14>(S[57], B1, sa);
    fmac_bc<14>(S[58], B2, sa);
    fmac_bc<14>(S[59], B3, sa);
    fmac_bc<15>(S[60], B0, sa);
    fmac_bc<15>(S[61], B1, sa);
    fmac_bc<15>(S[62], B2, sa);
    fmac_bc<15>(S[63], B3, sa);
    if (MODE == 2) {
      fmac_bc<14>(y0, R0, S[56]);
      fmac_bc<14>(y1, R1, S[57]);
      fmac_bc<14>(y2, R2, S[58]);
      fmac_bc<14>(y3, R3, S[59]);
      fmac_bc<15>(y0, R0, S[60]);
      fmac_bc<15>(y1, R1, S[61]);
      fmac_bc<15>(y2, R2, S[62]);
      fmac_bc<15>(y3, R3, S[63]);
    }
    if ((t & 31) == 31) {
      S[0] = mul_bc<0>(W0, S[0]);
      S[1] = mul_bc<0>(W1, S[1]);
      S[2] = mul_bc<0>(W2, S[2]);
      S[3] = mul_bc<0>(W3, S[3]);
      S[4] = mul_bc<1>(W0, S[4]);
      S[5] = mul_bc<1>(W1, S[5]);
      S[6] = mul_bc<1>(W2, S[6]);
      S[7] = mul_bc<1>(W3, S[7]);
      S[8] = mul_bc<2>(W0, S[8]);
      S[9] = mul_bc<2>(W1, S[9]);
      S[10] = mul_bc<2>(W2, S[10]);
      S[11] = mul_bc<2>(W3, S[11]);
      S[12] = mul_bc<3>(W0, S[12]);
      S[13] = mul_bc<3>(W1, S[13]);
      S[14] = mul_bc<3>(W2, S[14]);
      S[15] = mul_bc<3>(W3, S[15]);
      S[16] = mul_bc<4>(W0, S[16]);
      S[17] = mul_bc<4>(W1, S[17]);
      S[18] = mul_bc<4>(W2, S[18]);
      S[19] = mul_bc<4>(W3, S[19]);
      S[20] = mul_bc<5>(W0, S[20]);
      S[21] = mul_bc<5>(W1, S[21]);
      S[22] = mul_bc<5>(W2, S[22]);
      S[23] = mul_bc<5>(W3, S[23]);
      S[24] = mul_bc<6>(W0, S[24]);
      S[25] = mul_bc<6>(W1, S[25]);
      S[26] = mul_bc<6>(W2, S[26]);
      S[27] = mul_bc<6>(W3, S[27]);
      S[28] = mul_bc<7>(W0, S[28]);
      S[29] = mul_bc<7>(W1, S[29]);
      S[30] = mul_bc<7>(W2, S[30]);
      S[31] = mul_bc<7>(W3, S[31]);
      S[32] = mul_bc<8>(W0, S[32]);
      S[33] = mul_bc<8>(W1, S[33]);
      S[34] = mul_bc<8>(W2, S[34]);
      S[35] = mul_bc<8>(W3, S[35]);
      S[36] = mul_bc<9>(W0, S[36]);
      S[37] = mul_bc<9>(W1, S[37]);
      S[38] = mul_bc<9>(W2, S[38]);
      S[39] = mul_bc<9>(W3, S[39]);
      S[40] = mul_bc<10>(W0, S[40]);
      S[41] = mul_bc<10>(W1, S[41]);
      S[42] = mul_bc<10>(W2, S[42]);
      S[43] = mul_bc<10>(W3, S[43]);
      S[44] = mul_bc<11>(W0, S[44]);
      S[45] = mul_bc<11>(W1, S[45]);
      S[46] = mul_bc<11>(W2, S[46]);
      S[47] = mul_bc<11>(W3, S[47]);
      S[48] = mul_bc<12>(W0, S[48]);
      S[49] = mul_bc<12>(W1, S[49]);
      S[50] = mul_bc<12>(W2, S[50]);
      S[51] = mul_bc<12>(W3, S[51]);
      S[52] = mul_bc<13>(W0, S[52]);
      S[53] = mul_bc<13>(W1, S[53]);
      S[54] = mul_bc<13>(W2, S[54]);
      S[55] = mul_bc<13>(W3, S[55]);
      S[56] = mul_bc<14>(W0, S[56]);
      S[57] = mul_bc<14>(W1, S[57]);
      S[58] = mul_bc<14>(W2, S[58]);
      S[59] = mul_bc<14>(W3, S[59]);
      S[60] = mul_bc<15>(W0, S[60]);
      S[61] = mul_bc<15>(W1, S[61]);
      S[62] = mul_bc<15>(W2, S[62]);
      S[63] = mul_bc<15>(W3, S[63]);
      C0 = 1.f; C1 = 1.f; C2 = 1.f; C3 = 1.f;
    }
    if (MODE == 2) Yg[(size_t)t * 512 + lane] = (y0 + y1) + (y2 + y3);
    c0 = c1; c1 = c2;
  }
  if (Sout) {
#pragma unroll
    for (int k = 0; k < 64; k += 4) *(f32x4*)(Sout + (size_t)lane * 64 + k) = f32x4{S[k], S[k + 1], S[k + 2], S[k + 3]};
  }
}

constexpr int RC = 128;
constexpr int NCH = NP / RC;
DI void seqs_item(const Params& p, int layer, int hd, char* smem) {
  float* sS = (float*)smem;
  const int tid = tidx(), lane = tid & 63, w = tid >> 6, l31 = lane & 31, h = lane >> 5, wr = w >> 1, wc = w & 1;
  const float* PQ = (const float*)(p.ws + WS_Y) + (size_t)hd * NCH * 8192;
  float* SS = (float*)(p.ws + WS_H) + (size_t)hd * NCH * 4096;
  const unsigned* pqflag = (const unsigned*)(p.ws + WS_CTR) + 1024 + (layer * 8 + hd) * 64;
  __syncthreads();
  for (int i = tid; i < 64 * 65; i += 256) sS[i] = 0.f;
  for (int i = tid; i < 4096; i += 256) SS[i] = 0.f;
  if (tid == 0) {
    for (int j = 0; j < 5; ++j)
      while (__hip_atomic_load((unsigned*)pqflag + j, __ATOMIC_RELAXED, __HIP_MEMORY_SCOPE_AGENT) == 0u) __builtin_amdgcn_s_sleep(4);
    __builtin_amdgcn_fence(__ATOMIC_ACQUIRE, "agent");
    asm volatile("s_waitcnt vmcnt(0)" ::: "memory");
  }
  __syncthreads();
  float bP[32], bQ[16], nP[32], nQ[16];
#pragma unroll
  for (int ks = 0; ks < 32; ++ks) bP[ks] = PQ[(2 * ks + h) * 64 + 32 * wc + l31];
#pragma unroll
  for (int r = 0; r < 16; ++r) bQ[r] = PQ[4096 + (32 * wr + crow(r, h)) * 64 + 32 * wc + l31];
  for (int c = 0; c < NCH; ++c) {
    if ((c & 7) == 0 && c > 0) {
      if (tid == 0) {
        const int j0 = c >> 1, j1 = (c + 8 < NCH) ? j0 + 5 : j0 + 4;
        for (int j = j0; j < j1; ++j)
          while (__hip_atomic_load((unsigned*)pqflag + j, __ATOMIC_RELAXED, __HIP_MEMORY_SCOPE_AGENT) == 0u) __builtin_amdgcn_s_sleep(4);
        __builtin_amdgcn_fence(__ATOMIC_ACQUIRE, "agent");
        asm volatile("s_waitcnt vmcnt(0)" ::: "memory");
      }
      __syncthreads();
    }
    if (c + 1 < NCH) {
      const float* Pn = PQ + (size_t)(c + 1) * 8192;
#pragma unroll
      for (int ks = 0; ks < 32; ++ks) nP[ks] = Pn[(2 * ks + h) * 64 + 32 * wc + l31];
#pragma unroll
      for (int r = 0; r < 16; ++r) nQ[r] = Pn[4096 + (32 * wr + crow(r, h)) * 64 + 32 * wc + l31];
    }
    f32x16 acc;
#pragma unroll
    for (int r = 0; r < 16; ++r) acc[r] = bQ[r];
    float a[32];
#pragma unroll
    for (int ks = 0; ks < 32; ++ks) a[ks] = sS[(32 * wr + l31) * 65 + 2 * ks + h];
#pragma unroll
    for (int ks = 0; ks < 32; ++ks) acc = __builtin_amdgcn_mfma_f32_32x32x2f32(a[ks], bP[ks], acc, 0, 0, 0);
    __syncthreads();
    float* dst = (c + 1 < NCH) ? SS + (size_t)(c + 1) * 4096 : p.out + OFF_WKV_P + ((size_t)layer * 8 + hd) * 4096;
#pragma unroll
    for (int r = 0; r < 16; ++r) {
      const int row = 32 * wr + crow(r, h), col = 32 * wc + l31;
      sS[row * 65 + col] = acc[r];
      dst[row * 64 + col] = acc[r];
    }
    __syncthreads();
#pragma unroll
    for (int ks = 0; ks < 32; ++ks) bP[ks] = nP[ks];
#pragma unroll
    for (int r = 0; r < 16; ++r) bQ[r] = nQ[r];
  }
}

DI void phase_mix(const Params& p, int layer, char* smem, int* s_item) {
  constexpr int NQ_PQ = NCH * 2 / 4, NQ_SY = 4, NQ_SATT = 16, NQ_PATT = 128;
  int* qctr = (int*)(p.ws + WS_CTR) + 64 + layer * 8;
  int* actr = (int*)(p.ws + WS_CTR) + 192 + layer * 8;
  if (blockIdx.x < 8) { seqs_item(p, layer, blockIdx.x, smem); return; }
  const int home = blockIdx.x & 7;
  const int first = (blockIdx.x >> 3) & 1;
  for (int pass = 0; pass < 2; ++pass) {
    const int kind = pass ^ first;
    for (int qi = 0; qi < 8; ++qi) {
      const int hd = (home + qi) & 7;
      for (;;) {
        __syncthreads();
        if (tidx() == 0) *s_item = atomicAdd((kind == 0 ? qctr : actr) + hd, 1);
        __syncthreads();
        const int it = *s_item;
        const int wave = __builtin_amdgcn_readfirstlane(tidx() >> 6), lane = tidx() & 63;
        if (kind == 0) {
          if (it >= NQ_PQ + NQ_SY) break;
          if (it < NQ_PQ) {
            const int q = it * 4 + wave, mode = q & 1, ch = q >> 1;
            float* dstm = (float*)(p.ws + WS_Y) + ((size_t)(hd * NCH + ch) * 2 + mode) * 4096;
            if (mode == 0) rpl_item<0>(p, hd, ch * RC, RC, nullptr, dstm, nullptr, lane);
            else rpl_item<1>(p, hd, ch * RC, RC, nullptr, dstm, nullptr, lane);
            asm volatile("s_waitcnt vmcnt(0)" ::: "memory");
            __syncthreads();
            if (tidx() == 0) {
              __builtin_amdgcn_fence(__ATOMIC_RELEASE, "agent");
              asm volatile("s_waitcnt vmcnt(0)" ::: "memory");
              __hip_atomic_store((unsigned*)(p.ws + WS_CTR) + 1024 + (layer * 8 + hd) * 64 + it, 1u, __ATOMIC_RELAXED, __HIP_MEMORY_SCOPE_AGENT);
            }
            continue;
          }
          const int b = (it - NQ_PQ) * 4 + wave;
          rpl_item<2>(p, hd, NP + b * 64, 64, p.state_wkv + (((size_t)layer * 16 + b) * 8 + hd) * 4096,
                      p.out + OFF_WKV_S + (((size_t)layer * 16 + b) * 8 + hd) * 4096, (float*)(p.ws + WS_Y) + (size_t)(NP + b * 64) * 512 + hd * 64, lane);
        } else {
          if (it >= NQ_SATT + NQ_PATT) break;
          if (it < NQ_SATT) { attn_sample_item(p, layer, it, hd, smem); continue; }
          attn_prompt_item(p, layer, 127 - (it - NQ_SATT), hd, smem);
        }
      }
    }
  }
}
DI void phase_ypass(const Params& p, int layer) {
  const int wave = __builtin_amdgcn_readfirstlane(tidx() >> 6), lane = tidx() & 63;
  const int hd = blockIdx.x & 7, nb = (gridDim.x + 7 - hd) >> 3;
  for (int j = blockIdx.x >> 3; j < NCH / 4; j += nb) {
    const int ch = j * 4 + wave;
    rpl_item<2>(p, hd, ch * RC, RC, (const float*)(p.ws + WS_H) + (size_t)(hd * NCH + ch) * 4096, nullptr,
                (float*)(p.ws + WS_Y) + (size_t)(ch * RC) * 512 + hd * 64, lane);
  }
}

DI void phase_ob(const Params& p, int layer) {
  const int wave = tidx() >> 6, lane = tidx() & 63;
  const float* Y = (const float*)(p.ws + WS_Y);
  const u16* WK = (const u16*)(p.ws + WS_WKVIN);
  const u16* Z = (const u16*)(p.ws + WS_Z);
  u16* OB = (u16*)(p.ws + WS_Q);
  const int f = lane * 8, hd = lane >> 3, fl = (lane & 7) * 8;
  for (int t = blockIdx.x * 4 + wave; t < NT; t += gridDim.x * 4) {
    const float4 ya = *(const float4*)(Y + (size_t)t * 512 + f);
    const float4 yb = *(const float4*)(Y + (size_t)t * 512 + f + 4);
    float y[8] = {ya.x, ya.y, ya.z, ya.w, yb.x, yb.y, yb.z, yb.w};
    float s = 0.f;
#pragma unroll
    for (int j = 0; j < 8; ++j) s += y[j];
    s += __shfl_xor(s, 1); s += __shfl_xor(s, 2); s += __shfl_xor(s, 4);
    const float mu = s * (1.f / 64.f);
    float vs = 0.f;
#pragma unroll
    for (int j = 0; j < 8; ++j) { y[j] -= mu; vs += y[j] * y[j]; }
    vs += __shfl_xor(vs, 1); vs += __shfl_xor(vs, 2); vs += __shfl_xor(vs, 4);
    const float rs = rsqrtf(vs * (1.f / 64.f) + GN_EPS);
    const u16* wk = WK + ((size_t)hd * NT + t) * 384 + fl;
    const uint4 r8 = *(const uint4*)(wk + 0 * 64);
    const uint4 k8 = *(const uint4*)(wk + 2 * 64);
    const uint4 v8 = *(const uint4*)(wk + 3 * 64);
    const float rr[8] = {lo2f(r8.x), hi2f(r8.x), lo2f(r8.y), hi2f(r8.y), lo2f(r8.z), hi2f(r8.z), lo2f(r8.w), hi2f(r8.w)};
    const float kk[8] = {lo2f(k8.x), hi2f(k8.x), lo2f(k8.y), hi2f(k8.y), lo2f(k8.z), hi2f(k8.z), lo2f(k8.w), hi2f(k8.w)};
    const float vv[8] = {lo2f(v8.x), hi2f(v8.x), lo2f(v8.y), hi2f(v8.y), lo2f(v8.z), hi2f(v8.z), lo2f(v8.w), hi2f(v8.w)};
    const float4 rka = *(const float4*)(p.r_k + layer * 512 + f);
    const float4 rkb = *(const float4*)(p.r_k + layer * 512 + f + 4);
    const float rk[8] = {rka.x, rka.y, rka.z, rka.w, rkb.x, rkb.y, rkb.z, rkb.w};
    float bs = 0.f;
#pragma unroll
    for (int j = 0; j < 8; ++j) bs += rr[j] * kk[j] * rk[j];
    bs += __shfl_xor(bs, 1); bs += __shfl_xor(bs, 2); bs += __shfl_xor(bs, 4);
    const float4 lwa = *(const float4*)(p.lnx_w + layer * 512 + f);
    const float4 lwb = *(const float4*)(p.lnx_w + layer * 512 + f + 4);
    const float4 lba = *(const float4*)(p.lnx_b + layer * 512 + f);
    const float4 lbb = *(const float4*)(p.lnx_b + layer * 512 + f + 4);
    const float lw[8] = {lwa.x, lwa.y, lwa.z, lwa.w, lwb.x, lwb.y, lwb.z, lwb.w};
    const float lb[8] = {lba.x, lba.y, lba.z, lba.w, lbb.x, lbb.y, lbb.z, lbb.w};
    const uint4 g8 = *(const uint4*)(Z + (size_t)t * NZ + ZC_GB + f);
    const float gg[8] = {lo2f(g8.x), hi2f(g8.x), lo2f(g8.y), hi2f(g8.y), lo2f(g8.z), hi2f(g8.z), lo2f(g8.w), hi2f(g8.w)};
    float ov[8];
#pragma unroll
    for (int j = 0; j < 8; ++j) ov[j] = (y[j] * rs * lw[j] + lb[j] + bs * vv[j]) * siluf_(gg[j]);
    *(uint4*)(OB + (size_t)t * 512 + f) = make_uint4(pk2(ov[0], ov[1]), pk2(ov[2], ov[3]), pk2(ov[4], ov[5]), pk2(ov[6], ov[7]));
  }
}

DI void phase_merge(const Params& p, int layer, char* smem) {
  const u16* OA = (const u16*)(p.ws + WS_OA);
  const u16* OB = (const u16*)(p.ws + WS_Q);
  const u16* WA = (const u16*)(p.ws + (size_t)layer * WL_STRIDE + W_OA);
  const u16* WB = (const u16*)(p.ws + (size_t)layer * WL_STRIDE + W_OB);
  const u16* Z = (const u16*)(p.ws + WS_Z);
  u16* M = (u16*)(p.ws + WS_H);
  const int xcd = blockIdx.x & 7, jb = blockIdx.x >> 3, nb = (gridDim.x + 7 - xcd) >> 3;
  for (int m = jb; m < 16 * 8; m += nb) {
    const int tt = xcd + 8 * (m >> 3), ft = m & 7;
    f32x16 acc[2][2];
    zero_acc(acc);
    gemm_mainloop(OA + (size_t)tt * 128 * 512, 512, WA + (size_t)ft * 128 * 512, 512, 512, smem, acc);
    acc_to_lds(acc, smem);
    EPI_ROWS({
      const u32x2 g = *(const u32x2*)(Z + (size_t)(tt * 128 + row) * NZ + ZC_MA + ft * 128 + col);
      *(u32x2*)(M + (size_t)(tt * 128 + row) * 1024 + ft * 128 + col) =
          u32x2{pk2(v.x * sigmoidf_(lo2f(g.x)), v.y * sigmoidf_(hi2f(g.x))), pk2(v.z * sigmoidf_(lo2f(g.y)), v.w * sigmoidf_(hi2f(g.y)))};
    })
    zero_acc(acc);
    gemm_mainloop(OB + (size_t)tt * 128 * 512, 512, WB + (size_t)ft * 128 * 512, 512, 512, smem, acc);
    acc_to_lds(acc, smem);
    EPI_ROWS({
      const u32x2 g = *(const u32x2*)(Z + (size_t)(tt * 128 + row) * NZ + ZC_MB + ft * 128 + col);
      u32x2* mp = (u32x2*)(M + (size_t)(tt * 128 + row) * 1024 + ft * 128 + col);
      const u32x2 pm = *mp;
      *mp = u32x2{pk2(lo2f(pm.x) + v.x * sigmoidf_(lo2f(g.x)), hi2f(pm.x) + v.y * sigmoidf_(hi2f(g.x))),
                  pk2(lo2f(pm.y) + v.z * sigmoidf_(lo2f(g.y)), hi2f(pm.y) + v.w * sigmoidf_(hi2f(g.y)))};
    })
  }
  for (int m = jb; m < 2 * 16; m += nb) {
    const int r0 = (128 + xcd) * 128 + (m >> 4) * 64, c0 = (m & 15) * 64;
    f32x16 acc;
#pragma unroll
    for (int r = 0; r < 16; ++r) acc[r] = 0.f;
    gemm64_mainloop(OA + (size_t)r0 * 512, 512, WA + (size_t)c0 * 512, 512, 512, smem, acc);
    acc64_to_lds(acc, smem);
    EPI64_ROWS({
      const u32x2 g = *(const u32x2*)(Z + (size_t)(r0 + row) * NZ + ZC_MA + c0 + col);
      *(u32x2*)(M + (size_t)(r0 + row) * 1024 + c0 + col) =
          u32x2{pk2(v.x * sigmoidf_(lo2f(g.x)), v.y * sigmoidf_(hi2f(g.x))), pk2(v.z * sigmoidf_(lo2f(g.y)), v.w * sigmoidf_(hi2f(g.y)))};
    })
#pragma unroll
    for (int r = 0; r < 16; ++r) acc[r] = 0.f;
    gemm64_mainloop(OB + (size_t)r0 * 512, 512, WB + (size_t)c0 * 512, 512, 512, smem, acc);
    acc64_to_lds(acc, smem);
    EPI64_ROWS({
      const u32x2 g = *(const u32x2*)(Z + (size_t)(r0 + row) * NZ + ZC_MB + c0 + col);
      u32x2* mp = (u32x2*)(M + (size_t)(r0 + row) * 1024 + c0 + col);
      const u32x2 pm = *mp;
      *mp = u32x2{pk2(lo2f(pm.x) + v.x * sigmoidf_(lo2f(g.x)), hi2f(pm.x) + v.y * sigmoidf_(hi2f(g.x))),
                  pk2(lo2f(pm.y) + v.z * sigmoidf_(lo2f(g.y)), hi2f(pm.y) + v.w * sigmoidf_(hi2f(g.y)))};
    })
  }
}

DI void phase_out(const Params& p, int layer, char* smem) {
  const u16* M = (const u16*)(p.ws + WS_H);
  const u16* W = (const u16*)(p.ws + (size_t)layer * WL_STRIDE + W_O);
  const int xcd = blockIdx.x & 7, jb = blockIdx.x >> 3, nb = (gridDim.x + 7 - xcd) >> 3;
  for (int m = jb; m < 16 * 8; m += nb) {
    const int tt = xcd + 8 * (m >> 3), ft = m & 7;
    f32x16 acc[2][2];
    zero_acc(acc);
    gemm_mainloop(M + (size_t)tt * 128 * 1024, 1024, W + (size_t)ft * 128 * 1024, 1024, 1024, smem, acc);
    acc_to_lds(acc, smem);
    EPI_ROWS({
      const int t = tt * 128 + row, n = ft * 128 + col;
      const f32x4 xo = *(const f32x4*)(xrow(p, layer, t) + n);
      *(f32x4*)(p.out + (size_t)t * 1024 + n) = xo + v;
    })
  }
  for (int m = jb; m < 2 * 16; m += nb) {
    const int r0 = (128 + xcd) * 128 + (m >> 4) * 64, c0 = (m & 15) * 64;
    f32x16 acc;
#pragma unroll
    for (int r = 0; r < 16; ++r) acc[r] = 0.f;
    gemm64_mainloop(M + (size_t)r0 * 1024, 1024, W + (size_t)c0 * 1024, 1024, 1024, smem, acc);
    acc64_to_lds(acc, smem);
    EPI64_ROWS({
      const int t = r0 + row, n = c0 + col;
      const f32x4 xo = *(const f32x4*)(xrow(p, layer, t) + n);
      *(f32x4*)(p.out + (size_t)t * 1024 + n) = xo + v;
    })
  }
}

#define XB_TMO      128
#define XB_XCNT(j)  (256  + 64 * (j))
#define XB_XSUB(j)  (1280 + 64 * (j))
#define XB_XGEN(j)  (2304 + 64 * (j))
#define XB_TOP      3328
#define XB_TOPGEN   3392
#define XCD_BAR_WORDS 3456
#define XB_SPIN_CAP (1u << 22)
#define LAS __attribute__((address_space(3)))
DI unsigned xb_ld(unsigned* p) { return __hip_atomic_load(p, __ATOMIC_RELAXED, __HIP_MEMORY_SCOPE_AGENT); }
DI unsigned xb_add(unsigned* p, unsigned v) { return __hip_atomic_fetch_add(p, v, __ATOMIC_RELAXED, __HIP_MEMORY_SCOPE_AGENT); }
DI unsigned xb_xcc_id() { return (unsigned)__builtin_amdgcn_s_getreg((3 << 11) | 20) & 0xFu; }
#define XB_SPIN(cond, bar) do { unsigned _sp = 0; while (cond) { __builtin_amdgcn_s_sleep(1); \
    if ((++_sp & 255u) == 0u) { if (xb_ld(&(bar)[XB_TMO])) break; if (_sp > XB_SPIN_CAP) { atomicAdd(&(bar)[XB_TMO], 1u); break; } } } } while (0)
struct XcdBarrier { unsigned* bar; unsigned x; volatile LAS unsigned* st; };
DI XcdBarrier xcd_barrier_post(unsigned* bar, volatile LAS unsigned* st) {
  XcdBarrier b; b.bar = bar; b.x = xb_xcc_id(); b.st = st;
  if (threadIdx.x == 0) (void)xb_add(&bar[XB_XCNT(b.x)], 1u);
  return b;
}
DI void xcd_barrier_complete(unsigned* bar, unsigned x, unsigned& nloc, unsigned& nx) {
  const unsigned G = gridDim.x * gridDim.y * gridDim.z;
  unsigned sum, cnt, mine, sp = 0u;
  for (;;) {
    sum = 0u; cnt = 0u; mine = 0u;
#pragma unroll
    for (unsigned j = 0; j < 16; ++j) { const unsigned c = xb_ld(&bar[XB_XCNT(j)]); sum += c; cnt += (c > 0u) ? 1u : 0u; mine = (j == x) ? c : mine; }
    if (sum == G) break;
    __builtin_amdgcn_s_sleep(1);
    if ((++sp & 255u) == 0u) { if (xb_ld(&bar[XB_TMO])) break; if (sp > XB_SPIN_CAP) { atomicAdd(&bar[XB_TMO], 1u); break; } }
  }
  nloc = mine > 0u ? mine : 1u; nx = cnt > 0u ? cnt : 1u;
}
DI void xcd_barrier(const XcdBarrier& b) {
  asm volatile("s_waitcnt vmcnt(0)" ::: "memory");
  __syncthreads();
  if (threadIdx.x == 0) {
    unsigned* bar = b.bar;
    __builtin_amdgcn_s_waitcnt(0);
    unsigned nloc = b.st[0], nx = b.st[1];
    if (nloc == 0u) { xcd_barrier_complete(bar, b.x, nloc, nx); b.st[0] = nloc; b.st[1] = nx; }
    const unsigned old = xb_add(&bar[XB_XSUB(b.x)], 1u);
    const unsigned gen = old / nloc;
    if (old + 1u == (gen + 1u) * nloc) {
      __builtin_amdgcn_fence(__ATOMIC_RELEASE, "agent");
      asm volatile("s_waitcnt vmcnt(0)" ::: "memory");
      const unsigned og = xb_add(&bar[XB_TOP], 1u);
      const unsigned tg = og / nx;
      if (og + 1u == (tg + 1u) * nx) xb_add(&bar[XB_TOPGEN], 1u);
      else XB_SPIN(xb_ld(&bar[XB_TOPGEN]) == tg, bar);
      __builtin_amdgcn_fence(__ATOMIC_ACQUIRE, "agent");
      xb_add(&bar[XB_XGEN(b.x)], 1u);
      asm volatile("s_waitcnt vmcnt(0)" ::: "memory");
    } else {
      XB_SPIN(xb_ld(&bar[XB_XGEN(b.x)]) == gen, bar);
      __builtin_amdgcn_fence(__ATOMIC_ACQUIRE, "agent");
      asm volatile("s_waitcnt vmcnt(0)" ::: "memory");
    }
  }
  __syncthreads();
}

constexpr int PH_PER_LAYER = 8;
constexpr int N_PHASES = 1 + 4 * PH_PER_LAYER;

DI void run_phase(const Params& p, int ph, char* smem, int* s_item) {
#ifndef PHMASK
#define PHMASK 0x3FF
#endif
  if (ph == 0) { if (PHMASK & 0x100) phase_convert(p, smem); return; }
  const int layer = (ph - 1) / PH_PER_LAYER, sub = (ph - 1) % PH_PER_LAYER;
  switch (sub) {
    case 0: if (PHMASK & 1) phase_rmsnorm(p, layer); break;
    case 1: if (PHMASK & 2) phase_g1(p, layer, smem); break;
    case 2: if (PHMASK & 4) phase_norms_prep(p, layer, smem, s_item); break;
    case 3: if (PHMASK & 16) phase_mix(p, layer, smem, s_item); break;
    case 4: if (PHMASK & 16) phase_ypass(p, layer); break;
    case 5: if (PHMASK & 32) phase_ob(p, layer); break;
    case 6: if (PHMASK & 64) phase_merge(p, layer, smem); break;
    default: if (PHMASK & 128) phase_out(p, layer, smem); break;
  }
}

__global__ void __launch_bounds__(256, 2) mk_kernel(Params p, int ph0, int ph1, int coop) {
  __shared__ __attribute__((aligned(16))) char smem[SMEM_BYTES];
  __shared__ int s_item[4];
  __shared__ uint4 xb_words;
  if (threadIdx.x == 0) xb_words = make_uint4(0u, 0u, 0u, 0u);
  __syncthreads();
  XcdBarrier xb = xcd_barrier_post((unsigned*)(p.ws + WS_BAR), (volatile LAS unsigned*)&xb_words);
  for (int ph = ph0; ph < ph1; ++ph) {
    run_phase(p, ph, smem, s_item);
    if (coop && ph + 1 < ph1) {
      xcd_barrier(xb);
      if (coop == 0x5a5a5a) cg::this_grid().sync();
    }
  }
}

extern "C" void kernel_launch(void* const* d_in, const int* in_sizes, int n_in, void* d_out, int out_size, void* d_ws, size_t ws_size,
                              hipStream_t stream) {
  static int grid_blocks = 0;
  if (!grid_blocks) {
    int dev = 0, cus = 0, per_cu = 0;
    hipGetDevice(&dev);
    hipDeviceGetAttribute(&cus, hipDeviceAttributeMultiprocessorCount, dev);
    hipOccupancyMaxActiveBlocksPerMultiprocessor(&per_cu, mk_kernel, 256, 0);
    if (per_cu < 1) per_cu = 1;
    if (per_cu > 2) per_cu = 2;
    grid_blocks = cus * per_cu;
  }
  Params p{};
  const float** pp = (const float**)&p;
  for (int i = 0; i < 29; ++i) pp[i] = (const float*)d_in[i];
  p.out = (float*)d_out;
  p.ws = (char*)d_ws;
  const int ONE_LAUNCH = 1;
  hipMemsetAsync((char*)d_ws + WS_CTR, 0, 16384 + XCD_BAR_WORDS * 4, stream);
  if (ONE_LAUNCH) {
    int ph0 = 0, ph1 = N_PHASES, coop = 1;
    void* args[] = {&p, &ph0, &ph1, &coop};
    hipError_t e = hipLaunchCooperativeKernel((void*)mk_kernel, dim3(grid_blocks), dim3(256), args, 0, stream);
    if (e != hipSuccess) fprintf(stderr, "cooperative launch failed: %s (grid %d)\n", hipGetErrorString(e), grid_blocks);
  } else {
    for (int ph = 0; ph < N_PHASES; ++ph) mk_kernel<<<dim3(grid_blocks), dim3(256), 0, stream>>>(p, ph, ph + 1, 0);
  }
}
```

```cpp
#include <hip/hip_runtime.h>
#include <hip/hip_cooperative_groups.h>
#include <cstdio>
namespace cg = cooperative_groups;

#define DI __device__ __forceinline__
typedef unsigned short u16;
typedef __attribute__((ext_vector_type(8))) short bf16x8;
typedef __attribute__((ext_vector_type(4))) short s16x4;
typedef __attribute__((ext_vector_type(2))) __bf16 bf2_t;
typedef __attribute__((ext_vector_type(2))) float f2_t;
typedef __attribute__((ext_vector_type(16))) float f32x16;
typedef __attribute__((ext_vector_type(4))) unsigned u32x4;
typedef __attribute__((ext_vector_type(2))) unsigned u32x2;
typedef __attribute__((ext_vector_type(4))) float f32x4;
#define MFMA32(a, b, c) __builtin_amdgcn_mfma_f32_32x32x16_bf16((a), (b), (c), 0, 0, 0)

constexpr int NP = 16384;
constexpr int NSM = 1024;
constexpr int NT = NP + NSM;
constexpr int NZ = 5248;
constexpr int ZC_KV = 256, ZC_KPE = 384, ZC_GA = 512, ZC_ZS = 1024, ZC_GB = 2688, ZC_MA = 3200, ZC_MB = 4224;
constexpr float EPS = 1e-6f;
constexpr float GN_EPS = 64e-5f;
constexpr int SHW = 1664;

constexpr size_t OFF_CKV_P = 17825792;
constexpr size_t OFF_KPE_P = 26214400;
constexpr size_t OFF_WKV_P = 28311552;
constexpr size_t OFF_SH_P = 28442624;
constexpr size_t OFF_CKV_S = 28449280;
constexpr size_t OFF_KPE_S = 28973568;
constexpr size_t OFF_WKV_S = 29104640;
constexpr size_t OFF_SH_S = 31201792;

constexpr size_t WL_STRIDE = 15728640;
constexpr size_t W_IN = 0, W_UQ = 10747904, W_UKV = 11141120, W_W2 = 11403264, W_A2 = 11468800, W_OA = 11534336, W_OB = 12582912, W_O = 13631488;
constexpr size_t WS_H = 62914560;
constexpr size_t WS_Z = WS_H + 35651584;
constexpr size_t WS_Q = WS_Z + 182714368;
constexpr size_t WS_CKVB = WS_Q + 26738688;
constexpr size_t WS_KPEB = WS_CKVB + 4456448;
constexpr size_t WS_KN = WS_KPEB + 1114112;
constexpr size_t WS_VT = WS_KN + 16777216;
constexpr size_t WS_WKVIN = WS_VT + 16777216;
constexpr size_t WS_OA = WS_WKVIN + 106954752;
constexpr size_t WS_Y = WS_OA + 17825792;
constexpr size_t WS_CTR = WS_Y + 35651584;
constexpr size_t WS_BAR = WS_CTR + 16384;
constexpr size_t WS_SH0 = WS_BAR + 16384;
constexpr size_t WS_CKB = WS_SH0 + 65536;
constexpr size_t WS_KPB = WS_CKB + 16777216;
constexpr size_t WS_TOTAL = WS_KPB + 4194304;
static_assert(WS_TOTAL < 536870912, "ws");

constexpr int SMEM_BYTES = 39424 + 128 * 136 * 2;

struct Params {
  const float *x_prompt, *x_sample, *cache_ckv, *cache_kpe, *state_wkv, *state_shift;
  const float *norm_w, *w_in, *q_norm_w, *kv_norm_w, *w_uq, *w_ukv, *qn_nope, *qn_rope, *kn_nope, *kn_rope;
  const float *mu_shift, *w0, *w2, *a0, *a2, *k_k, *k_a, *r_k, *lnx_w, *lnx_b, *w_out_a, *w_out_b, *w_o;
  float* out;
  char* ws;
};

__device__ const float ROPE_INV[16] = {1.0f, 0.5623413324356079f, 0.3162277638912201f, 0.17782793939113617f, 0.10000000149011612f, 0.05623413249850273f, 0.03162277489900589f, 0.017782794311642647f, 0.009999999776482582f, 0.005623413249850273f, 0.003162277629598975f, 0.0017782794311642647f, 0.0010000000474974513f, 0.000562341301701963f, 0.0003162277571391314f, 0.00017782794020604342f};

DI int tidx() { int t = threadIdx.x; asm volatile("" : "+v"(t)); return t; }
DI float bf2f(u16 h) { return __uint_as_float(((unsigned)h) << 16); }
DI unsigned pk2(float a, float b) { f2_t v = {a, b}; bf2_t r = __builtin_convertvector(v, bf2_t); return __builtin_bit_cast(unsigned, r); }
DI u16 f2bf(float a) { return (u16)(pk2(a, 0.f) & 0xffffu); }
DI float lo2f(unsigned u) { return __uint_as_float(u << 16); }
DI float hi2f(unsigned u) { return __uint_as_float(u & 0xffff0000u); }
DI float wave_sum(float v) {
  v += __builtin_bit_cast(float, __builtin_amdgcn_update_dpp(0, __builtin_bit_cast(int, v), 0x128, 0xF, 0xF, false));
  v += __builtin_bit_cast(float, __builtin_amdgcn_update_dpp(0, __builtin_bit_cast(int, v), 0x124, 0xF, 0xF, false));
  v += __builtin_bit_cast(float, __builtin_amdgcn_update_dpp(0, __builtin_bit_cast(int, v), 0x122, 0xF, 0xF, false));
  v += __builtin_bit_cast(float, __builtin_amdgcn_update_dpp(0, __builtin_bit_cast(int, v), 0x121, 0xF, 0xF, false));
  const int iv = __builtin_bit_cast(int, v);
  const float s0 = __builtin_bit_cast(float, __builtin_amdgcn_readlane(iv, 0)), s1 = __builtin_bit_cast(float, __builtin_amdgcn_readlane(iv, 16));
  const float s2 = __builtin_bit_cast(float, __builtin_amdgcn_readlane(iv, 32)), s3 = __builtin_bit_cast(float, __builtin_amdgcn_readlane(iv, 48));
  return (s0 + s1) + (s2 + s3);
}
DI float xor32(float v) { return __shfl_xor(v, 32); }
DI int crow(int reg, int h) { return (reg & 3) + 8 * (reg >> 2) + 4 * h; }
DI float sigmoidf_(float x) { return __builtin_amdgcn_rcpf(1.f + __expf(-x)); }
DI float siluf_(float x) { return x * __builtin_amdgcn_rcpf(1.f + __expf(-x)); }
DI void rope_sincos(int pos, int i, float& s, float& c) {
  float ang = (float)pos * ROPE_INV[i];
  double rev = (double)ang * 0.15915494309189533577;
  double fr = rev - rint(rev);
  float f = (float)fr;
  s = __builtin_amdgcn_sinf(f);
  c = __builtin_amdgcn_cosf(f);
}
DI const float* xrow(const Params& p, int layer, int t) {
  if (layer == 0) return (t < NP) ? p.x_prompt + (size_t)t * 1024 : p.x_sample + (size_t)(t - NP) * 1024;
  return p.out + (size_t)t * 1024;
}
DI int tok_pos(int t) { return (t < NP) ? t : 4096 + ((t - NP) & 63); }

DI void conv_tile(const float* __restrict__ src, int N, u16* __restrict__ dst, int K, int k0, int n0, int kind, float* sm) {
  const int tid = tidx();
  const int n4 = (tid & 15) * 4, kb = tid >> 4;
  const int np_ = n0 + n4;
  int sc = np_;
  if (kind == 1) sc = (np_ < 416) ? np_ : ((np_ < 512) ? -1 : np_ - 96);
#pragma unroll
  for (int i = 0; i < 4; ++i) {
    const int kl = kb + 16 * i;
    f32x4 v = {0.f, 0.f, 0.f, 0.f};
    if (sc >= 0) v = *(const f32x4*)(src + (size_t)(k0 + kl) * N + sc);
    sm[kl * 65 + n4] = v.x; sm[kl * 65 + n4 + 1] = v.y; sm[kl * 65 + n4 + 2] = v.z; sm[kl * 65 + n4 + 3] = v.w;
  }
  __syncthreads();
  const int nr = tid >> 2, kc = (tid & 3) * 16;
  unsigned o[8];
#pragma unroll
  for (int j = 0; j < 8; ++j) o[j] = pk2(sm[(kc + 2 * j) * 65 + nr], sm[(kc + 2 * j + 1) * 65 + nr]);
  uint4* d = (uint4*)(dst + (size_t)(n0 + nr) * K + k0 + kc);
  d[0] = make_uint4(o[0], o[1], o[2], o[3]);
  d[1] = make_uint4(o[4], o[5], o[6], o[7]);
  __syncthreads();
}

DI void phase_convert(const Params& p, char* smem) {
  float* sm = (float*)smem;
  for (int it = blockIdx.x; it < 4 * 1920; it += gridDim.x) {
    const int layer = it / 1920;
    int r = it % 1920;
    const float* src; u16* dst; int K, N, kind = 0, nt;
    char* wl = p.ws + (size_t)layer * WL_STRIDE;
    if (r < 1312) { src = p.w_in + (size_t)layer * 1024 * 5152; dst = (u16*)(wl + W_IN); K = 1024; N = 5152; kind = 1; nt = 82; }
    else if (r < 1360) { r -= 1312; src = p.w_uq + (size_t)layer * 256 * 768; dst = (u16*)(wl + W_UQ); K = 256; N = 768; nt = 12; }
    else if (r < 1392) { r -= 1360; src = p.w_ukv + (size_t)layer * 128 * 1024; dst = (u16*)(wl + W_UKV); K = 128; N = 1024; nt = 16; }
    else if (r < 1400) { r -= 1392; src = p.w2 + (size_t)layer * 64 * 512; dst = (u16*)(wl + W_W2); K = 64; N = 512; nt = 8; }
    else if (r < 1408) { r -= 1400; src = p.a2 + (size_t)layer * 64 * 512; dst = (u16*)(wl + W_A2); K = 64; N = 512; nt = 8; }
    else if (r < 1536) { r -= 1408; src = p.w_out_a + (size_t)layer * 512 * 1024; dst = (u16*)(wl + W_OA); K = 512; N = 1024; nt = 16; }
    else if (r < 1664) { r -= 1536; src = p.w_out_b + (size_t)layer * 512 * 1024; dst = (u16*)(wl + W_OB); K = 512; N = 1024; nt = 16; }
    else { r -= 1664; src = p.w_o + (size_t)layer * 1024 * 1024; dst = (u16*)(wl + W_O); K = 1024; N = 1024; nt = 16; }
    const int kt = r / nt, ntile = r % nt;
    conv_tile(src, N, dst, K, kt * 64, ntile * 64, kind, sm);
  }
}

DI void phase_rmsnorm(const Params& p, int layer) {
  const int wave = tidx() >> 6, lane = tidx() & 63;
  u16* H = (u16*)(p.ws + WS_H);
  const float* g = p.norm_w + layer * 1024;
  {
    u16* sh0 = (u16*)(p.ws + WS_SH0);
    for (int i = blockIdx.x * 256 + tidx(); i < 17 * SHW / 4; i += gridDim.x * 256) {
      const int e = i * 4, r = e / SHW, c = e - r * SHW;
      f32x4 v = {0.f, 0.f, 0.f, 0.f};
      if (r > 0) v = *(const f32x4*)(p.state_shift + ((size_t)layer * 16 + (r - 1)) * SHW + c);
      *(u32x2*)(sh0 + e) = u32x2{pk2(v.x, v.y), pk2(v.z, v.w)};
    }
  }
  {
    const float* c1 = p.cache_ckv + (size_t)layer * 16 * 4096 * 128;
    const float* c2 = p.cache_kpe + (size_t)layer * 16 * 4096 * 32;
    u16* d1 = (u16*)(p.ws + WS_CKB);
    u16* d2 = (u16*)(p.ws + WS_KPB);
    constexpr int N1 = 16 * 4096 * 128 / 8, N2 = 16 * 4096 * 32 / 8;
    for (int i = blockIdx.x * 256 + tidx(); i < N1 + N2; i += gridDim.x * 256) {
      const float* sp = (i < N1) ? c1 + (size_t)i * 8 : c2 + (size_t)(i - N1) * 8;
      u16* dp = (i < N1) ? d1 + (size_t)i * 8 : d2 + (size_t)(i - N1) * 8;
      const f32x4 a = *(const f32x4*)sp, b = *(const f32x4*)(sp + 4);
      *(u32x4*)dp = u32x4{pk2(a.x, a.y), pk2(a.z, a.w), pk2(b.x, b.y), pk2(b.z, b.w)};
    }
  }
  for (int t = blockIdx.x * 4 + wave; t < NT; t += gridDim.x * 4) {
    const float* xr = xrow(p, layer, t);
    float4 v[4];
    float ss = 0.f;
#pragma unroll
    for (int i = 0; i < 4; ++i) {
      v[i] = *(const float4*)(xr + i * 256 + lane * 4);
      ss += v[i].x * v[i].x + v[i].y * v[i].y + v[i].z * v[i].z + v[i].w * v[i].w;
    }
    ss = wave_sum(ss);
    const float rinv = rsqrtf(ss * (1.f / 1024.f) + EPS);
#pragma unroll
    for (int i = 0; i < 4; ++i) {
      const float4 g4 = *(const float4*)(g + i * 256 + lane * 4);
      uint2 o;
      o.x = pk2(v[i].x * rinv * g4.x, v[i].y * rinv * g4.y);
      o.y = pk2(v[i].z * rinv * g4.z, v[i].w * rinv * g4.w);
      *(uint2*)(H + (size_t)t * 1024 + i * 256 + lane * 4) = o;
    }
  }
}

DI void gemm_mainloop(const u16* __restrict__ R, int ldr, const u16* __restrict__ C, int ldc, int K, char* smem, f32x16 (&acc)[2][2]) {
  const int tid = tidx(), lane = tid & 63, w = tid >> 6, wr = w >> 1, wc = w & 1;
  const int l31 = lane & 31, h = lane >> 5;
  const int lrow = tid >> 3, lkc = (tid & 7) * 8;
  u32x4 rr[4], rc[4];
  const int nk = K >> 6;
#pragma unroll
  for (int i = 0; i < 4; ++i) {
    rr[i] = *(const u32x4*)(R + (size_t)(lrow + 32 * i) * ldr + lkc);
    rc[i] = *(const u32x4*)(C + (size_t)(lrow + 32 * i) * ldc + lkc);
  }
  __syncthreads();
  {
    u16* sR = (u16*)smem;
    u16* sC = sR + 128 * 72;
#pragma unroll
    for (int i = 0; i < 4; ++i) {
      *(u32x4*)(sR + (lrow + 32 * i) * 72 + lkc) = rr[i];
      *(u32x4*)(sC + (lrow + 32 * i) * 72 + lkc) = rc[i];
    }
  }
  if (nk > 1) {
#pragma unroll
    for (int i = 0; i < 4; ++i) {
      rr[i] = *(const u32x4*)(R + (size_t)(lrow + 32 * i) * ldr + 64 + lkc);
      rc[i] = *(const u32x4*)(C + (size_t)(lrow + 32 * i) * ldc + 64 + lkc);
    }
  }
  __syncthreads();
  for (int kt = 0; kt < nk; ++kt) {
    const u16* sR = (const u16*)smem + (kt & 1) * (2 * 128 * 72);
    const u16* sC = sR + 128 * 72;
    if (kt + 1 < nk) {
      u16* nR = (u16*)smem + ((kt + 1) & 1) * (2 * 128 * 72);
      u16* nC = nR + 128 * 72;
#pragma unroll
      for (int i = 0; i < 4; ++i) {
        *(u32x4*)(nR + (lrow + 32 * i) * 72 + lkc) = rr[i];
        *(u32x4*)(nC + (lrow + 32 * i) * 72 + lkc) = rc[i];
      }
    }
    if (kt + 2 < nk) {
      const int k0 = (kt + 2) * 64;
#pragma unroll
      for (int i = 0; i < 4; ++i) {
        rr[i] = *(const u32x4*)(R + (size_t)(lrow + 32 * i) * ldr + k0 + lkc);
        rc[i] = *(const u32x4*)(C + (size_t)(lrow + 32 * i) * ldc + k0 + lkc);
      }
    }
#pragma unroll
    for (int ks = 0; ks < 4; ++ks) {
      bf16x8 a[2], b[2];
#pragma unroll
      for (int mi = 0; mi < 2; ++mi) a[mi] = *(const bf16x8*)(sR + (wr * 64 + mi * 32 + l31) * 72 + ks * 16 + h * 8);
#pragma unroll
      for (int ni = 0; ni < 2; ++ni) b[ni] = *(const bf16x8*)(sC + (wc * 64 + ni * 32 + l31) * 72 + ks * 16 + h * 8);
#pragma unroll
      for (int mi = 0; mi < 2; ++mi)
#pragma unroll
        for (int ni = 0; ni < 2; ++ni) acc[mi][ni] = MFMA32(a[mi], b[ni], acc[mi][ni]);
    }
    __syncthreads();
  }
}
DI void zero_acc(f32x16 (&acc)[2][2]) {
#pragma unroll
  for (int mi = 0; mi < 2; ++mi)
#pragma unroll
    for (int ni = 0; ni < 2; ++ni)
#pragma unroll
      for (int r = 0; r < 16; ++r) acc[mi][ni][r] = 0.f;
}
DI void acc_to_lds(const f32x16 (&acc)[2][2], char* smem) {
  float* sT = (float*)smem;
  const int lane = tidx() & 63, w = tidx() >> 6;
  const int l31 = lane & 31, h = lane >> 5, wr = w >> 1, wc = w & 1;
  __syncthreads();
#pragma unroll
  for (int mi = 0; mi < 2; ++mi)
#pragma unroll
    for (int ni = 0; ni < 2; ++ni)
#pragma unroll
      for (int reg = 0; reg < 16; ++reg) sT[(wr * 64 + mi * 32 + crow(reg, h)) * 132 + wc * 64 + ni * 32 + l31] = acc[mi][ni][reg];
  __syncthreads();
}
#define EPI_ROWS(...)                                                          \
  {                                                                            \
    const float* sT_ = (const float*)smem;                                     \
    _Pragma("unroll 2") for (int it_ = 0; it_ < 16; ++it_) {                   \
      const int row = it_ * 8 + (tidx() >> 5), col = (tidx() & 31) * 4; \
      const f32x4 v = *(const f32x4*)(sT_ + row * 132 + col);                  \
      __VA_ARGS__                                                              \
    }                                                                          \
  }

DI void gemm64_mainloop(const u16* __restrict__ R, int ldr, const u16* __restrict__ C, int ldc, int K, char* smem, f32x16& acc) {
  const int tid = tidx(), lane = tid & 63, w = tid >> 6, wr = w >> 1, wc = w & 1;
  const int l31 = lane & 31, h = lane >> 5;
  const int lrow = tid >> 3, lkc = (tid & 7) * 8;
  u32x4 rr[2][2], rc[2][2];
  const int nk = K >> 6;
#define G64_GLOAD(SET, KT)                                                                    \
  {                                                                                           \
    const int k0_ = (KT) * 64;                                                                \
    _Pragma("unroll") for (int i = 0; i < 2; ++i) {                                           \
      rr[SET][i] = *(const u32x4*)(R + (size_t)(lrow + 32 * i) * ldr + k0_ + lkc);            \
      rc[SET][i] = *(const u32x4*)(C + (size_t)(lrow + 32 * i) * ldc + k0_ + lkc);            \
    }                                                                                         \
  }
#define G64_LSTORE(SET, BUF)                                                                  \
  {                                                                                           \
    u16* nR_ = (u16*)smem + (BUF) * (2 * 64 * 72);                                            \
    u16* nC_ = nR_ + 64 * 72;                                                                 \
    _Pragma("unroll") for (int i = 0; i < 2; ++i) {                                           \
      *(u32x4*)(nR_ + (lrow + 32 * i) * 72 + lkc) = rr[SET][i];                               \
      *(u32x4*)(nC_ + (lrow + 32 * i) * 72 + lkc) = rc[SET][i];                               \
    }                                                                                         \
  }
  G64_GLOAD(0, 0)
  G64_GLOAD(1, 1)
  __syncthreads();
  G64_LSTORE(0, 0)
  G64_GLOAD(0, 2)
  __syncthreads();
  for (int kt0 = 0; kt0 < nk; kt0 += 2) {
#pragma unroll
    for (int u = 0; u < 2; ++u) {
      const int kt = kt0 + u;
      const u16* sR = (const u16*)smem + u * (2 * 64 * 72);
      const u16* sC = sR + 64 * 72;
      if (kt + 1 < nk) G64_LSTORE(1 - u, 1 - u)
      if (kt + 3 < nk) G64_GLOAD(1 - u, kt + 3)
#pragma unroll
      for (int ks = 0; ks < 4; ++ks) {
        const bf16x8 a = *(const bf16x8*)(sR + (wr * 32 + l31) * 72 + ks * 16 + h * 8);
        const bf16x8 b = *(const bf16x8*)(sC + (wc * 32 + l31) * 72 + ks * 16 + h * 8);
        acc = MFMA32(a, b, acc);
      }
      __syncthreads();
    }
  }
#undef G64_GLOAD
#undef G64_LSTORE
}
DI void acc64_to_lds(const f32x16& acc, char* smem) {
  float* sT = (float*)smem;
  const int lane = tidx() & 63, w = tidx() >> 6;
  const int l31 = lane & 31, h = lane >> 5, wr = w >> 1, wc = w & 1;
  __syncthreads();
#pragma unroll
  for (int reg = 0; reg < 16; ++reg) sT[(wr * 32 + crow(reg, h)) * 68 + wc * 32 + l31] = acc[reg];
  __syncthreads();
}
#define EPI64_ROWS(...)                                                        \
  {                                                                            \
    const float* sT_ = (const float*)smem;                                     \
    _Pragma("unroll") for (int it_ = 0; it_ < 4; ++it_) {                      \
      const int row = it_ * 16 + (tidx() >> 4), col = (tidx() & 15) * 4;       \
      const f32x4 v = *(const f32x4*)(sT_ + row * 68 + col);                   \
      __VA_ARGS__                                                              \
    }                                                                          \
  }

DI void phase_g1(const Params& p, int layer, char* smem) {
  const u16* H = (const u16*)(p.ws + WS_H);
  const u16* W = (const u16*)(p.ws + (size_t)layer * WL_STRIDE + W_IN);
  u16* Z = (u16*)(p.ws + WS_Z);
  const int xcd = blockIdx.x & 7, jb = blockIdx.x >> 3, nb = (gridDim.x + 7 - xcd) >> 3;
  for (int m = jb; m < 17 * 41; m += nb) {
    const int ft = m / 17, tt = xcd + 8 * (m % 17);
    f32x16 acc[2][2];
    zero_acc(acc);
    gemm_mainloop(H + (size_t)tt * 128 * 1024, 1024, W + (size_t)ft * 128 * 1024, 1024, 1024, smem, acc);
    acc_to_lds(acc, smem);
    EPI_ROWS({ *(u32x2*)(Z + (size_t)(tt * 128 + row) * NZ + ft * 128 + col) = u32x2{pk2(v.x, v.y), pk2(v.z, v.w)}; })
  }
}

DI void norms_token(const Params& p, int layer, int t, int lane) {
  const u16* zr = (const u16*)(p.ws + WS_Z) + (size_t)t * NZ;
  u16* CQN = (u16*)(p.ws + WS_H);
  u16* CKVB = (u16*)(p.ws + WS_CKVB);
  u16* KPEB = (u16*)(p.ws + WS_KPEB);
  {
    const uint2 raw = *(const uint2*)(zr + lane * 4);
    const float c0 = lo2f(raw.x), c1 = hi2f(raw.x), c2 = lo2f(raw.y), c3 = hi2f(raw.y);
    float ss = wave_sum(c0 * c0 + c1 * c1 + c2 * c2 + c3 * c3);
    const float rinv = rsqrtf(ss * (1.f / 256.f) + EPS);
    const float4 g = *(const float4*)(p.q_norm_w + layer * 256 + lane * 4);
    uint2 o;
    o.x = pk2(c0 * rinv * g.x, c1 * rinv * g.y);
    o.y = pk2(c2 * rinv * g.z, c3 * rinv * g.w);
    *(uint2*)(CQN + (size_t)t * 256 + lane * 4) = o;
  }
  {
    const unsigned raw = *(const unsigned*)(zr + ZC_KV + lane * 2);
    const float c0 = lo2f(raw), c1 = hi2f(raw);
    float ss = wave_sum(c0 * c0 + c1 * c1);
    const float rinv = rsqrtf(ss * (1.f / 128.f) + EPS);
    const float2 g = *(const float2*)(p.kv_norm_w + layer * 128 + lane * 2);
    const float o0 = c0 * rinv * g.x, o1 = c1 * rinv * g.y;
    float* dst = (t < NP) ? p.out + OFF_CKV_P + ((size_t)layer * NP + t) * 128 : p.out + OFF_CKV_S + ((size_t)layer * NSM + (t - NP)) * 128;
    *(float2*)(dst + lane * 2) = make_float2(o0, o1);
    *(unsigned*)(CKVB + (size_t)t * 128 + lane * 2) = pk2(o0, o1);
  }
  {
    float v = (lane < 32) ? bf2f(zr[ZC_KPE + lane]) : 0.f;
    float ss = wave_sum(v * v);
    const float rinv = rsqrtf(ss * (1.f / 32.f) + EPS);
    v = v * rinv * p.kn_rope[layer * 32 + (lane & 31)];
    const float pr = __shfl_xor(v, 16);
    float s, c;
    rope_sincos(tok_pos(t), lane & 15, s, c);
    const float o = ((lane & 16) == 0) ? (v * c - pr * s) : (v * c + pr * s);
    if (lane < 32) {
      float* dst = (t < NP) ? p.out + OFF_KPE_P + ((size_t)layer * NP + t) * 32 : p.out + OFF_KPE_S + ((size_t)layer * NSM + (t - NP)) * 32;
      dst[lane] = o;
      KPEB[(size_t)t * 32 + lane] = f2bf(o);
    }
  }
  float* sh = nullptr;
  if (t == NP - 1) sh = p.out + OFF_SH_P + (size_t)layer * SHW;
  else if (t >= NP && ((t - NP) & 63) == 63) sh = p.out + OFF_SH_S + ((size_t)layer * 16 + ((t - NP) >> 6)) * SHW;
  if (sh) {
#pragma unroll 1
    for (int ch = lane; ch < 208; ch += 64) {
      const u32x4 q = *(const u32x4*)(zr + ZC_ZS + ch * 8);
      *(f32x4*)(sh + ch * 8) = f32x4{lo2f(q.x), hi2f(q.x), lo2f(q.y), hi2f(q.y)};
      *(f32x4*)(sh + ch * 8 + 4) = f32x4{lo2f(q.z), hi2f(q.z), lo2f(q.w), hi2f(q.w)};
    }
  }
}

DI void zm4(const Params& p, int layer, int t, int c, float (&o)[4]) {
  const u16* zr = (const u16*)(p.ws + WS_Z) + (size_t)t * NZ + ZC_ZS + c;
  const u32x2 a = *(const u32x2*)zr;
  const bool first = (t < NP) ? (t == 0) : (((t - NP) & 63) == 0);
  const int srow = (t < NP) ? 0 : 1 + ((t - NP) >> 6);
  const u16* pr = first ? (const u16*)(p.ws + WS_SH0) + srow * SHW + c : zr - NZ;
  const u32x2 b = *(const u32x2*)pr;
  const f32x4 mu = *(const f32x4*)(p.mu_shift + layer * SHW + c);
  const float c0 = lo2f(a.x), c1 = hi2f(a.x), c2 = lo2f(a.y), c3 = hi2f(a.y);
  o[0] = c0 + (lo2f(b.x) - c0) * mu.x;
  o[1] = c1 + (hi2f(b.x) - c1) * mu.y;
  o[2] = c2 + (lo2f(b.y) - c2) * mu.z;
  o[3] = c3 + (hi2f(b.y) - c3) * mu.w;
}
DI float tanhf_(float x) {
  const float t = __expf(-2.f * fabsf(x));
  const float r = (1.f - t) * __builtin_amdgcn_rcpf(1.f + t);
  return x < 0.f ? -r : r;
}

constexpr int WPS = 900;
DI void zml(const u16* sz, int row, int col, const float* mu, float (&o)[4]) {
  const u32x2 a = *(const u32x2*)(sz + (row + 1) * WPS + col);
  const u32x2 b = *(const u32x2*)(sz + row * WPS + col);
  const f32x4 m4 = *(const f32x4*)mu;
  const float c0 = lo2f(a.x), c1 = hi2f(a.x), c2 = lo2f(a.y), c3 = hi2f(a.y);
  o[0] = c0 + (lo2f(b.x) - c0) * m4.x;
  o[1] = c1 + (hi2f(b.x) - c1) * m4.y;
  o[2] = c2 + (lo2f(b.y) - c2) * m4.z;
  o[3] = c3 + (hi2f(b.y) - c3) * m4.w;
}
DI void wkvprep_block(const Params& p, int layer, int tt, int hg, char* smem) {
  u16* sz = (u16*)smem;
  const int tid = tidx(), lane = tid & 63, w = tid >> 6, l31 = lane & 31, h = lane >> 5;
  const int t0 = tt * 32;
  const int hd = hg * 4 + w;
  const u16* Z = (const u16*)(p.ws + WS_Z);
  const bool seq_start = (t0 < NP) ? (t0 == 0) : (((t0 - NP) & 63) == 0);
  const u16* prevrow = seq_start ? (const u16*)(p.ws + WS_SH0) + ((t0 < NP) ? 0 : 1 + ((t0 - NP) >> 6)) * SHW : Z + (size_t)(t0 - 1) * NZ + ZC_ZS;
  __syncthreads();
  for (int ci = tid; ci < 33 * 112; ci += 256) {
    const int row = ci / 112, cc = ci - row * 112;
    int scol, lcol;
    if (cc < 16) { scol = 1536 + cc * 8; lcol = cc * 8; }
    else {
      const int j = cc - 16, ww = j / 24, r2 = j - ww * 24, part = r2 >> 3, o = (r2 & 7) * 8;
      scol = part * 512 + (hg * 4 + ww) * 64 + o;
      lcol = 128 + ww * 192 + part * 64 + o;
    }
    const u16* src = (row == 0) ? prevrow + scol : Z + (size_t)(t0 + row - 1) * NZ + ZC_ZS + scol;
    const u32x4 v = *(const u32x4*)src;
    u32x2* d = (u32x2*)(sz + row * WPS + lcol);
    d[0] = u32x2{v.x, v.y};
    d[1] = u32x2{v.z, v.w};
  }
  __syncthreads();
  const int tok = t0 + l31;
  const u16* W2T = (const u16*)(p.ws + (size_t)layer * WL_STRIDE + W_W2);
  const u16* A2T = (const u16*)(p.ws + (size_t)layer * WL_STRIDE + W_A2);
  const float* mu = p.mu_shift + layer * SHW;
  u16* WK = (u16*)(p.ws + WS_WKVIN) + ((size_t)hd * NT + tok) * 384;
  f32x16 accW[2], accA[2];
#pragma unroll
  for (int m = 0; m < 2; ++m)
#pragma unroll
    for (int r = 0; r < 16; ++r) { accW[m][r] = 0.f; accA[m][r] = 0.f; }
#pragma unroll
  for (int ks = 0; ks < 4; ++ks) {
    const int c0 = ks * 16 + 8 * h;
    float t0a[4], t1a[4], u0[4], u1[4];
    zml(sz, l31, c0, mu + 1536 + c0, t0a);
    zml(sz, l31, c0 + 4, mu + 1536 + c0 + 4, t1a);
    zml(sz, l31, 64 + c0, mu + 1600 + c0, u0);
    zml(sz, l31, 64 + c0 + 4, mu + 1600 + c0 + 4, u1);
    u32x4 bw, ba;
    bw.x = pk2(tanhf_(t0a[0]), tanhf_(t0a[1])); bw.y = pk2(tanhf_(t0a[2]), tanhf_(t0a[3]));
    bw.z = pk2(tanhf_(t1a[0]), tanhf_(t1a[1])); bw.w = pk2(tanhf_(t1a[2]), tanhf_(t1a[3]));
    ba.x = pk2(u0[0], u0[1]); ba.y = pk2(u0[2], u0[3]); ba.z = pk2(u1[0], u1[1]); ba.w = pk2(u1[2], u1[3]);
    const bf16x8 bwf = __builtin_bit_cast(bf16x8, bw), baf = __builtin_bit_cast(bf16x8, ba);
#pragma unroll
    for (int m = 0; m < 2; ++m) {
      const bf16x8 aw = *(const bf16x8*)(W2T + (size_t)(hd * 64 + m * 32 + l31) * 64 + ks * 16 + h * 8);
      const bf16x8 aa = *(const bf16x8*)(A2T + (size_t)(hd * 64 + m * 32 + l31) * 64 + ks * 16 + h * 8);
      accW[m] = MFMA32(aw, bwf, accW[m]);
      accA[m] = MFMA32(aa, baf, accA[m]);
    }
  }
  const int hb = 128 + w * 192;
  float ss = 0.f;
#pragma unroll
  for (int m = 0; m < 2; ++m)
#pragma unroll
    for (int q = 0; q < 4; ++q) {
      const int f0 = m * 32 + 8 * q + 4 * h, F = hd * 64 + f0;
      float k4[4];
      zml(sz, l31, hb + 64 + f0, mu + 512 + F, k4);
      const float4 kk_ = *(const float4*)(p.k_k + layer * 512 + F);
      const float a = k4[0] * kk_.x, b = k4[1] * kk_.y, c = k4[2] * kk_.z, d = k4[3] * kk_.w;
      ss += a * a + b * b + c * c + d * d;
    }
  ss += xor32(ss);
  const float rn = 1.f / fmaxf(sqrtf(ss), 1e-12f);
#pragma unroll
  for (int m = 0; m < 2; ++m)
#pragma unroll
    for (int q = 0; q < 4; ++q) {
      const int f0 = m * 32 + 8 * q + 4 * h, F = hd * 64 + f0;
      float r4[4], k4[4], v4[4];
      zml(sz, l31, hb + f0, mu + F, r4);
      zml(sz, l31, hb + 64 + f0, mu + 512 + F, k4);
      zml(sz, l31, hb + 128 + f0, mu + 1024 + F, v4);
      const float4 w0 = *(const float4*)(p.w0 + layer * 512 + F);
      const float4 a0 = *(const float4*)(p.a0 + layer * 512 + F);
      const float4 kk_ = *(const float4*)(p.k_k + layer * 512 + F);
      const float4 ka_ = *(const float4*)(p.k_a + layer * 512 + F);
      const float w0a[4] = {w0.x, w0.y, w0.z, w0.w}, a0a[4] = {a0.x, a0.y, a0.z, a0.w};
      const float kka[4] = {kk_.x, kk_.y, kk_.z, kk_.w}, kaa[4] = {ka_.x, ka_.y, ka_.z, ka_.w};
      float e4[4], kp4[4], kn4[4], b4[4];
#pragma unroll
      for (int j = 0; j < 4; ++j) {
        const float lw = w0a[j] + accW[m][4 * q + j];
        const float nx = -lw;
        const float sp = fmaxf(nx, 0.f) + __logf(1.f + __expf(-fabsf(nx)));
        e4[j] = __expf(-sp - 0.5f);
        const float a = sigmoidf_(a0a[j] + accA[m][4 * q + j]);
        kn4[j] = k4[j] * kka[j] * rn;
        b4[j] = kn4[j] * a;
        kp4[j] = k4[j] * (1.f + (a - 1.f) * kaa[j]);
      }
      *(u32x2*)(WK + 0 * 64 + f0) = u32x2{pk2(r4[0], r4[1]), pk2(r4[2], r4[3])};
      *(u32x2*)(WK + 1 * 64 + f0) = u32x2{pk2(e4[0] * -1.4426950408889634f, e4[1] * -1.4426950408889634f), pk2(e4[2] * -1.4426950408889634f, e4[3] * -1.4426950408889634f)};
      *(u32x2*)(WK + 2 * 64 + f0) = u32x2{pk2(kp4[0], kp4[1]), pk2(kp4[2], kp4[3])};
      *(u32x2*)(WK + 3 * 64 + f0) = u32x2{pk2(v4[0], v4[1]), pk2(v4[2], v4[3])};
      *(u32x2*)(WK + 4 * 64 + f0) = u32x2{pk2(-kn4[0], -kn4[1]), pk2(-kn4[2], -kn4[3])};
      *(u32x2*)(WK + 5 * 64 + f0) = u32x2{pk2(b4[0], b4[1]), pk2(b4[2], b4[3])};
    }
}

DI void qproj_item(const Params& p, int layer, int tt, int hd, int lane);
DI void kvproj_item(const Params& p, int layer, int tt, int hd, int lane);
DI void phase_norms_prep(const Params& p, int layer, char* smem, int* s_item) {
  int* ctr = (int*)(p.ws + WS_CTR) + 4 + layer;
  const int wave = tidx() >> 6, lane = tidx() & 63;
  for (;;) {
    __syncthreads();
    if (tidx() == 0) *s_item = atomicAdd(ctr, 1);
    __syncthreads();
    const int it = *s_item;
    if (it >= 272 + 1088 + 2112) break;
    if (it < 272) {
      const int tb = it * 64 + wave * 16;
      for (int j = 0; j < 16; ++j) norms_token(p, layer, tb + j, lane);
      continue;
    }
    if (it < 272 + 1088) { const int wi = it - 272; wkvprep_block(p, layer, wi >> 1, wi & 1, smem); continue; }
    {
      const int wi = (it - 272 - 1088) * 4 + wave;
      if (wi < 544 * 8) qproj_item(p, layer, wi >> 3, wi & 7, lane);
      else { const int j = wi - 544 * 8; kvproj_item(p, layer, j >> 3, j & 7, lane); }
    }
  }
}

DI bf16x8 normed_frag(const u16* zsrc, const float* g, float& ssq) {
  const u32x4 raw = *(const u32x4*)zsrc;
  const f32x4 g0 = *(const f32x4*)g, g1 = *(const f32x4*)(g + 4);
  const float f0 = lo2f(raw.x), f1 = hi2f(raw.x), f2 = lo2f(raw.y), f3 = hi2f(raw.y);
  const float f4 = lo2f(raw.z), f5 = hi2f(raw.z), f6 = lo2f(raw.w), f7 = hi2f(raw.w);
  ssq += (f0 * f0 + f1 * f1) + (f2 * f2 + f3 * f3) + (f4 * f4 + f5 * f5) + (f6 * f6 + f7 * f7);
  const u32x4 o = {pk2(f0 * g0.x, f1 * g0.y), pk2(f2 * g0.z, f3 * g0.w), pk2(f4 * g1.x, f5 * g1.y), pk2(f6 * g1.z, f7 * g1.w)};
  return __builtin_bit_cast(bf16x8, o);
}
DI void qproj_item(const Params& p, int layer, int tt, int hd, int lane) {
  const int l31 = lane & 31, h = lane >> 5;
  const int tok = tt * 32 + l31;
  const u16* zq = (const u16*)(p.ws + WS_Z) + (size_t)tok * NZ;
  const float* gq = p.q_norm_w + layer * 256;
  float ssq = 0.f;
  const u16* WT = (const u16*)(p.ws + (size_t)layer * WL_STRIDE + W_UQ);
  u16* Q = (u16*)(p.ws + WS_Q);
  f32x16 acc[3];
#pragma unroll
  for (int m = 0; m < 3; ++m)
#pragma unroll
    for (int r = 0; r < 16; ++r) acc[m][r] = 0.f;
#pragma unroll 4
  for (int ks = 0; ks < 16; ++ks) {
    const bf16x8 bfr = normed_frag(zq + ks * 16 + h * 8, gq + ks * 16 + h * 8, ssq);
#pragma unroll
    for (int m = 0; m < 3; ++m) {
      const bf16x8 afr = *(const bf16x8*)(WT + (size_t)(hd * 96 + m * 32 + l31) * 256 + ks * 16 + h * 8);
      acc[m] = MFMA32(afr, bfr, acc[m]);
    }
  }
  {
    ssq += xor32(ssq);
    const float rinv = rsqrtf(ssq * (1.f / 256.f) + EPS);
#pragma unroll
    for (int m = 0; m < 3; ++m)
#pragma unroll
      for (int r = 0; r < 16; ++r) acc[m][r] *= rinv;
  }
  const float qs = 0.10206207261596577f * 1.4426950408889634f;
  float ss = 0.f;
#pragma unroll
  for (int m = 0; m < 2; ++m)
#pragma unroll
    for (int r = 0; r < 16; ++r) ss += acc[m][r] * acc[m][r];
  ss += xor32(ss);
  const float rn = rsqrtf(ss * (1.f / 64.f) + EPS) * qs;
  u16* qd = Q + (size_t)tok * 768 + hd * 96;
#pragma unroll
  for (int m = 0; m < 2; ++m)
#pragma unroll
    for (int q = 0; q < 4; ++q) {
      const int f0 = m * 32 + 8 * q + 4 * h;
      const float4 g = *(const float4*)(p.qn_nope + layer * 64 + f0);
      *(uint2*)(qd + f0) = make_uint2(pk2(acc[m][4 * q] * rn * g.x, acc[m][4 * q + 1] * rn * g.y), pk2(acc[m][4 * q + 2] * rn * g.z, acc[m][4 * q + 3] * rn * g.w));
    }
  float sr = 0.f;
#pragma unroll
  for (int r = 0; r < 16; ++r) sr += acc[2][r] * acc[2][r];
  sr += xor32(sr);
  const float rr = rsqrtf(sr * (1.f / 32.f) + EPS);
  const int pos = tok_pos(tok);
  float o1[8], o2[8];
#pragma unroll
  for (int r = 0; r < 8; ++r) {
    const int i = crow(r, h);
    const float x1 = acc[2][r] * rr * p.qn_rope[layer * 32 + i];
    const float x2 = acc[2][r + 8] * rr * p.qn_rope[layer * 32 + i + 16];
    float s, c;
    rope_sincos(pos, i, s, c);
    o1[r] = (x1 * c - x2 * s) * qs;
    o2[r] = (x2 * c + x1 * s) * qs;
  }
#pragma unroll
  for (int q = 0; q < 2; ++q) {
    const int i0 = 8 * q + 4 * h;
    *(uint2*)(qd + 64 + i0) = make_uint2(pk2(o1[4 * q], o1[4 * q + 1]), pk2(o1[4 * q + 2], o1[4 * q + 3]));
    *(uint2*)(qd + 64 + 16 + i0) = make_uint2(pk2(o2[4 * q], o2[4 * q + 1]), pk2(o2[4 * q + 2], o2[4 * q + 3]));
  }
}

DI void kvproj_item(const Params& p, int layer, int tt, int hd, int lane) {
  const int l31 = lane & 31, h = lane >> 5;
  const int tok = tt * 32 + l31;
  const u16* zk = (const u16*)(p.ws + WS_Z) + (size_t)tok * NZ + ZC_KV;
  const float* gk = p.kv_norm_w + layer * 128;
  float ssq = 0.f;
  const u16* WT = (const u16*)(p.ws + (size_t)layer * WL_STRIDE + W_UKV);
  u16* KN = (u16*)(p.ws + WS_KN);
  u16* VT = (u16*)(p.ws + WS_VT);
  f32x16 acc[4];
#pragma unroll
  for (int m = 0; m < 4; ++m)
#pragma unroll
    for (int r = 0; r < 16; ++r) acc[m][r] = 0.f;
#pragma unroll 4
  for (int ks = 0; ks < 8; ++ks) {
    const bf16x8 bfr = normed_frag(zk + ks * 16 + h * 8, gk + ks * 16 + h * 8, ssq);
#pragma unroll
    for (int m = 0; m < 4; ++m) {
      const bf16x8 afr = *(const bf16x8*)(WT + (size_t)(hd * 128 + m * 32 + l31) * 128 + ks * 16 + h * 8);
      acc[m] = MFMA32(afr, bfr, acc[m]);
    }
  }
  {
    ssq += xor32(ssq);
    const float rinv = rsqrtf(ssq * (1.f / 128.f) + EPS);
#pragma unroll
    for (int m = 0; m < 4; ++m)
#pragma unroll
      for (int r = 0; r < 16; ++r) acc[m][r] *= rinv;
  }
  float ss = 0.f;
#pragma unroll
  for (int m = 0; m < 2; ++m)
#pragma unroll
    for (int r = 0; r < 16; ++r) ss += acc[m][r] * acc[m][r];
  ss += xor32(ss);
  const float rn = rsqrtf(ss * (1.f / 64.f) + EPS);
  u16* kd = KN + ((size_t)hd * NP + tok) * 64;
#pragma unroll
  for (int m = 0; m < 2; ++m)
#pragma unroll
    for (int q = 0; q < 4; ++q) {
      const int f0 = m * 32 + 8 * q + 4 * h;
      const float4 g = *(const float4*)(p.kn_nope + layer * 64 + f0);
      *(uint2*)(kd + f0) = make_uint2(pk2(acc[m][4 * q] * rn * g.x, acc[m][4 * q + 1] * rn * g.y), pk2(acc[m][4 * q + 2] * rn * g.z, acc[m][4 * q + 3] * rn * g.w));
    }
#pragma unroll
  for (int m = 0; m < 2; ++m)
#pragma unroll
    for (int r = 0; r < 16; ++r) {
      const int d = m * 32 + crow(r, h);
      VT[((size_t)hd * 64 + d) * NP + tok] = f2bf(acc[2 + m][r]);
    }
}

DI void phase_proj(const Params& p, int layer) {
  const int wave = tidx() >> 6, lane = tidx() & 63;
  const int nw = gridDim.x * 4, gw = blockIdx.x * 4 + wave;
  for (int it = gw; it < 544 * 8 + 512 * 8; it += nw) {
    if (it < 544 * 8) qproj_item(p, layer, it >> 3, it & 7, lane);
    else { const int j = it - 544 * 8; kvproj_item(p, layer, j >> 3, j & 7, lane); }
  }
}

DI float wave_max(float v) {
#pragma unroll
  for (int o = 32; o > 0; o >>= 1) v = fmaxf(v, __shfl_xor(v, o));
  return v;
}
DI float attn_bound(const Params& p, int layer, int lane) {
  const float gqn = wave_max(fabsf(p.qn_nope[layer * 64 + lane])), gkn = wave_max(fabsf(p.kn_nope[layer * 64 + lane]));
  const float gqr = wave_max(fabsf(p.qn_rope[layer * 32 + (lane & 31)])), gkr = wave_max(fabsf(p.kn_rope[layer * 32 + (lane & 31)]));
  const float qs = 0.10206207261596577f * 1.4426950408889634f;
  return 1.02f * qs * (64.f * gqn * gkn + 32.f * gqr * gkr) + 0.25f;
}
template <int NSUB>
DI void attn_tile(const bf16x8 (&qf)[6], const u16* sK, const u16* sVT, int ksub0, f32x16 (&o)[2], float& l, float negB, int l31, int h) {
  f32x16 s[NSUB];
  {
    bf16x8 kf[NSUB][6];
#pragma unroll
    for (int i = 0; i < NSUB; ++i)
#pragma unroll
      for (int ks = 0; ks < 6; ++ks) kf[i][ks] = *(const bf16x8*)(sK + ((ksub0 + i) * 32 + l31) * 104 + ks * 16 + h * 8);
#pragma unroll
    for (int i = 0; i < NSUB; ++i) {
#pragma unroll
      for (int r = 0; r < 16; ++r) s[i][r] = negB;
#pragma unroll
      for (int ks = 0; ks < 6; ++ks) s[i] = MFMA32(kf[i][ks], qf[ks], s[i]);
    }
    __builtin_amdgcn_sched_group_barrier(0x100, 6 * NSUB, 0);
    __builtin_amdgcn_sched_group_barrier(0x008, 6 * NSUB, 0);
  }
  bf16x8 vf[NSUB][2][2];
#pragma unroll
  for (int i = 0; i < NSUB; ++i)
#pragma unroll
    for (int st = 0; st < 2; ++st)
#pragma unroll
      for (int md = 0; md < 2; ++md) {
        const u16* vp = sVT + (md * 32 + l31) * 68 + (ksub0 + i) * 32 + 16 * st + 4 * h;
        const s16x4 lo = *(const s16x4*)vp;
        const s16x4 hi = *(const s16x4*)(vp + 8);
        vf[i][st][md] = __builtin_shufflevector(lo, hi, 0, 1, 2, 3, 4, 5, 6, 7);
      }
  float ps = 0.f;
#pragma unroll
  for (int i = 0; i < NSUB; ++i)
#pragma unroll
    for (int r = 0; r < 16; ++r) {
      const float pv = __builtin_amdgcn_exp2f(s[i][r]);
      ps += pv;
      s[i][r] = pv;
    }
  l += ps;
#pragma unroll
  for (int i = 0; i < NSUB; ++i)
#pragma unroll
    for (int st = 0; st < 2; ++st) {
      u32x4 pu;
      pu.x = pk2(s[i][8 * st + 0], s[i][8 * st + 1]);
      pu.y = pk2(s[i][8 * st + 2], s[i][8 * st + 3]);
      pu.z = pk2(s[i][8 * st + 4], s[i][8 * st + 5]);
      pu.w = pk2(s[i][8 * st + 6], s[i][8 * st + 7]);
      const bf16x8 pf = __builtin_bit_cast(bf16x8, pu);
#pragma unroll
      for (int md = 0; md < 2; ++md) o[md] = MFMA32(vf[i][st][md], pf, o[md]);
    }
}

DI void attn_store(const Params& p, int tok, int hd, const f32x16 (&o)[2], float linv, int h) {
  const u16* gz = (const u16*)(p.ws + WS_Z) + (size_t)tok * NZ + ZC_GA + hd * 64;
  u16* OA = (u16*)(p.ws + WS_OA) + (size_t)tok * 512 + hd * 64;
#pragma unroll
  for (int md = 0; md < 2; ++md)
#pragma unroll
    for (int q = 0; q < 4; ++q) {
      const int d0 = md * 32 + 8 * q + 4 * h;
      const uint2 g = *(const uint2*)(gz + d0);
      const float v0 = o[md][4 * q] * linv * siluf_(lo2f(g.x));
      const float v1 = o[md][4 * q + 1] * linv * siluf_(hi2f(g.x));
      const float v2 = o[md][4 * q + 2] * linv * siluf_(lo2f(g.y));
      const float v3 = o[md][4 * q + 3] * linv * siluf_(hi2f(g.y));
      *(uint2*)(OA + d0) = make_uint2(pk2(v0, v1), pk2(v2, v3));
    }
}

DI void attn_prompt_item(const Params& p, int layer, int qt, int hd, char* smem) {
  u16* sK = (u16*)smem;
  u16* sVT = (u16*)(smem + 13312);
  const int tid = tidx(), lane = tid & 63, w = tid >> 6, l31 = lane & 31, h = lane >> 5;
  const int tok = qt * 128 + w * 32 + l31;
  const u16* Q = (const u16*)(p.ws + WS_Q);
  const u16* KN = (const u16*)(p.ws + WS_KN) + (size_t)hd * NP * 64;
  const u16* KPEB = (const u16*)(p.ws + WS_KPEB);
  const u16* VT = (const u16*)(p.ws + WS_VT) + (size_t)hd * 64 * NP;
  bf16x8 qf[6];
#pragma unroll
  for (int ks = 0; ks < 6; ++ks) qf[ks] = *(const bf16x8*)(Q + (size_t)tok * 768 + hd * 96 + ks * 16 + h * 8);
  f32x16 o[2];
#pragma unroll
  for (int d = 0; d < 2; ++d)
#pragma unroll
    for (int r = 0; r < 16; ++r) o[d][r] = 0.f;
  float l = 0.f;
  const float negB = -attn_bound(p, layer, lane);
  const int nkt = 2 * qt + 2;
  const int my_nkt = (w < 2) ? nkt - 1 : nkt;
  u32x4 pk[2][2], pr[2], pv[2][2];
#define PA_GLOAD(SET, KT)                                                                        \
  {                                                                                              \
    const int key0_ = (KT) * 64;                                                                 \
    _Pragma("unroll") for (int i = 0; i < 2; ++i) {                                              \
      const int c = tid + 256 * i;                                                               \
      pk[SET][i] = *(const u32x4*)(KN + (size_t)(key0_ + (c >> 3)) * 64 + (c & 7) * 8);          \
      pv[SET][i] = *(const u32x4*)(VT + (size_t)(c >> 3) * NP + key0_ + (c & 7) * 8);            \
    }                                                                                            \
    pr[SET] = *(const u32x4*)(KPEB + (size_t)(key0_ + (tid >> 2)) * 32 + (tid & 3) * 8);         \
  }
  PA_GLOAD(0, 0)
  PA_GLOAD(1, 1)
  for (int kt0 = 0; kt0 < nkt; kt0 += 2) {
#pragma unroll
    for (int u = 0; u < 2; ++u) {
      const int kt = kt0 + u;
      __syncthreads();
#pragma unroll
      for (int i = 0; i < 2; ++i) {
        const int c = tid + 256 * i;
        *(u32x4*)(sK + (c >> 3) * 104 + (c & 7) * 8) = pk[u][i];
        u32x2* vd = (u32x2*)(sVT + (c >> 3) * 68 + (c & 7) * 8);
        vd[0] = u32x2{pv[u][i].x, pv[u][i].y};
        vd[1] = u32x2{pv[u][i].z, pv[u][i].w};
      }
      *(u32x4*)(sK + (tid >> 2) * 104 + 64 + (tid & 3) * 8) = pr[u];
      __syncthreads();
      if (kt + 2 < nkt) PA_GLOAD(u, kt + 2)
      if (kt < my_nkt) attn_tile<2>(qf, sK, sVT, 0, o, l, negB, l31, h);
    }
  }
#undef PA_GLOAD
  l += xor32(l);
  attn_store(p, tok, hd, o, 1.f / l, h);
}

DI void attn_sample_item(const Params& p, int layer, int b, int hd, char* smem) {
  u16* sC = (u16*)smem;
  u16* sK = (u16*)(smem + 17408);
  u16* sVT = (u16*)(smem + 17408 + 13312);
  u16* sW = (u16*)(smem + 39424);
  const int tid = tidx(), lane = tid & 63, w = tid >> 6, l31 = lane & 31, h = lane >> 5;
  const int khu = w & 1, part = w >> 1;
  const int qh = w >> 1, kh = w & 1;
  const int tok = NP + b * 64 + qh * 32 + l31;
  const u16* Q = (const u16*)(p.ws + WS_Q);
  const u16* WT = (const u16*)(p.ws + (size_t)layer * WL_STRIDE + W_UKV) + (size_t)hd * 128 * 128;
  __syncthreads();
#pragma unroll
  for (int i = 0; i < 8; ++i) {
    const int c = tid + 256 * i;
    *(u32x4*)(sW + (c >> 4) * 136 + (c & 15) * 8) = *(const u32x4*)(WT + (size_t)c * 8);
  }
  bf16x8 qf[6];
#pragma unroll
  for (int ks = 0; ks < 6; ++ks) qf[ks] = *(const bf16x8*)(Q + (size_t)tok * 768 + hd * 96 + ks * 16 + h * 8);
  f32x16 o[2];
#pragma unroll
  for (int d = 0; d < 2; ++d)
#pragma unroll
    for (int r = 0; r < 16; ++r) o[d][r] = 0.f;
  float l = 0.f;
  const float negB = -attn_bound(p, layer, lane);
  const u16* cck = (const u16*)(p.ws + WS_CKB) + (size_t)b * 4096 * 128;
  const u16* ckp = (const u16*)(p.ws + WS_KPB) + (size_t)b * 4096 * 32;
  const u16* nck = (const u16*)(p.ws + WS_CKVB) + (size_t)(NP + b * 64) * 128;
  const u16* nkp = (const u16*)(p.ws + WS_KPEB) + (size_t)(NP + b * 64) * 32;
  u32x4 pc[4], pp;
#define SA_GLOAD(KT)                                                                      \
  {                                                                                       \
    const u16* s1_ = ((KT) < 64) ? cck + (size_t)(KT) * 64 * 128 : nck;                   \
    const u16* s2_ = ((KT) < 64) ? ckp + (size_t)(KT) * 64 * 32 : nkp;                    \
    _Pragma("unroll") for (int i = 0; i < 4; ++i) pc[i] = *(const u32x4*)(s1_ + (size_t)(tid + 256 * i) * 8); \
    pp = *(const u32x4*)(s2_ + (size_t)tid * 8);                                          \
  }
  SA_GLOAD(0)
  for (int kt = 0; kt < 65; ++kt) {
    __syncthreads();
#pragma unroll
    for (int i = 0; i < 4; ++i) {
      const int c = tid + 256 * i;
      *(u32x4*)(sC + (c >> 4) * 136 + (c & 15) * 8) = pc[i];
    }
    *(u32x4*)(sK + (tid >> 2) * 104 + 64 + (tid & 3) * 8) = pp;
    __syncthreads();
    if (kt + 1 < 65) SA_GLOAD(kt + 1)
    {
      f32x16 acc[2];
#pragma unroll
      for (int mt = 0; mt < 2; ++mt)
#pragma unroll
        for (int r = 0; r < 16; ++r) acc[mt][r] = 0.f;
      bf16x8 cfa[8];
#pragma unroll
      for (int ks = 0; ks < 8; ++ks) cfa[ks] = *(const bf16x8*)(sC + (khu * 32 + l31) * 136 + ks * 16 + h * 8);
#pragma unroll
      for (int mt = 0; mt < 2; ++mt) {
        bf16x8 wfa[8];
#pragma unroll
        for (int ks = 0; ks < 8; ++ks) wfa[ks] = *(const bf16x8*)(sW + (part * 64 + mt * 32 + l31) * 136 + ks * 16 + h * 8);
#pragma unroll
        for (int ks = 0; ks < 8; ++ks) {
          if (part == 0) acc[mt] = MFMA32(wfa[ks], cfa[ks], acc[mt]);
          else acc[mt] = MFMA32(cfa[ks], wfa[ks], acc[mt]);
        }
      }
      if (part == 0) {
        float ss = 0.f;
#pragma unroll
        for (int mt = 0; mt < 2; ++mt)
#pragma unroll
          for (int r = 0; r < 16; ++r) ss += acc[mt][r] * acc[mt][r];
        ss += xor32(ss);
        const float rn = rsqrtf(ss * (1.f / 64.f) + EPS);
#pragma unroll
        for (int mt = 0; mt < 2; ++mt)
#pragma unroll
          for (int q = 0; q < 4; ++q) {
            const int f0 = mt * 32 + 8 * q + 4 * h;
            const float4 g = *(const float4*)(p.kn_nope + layer * 64 + f0);
            *(u32x2*)(sK + (khu * 32 + l31) * 104 + f0) = u32x2{pk2(acc[mt][4 * q] * rn * g.x, acc[mt][4 * q + 1] * rn * g.y), pk2(acc[mt][4 * q + 2] * rn * g.z, acc[mt][4 * q + 3] * rn * g.w)};
          }
      } else {
#pragma unroll
        for (int mt = 0; mt < 2; ++mt)
#pragma unroll
          for (int q = 0; q < 4; ++q)
            *(u32x2*)(sVT + (mt * 32 + l31) * 68 + khu * 32 + 8 * q + 4 * h) =
                u32x2{pk2(acc[mt][4 * q], acc[mt][4 * q + 1]), pk2(acc[mt][4 * q + 2], acc[mt][4 * q + 3])};
      }
    }
    __syncthreads();
    attn_tile<1>(qf, sK, sVT, kh, o, l, negB, l31, h);
  }
#undef SA_GLOAD
  __syncthreads();
  float* cb = (float*)smem;
  if (kh == 1) {
    float* d = cb + (qh * 64 + lane) * 34;
#pragma unroll
    for (int r = 0; r < 16; ++r) { d[r] = o[0][r]; d[16 + r] = o[1][r]; }
    d[32] = l;
  }
  __syncthreads();
  if (kh == 0) {
    const float* d = cb + (qh * 64 + lane) * 34;
#pragma unroll
    for (int r = 0; r < 16; ++r) { o[0][r] += d[r]; o[1][r] += d[16 + r]; }
    l += d[32];
    l += xor32(l);
    attn_store(p, tok, hd, o, 1.f / l, h);
  }
}

template <int N> DI void fmac_bc(float& acc, float srcvec, float other) {
  asm("v_fmac_f32_dpp %0, %1, %2 row_newbcast:%3 row_mask:0xf bank_mask:0xf" : "+v"(acc) : "v"(srcvec), "v"(other), "n"(N));
}
template <int N> DI float mul_bc(float srcvec, float other) {
  float r;
  asm("v_mul_f32_dpp %0, %1, %2 row_newbcast:%3 row_mask:0xf bank_mask:0xf" : "=v"(r) : "v"(srcvec), "v"(other), "n"(N));
  return r;
}
struct RplRaw { u32x2 r, e, k, a, b; unsigned v; };
template <int MODE> DI void rpl_load(RplRaw& q, const u16* s, int n, int lane) {
  q.e = *(const u32x2*)(s + 64 + 4 * n);
  q.a = *(const u32x2*)(s + 256 + 4 * n);
  q.b = *(const u32x2*)(s + 320 + 4 * n);
  if (MODE >= 1) { q.k = *(const u32x2*)(s + 128 + 4 * n); q.v = s[192 + lane]; }
  if (MODE == 2) q.r = *(const u32x2*)(s + 4 * n);
}
template <int MODE>
DI void rpl_item(const Params& p, int hd, int tok0, int nsteps, const float* Sinit, float* Sout, float* Yg, int lane) {
  const int n = lane & 15;
  float S[64];
  if (MODE == 0) {
#pragma unroll
    for (int k = 0; k < 64; ++k) S[k] = (k == lane) ? 1.f : 0.f;
  } else if (MODE == 1) {
#pragma unroll
    for (int k = 0; k < 64; ++k) S[k] = 0.f;
  } else {
#pragma unroll
    for (int k = 0; k < 64; k += 4) {
      const f32x4 t = *(const f32x4*)(Sinit + (size_t)lane * 64 + k);
      S[k] = t.x; S[k + 1] = t.y; S[k + 2] = t.z; S[k + 3] = t.w;
    }
  }
  const u16* src = (const u16*)(p.ws + WS_WKVIN) + ((size_t)hd * NT + tok0) * 384;
  float C0 = 1.f, C1 = 1.f, C2 = 1.f, C3 = 1.f;
  RplRaw c0, c1, c2;
  rpl_load<MODE>(c0, src, n, lane);
  rpl_load<MODE>(c1, src + 384, n, lane);
  for (int t = 0; t < nsteps; ++t) {
    if (t + 2 < nsteps) rpl_load<MODE>(c2, src + (size_t)(t + 2) * 384, n, lane);
    float A0 = lo2f(c0.a.x), A1 = hi2f(c0.a.x), A2 = lo2f(c0.a.y), A3 = hi2f(c0.a.y);
    float W0 = __builtin_amdgcn_exp2f(lo2f(c0.e.x)), W1 = __builtin_amdgcn_exp2f(hi2f(c0.e.x)), W2 = __builtin_amdgcn_exp2f(lo2f(c0.e.y)), W3 = __builtin_amdgcn_exp2f(hi2f(c0.e.y));
    float B0 = lo2f(c0.b.x), B1 = hi2f(c0.b.x), B2 = lo2f(c0.b.y), B3 = hi2f(c0.b.y);
    float K0 = 0.f, K1 = 0.f, K2 = 0.f, K3 = 0.f, R0 = 0.f, R1 = 0.f, R2 = 0.f, R3 = 0.f, vv = 0.f;
    if (MODE >= 1) { K0 = lo2f(c0.k.x); K1 = hi2f(c0.k.x); K2 = lo2f(c0.k.y); K3 = hi2f(c0.k.y); vv = lo2f(c0.v); }
    if (MODE == 2) { R0 = lo2f(c0.r.x); R1 = hi2f(c0.r.x); R2 = lo2f(c0.r.y); R3 = hi2f(c0.r.y); }
    A0 *= C0; A1 *= C1; A2 *= C2; A3 *= C3;
    C0 *= W0; C1 *= W1; C2 *= W2; C3 *= W3;
    {
      const float i0 = __builtin_amdgcn_rcpf(C0), i1 = __builtin_amdgcn_rcpf(C1), i2 = __builtin_amdgcn_rcpf(C2), i3 = __builtin_amdgcn_rcpf(C3);
      B0 *= i0; B1 *= i1; B2 *= i2; B3 *= i3;
      if (MODE >= 1) { K0 *= i0; K1 *= i1; K2 *= i2; K3 *= i3; }
      if (MODE == 2) { R0 *= C0; R1 *= C1; R2 *= C2; R3 *= C3; }
    }
    W0 = C0; W1 = C1; W2 = C2; W3 = C3;
    asm volatile("s_nop 1" : "+v"(A0), "+v"(A1), "+v"(A2), "+v"(A3), "+v"(W0), "+v"(W1), "+v"(W2), "+v"(W3), "+v"(B0), "+v"(B1), "+v"(B2), "+v"(B3));
    asm volatile("s_nop 1" : "+v"(K0), "+v"(K1), "+v"(K2), "+v"(K3), "+v"(R0), "+v"(R1), "+v"(R2), "+v"(R3));
    float sa0 = 0.f, sa1 = 0.f, sa2 = 0.f, sa3 = 0.f;
    fmac_bc<0>(sa0, A0, S[0]);
    fmac_bc<0>(sa1, A1, S[1]);
    fmac_bc<0>(sa2, A2, S[2]);
    fmac_bc<0>(sa3, A3, S[3]);
    fmac_bc<1>(sa0, A0, S[4]);
    fmac_bc<1>(sa1, A1, S[5]);
    fmac_bc<1>(sa2, A2, S[6]);
    fmac_bc<1>(sa3, A3, S[7]);
    fmac_bc<2>(sa0, A0, S[8]);
    fmac_bc<2>(sa1, A1, S[9]);
    fmac_bc<2>(sa2, A2, S[10]);
    fmac_bc<2>(sa3, A3, S[11]);
    fmac_bc<3>(sa0, A0, S[12]);
    fmac_bc<3>(sa1, A1, S[13]);
    fmac_bc<3>(sa2, A2, S[14]);
    fmac_bc<3>(sa3, A3, S[15]);
    fmac_bc<4>(sa0, A0, S[16]);
    fmac_bc<4>(sa1, A1, S[17]);
    fmac_bc<4>(sa2, A2, S[18]);
    fmac_bc<4>(sa3, A3, S[19]);
    fmac_bc<5>(sa0, A0, S[20]);
    fmac_bc<5>(sa1, A1, S[21]);
    fmac_bc<5>(sa2, A2, S[22]);
    fmac_bc<5>(sa3, A3, S[23]);
    fmac_bc<6>(sa0, A0, S[24]);
    fmac_bc<6>(sa1, A1, S[25]);
    fmac_bc<6>(sa2, A2, S[26]);
    fmac_bc<6>(sa3, A3, S[27]);
    fmac_bc<7>(sa0, A0, S[28]);
    fmac_bc<7>(sa1, A1, S[29]);
    fmac_bc<7>(sa2, A2, S[30]);
    fmac_bc<7>(sa3, A3, S[31]);
    fmac_bc<8>(sa0, A0, S[32]);
    fmac_bc<8>(sa1, A1, S[33]);
    fmac_bc<8>(sa2, A2, S[34]);
    fmac_bc<8>(sa3, A3, S[35]);
    fmac_bc<9>(sa0, A0, S[36]);
    fmac_bc<9>(sa1, A1, S[37]);
    fmac_bc<9>(sa2, A2, S[38]);
    fmac_bc<9>(sa3, A3, S[39]);
    fmac_bc<10>(sa0, A0, S[40]);
    fmac_bc<10>(sa1, A1, S[41]);
    fmac_bc<10>(sa2, A2, S[42]);
    fmac_bc<10>(sa3, A3, S[43]);
    fmac_bc<11>(sa0, A0, S[44]);
    fmac_bc<11>(sa1, A1, S[45]);
    fmac_bc<11>(sa2, A2, S[46]);
    fmac_bc<11>(sa3, A3, S[47]);
    fmac_bc<12>(sa0, A0, S[48]);
    fmac_bc<12>(sa1, A1, S[49]);
    fmac_bc<12>(sa2, A2, S[50]);
    fmac_bc<12>(sa3, A3, S[51]);
    fmac_bc<13>(sa0, A0, S[52]);
    fmac_bc<13>(sa1, A1, S[53]);
    fmac_bc<13>(sa2, A2, S[54]);
    fmac_bc<13>(sa3, A3, S[55]);
    fmac_bc<14>(sa0, A0, S[56]);
    fmac_bc<14>(sa1, A1, S[57]);
    fmac_bc<14>(sa2, A2, S[58]);
    fmac_bc<14>(sa3, A3, S[59]);
    fmac_bc<15>(sa0, A0, S[60]);
    fmac_bc<15>(sa1, A1, S[61]);
    fmac_bc<15>(sa2, A2, S[62]);
    fmac_bc<15>(sa3, A3, S[63]);
    const float sa = (sa0 + sa1) + (sa2 + sa3);
    float y0 = 0.f, y1 = 0.f, y2 = 0.f, y3 = 0.f;
    if (MODE >= 1) {
      fmac_bc<0>(S[0], K0, vv);
      fmac_bc<0>(S[1], K1, vv);
      fmac_bc<0>(S[2], K2, vv);
      fmac_bc<0>(S[3], K3, vv);
      fmac_bc<1>(S[4], K0, vv);
      fmac_bc<1>(S[5], K1, vv);
      fmac_bc<1>(S[6], K2, vv);
      fmac_bc<1>(S[7], K3, vv);
    }
    fmac_bc<0>(S[0], B0, sa);
    fmac_bc<0>(S[1], B1, sa);
    fmac_bc<0>(S[2], B2, sa);
    fmac_bc<0>(S[3], B3, sa);
    fmac_bc<1>(S[4], B0, sa);
    fmac_bc<1>(S[5], B1, sa);
    fmac_bc<1>(S[6], B2, sa);
    fmac_bc<1>(S[7], B3, sa);
    if (MODE == 2) {
      fmac_bc<0>(y0, R0, S[0]);
      fmac_bc<0>(y1, R1, S[1]);
      fmac_bc<0>(y2, R2, S[2]);
      fmac_bc<0>(y3, R3, S[3]);
      fmac_bc<1>(y0, R0, S[4]);
      fmac_bc<1>(y1, R1, S[5]);
      fmac_bc<1>(y2, R2, S[6]);
      fmac_bc<1>(y3, R3, S[7]);
    }
    if (MODE >= 1) {
      fmac_bc<2>(S[8], K0, vv);
      fmac_bc<2>(S[9], K1, vv);
      fmac_bc<2>(S[10], K2, vv);
      fmac_bc<2>(S[11], K3, vv);
      fmac_bc<3>(S[12], K0, vv);
      fmac_bc<3>(S[13], K1, vv);
      fmac_bc<3>(S[14], K2, vv);
      fmac_bc<3>(S[15], K3, vv);
    }
    fmac_bc<2>(S[8], B0, sa);
    fmac_bc<2>(S[9], B1, sa);
    fmac_bc<2>(S[10], B2, sa);
    fmac_bc<2>(S[11], B3, sa);
    fmac_bc<3>(S[12], B0, sa);
    fmac_bc<3>(S[13], B1, sa);
    fmac_bc<3>(S[14], B2, sa);
    fmac_bc<3>(S[15], B3, sa);
    if (MODE == 2) {
      fmac_bc<2>(y0, R0, S[8]);
      fmac_bc<2>(y1, R1, S[9]);
      fmac_bc<2>(y2, R2, S[10]);
      fmac_bc<2>(y3, R3, S[11]);
      fmac_bc<3>(y0, R0, S[12]);
      fmac_bc<3>(y1, R1, S[13]);
      fmac_bc<3>(y2, R2, S[14]);
      fmac_bc<3>(y3, R3, S[15]);
    }
    if (MODE >= 1) {
      fmac_bc<4>(S[16], K0, vv);
      fmac_bc<4>(S[17], K1, vv);
      fmac_bc<4>(S[18], K2, vv);
      fmac_bc<4>(S[19], K3, vv);
      fmac_bc<5>(S[20], K0, vv);
      fmac_bc<5>(S[21], K1, vv);
      fmac_bc<5>(S[22], K2, vv);
      fmac_bc<5>(S[23], K3, vv);
    }
    fmac_bc<4>(S[16], B0, sa);
    fmac_bc<4>(S[17], B1, sa);
    fmac_bc<4>(S[18], B2, sa);
    fmac_bc<4>(S[19], B3, sa);
    fmac_bc<5>(S[20], B0, sa);
    fmac_bc<5>(S[21], B1, sa);
    fmac_bc<5>(S[22], B2, sa);
    fmac_bc<5>(S[23], B3, sa);
    if (MODE == 2) {
      fmac_bc<4>(y0, R0, S[16]);
      fmac_bc<4>(y1, R1, S[17]);
      fmac_bc<4>(y2, R2, S[18]);
      fmac_bc<4>(y3, R3, S[19]);
      fmac_bc<5>(y0, R0, S[20]);
      fmac_bc<5>(y1, R1, S[21]);
      fmac_bc<5>(y2, R2, S[22]);
      fmac_bc<5>(y3, R3, S[23]);
    }
    if (MODE >= 1) {
      fmac_bc<6>(S[24], K0, vv);
      fmac_bc<6>(S[25], K1, vv);
      fmac_bc<6>(S[26], K2, vv);
      fmac_bc<6>(S[27], K3, vv);
      fmac_bc<7>(S[28], K0, vv);
      fmac_bc<7>(S[29], K1, vv);
      fmac_bc<7>(S[30], K2, vv);
      fmac_bc<7>(S[31], K3, vv);
    }
    fmac_bc<6>(S[24], B0, sa);
    fmac_bc<6>(S[25], B1, sa);
    fmac_bc<6>(S[26], B2, sa);
    fmac_bc<6>(S[27], B3, sa);
    fmac_bc<7>(S[28], B0, sa);
    fmac_bc<7>(S[29], B1, sa);
    fmac_bc<7>(S[30], B2, sa);
    fmac_bc<7>(S[31], B3, sa);
    if (MODE == 2) {
      fmac_bc<6>(y0, R0, S[24]);
      fmac_bc<6>(y1, R1, S[25]);
      fmac_bc<6>(y2, R2, S[26]);
      fmac_bc<6>(y3, R3, S[27]);
      fmac_bc<7>(y0, R0, S[28]);
      fmac_bc<7>(y1, R1, S[29]);
      fmac_bc<7>(y2, R2, S[30]);
      fmac_bc<7>(y3, R3, S[31]);
    }
    if (MODE >= 1) {
      fmac_bc<8>(S[32], K0, vv);
      fmac_bc<8>(S[33], K1, vv);
      fmac_bc<8>(S[34], K2, vv);
      fmac_bc<8>(S[35], K3, vv);
      fmac_bc<9>(S[36], K0, vv);
      fmac_bc<9>(S[37], K1, vv);
      fmac_bc<9>(S[38], K2, vv);
      fmac_bc<9>(S[39], K3, vv);
    }
    fmac_bc<8>(S[32], B0, sa);
    fmac_bc<8>(S[33], B1, sa);
    fmac_bc<8>(S[34], B2, sa);
    fmac_bc<8>(S[35], B3, sa);
    fmac_bc<9>(S[36], B0, sa);
    fmac_bc<9>(S[37], B1, sa);
    fmac_bc<9>(S[38], B2, sa);
    fmac_bc<9>(S[39], B3, sa);
    if (MODE == 2) {
      fmac_bc<8>(y0, R0, S[32]);
      fmac_bc<8>(y1, R1, S[33]);
      fmac_bc<8>(y2, R2, S[34]);
      fmac_bc<8>(y3, R3, S[35]);
      fmac_bc<9>(y0, R0, S[36]);
      fmac_bc<9>(y1, R1, S[37]);
      fmac_bc<9>(y2, R2, S[38]);
      fmac_bc<9>(y3, R3, S[39]);
    }
    if (MODE >= 1) {
      fmac_bc<10>(S[40], K0, vv);
      fmac_bc<10>(S[41], K1, vv);
      fmac_bc<10>(S[42], K2, vv);
      fmac_bc<10>(S[43], K3, vv);
      fmac_bc<11>(S[44], K0, vv);
      fmac_bc<11>(S[45], K1, vv);
      fmac_bc<11>(S[46], K2, vv);
      fmac_bc<11>(S[47], K3, vv);
    }
    fmac_bc<10>(S[40], B0, sa);
    fmac_bc<10>(S[41], B1, sa);
    fmac_bc<10>(S[42], B2, sa);
    fmac_bc<10>(S[43], B3, sa);
    fmac_bc<11>(S[44], B0, sa);
    fmac_bc<11>(S[45], B1, sa);
    fmac_bc<11>(S[46], B2, sa);
    fmac_bc<11>(S[47], B3, sa);
    if (MODE == 2) {
      fmac_bc<10>(y0, R0, S[40]);
      fmac_bc<10>(y1, R1, S[41]);
      fmac_bc<10>(y2, R2, S[42]);
      fmac_bc<10>(y3, R3, S[43]);
      fmac_bc<11>(y0, R0, S[44]);
      fmac_bc<11>(y1, R1, S[45]);
      fmac_bc<11>(y2, R2, S[46]);
      fmac_bc<11>(y3, R3, S[47]);
    }
    if (MODE >= 1) {
      fmac_bc<12>(S[48], K0, vv);
      fmac_bc<12>(S[49], K1, vv);
      fmac_bc<12>(S[50], K2, vv);
      fmac_bc<12>(S[51], K3, vv);
      fmac_bc<13>(S[52], K0, vv);
      fmac_bc<13>(S[53], K1, vv);
      fmac_bc<13>(S[54], K2, vv);
      fmac_bc<13>(S[55], K3, vv);
    }
    fmac_bc<12>(S[48], B0, sa);
    fmac_bc<12>(S[49], B1, sa);
    fmac_bc<12>(S[50], B2, sa);
    fmac_bc<12>(S[51], B3, sa);
    fmac_bc<13>(S[52], B0, sa);
    fmac_bc<13>(S[53], B1, sa);
    fmac_bc<13>(S[54], B2, sa);
    fmac_bc<13>(S[55], B3, sa);
    if (MODE == 2) {
      fmac_bc<12>(y0, R0, S[48]);
      fmac_bc<12>(y1, R1, S[49]);
      fmac_bc<12>(y2, R2, S[50]);
      fmac_bc<12>(y3, R3, S[51]);
      fmac_bc<13>(y0, R0, S[52]);
      fmac_bc<13>(y1, R1, S[53]);
      fmac_bc<13>(y2, R2, S[54]);
      fmac_bc<13>(y3, R3, S[55]);
    }
    if (MODE >= 1) {
      fmac_bc<14>(S[56], K0, vv);
      fmac_bc<14>(S[57], K1, vv);
      fmac_bc<14>(S[58], K2, vv);
      fmac_bc<14>(S[59], K3, vv);
      fmac_bc<15>(S[60], K0, vv);
      fmac_bc<15>(S[61], K1, vv);
      fmac_bc<15>(S[62], K2, vv);
      fmac_bc<15>(S[63], K3, vv);
    }
    fmac_bc<14>(S[56], B0, sa);
    fmac_bc<14>(S[57], B1, sa);
    fmac_bc<14>(S[58], B2, sa);
    fmac_bc<14>(S[59], B3, sa);
    fmac_bc<15>(S[60], B0, sa);
    fmac_bc<15>(S[61], B1, sa);
    fmac_bc<15>(S[62], B2, sa);
    fmac_bc<15>(S[63], B3, sa);
    if (MODE == 2) {
      fmac_bc<14>(y0, R0, S[56]);
      fmac_bc<14>(y1, R1, S[57]);
      fmac_bc<14>(y2, R2, S[58]);
      fmac_bc<14>(y3, R3, S[59]);
      fmac_bc<15>(y0, R0, S[60]);
      fmac_bc<15>(y1, R1, S[61]);
      fmac_bc<15>(y2, R2, S[62]);
      fmac_bc<15>(y3, R3, S[63]);
    }
    if ((t & 31) == 31) {
      S[0] = mul_bc<0>(W0, S[0]);
      S[1] = mul_bc<0>(W1, S[1]);
      S[2] = mul_bc<0>(W2, S[2]);
      S[3] = mul_bc<0>(W3, S[3]);
      S[4] = mul_bc<1>(W0, S[4]);
      S[5] = mul_bc<1>(W1, S[5]);
      S[6] = mul_bc<1>(W2, S[6]);
      S[7] = mul_bc<1>(W3, S[7]);
      S[8] = mul_bc<2>(W0, S[8]);
      S[9] = mul_bc<2>(W1, S[9]);
      S[10] = mul_bc<2>(W2, S[10]);
      S[11] = mul_bc<2>(W3, S[11]);
      S[12] = mul_bc<3>(W0, S[12]);
      S[13] = mul_bc<3>(W1, S[13]);
      S[14] = mul_bc<3>(W2, S[14]);
      S[15] = mul_bc<3>(W3, S[15]);
      S[16] = mul_bc<4>(W0, S[16]);
      S[17] = mul_bc<4>(W1, S[17]);
      S[18] = mul_bc<4>(W2, S[18]);
      S[19] = mul_bc<4>(W3, S[19]);
      S[20] = mul_bc<5>(W0, S[20]);
      S[21] = mul_bc<5>(W1, S[21]);
      S[22] = mul_bc<5>(W2, S[22]);
      S[23] = mul_bc<5>(W3, S[23]);
      S[24] = mul_bc<6>(W0, S[24]);
      S[25] = mul_bc<6>(W1, S[25]);
      S[26] = mul_bc<6>(W2, S[26]);
      S[27] = mul_bc<6>(W3, S[27]);
      S[28] = mul_bc<7>(W0, S[28]);
      S[29] = mul_bc<7>(W1, S[29]);
      S[30] = mul_bc<7>(W2, S[30]);
      S[31] = mul_bc<7>(W3, S[31]);
      S[32] = mul_bc<8>(W0, S[32]);
      S[33] = mul_bc<8>(W1, S[33]);
      S[34] = mul_bc<8>(W2, S[34]);
      S[35] = mul_bc<8>(W3, S[35]);
      S[36] = mul_bc<9>(W0, S[36]);
      S[37] = mul_bc<9>(W1, S[37]);
      S[38] = mul_bc<9>(W2, S[38]);
      S[39] = mul_bc<9>(W3, S[39]);
      S[40] = mul_bc<10>(W0, S[40]);
      S[41] = mul_bc<10>(W1, S[41]);
      S[42] = mul_bc<10>(W2, S[42]);
      S[43] = mul_bc<10>(W3, S[43]);
      S[44] = mul_bc<11>(W0, S[44]);
      S[45] = mul_bc<11>(W1, S[45]);
      S[46] = mul_bc<11>(W2, S[46]);
      S[47] = mul_bc<11>(W3, S[47]);
      S[48] = mul_bc<12>(W0, S[48]);
      S[49] = mul_bc<12>(W1, S[49]);
      S[50] = mul_bc<12>(W2, S[50]);
      S[51] = mul_bc<12>(W3, S[51]);
      S[52] = mul_bc<13>(W0, S[52]);
      S[53] = mul_bc<13>(W1, S[53]);
      S[54] = mul_bc<13>(W2, S[54]);
      S[55] = mul_bc<13>(W3, S[55]);
      S[56] = mul_bc<14>(W0, S[56]);
      S[57] = mul_bc<14>(W1, S[57]);
      S[58] = mul_bc<14>(W2, S[58]);
      S[59] = mul_bc<14>(W3, S[59]);
      S[60] = mul_bc<15>(W0, S[60]);
      S[61] = mul_bc<15>(W1, S[61]);
      S[62] = mul_bc<15>(W2, S[62]);
      S[63] = mul_bc<15>(W3, S[63]);
      C0 = 1.f; C1 = 1.f; C2 = 1.f; C3 = 1.f;
    }
    if (MODE == 2) Yg[(size_t)t * 512 + lane] = (y0 + y1) + (y2 + y3);
    c0 = c1; c1 = c2;
  }
  if (Sout) {
#pragma unroll
    for (int k = 0; k < 64; k += 4) *(f32x4*)(Sout + (size_t)lane * 64 + k) = f32x4{S[k], S[k + 1], S[k + 2], S[k + 3]};
  }
}

constexpr int RC = 128;
constexpr int NCH = NP / RC;
DI void seqs_item(const Params& p, int layer, int hd, char* smem) {
  float* sS = (float*)smem;
  const int tid = tidx(), lane = tid & 63, w = tid >> 6, l31 = lane & 31, h = lane >> 5, wr = w >> 1, wc = w & 1;
  const float* PQ = (const float*)(p.ws + WS_Y) + (size_t)hd * NCH * 8192;
  float* SS = (float*)(p.ws + WS_H) + (size_t)hd * NCH * 4096;
  const unsigned* pqflag = (const unsigned*)(p.ws + WS_CTR) + 1024 + (layer * 8 + hd) * 64;
  __syncthreads();
  for (int i = tid; i < 64 * 65; i += 256) sS[i] = 0.f;
  for (int i = tid; i < 4096; i += 256) SS[i] = 0.f;
  if (tid == 0) {
    for (int j = 0; j < 5; ++j)
      while (__hip_atomic_load((unsigned*)pqflag + j, __ATOMIC_RELAXED, __HIP_MEMORY_SCOPE_AGENT) == 0u) __builtin_amdgcn_s_sleep(4);
    __builtin_amdgcn_fence(__ATOMIC_ACQUIRE, "agent");
    asm volatile("s_waitcnt vmcnt(0)" ::: "memory");
  }
  __syncthreads();
  float bP[32], bQ[16], nP[32], nQ[16];
#pragma unroll
  for (int ks = 0; ks < 32; ++ks) bP[ks] = PQ[(2 * ks + h) * 64 + 32 * wc + l31];
#pragma unroll
  for (int r = 0; r < 16; ++r) bQ[r] = PQ[4096 + (32 * wr + crow(r, h)) * 64 + 32 * wc + l31];
  for (int c = 0; c < NCH; ++c) {
    if ((c & 7) == 0 && c > 0) {
      if (tid == 0) {
        const int j0 = c >> 1, j1 = (c + 8 < NCH) ? j0 + 5 : j0 + 4;
        for (int j = j0; j < j1; ++j)
          while (__hip_atomic_load((unsigned*)pqflag + j, __ATOMIC_RELAXED, __HIP_MEMORY_SCOPE_AGENT) == 0u) __builtin_amdgcn_s_sleep(4);
        __builtin_amdgcn_fence(__ATOMIC_ACQUIRE, "agent");
        asm volatile("s_waitcnt vmcnt(0)" ::: "memory");
      }
      __syncthreads();
    }
    if (c + 1 < NCH) {
      const float* Pn = PQ + (size_t)(c + 1) * 8192;
#pragma unroll
      for (int ks = 0; ks < 32; ++ks) nP[ks] = Pn[(2 * ks + h) * 64 + 32 * wc + l31];
#pragma unroll
      for (int r = 0; r < 16; ++r) nQ[r] = Pn[4096 + (32 * wr + crow(r, h)) * 64 + 32 * wc + l31];
    }
    f32x16 acc;
#pragma unroll
    for (int r = 0; r < 16; ++r) acc[r] = bQ[r];
    float a[32];
#pragma unroll
    for (int ks = 0; ks < 32; ++ks) a[ks] = sS[(32 * wr + l31) * 65 + 2 * ks + h];
#pragma unroll
    for (int ks = 0; ks < 32; ++ks) acc = __builtin_amdgcn_mfma_f32_32x32x2f32(a[ks], bP[ks], acc, 0, 0, 0);
    __syncthreads();
    float* dst = (c + 1 < NCH) ? SS + (size_t)(c + 1) * 4096 : p.out + OFF_WKV_P + ((size_t)layer * 8 + hd) * 4096;
#pragma unroll
    for (int r = 0; r < 16; ++r) {
      const int row = 32 * wr + crow(r, h), col = 32 * wc + l31;
      sS[row * 65 + col] = acc[r];
      dst[row * 64 + col] = acc[r];
    }
    __syncthreads();
#pragma unroll
    for (int ks = 0; ks < 32; ++ks) bP[ks] = nP[ks];
#pragma unroll
    for (int r = 0; r < 16; ++r) bQ[r] = nQ[r];
  }
}

DI void phase_mix(const Params& p, int layer, char* smem, int* s_item) {
  constexpr int NQ_PQ = NCH * 2 / 4, NQ_SY = 4, NQ_SATT = 16, NQ_PATT = 128;
  int* qctr = (int*)(p.ws + WS_CTR) + 64 + layer * 8;
  int* actr = (int*)(p.ws + WS_CTR) + 192 + layer * 8;
  if (blockIdx.x < 8) { seqs_item(p, layer, blockIdx.x, smem); return; }
  const int home = blockIdx.x & 7;
  const int first = (blockIdx.x >> 3) & 1;
  for (int pass = 0; pass < 2; ++pass) {
    const int kind = pass ^ first;
    for (int qi = 0; qi < 8; ++qi) {
      const int hd = (home + qi) & 7;
      for (;;) {
        __syncthreads();
        if (tidx() == 0) *s_item = atomicAdd((kind == 0 ? qctr : actr) + hd, 1);
        __syncthreads();
        const int it = *s_item;
        const int wave = __builtin_amdgcn_readfirstlane(tidx() >> 6), lane = tidx() & 63;
        if (kind == 0) {
          if (it >= NQ_PQ + NQ_SY) break;
          if (it < NQ_PQ) {
            const int q = it * 4 + wave, mode = q & 1, ch = q >> 1;
            float* dstm = (float*)(p.ws + WS_Y) + ((size_t)(hd * NCH + ch) * 2 + mode) * 4096;
            if (mode == 0) rpl_item<0>(p, hd, ch * RC, RC, nullptr, dstm, nullptr, lane);
            else rpl_item<1>(p, hd, ch * RC, RC, nullptr, dstm, nullptr, lane);
            asm volatile("s_waitcnt vmcnt(0)" ::: "memory");
            __syncthreads();
            if (tidx() == 0) {
              __builtin_amdgcn_fence(__ATOMIC_RELEASE, "agent");
              asm volatile("s_waitcnt vmcnt(0)" ::: "memory");
              __hip_atomic_store((unsigned*)(p.ws + WS_CTR) + 1024 + (layer * 8 + hd) * 64 + it, 1u, __ATOMIC_RELAXED, __HIP_MEMORY_SCOPE_AGENT);
            }
            continue;
          }
          const int b = (it - NQ_PQ) * 4 + wave;
          rpl_item<2>(p, hd, NP + b * 64, 64, p.state_wkv + (((size_t)layer * 16 + b) * 8 + hd) * 4096,
                      p.out + OFF_WKV_S + (((size_t)layer * 16 + b) * 8 + hd) * 4096, (float*)(p.ws + WS_Y) + (size_t)(NP + b * 64) * 512 + hd * 64, lane);
        } else {
          if (it >= NQ_SATT + NQ_PATT) break;
          if (it < NQ_SATT) { attn_sample_item(p, layer, it, hd, smem); continue; }
          attn_prompt_item(p, layer, 127 - (it - NQ_SATT), hd, smem);
        }
      }
    }
  }
}
DI void phase_ypass(const Params& p, int layer) {
  const int wave = __builtin_amdgcn_readfirstlane(tidx() >> 6), lane = tidx() & 63;
  const int hd = blockIdx.x & 7, nb = (gridDim.x + 7 - hd) >> 3;
  for (int j = blockIdx.x >> 3; j < NCH / 4; j += nb) {
    const int ch = j * 4 + wave;
    rpl_item<2>(p, hd, ch * RC, RC, (const float*)(p.ws + WS_H) + (size_t)(hd * NCH + ch) * 4096, nullptr,
                (float*)(p.ws + WS_Y) + (size_t)(ch * RC) * 512 + hd * 64, lane);
  }
}

DI void phase_ob(const Params& p, int layer) {
  const int wave = tidx() >> 6, lane = tidx() & 63;
  const float* Y = (const float*)(p.ws + WS_Y);
  const u16* WK = (const u16*)(p.ws + WS_WKVIN);
  const u16* Z = (const u16*)(p.ws + WS_Z);
  u16* OB = (u16*)(p.ws + WS_Q);
  const int f = lane * 8, hd = lane >> 3, fl = (lane & 7) * 8;
  for (int t = blockIdx.x * 4 + wave; t < NT; t += gridDim.x * 4) {
    const float4 ya = *(const float4*)(Y + (size_t)t * 512 + f);
    const float4 yb = *(const float4*)(Y + (size_t)t * 512 + f + 4);
    float y[8] = {ya.x, ya.y, ya.z, ya.w, yb.x, yb.y, yb.z, yb.w};
    float s = 0.f;
#pragma unroll
    for (int j = 0; j < 8; ++j) s += y[j];
    s += __shfl_xor(s, 1); s += __shfl_xor(s, 2); s += __shfl_xor(s, 4);
    const float mu = s * (1.f / 64.f);
    float vs = 0.f;
#pragma unroll
    for (int j = 0; j < 8; ++j) { y[j] -= mu; vs += y[j] * y[j]; }
    vs += __shfl_xor(vs, 1); vs += __shfl_xor(vs, 2); vs += __shfl_xor(vs, 4);
    const float rs = rsqrtf(vs * (1.f / 64.f) + GN_EPS);
    const u16* wk = WK + ((size_t)hd * NT + t) * 384 + fl;
    const uint4 r8 = *(const uint4*)(wk + 0 * 64);
    const uint4 k8 = *(const uint4*)(wk + 2 * 64);
    const uint4 v8 = *(const uint4*)(wk + 3 * 64);
    const float rr[8] = {lo2f(r8.x), hi2f(r8.x), lo2f(r8.y), hi2f(r8.y), lo2f(r8.z), hi2f(r8.z), lo2f(r8.w), hi2f(r8.w)};
    const float kk[8] = {lo2f(k8.x), hi2f(k8.x), lo2f(k8.y), hi2f(k8.y), lo2f(k8.z), hi2f(k8.z), lo2f(k8.w), hi2f(k8.w)};
    const float vv[8] = {lo2f(v8.x), hi2f(v8.x), lo2f(v8.y), hi2f(v8.y), lo2f(v8.z), hi2f(v8.z), lo2f(v8.w), hi2f(v8.w)};
    const float4 rka = *(const float4*)(p.r_k + layer * 512 + f);
    const float4 rkb = *(const float4*)(p.r_k + layer * 512 + f + 4);
    const float rk[8] = {rka.x, rka.y, rka.z, rka.w, rkb.x, rkb.y, rkb.z, rkb.w};
    float bs = 0.f;
#pragma unroll
    for (int j = 0; j < 8; ++j) bs += rr[j] * kk[j] * rk[j];
    bs += __shfl_xor(bs, 1); bs += __shfl_xor(bs, 2); bs += __shfl_xor(bs, 4);
    const float4 lwa = *(const float4*)(p.lnx_w + layer * 512 + f);
    const float4 lwb = *(const float4*)(p.lnx_w + layer * 512 + f + 4);
    const float4 lba = *(const float4*)(p.lnx_b + layer * 512 + f);
    const float4 lbb = *(const float4*)(p.lnx_b + layer * 512 + f + 4);
    const float lw[8] = {lwa.x, lwa.y, lwa.z, lwa.w, lwb.x, lwb.y, lwb.z, lwb.w};
    const float lb[8] = {lba.x, lba.y, lba.z, lba.w, lbb.x, lbb.y, lbb.z, lbb.w};
    const uint4 g8 = *(const uint4*)(Z + (size_t)t * NZ + ZC_GB + f);
    const float gg[8] = {lo2f(g8.x), hi2f(g8.x), lo2f(g8.y), hi2f(g8.y), lo2f(g8.z), hi2f(g8.z), lo2f(g8.w), hi2f(g8.w)};
    float ov[8];
#pragma unroll
    for (int j = 0; j < 8; ++j) ov[j] = (y[j] * rs * lw[j] + lb[j] + bs * vv[j]) * siluf_(gg[j]);
    *(uint4*)(OB + (size_t)t * 512 + f) = make_uint4(pk2(ov[0], ov[1]), pk2(ov[2], ov[3]), pk2(ov[4], ov[5]), pk2(ov[6], ov[7]));
  }
}

DI void phase_merge(const Params& p, int layer, char* smem) {
  const u16* OA = (const u16*)(p.ws + WS_OA);
  const u16* OB = (const u16*)(p.ws + WS_Q);
  const u16* WA = (const u16*)(p.ws + (size_t)layer * WL_STRIDE + W_OA);
  const u16* WB = (const u16*)(p.ws + (size_t)layer * WL_STRIDE + W_OB);
  const u16* Z = (const u16*)(p.ws + WS_Z);
  u16* M = (u16*)(p.ws + WS_H);
  const int xcd = blockIdx.x & 7, jb = blockIdx.x >> 3, nb = (gridDim.x + 7 - xcd) >> 3;
  for (int m = jb; m < 16 * 8; m += nb) {
    const int tt = xcd + 8 * (m >> 3), ft = m & 7;
    f32x16 acc[2][2];
    zero_acc(acc);
    gemm_mainloop(OA + (size_t)tt * 128 * 512, 512, WA + (size_t)ft * 128 * 512, 512, 512, smem, acc);
    acc_to_lds(acc, smem);
    EPI_ROWS({
      const u32x2 g = *(const u32x2*)(Z + (size_t)(tt * 128 + row) * NZ + ZC_MA + ft * 128 + col);
      *(u32x2*)(M + (size_t)(tt * 128 + row) * 1024 + ft * 128 + col) =
          u32x2{pk2(v.x * sigmoidf_(lo2f(g.x)), v.y * sigmoidf_(hi2f(g.x))), pk2(v.z * sigmoidf_(lo2f(g.y)), v.w * sigmoidf_(hi2f(g.y)))};
    })
    zero_acc(acc);
    gemm_mainloop(OB + (size_t)tt * 128 * 512, 512, WB + (size_t)ft * 128 * 512, 512, 512, smem, acc);
    acc_to_lds(acc, smem);
    EPI_ROWS({
      const u32x2 g = *(const u32x2*)(Z + (size_t)(tt * 128 + row) * NZ + ZC_MB + ft * 128 + col);
      u32x2* mp = (u32x2*)(M + (size_t)(tt * 128 + row) * 1024 + ft * 128 + col);
      const u32x2 pm = *mp;
      *mp = u32x2{pk2(lo2f(pm.x) + v.x * sigmoidf_(lo2f(g.x)), hi2f(pm.x) + v.y * sigmoidf_(hi2f(g.x))),
                  pk2(lo2f(pm.y) + v.z * sigmoidf_(lo2f(g.y)), hi2f(pm.y) + v.w * sigmoidf_(hi2f(g.y)))};
    })
  }
  for (int m = jb; m < 2 * 16; m += nb) {
    const int r0 = (128 + xcd) * 128 + (m >> 4) * 64, c0 = (m & 15) * 64;
    f32x16 acc;
#pragma unroll
    for (int r = 0; r < 16; ++r) acc[r] = 0.f;
    gemm64_mainloop(OA + (size_t)r0 * 512, 512, WA + (size_t)c0 * 512, 512, 512, smem, acc);
    acc64_to_lds(acc, smem);
    EPI64_ROWS({
      const u32x2 g = *(const u32x2*)(Z + (size_t)(r0 + row) * NZ + ZC_MA + c0 + col);
      *(u32x2*)(M + (size_t)(r0 + row) * 1024 + c0 + col) =
          u32x2{pk2(v.x * sigmoidf_(lo2f(g.x)), v.y * sigmoidf_(hi2f(g.x))), pk2(v.z * sigmoidf_(lo2f(g.y)), v.w * sigmoidf_(hi2f(g.y)))};
    })
#pragma unroll
    for (int r = 0; r < 16; ++r) acc[r] = 0.f;
    gemm64_mainloop(OB + (size_t)r0 * 512, 512, WB + (size_t)c0 * 512, 512, 512, smem, acc);
    acc64_to_lds(acc, smem);
    EPI64_ROWS({
      const u32x2 g = *(const u32x2*)(Z + (size_t)(r0 + row) * NZ + ZC_MB + c0 + col);
      u32x2* mp = (u32x2*)(M + (size_t)(r0 + row) * 1024 + c0 + col);
      const u32x2 pm = *mp;
      *mp = u32x2{pk2(lo2f(pm.x) + v.x * sigmoidf_(lo2f(g.x)), hi2f(pm.x) + v.y * sigmoidf_(hi2f(g.x))),
                  pk2(lo2f(pm.y) + v.z * sigmoidf_(lo2f(g.y)), hi2f(pm.y) + v.w * sigmoidf_(hi2f(g.y)))};
    })
  }
}

DI void phase_out(const Params& p, int layer, char* smem) {
  const u16* M = (const u16*)(p.ws + WS_H);
  const u16* W = (const u16*)(p.ws + (size_t)layer * WL_STRIDE + W_O);
  const int xcd = blockIdx.x & 7, jb = blockIdx.x >> 3, nb = (gridDim.x + 7 - xcd) >> 3;
  for (int m = jb; m < 16 * 8; m += nb) {
    const int tt = xcd + 8 * (m >> 3), ft = m & 7;
    f32x16 acc[2][2];
    zero_acc(acc);
    gemm_mainloop(M + (size_t)tt * 128 * 1024, 1024, W + (size_t)ft * 128 * 1024, 1024, 1024, smem, acc);
    acc_to_lds(acc, smem);
    EPI_ROWS({
      const int t = tt * 128 + row, n = ft * 128 + col;
      const f32x4 xo = *(const f32x4*)(xrow(p, layer, t) + n);
      *(f32x4*)(p.out + (size_t)t * 1024 + n) = xo + v;
    })
  }
  for (int m = jb; m < 2 * 16; m += nb) {
    const int r0 = (128 + xcd) * 128 + (m >> 4) * 64, c0 = (m & 15) * 64;
    f32x16 acc;
#pragma unroll
    for (int r = 0; r < 16; ++r) acc[r] = 0.f;
    gemm64_mainloop(M + (size_t)r0 * 1024, 1024, W + (size_t)c0 * 1024, 1024, 1024, smem, acc);
    acc64_to_lds(acc, smem);
    EPI64_ROWS({
      const int t = r0 + row, n = c0 + col;
      const f32x4 xo = *(const f32x4*)(xrow(p, layer, t) + n);
      *(f32x4*)(p.out + (size_t)t * 1024 + n) = xo + v;
    })
  }
}

#define XB_TMO      128
#define XB_XCNT(j)  (256  + 64 * (j))
#define XB_XSUB(j)  (1280 + 64 * (j))
#define XB_XGEN(j)  (2304 + 64 * (j))
#define XB_TOP      3328
#define XB_TOPGEN   3392
#define XCD_BAR_WORDS 3456
#define XB_SPIN_CAP (1u << 22)
#define LAS __attribute__((address_space(3)))
DI unsigned xb_ld(unsigned* p) { return __hip_atomic_load(p, __ATOMIC_RELAXED, __HIP_MEMORY_SCOPE_AGENT); }
DI unsigned xb_add(unsigned* p, unsigned v) { return __hip_atomic_fetch_add(p, v, __ATOMIC_RELAXED, __HIP_MEMORY_SCOPE_AGENT); }
DI unsigned xb_xcc_id() { return (unsigned)__builtin_amdgcn_s_getreg((3 << 11) | 20) & 0xFu; }
#define XB_SPIN(cond, bar) do { unsigned _sp = 0; while (cond) { __builtin_amdgcn_s_sleep(1); \
    if ((++_sp & 255u) == 0u) { if (xb_ld(&(bar)[XB_TMO])) break; if (_sp > XB_SPIN_CAP) { atomicAdd(&(bar)[XB_TMO], 1u); break; } } } } while (0)
struct XcdBarrier { unsigned* bar; unsigned x; volatile LAS unsigned* st; };
DI XcdBarrier xcd_barrier_post(unsigned* bar, volatile LAS unsigned* st) {
  XcdBarrier b; b.bar = bar; b.x = xb_xcc_id(); b.st = st;
  if (threadIdx.x == 0) (void)xb_add(&bar[XB_XCNT(b.x)], 1u);
  return b;
}
DI void xcd_barrier_complete(unsigned* bar, unsigned x, unsigned& nloc, unsigned& nx) {
  const unsigned G = gridDim.x * gridDim.y * gridDim.z;
  unsigned sum, cnt, mine, sp = 0u;
  for (;;) {
    sum = 0u; cnt = 0u; mine = 0u;
#pragma unroll
    for (unsigned j = 0; j < 16; ++j) { const unsigned c = xb_ld(&bar[XB_XCNT(j)]); sum += c; cnt += (c > 0u) ? 1u : 0u; mine = (j == x) ? c : mine; }
    if (sum == G) break;
    __builtin_amdgcn_s_sleep(1);
    if ((++sp & 255u) == 0u) { if (xb_ld(&bar[XB_TMO])) break; if (sp > XB_SPIN_CAP) { atomicAdd(&bar[XB_TMO], 1u); break; } }
  }
  nloc = mine > 0u ? mine : 1u; nx = cnt > 0u ? cnt : 1u;
}
DI void xcd_barrier(const XcdBarrier& b) {
  asm volatile("s_waitcnt vmcnt(0)" ::: "memory");
  __syncthreads();
  if (threadIdx.x == 0) {
    unsigned* bar = b.bar;
    __builtin_amdgcn_s_waitcnt(0);
    unsigned nloc = b.st[0], nx = b.st[1];
    if (nloc == 0u) { xcd_barrier_complete(bar, b.x, nloc, nx); b.st[0] = nloc; b.st[1] = nx; }
    const unsigned old = xb_add(&bar[XB_XSUB(b.x)], 1u);
    const unsigned gen = old / nloc;
    if (old + 1u == (gen + 1u) * nloc) {
      __builtin_amdgcn_fence(__ATOMIC_RELEASE, "agent");
      asm volatile("s_waitcnt vmcnt(0)" ::: "memory");
      const unsigned og = xb_add(&bar[XB_TOP], 1u);
      const unsigned tg = og / nx;
      if (og + 1u == (tg + 1u) * nx) xb_add(&bar[XB_TOPGEN], 1u);
      else XB_SPIN(xb_ld(&bar[XB_TOPGEN]) == tg, bar);
      __builtin_amdgcn_fence(__ATOMIC_ACQUIRE, "agent");
      xb_add(&bar[XB_XGEN(b.x)], 1u);
      asm volatile("s_waitcnt vmcnt(0)" ::: "memory");
    } else {
      XB_SPIN(xb_ld(&bar[XB_XGEN(b.x)]) == gen, bar);
      __builtin_amdgcn_fence(__ATOMIC_ACQUIRE, "agent");
      asm volatile("s_waitcnt vmcnt(0)" ::: "memory");
    }
  }
  __syncthreads();
}

constexpr int PH_PER_LAYER = 8;
constexpr int N_PHASES = 1 + 4 * PH_PER_LAYER;

DI void run_phase(const Params& p, int ph, char* smem, int* s_item) {
#ifndef PHMASK
#define PHMASK 0x3FF
#endif
  if (ph == 0) { if (PHMASK & 0x100) phase_convert(p, smem); return; }
  const int layer = (ph - 1) / PH_PER_LAYER, sub = (ph - 1) % PH_PER_LAYER;
  switch (sub) {
    case 0: if (PHMASK & 1) phase_rmsnorm(p, layer); break;
    case 1: if (PHMASK & 2) phase_g1(p, layer, smem); break;
    case 2: if (PHMASK & 4) phase_norms_prep(p, layer, smem, s_item); break;
    case 3: if (PHMASK & 16) phase_mix(p, layer, smem, s_item); break;
    case 4: if (PHMASK & 16) phase_ypass(p, layer); break;
    case 5: if (PHMASK & 32) phase_ob(p, layer); break;
    case 6: if (PHMASK & 64) phase_merge(p, layer, smem); break;
    default: if (PHMASK & 128) phase_out(p, layer, smem); break;
  }
}

__global__ void __launch_bounds__(256, 2) mk_kernel(Params p, int ph0, int ph1, int coop) {
  __shared__ __attribute__((aligned(16))) char smem[SMEM_BYTES];
  __shared__ int s_item[4];
  __shared__ uint4 xb_words;
  if (threadIdx.x == 0) xb_words = make_uint4(0u, 0u, 0u, 0u);
  __syncthreads();
  XcdBarrier xb = xcd_barrier_post((unsigned*)(p.ws + WS_BAR), (volatile LAS unsigned*)&xb_words);
  for (int ph = ph0; ph < ph1; ++ph) {
    run_phase(p, ph, smem, s_item);
    if (coop && ph + 1 < ph1) {
      xcd_barrier(xb);
      if (coop == 0x5a5a5a) cg::this_grid().sync();
    }
  }
}

extern "C" void kernel_launch(void* const* d_in, const int* in_sizes, int n_in, void* d_out, int out_size, void* d_ws, size_t ws_size,
                              hipStream_t stream) {
  static int grid_blocks = 0;
  if (!grid_blocks) {
    int dev = 0, cus = 0, per_cu = 0;
    hipGetDevice(&dev);
    hipDeviceGetAttribute(&cus, hipDeviceAttributeMultiprocessorCount, dev);
    hipOccupancyMaxActiveBlocksPerMultiprocessor(&per_cu, mk_kernel, 256, 0);
    if (per_cu < 1) per_cu = 1;
    if (per_cu > 2) per_cu = 2;
    grid_blocks = cus * per_cu;
  }
  Params p{};
  const float** pp = (const float**)&p;
  for (int i = 0; i < 29; ++i) pp[i] = (const float*)d_in[i];
  p.out = (float*)d_out;
  p.ws = (char*)d_ws;
  const int ONE_LAUNCH = 1;
  hipMemsetAsync((char*)d_ws + WS_CTR, 0, 16384 + XCD_BAR_WORDS * 4, stream);
  if (ONE_LAUNCH) {
    int ph0 = 0, ph1 = N_PHASES, coop = 1;
    void* args[] = {&p, &ph0, &ph1, &coop};
    hipError_t e = hipLaunchCooperativeKernel((void*)mk_kernel, dim3(grid_blocks), dim3(256), args, 0, stream);
    if (e != hipSuccess) fprintf(stderr, "cooperative launch failed: %s (grid %d)\n", hipGetErrorString(e), grid_blocks);
  } else {
    for (int ph = 0; ph < N_PHASES; ++ph) mk_kernel<<<dim3(grid_blocks), dim3(256), 0, stream>>>(p, ph, ph + 1, 0);
  }
}
```
